# Optimizing an MI355X kernel written in HIP

```python
import jax
import jax.numpy as jnp
from jax import lax
import numpy as np

D_MODEL = 1024
BATCH = 8
SEQ = 2048
DEPTH = 4

HGRN_HEADS = 4
HGRN_DK = 128
HGRN_DV = 128
HGRN_CHUNK = 64
HGRN_KW = HGRN_HEADS * HGRN_DK
HGRN_VW = HGRN_HEADS * HGRN_DV
MLA_HEADS = 8
MLA_Q_RANK = 384
MLA_KV_RANK = 256
MLA_NOPE = 64
MLA_ROPE = 32
MLA_DV = 64
MLA_VW = MLA_HEADS * MLA_DV
ROPE_THETA = 10000.0
Q_BLOCK = 128
N_EXPERTS = 32
TOP_K = 4
D_EXPERT = 1024
SWIGLU_LIMIT = 7.0
SWIGLU_ALPHA = 1.702
MOE_BLOCK = 256
N_BRANCHES = 2
NORM_EPS = 1e-6
IN_SPLITS = (HGRN_KW, HGRN_KW, HGRN_KW, HGRN_VW, HGRN_VW, MLA_Q_RANK, MLA_KV_RANK, MLA_ROPE, N_BRANCHES * D_MODEL)
IN_WIDTH = 3 * HGRN_KW + 2 * HGRN_VW + MLA_Q_RANK + MLA_KV_RANK + MLA_ROPE + N_BRANCHES * D_MODEL

kernel_name = "hybrid_hgrn2_mla_moe_adaln_encoder"


def rms_norm(x, gain):
    xf = x.astype(jnp.float32)
    y = xf * lax.rsqrt(jnp.mean(jnp.square(xf), axis=-1, keepdims=True) + NORM_EPS)
    return (y * gain.astype(jnp.float32)).astype(x.dtype)


def rope_tables(positions):
    inv_freq = ROPE_THETA ** (-jnp.arange(0, MLA_ROPE, 2, dtype=jnp.float32) / MLA_ROPE)
    ang = positions.astype(jnp.float32)[..., None] * inv_freq
    return jnp.cos(ang), jnp.sin(ang)


def apply_rope(x, cos, sin):
    half = x.shape[-1] // 2
    xf = x.astype(jnp.float32)
    x1, x2 = xf[..., :half], xf[..., half:]
    return jnp.concatenate([x1 * cos - x2 * sin, x2 * cos + x1 * sin], axis=-1).astype(x.dtype)


def hgrn2_chunk_scan(q, k, v, log_f):
    B, H, L, DK = q.shape
    DV = v.shape[-1]
    n = L // HGRN_CHUNK

    def to_chunks(a):
        return a.reshape(B, H, n, HGRN_CHUNK, a.shape[-1]).transpose(2, 0, 1, 3, 4)

    mask = jnp.tril(jnp.ones((HGRN_CHUNK, HGRN_CHUNK), dtype=bool))[:, :, None]

    def step(state, inp):
        q_c, k_c, v_c, g_c = inp
        b = jnp.cumsum(g_c, axis=-2)
        diff = b[..., :, None, :] - b[..., None, :, :]
        decay = jnp.exp(jnp.where(mask, diff, -jnp.inf))
        scores = jnp.einsum('bhtd,bhsd,bhtsd->bhts', q_c, k_c, decay)
        o = (jnp.einsum('bhts,bhsv->bhtv', scores, v_c)
             + jnp.einsum('bhtd,bhdv->bhtv', q_c * jnp.exp(b), state))
        b_last = b[..., -1:, :]
        state = (jnp.exp(b_last[..., 0, :])[..., None] * state
                 + jnp.einsum('bhsd,bhsv->bhdv', k_c * jnp.exp(b_last - b), v_c))
        return state, o

    s0 = jnp.zeros((B, H, DK, DV), jnp.float32)
    _, o = lax.scan(step, s0, (to_chunks(q), to_chunks(k), to_chunks(v), to_chunks(log_f)))
    return o.transpose(1, 2, 0, 3, 4).reshape(B, H, L, DV)


def hgrn2_branch(q_in, f_fw_in, f_bw_in, i_in, g_in, lb_fw, lb_bw, out_gain):
    B, S, _ = q_in.shape

    def heads(a, d):
        return a.reshape(B, S, HGRN_HEADS, d).transpose(0, 2, 1, 3).astype(jnp.float32)

    q = heads(jax.nn.silu(q_in.astype(jnp.float32)), HGRN_DK)
    v = heads(i_in, HGRN_DV)

    def forget(f_in, lb):
        f = lb + (1.0 - lb) * jax.nn.sigmoid(f_in.astype(jnp.float32))
        return heads(1.0 - f, HGRN_DK), heads(jnp.log(f), HGRN_DK)

    k_fw, lf_fw = forget(f_fw_in, lb_fw)
    k_bw, lf_bw = forget(f_bw_in, lb_bw)
    flip = lambda a: jnp.flip(a, axis=2)
    o = (hgrn2_chunk_scan(q, k_fw, v, lf_fw)
         + flip(hgrn2_chunk_scan(flip(q), flip(k_bw), flip(v), flip(lf_bw))))
    o = rms_norm(o, out_gain)
    o = o.transpose(0, 2, 1, 3).reshape(B, S, HGRN_VW)
    return (o * jax.nn.sigmoid(g_in.astype(jnp.float32))).astype(q_in.dtype)


def mla_branch(c_q, c_kv, k_pe, cos, sin, q_norm_gain, w_q_up, kv_norm_gain, w_kv_up):
    B, S, _ = c_q.shape
    q = (rms_norm(c_q, q_norm_gain) @ w_q_up).reshape(B, S, MLA_HEADS, MLA_NOPE + MLA_ROPE)
    q_nope, q_pe = q[..., :MLA_NOPE], q[..., MLA_NOPE:]
    q_pe = apply_rope(q_pe, cos[:, :, None, :], sin[:, :, None, :])
    kv = (rms_norm(c_kv, kv_norm_gain) @ w_kv_up).reshape(B, S, MLA_HEADS, MLA_NOPE + MLA_DV)
    k_nope, v = kv[..., :MLA_NOPE], kv[..., MLA_NOPE:]
    k_pe = apply_rope(k_pe, cos, sin)
    n_blocks = S // Q_BLOCK
    scale = (MLA_NOPE + MLA_ROPE) ** -0.5

    def to_blocks(a):
        return a.reshape(B, n_blocks, Q_BLOCK, *a.shape[2:]).swapaxes(0, 1)

    def attend(blk):
        qn, qp = blk
        s = (jnp.einsum('bqhd,bkhd->bhqk', qn, k_nope)
             + jnp.einsum('bqhr,bkr->bhqk', qp, k_pe))
        p = jax.nn.softmax(s.astype(jnp.float32) * scale, axis=-1)
        return jnp.einsum('bhqk,bkhv->bqhv', p.astype(v.dtype), v)

    o = lax.map(attend, (to_blocks(q_nope), to_blocks(q_pe)))
    return o.swapaxes(0, 1).reshape(B, S, MLA_VW)


def hybrid_mixer(h, cos, sin, w_in, lb_fw, lb_bw, hgrn_gain, w_out_hgrn,
                 q_norm_gain, w_q_up, kv_norm_gain, w_kv_up, w_out_mla, w_o):
    proj = h @ w_in
    split_at = np.cumsum(IN_SPLITS)[:-1].tolist()
    q_a, f_fw, f_bw, i_a, g_a, c_q, c_kv, k_pe, gates = jnp.split(proj, split_at, axis=-1)
    y_a = hgrn2_branch(q_a, f_fw, f_bw, i_a, g_a, lb_fw, lb_bw, hgrn_gain) @ w_out_hgrn
    y_b = mla_branch(c_q, c_kv, k_pe, cos, sin, q_norm_gain, w_q_up, kv_norm_gain, w_kv_up) @ w_out_mla
    gate_a, gate_b = jnp.split(gates, N_BRANCHES, axis=-1)
    y = jax.nn.sigmoid(gate_a) * y_a + jax.nn.sigmoid(gate_b) * y_b
    return y @ w_o


def moe_ffn(h, w_router, b_router, w_gate_up, b_gate_up, w_down, b_down):
    T, D = h.shape
    logits = (h @ w_router + b_router).astype(jnp.float32)
    top_val, top_idx = lax.top_k(logits, TOP_K)
    top_w = jax.nn.softmax(top_val, axis=-1)
    A = T * TOP_K
    flat_e = top_idx.reshape(A)
    order = jnp.argsort(flat_e)
    e_sorted = flat_e[order]
    tok_sorted = order // TOP_K
    w_sorted = top_w.reshape(A)[order]
    counts = jnp.bincount(flat_e, length=N_EXPERTS)
    padded = (counts + MOE_BLOCK - 1) // MOE_BLOCK * MOE_BLOCK
    pad_end = jnp.cumsum(padded)
    pad_start = pad_end - padded
    start = jnp.cumsum(counts) - counts
    dest = pad_start[e_sorted] + jnp.arange(A, dtype=jnp.int32) - start[e_sorted]
    n_blocks = -(-(A + N_EXPERTS * (MOE_BLOCK - 1)) // MOE_BLOCK)
    rows = n_blocks * MOE_BLOCK
    x_rows = jnp.zeros((rows, D), h.dtype).at[dest].set(h[tok_sorted])
    block_start = jnp.arange(n_blocks, dtype=jnp.int32) * MOE_BLOCK
    block_e = jnp.minimum(jnp.searchsorted(pad_end, block_start, side='right'), N_EXPERTS - 1)

    def expert_block(args):
        xb, e = args
        gu = xb @ w_gate_up[e] + b_gate_up[e]
        gate = jnp.minimum(gu[:, 0::2], SWIGLU_LIMIT)
        up = jnp.clip(gu[:, 1::2], -SWIGLU_LIMIT, SWIGLU_LIMIT)
        act = (up + 1.0) * gate * jax.nn.sigmoid(SWIGLU_ALPHA * gate)
        return act @ w_down[e] + b_down[e]

    y_rows = lax.map(expert_block, (x_rows.reshape(n_blocks, MOE_BLOCK, D), block_e)).reshape(rows, D)
    contrib = y_rows[dest].astype(jnp.float32) * w_sorted[:, None]
    out = jnp.zeros((T, D), jnp.float32).at[tok_sorted].add(contrib)
    return out.astype(h.dtype)


def setup_inputs(seed: int = 0) -> dict:
    key = jax.random.key(seed)
    ks = jax.random.split(key, 24)

    def nrm(k, shape, scale):
        return jax.random.normal(k, shape, jnp.float32) * scale

    D = D_MODEL
    return {
        "x": nrm(ks[0], (BATCH, SEQ, D), 1.0),
        "c": nrm(ks[1], (BATCH, D), 1.0),
        "positions": (jnp.arange(SEQ, dtype=jnp.int32)[None, :]
                      + jax.random.randint(ks[2], (BATCH, 1), 0, SEQ, dtype=jnp.int32)),
        "w_ada": nrm(ks[3], (DEPTH, D, 6 * D), 0.5 * D ** -0.5),
        "b_ada": nrm(ks[4], (DEPTH, 6 * D), 0.02),
        "norm_mix_gain": 1.0 + nrm(ks[5], (DEPTH, D), 0.02),
        "norm_ffn_gain": 1.0 + nrm(ks[6], (DEPTH, D), 0.02),
        "w_in": nrm(ks[7], (DEPTH, D, IN_WIDTH), D ** -0.5),
        "hgrn_lb_logits": nrm(ks[8], (DEPTH, 2, HGRN_KW), 0.5),
        "hgrn_out_norm_gain": 1.0 + nrm(ks[9], (DEPTH, HGRN_DV), 0.02),
        "w_out_hgrn": nrm(ks[10], (DEPTH, HGRN_VW, D), HGRN_VW ** -0.5),
        "mla_q_norm_gain": 1.0 + nrm(ks[11], (DEPTH, MLA_Q_RANK), 0.02),
        "w_q_up": nrm(ks[12], (DEPTH, MLA_Q_RANK, MLA_HEADS * (MLA_NOPE + MLA_ROPE)), MLA_Q_RANK ** -0.5),
        "mla_kv_norm_gain": 1.0 + nrm(ks[13], (DEPTH, MLA_KV_RANK), 0.02),
        "w_kv_up": nrm(ks[14], (DEPTH, MLA_KV_RANK, MLA_HEADS * (MLA_NOPE + MLA_DV)), MLA_KV_RANK ** -0.5),
        "w_out_mla": nrm(ks[15], (DEPTH, MLA_VW, D), MLA_VW ** -0.5),
        "w_o": nrm(ks[16], (DEPTH, D, D), D ** -0.5),
        "w_router": nrm(ks[17], (DEPTH, D, N_EXPERTS), D ** -0.5),
        "b_router": nrm(ks[18], (DEPTH, N_EXPERTS), 0.01),
        "w_gate_up": nrm(ks[19], (DEPTH, N_EXPERTS, D, 2 * D_EXPERT), D ** -0.5),
        "b_gate_up": nrm(ks[20], (DEPTH, N_EXPERTS, 2 * D_EXPERT), 0.02),
        "w_down": nrm(ks[21], (DEPTH, N_EXPERTS, D_EXPERT, D), D_EXPERT ** -0.5),
        "b_down": nrm(ks[22], (DEPTH, N_EXPERTS, D), 0.02),
        "final_norm_gain": 1.0 + nrm(ks[23], (D,), 0.02),
    }


def reference(x, c, positions, w_ada, b_ada, norm_mix_gain, norm_ffn_gain, w_in, hgrn_lb_logits,
              hgrn_out_norm_gain, w_out_hgrn, mla_q_norm_gain, w_q_up, mla_kv_norm_gain, w_kv_up,
              w_out_mla, w_o, w_router, b_router, w_gate_up, b_gate_up, w_down, b_down,
              final_norm_gain):
    B, S, D = x.shape
    cos, sin = rope_tables(positions)
    lb = jnp.cumsum(jax.nn.softmax(hgrn_lb_logits.astype(jnp.float32), axis=0), axis=0)
    lb = lb - lb[0]
    cond = jax.nn.silu(c)
    for l in range(DEPTH):
        mod = cond @ w_ada[l] + b_ada[l]
        sh1, sc1, g1, sh2, sc2, g2 = jnp.split(mod[:, None, :], 6, axis=-1)
        h = rms_norm(x, norm_mix_gain[l]) * (1.0 + sc1) + sh1
        x = x + g1 * hybrid_mixer(h, cos, sin, w_in[l], lb[l, 0], lb[l, 1], hgrn_out_norm_gain[l],
                                  w_out_hgrn[l], mla_q_norm_gain[l], w_q_up[l], mla_kv_norm_gain[l],
                                  w_kv_up[l], w_out_mla[l], w_o[l])
        h = rms_norm(x, norm_ffn_gain[l]) * (1.0 + sc2) + sh2
        x = x + g2 * moe_ffn(h.reshape(B * S, D), w_router[l], b_router[l], w_gate_up[l],
                             b_gate_up[l], w_down[l], b_down[l]).reshape(B, S, D)
    return rms_norm(x, final_norm_gain)
```

```cpp
#include <hip/hip_runtime.h>
#include <cstdio>
#include <cstdint>

#ifndef PHASE_MASK
#define PHASE_MASK 0xFFFFu
#endif
#define EN(k) (((PHASE_MASK) >> (k)) & 1u)
#ifndef MK_PER_PHASE
#define MK_PER_PHASE 1
#endif

#define GAS __attribute__((address_space(1)))
#define LAS __attribute__((address_space(3)))
typedef unsigned short bf16;
typedef short bf16x8 __attribute__((ext_vector_type(8)));
typedef float f32x4 __attribute__((ext_vector_type(4)));
typedef float f32x2 __attribute__((ext_vector_type(2)));
typedef float f32x16 __attribute__((ext_vector_type(16)));
typedef unsigned u32x4 __attribute__((ext_vector_type(4)));
typedef unsigned u32x2 __attribute__((ext_vector_type(2)));
typedef __bf16 bfv2 __attribute__((ext_vector_type(2)));

__device__ __forceinline__ unsigned pk2(float lo, float hi) { f32x2 v = {lo, hi}; bfv2 r = __builtin_convertvector(v, bfv2); return __builtin_bit_cast(unsigned, r); }
__device__ __forceinline__ float bf2f(unsigned short b) { return __uint_as_float(((unsigned)b) << 16); }
__device__ __forceinline__ float bflo(unsigned w) { return __uint_as_float(w << 16); }
__device__ __forceinline__ float bfhi(unsigned w) { return __uint_as_float(w & 0xffff0000u); }
__device__ __forceinline__ u32x4 pack8(f32x4 a, f32x4 b) { u32x4 w; w.x = pk2(a[0], a[1]); w.y = pk2(a[2], a[3]); w.z = pk2(b[0], b[1]); w.w = pk2(b[2], b[3]); return w; }
__device__ __forceinline__ void unpack8(u32x4 w, f32x4& a, f32x4& b) { a[0] = bflo(w.x); a[1] = bfhi(w.x); a[2] = bflo(w.y); a[3] = bfhi(w.y); b[0] = bflo(w.z); b[1] = bfhi(w.z); b[2] = bflo(w.w); b[3] = bfhi(w.w); }
__device__ __forceinline__ float sigmoidf_(float x) { return 1.0f / (1.0f + __expf(-x)); }
__device__ __forceinline__ float wave_sum(float v) {
#pragma unroll
    for (int o = 1; o < 64; o <<= 1) v += __shfl_xor(v, o);
    return v;
}
#define LDS_WAIT() asm volatile("s_waitcnt lgkmcnt(0)" ::: "memory")
#define VM_WAIT() asm volatile("s_waitcnt vmcnt(0)" ::: "memory")

#define XB_TMO      128
#define XB_XCNT(j)  (256  + 64 * (j))
#define XB_XSUB(j)  (1280 + 64 * (j))
#define XB_XGEN(j)  (2304 + 64 * (j))
#define XB_TOP      3328
#define XB_TOPGEN   3392
#define XCD_BAR_WORDS 3456
#define XB_SPIN_CAP (1u << 20)

__device__ __forceinline__ unsigned xb_ld(unsigned* p)              { return __hip_atomic_load(p, __ATOMIC_RELAXED, __HIP_MEMORY_SCOPE_AGENT); }
__device__ __forceinline__ unsigned xb_add(unsigned* p, unsigned v) { return __hip_atomic_fetch_add(p, v, __ATOMIC_RELAXED, __HIP_MEMORY_SCOPE_AGENT); }
__device__ __forceinline__ unsigned xb_xcc_id() { return (unsigned)__builtin_amdgcn_s_getreg((3 << 11) | 20) & 0xFu; }
#define XB_SPIN(cond, bar) do { unsigned _sp = 0; while (cond) { __builtin_amdgcn_s_sleep(1); \
    if ((++_sp & 255u) == 0u) { if (xb_ld(&(bar)[XB_TMO])) break; if (_sp > XB_SPIN_CAP) { atomicAdd(&(bar)[XB_TMO], 1u); break; } } } } while (0)

struct XcdBarrier { unsigned* bar; unsigned x; volatile LAS unsigned* st; };

__device__ __forceinline__ XcdBarrier xcd_barrier_post(unsigned* bar, volatile LAS unsigned* st) {
    XcdBarrier b; b.bar = bar; b.x = xb_xcc_id(); b.st = st;
    if (threadIdx.x == 0) (void)xb_add(&bar[XB_XCNT(b.x)], 1u);
    return b;
}
__device__ __forceinline__ void xcd_barrier_complete(unsigned* bar, unsigned x, unsigned& nloc, unsigned& nx) {
    const unsigned G = gridDim.x * gridDim.y * gridDim.z;
    unsigned sum, cnt, mine, sp = 0u;
    for (;;) {
        sum = 0u; cnt = 0u; mine = 0u;
#pragma unroll
        for (unsigned j = 0; j < 16; ++j) { const unsigned c = xb_ld(&bar[XB_XCNT(j)]); sum += c; cnt += (c > 0u) ? 1u : 0u; mine = (j == x) ? c : mine; }
        if (sum == G) break;
        __builtin_amdgcn_s_sleep(1);
        if ((++sp & 255u) == 0u) { if (xb_ld(&bar[XB_TMO])) break; if (sp > XB_SPIN_CAP) { atomicAdd(&bar[XB_TMO], 1u); break; } }
    }
    nloc = mine > 0u ? mine : 1u; nx = cnt > 0u ? cnt : 1u;
}
__device__ __forceinline__ void xcd_barrier(const XcdBarrier& b) {
    asm volatile("s_waitcnt vmcnt(0)" ::: "memory");
    __syncthreads();
    if (threadIdx.x == 0) {
        unsigned* bar = b.bar;
        __builtin_amdgcn_s_waitcnt(0);
        unsigned nloc = b.st[0], nx = b.st[1];
        if (nloc == 0u) { xcd_barrier_complete(bar, b.x, nloc, nx); b.st[0] = nloc; b.st[1] = nx; }
        const unsigned old = xb_add(&bar[XB_XSUB(b.x)], 1u);
        const unsigned gen = old / nloc;
        if (old + 1u == (gen + 1u) * nloc) {
            __builtin_amdgcn_fence(__ATOMIC_RELEASE, "agent");
            asm volatile("s_waitcnt vmcnt(0)" ::: "memory");
            const unsigned og = xb_add(&bar[XB_TOP], 1u);
            const unsigned tg = og / nx;
            if (og + 1u == (tg + 1u) * nx) xb_add(&bar[XB_TOPGEN], 1u);
            else XB_SPIN(xb_ld(&bar[XB_TOPGEN]) == tg, bar);
            __builtin_amdgcn_fence(__ATOMIC_ACQUIRE, "agent");
            xb_add(&bar[XB_XGEN(b.x)], 1u);
            asm volatile("s_waitcnt vmcnt(0)" ::: "memory");
        } else {
            XB_SPIN(xb_ld(&bar[XB_XGEN(b.x)]) == gen, bar);
            __builtin_amdgcn_fence(__ATOMIC_ACQUIRE, "agent");
            asm volatile("s_waitcnt vmcnt(0)" ::: "memory");
        }
    }
    __syncthreads();
}

constexpr int D = 1024, NB = 8, SEQ = 2048, T = NB * SEQ, DEPTH = 4;
constexpr int NPROJ = 5376;
constexpr int PQ = 0, PFF = 512, PFB = 1024, PI = 1536, PGT = 2048, PGA = 2560, PGB = 3584, PCQ = 4608, PCKV = 4992, PKPE = 5248;
constexpr int NE = 32, TOPK = 4, NASSIGN = T * TOPK, ACT_ROWS = NASSIGN + NE * 256;
constexpr float EPS = 1e-6f;
constexpr float QSCALE = 0.10206207261596575f * 1.4426950408889634f;

constexpr size_t MiB = 1u << 20;
constexpr size_t WS_CTL = 0, CTL_ZERO_BYTES = 1 * MiB;
constexpr size_t WS_MOD = 1 * MiB, WS_LB = 2 * MiB, WS_COS = 3 * MiB, WS_SIN = 4 * MiB, WS_RSQ = 5 * MiB, WS_RSKV = 5 * MiB + 65536, WS_AW = 6 * MiB, WS_LIST = 7 * MiB;
constexpr size_t WS_X = 16 * MiB, WS_HB = 80 * MiB, WS_PROJ = 112 * MiB, WS_Q = 280 * MiB, WS_K = 304 * MiB, WS_VT = 328 * MiB, WS_OF = 344 * MiB, WS_OB = 376 * MiB;
constexpr size_t WS_HA = 408 * MiB, WS_Y = 440 * MiB, WS_ACT = 472 * MiB, WS_YR = 616 * MiB, WS_W = 768 * MiB;
constexpr size_t WL_IN = 0, WL_Q = 11 * MiB, WL_K = 12 * MiB, WL_V = 12 * MiB + 256 * 1024, WL_OUT = 13 * MiB, WL_O = 15 * MiB, WL_GU = 17 * MiB, WL_DN = 145 * MiB, WL_STRIDE = 209 * MiB;
constexpr size_t WS_END = WS_W + DEPTH * WL_STRIDE;
static_assert((size_t)T * NPROJ * 2 <= WS_Q - WS_PROJ && (size_t)ACT_ROWS * 1024 * 2 <= WS_YR - WS_ACT && (size_t)NASSIGN * 1024 * 2 <= WS_W - WS_YR, "ws map");
constexpr int CW_BAR = 4096, CW_CNT = 16384;

constexpr int RING_BYTES = 131072;
constexpr int LDSCTL_OFF = 139264, MISC_OFF = LDSCTL_OFF + 320, MOE_OFF = LDSCTL_OFF + 1024;
constexpr int LDS_BYTES = 147456;
constexpr int NWAVES = 8;

namespace pg8 {
constexpr int BM = 256, BK = 64, HALF = 128, HTB = HALF * BK * 2, NXCD = 8, WGM = 8;
__device__ __forceinline__ int lds_byte(int r, int c) { const int st = (r >> 4) * 2 + (c >> 5), rr = r & 15, cc = c & 31, ob = rr * 64 + cc * 2; return st * 1024 + (ob ^ (((ob >> 9) & 1) << 5)); }
__device__ __forceinline__ void stage_rc(int b, int& R, int& C) { const int st = b / 1024, sb = b % 1024, swz = sb ^ (((sb >> 9) & 1) << 5); R = (st >> 1) * 16 + swz / 64; C = (st & 1) * 32 + (swz % 64) / 2; }
__device__ __forceinline__ int perm32(int rho) { const int n = rho >> 4, i = rho & 15; return 8 * (i >> 2) + 4 * n + (i & 3); }

struct Unit { const char* A; const char* B; int pm, pn, e, rowbase, mrows; };

struct DenseOrder {
    static constexpr bool GATHER_A = false;
    int nM, nN, nwg, G, c; const char* Abase; const char* Bbase; int lda, ldb;
    __device__ __forceinline__ void init(int M, int N, int G_, int c_, const void* A, int lda_, const void* B, int ldb_) { nM = M / BM; nN = N / BM; nwg = nM * nN; G = G_; c = c_; Abase = (const char*)A; Bbase = (const char*)B; lda = lda_; ldb = ldb_; }
    __device__ __forceinline__ bool next(int i, Unit& u) const {
        const long L = (long)i * G + c; if (L >= nwg) return false;
        int wgid = (int)L; { const int q = nwg / NXCD, r = nwg % NXCD, xcd = wgid % NXCD, off = wgid / NXCD; wgid = (xcd < r ? xcd * (q + 1) : r * (q + 1) + (xcd - r) * q) + off; }
        const int nig = WGM * nN, gid = wgid / nig, fm = gid * WGM, gsz = (nM - fm) < WGM ? (nM - fm) : WGM;
        u.pm = fm + ((wgid % nig) % gsz); u.pn = (wgid % nig) / gsz; u.e = 0; u.rowbase = 0; u.mrows = 256;
        u.A = Abase + (size_t)u.pm * 256 * lda * 2; u.B = Bbase + (size_t)u.pn * 256 * ldb * 2; return true;
    }
    __device__ __forceinline__ void aoff(const Unit&, const int (&R)[2], const int (&C)[2], unsigned (&v)[2][2]) const {
#pragma unroll
        for (int h = 0; h < 2; ++h)
#pragma unroll
            for (int i = 0; i < 2; ++i) v[h][i] = (unsigned)((128 * h + R[i]) * lda + C[i]) * 2u;
    }
};
template <bool GATHER> struct MoeOrder {
    static constexpr bool GATHER_A = GATHER;
    const LAS int* toff; const LAS int* cnt; int NT, G, c; const char* Abase; const char* Bbase; size_t b_expert_bytes; const int* list; int lda, ldb;
    __device__ __forceinline__ bool next(int i, Unit& u) const {
        const int L = i * G + c; if (L >= toff[NE] * NT) return false;
        int e = 0; while (toff[e + 1] * NT <= L) ++e;
        const int local = L - toff[e] * NT; u.e = e; u.pm = local / NT; u.pn = local % NT; u.rowbase = (toff[e] + u.pm) * 256; u.mrows = cnt[e] - u.pm * 256;
        u.A = GATHER ? Abase : Abase + (size_t)u.rowbase * lda * 2; u.B = Bbase + (size_t)e * b_expert_bytes + (size_t)u.pn * 256 * ldb * 2; return true;
    }
    __device__ __forceinline__ void aoff(const Unit& u, const int (&R)[2], const int (&C)[2], unsigned (&v)[2][2]) const {
#pragma unroll
        for (int h = 0; h < 2; ++h)
#pragma unroll
            for (int i = 0; i < 2; ++i) {
                if (GATHER) { const int rl = 128 * h + R[i]; const int a = list[(size_t)u.e * T + u.pm * 256 + (rl < u.mrows ? rl : 0)]; v[h][i] = (unsigned)((a >> 2) * lda + C[i]) * 2u; }
                else v[h][i] = (unsigned)((128 * h + R[i]) * lda + C[i]) * 2u;
            }
    }
};

template <class Epi, class Sched>
__device__ __forceinline__ void gemm_phase(LAS unsigned char* lds, const int K, const Sched& S, const Epi& E) {
    int tid_ = threadIdx.x; asm volatile("" : "+v"(tid_));
    const int tid = tid_, wid = __builtin_amdgcn_readfirstlane(tid >> 6), lane = tid & 63, wr = wid >> 2, wc = wid & 3, fr = lane & 15, fq = lane >> 4;
    const int nt = K / BK;
    int sR[2], sC[2]; unsigned voffB[2];
#pragma unroll
    for (int i = 0; i < 2; ++i) { stage_rc(tid * 16 + i * 8192, sR[i], sC[i]); const int Rb = (sR[i] & ~31) + perm32(sR[i] & 31); voffB[i] = (unsigned)(Rb * S.ldb + sC[i]) * 2u; }
    constexpr bool GA = Sched::GATHER_A;
    unsigned voffA[2];
#pragma unroll
    for (int i = 0; i < 2; ++i) voffA[i] = (unsigned)(sR[i] * S.lda + sC[i]) * 2u;
    const size_t kstep = (size_t)(BK * 2);
    const size_t hstepB = (size_t)HALF * S.ldb * 2, hstepA = (size_t)HALF * S.lda * 2;
    const unsigned ldsw = (unsigned)wid * 1024u;
    const int aoff = lds_byte(wr * 64 + fr, fq * 8), boff = lds_byte(wc * 32 + fr, fq * 8);
#define PG8_SA(b, h) (((b) * 2 + (h)) * HTB)
#define PG8_SB(b, h) ((4 + (b) * 2 + (h)) * HTB)
#define PG8_STAGE(bufoff, gbase, voff) do { _Pragma("unroll") for (int _i = 0; _i < 2; ++_i) \
        __builtin_amdgcn_global_load_lds((const unsigned*)((const char*)(gbase) + (voff)[_i]), (LAS unsigned*)(lds + (bufoff) + ldsw + _i * 8192), 16, 0, 0); } while (0)
#define PG8_STAGEA(bufoff, gbase, h, nx) do { _Pragma("unroll") for (int _i = 0; _i < 2; ++_i) { \
        const char* _p = GA ? (const char*)(gbase) + ((nx) ? nvA[h][_i] : vA[h][_i]) : (const char*)(gbase) + (size_t)(h) * hstepA + voffA[_i]; \
        __builtin_amdgcn_global_load_lds((const unsigned*)_p, (LAS unsigned*)(lds + (bufoff) + ldsw + _i * 8192), 16, 0, 0); } } while (0)
#define PG8_LDA(dst, b, h) do { _Pragma("unroll") for (int m = 0; m < 4; ++m) _Pragma("unroll") for (int k = 0; k < 2; ++k) dst[m][k] = *(const LAS bf16x8*)(lds + PG8_SA(b, h) + aoff + m * 2048 + k * 1024); } while (0)
#define PG8_LDB(dst, b, h) do { _Pragma("unroll") for (int n = 0; n < 2; ++n) _Pragma("unroll") for (int k = 0; k < 2; ++k) dst[n][k] = *(const LAS bf16x8*)(lds + PG8_SB(b, h) + boff + n * 2048 + k * 1024); } while (0)
#define PG8_MMA(ai, bj, At, Bt) do { __builtin_amdgcn_s_setprio(1); _Pragma("unroll") for (int m = 0; m < 4; ++m) _Pragma("unroll") for (int n = 0; n < 2; ++n) _Pragma("unroll") for (int k = 0; k < 2; ++k) \
        acc[ai][bj][m][n] = __builtin_amdgcn_mfma_f32_16x16x32_bf16(Bt[n][k], At[m][k], acc[ai][bj][m][n], 0, 0, 0); __builtin_amdgcn_s_setprio(0); } while (0)
#define PG8_WAIT_V(n) asm volatile("s_waitcnt vmcnt(" #n ")" ::: "memory")
#define PG8_WAIT_L(n) asm volatile("s_waitcnt lgkmcnt(" #n ")" ::: "memory")
#define PG8_BAR __builtin_amdgcn_s_barrier()
#define PG8_SCHED __builtin_amdgcn_sched_barrier(0)
    Unit cur, nxt; int ui = 0;
    if (!S.next(0, cur)) return;
    f32x4 acc[2][2][4][2];
#pragma unroll
    for (int a = 0; a < 2; ++a)
#pragma unroll
        for (int b = 0; b < 2; ++b)
#pragma unroll
            for (int m = 0; m < 4; ++m)
#pragma unroll
                for (int n = 0; n < 2; ++n) acc[a][b][m][n] = (f32x4){0.f, 0.f, 0.f, 0.f};
    bf16x8 At[4][2], B0[2][2], B1[2][2];
    unsigned vA[2][2], nvA[2][2];
    if constexpr (GA) { S.aoff(cur, sR, sC, vA); }
    const char* cA = cur.A; const char* cB = cur.B;
    PG8_STAGE(PG8_SB(0, 0), cB, voffB); PG8_STAGE(PG8_SB(0, 1), cB + hstepB, voffB); PG8_STAGEA(PG8_SA(0, 0), cA, 0, false); PG8_STAGEA(PG8_SA(0, 1), cA, 1, false);
    if (wr == 1) PG8_BAR;
    PG8_WAIT_V(2); PG8_BAR;
    PG8_STAGE(PG8_SB(1, 0), cB + kstep, voffB); PG8_STAGEA(PG8_SA(1, 0), cA + kstep, 0, false); PG8_STAGE(PG8_SB(1, 1), cB + hstepB + kstep, voffB);
    PG8_WAIT_V(6); PG8_BAR;
    for (;;) {
        const bool has_next = S.next(ui + 1, nxt);
        const char* nA = has_next ? nxt.A : cA; const char* nB = has_next ? nxt.B : cB;
        if constexpr (GA) {
            if (has_next) S.aoff(nxt, sR, sC, nvA);
            else {
#pragma unroll
                for (int h = 0; h < 2; ++h)
#pragma unroll
                    for (int i = 0; i < 2; ++i) nvA[h][i] = vA[h][i]; } }
#pragma unroll 1
        for (int t = 0; t < nt; t += 2) {
            const bool last = (t == nt - 2);
            const char* a1 = cA + (size_t)(t + 1) * kstep;
            const char* a2 = last ? nA : cA + (size_t)(t + 2) * kstep; const char* b2 = last ? nB : cB + (size_t)(t + 2) * kstep;
            const char* a3 = a2 + kstep; const char* b3 = b2 + kstep;
            PG8_LDB(B0, 0, 0); PG8_LDB(B1, 0, 1); PG8_SCHED; PG8_LDA(At, 0, 0); PG8_STAGEA(PG8_SA(1, 1), a1, 1, false);
            PG8_WAIT_V(8); PG8_WAIT_L(0); PG8_BAR; PG8_MMA(0, 0, At, B0); PG8_MMA(0, 1, At, B1); PG8_BAR; PG8_SCHED;
            PG8_LDA(At, 0, 1); PG8_STAGE(PG8_SB(0, 0), b2, voffB); PG8_STAGE(PG8_SB(0, 1), b2 + hstepB, voffB); PG8_STAGEA(PG8_SA(0, 0), a2, 0, last);
            PG8_WAIT_V(8); PG8_WAIT_L(0); PG8_BAR; PG8_MMA(1, 0, At, B0); PG8_MMA(1, 1, At, B1); PG8_BAR; PG8_SCHED;
            PG8_LDB(B0, 1, 0); PG8_LDB(B1, 1, 1); PG8_SCHED; PG8_LDA(At, 1, 0); PG8_STAGEA(PG8_SA(0, 1), a2, 1, last);
            PG8_WAIT_V(8); PG8_WAIT_L(0); PG8_BAR; PG8_MMA(0, 0, At, B0); PG8_MMA(0, 1, At, B1); PG8_BAR; PG8_SCHED;
            PG8_LDA(At, 1, 1); PG8_STAGE(PG8_SB(1, 0), b3, voffB); PG8_STAGE(PG8_SB(1, 1), b3 + hstepB, voffB); PG8_STAGEA(PG8_SA(1, 0), a3, 0, last);
            PG8_WAIT_V(8); PG8_WAIT_L(0); PG8_BAR; PG8_MMA(1, 0, At, B0); PG8_MMA(1, 1, At, B1); PG8_BAR; PG8_SCHED;
        }
        if (wr == 0) PG8_BAR;
        E(acc, cur, wr, wc, fr, fq);
        if (!has_next) break;
#pragma unroll
        for (int a = 0; a < 2; ++a)
#pragma unroll
            for (int b = 0; b < 2; ++b)
#pragma unroll
                for (int m = 0; m < 4; ++m)
#pragma unroll
                    for (int n = 0; n < 2; ++n) acc[a][b][m][n] = (f32x4){0.f, 0.f, 0.f, 0.f};
        cur = nxt; cA = nA; cB = nB; ++ui;
        if constexpr (GA) {
#pragma unroll
            for (int h = 0; h < 2; ++h)
#pragma unroll
                for (int i = 0; i < 2; ++i) vA[h][i] = nvA[h][i]; }
        if (wr == 1) PG8_BAR;
    }
    PG8_WAIT_V(0);
    PG8_BAR;
#undef PG8_SA
#undef PG8_SB
#undef PG8_STAGE
#undef PG8_STAGEA
#undef PG8_LDA
#undef PG8_LDB
#undef PG8_MMA
#undef PG8_WAIT_V
#undef PG8_WAIT_L
#undef PG8_BAR
#undef PG8_SCHED
}
}
using pg8::Unit;
typedef const f32x4 (&AccRef)[2][2][4][2];

struct Args {
    const float* in[24]; float* out; unsigned char* ws; int ph_lo, ph_hi;
};
struct Frame {
    LAS unsigned char* lds; unsigned char* ws; int tid, lane, wave, G, bid;
    const float* const* in;
};
__device__ __forceinline__ unsigned char* wl(unsigned char* ws, int l, size_t off) { return ws + WS_W + (size_t)l * WL_STRIDE + off; }

#define EPI_LOOP_BEGIN _Pragma("unroll") for (int ai = 0; ai < 2; ++ai) _Pragma("unroll") for (int m = 0; m < 4; ++m) { const int rl = ai * 128 + wr * 64 + m * 16 + fr; _Pragma("unroll") for (int bj = 0; bj < 2; ++bj) { const int cl = bj * 128 + wc * 32 + 8 * fq; const f32x4 v0 = acc[ai][bj][m][0], v1 = acc[ai][bj][m][1];
#define EPI_LOOP_END } asm volatile("" ::: "memory"); }

struct EpiProj {
    bf16* O;
    __device__ __forceinline__ void operator()(AccRef acc, const Unit& u, int wr, int wc, int fr, int fq) const {
        EPI_LOOP_BEGIN
            *(u32x4*)(O + (size_t)(u.pm * 256 + rl) * NPROJ + u.pn * 256 + cl) = pack8(v0, v1);
        EPI_LOOP_END
    }
};
struct EpiQ {
    bf16* Q; const float* rsq; const float* cs; const float* sn;
    __device__ __forceinline__ void operator()(AccRef acc, const Unit& u, int wr, int wc, int fr, int fq) const {
        EPI_LOOP_BEGIN
            const int t = u.pm * 256 + rl, c0 = u.pn * 256 + cl, head = c0 / 96, w = c0 - head * 96, b = t >> 11, s = t & 2047;
            const float sc = rsq[t] * QSCALE;
            bf16* qp = Q + ((size_t)(b * 8 + head) * SEQ + s) * 96;
            f32x4 a = v0 * sc, d = v1 * sc;
            if (w < 64) { *(u32x4*)(qp + w) = pack8(a, d); }
            else { const int g = (w - 64) >> 3; const f32x4 co = *(const f32x4*)(cs + (size_t)t * 16 + 4 * g), si = *(const f32x4*)(sn + (size_t)t * 16 + 4 * g);
                const f32x4 o1 = a * co - d * si, o2 = d * co + a * si;
                u32x2 w1, w2; w1.x = pk2(o1[0], o1[1]); w1.y = pk2(o1[2], o1[3]); w2.x = pk2(o2[0], o2[1]); w2.y = pk2(o2[2], o2[3]);
                *(u32x2*)(qp + 64 + 4 * g) = w1; *(u32x2*)(qp + 80 + 4 * g) = w2; }
        EPI_LOOP_END
    }
};
struct EpiK {
    bf16* Kb; const float* rskv;
    __device__ __forceinline__ void operator()(AccRef acc, const Unit& u, int wr, int wc, int fr, int fq) const {
        EPI_LOOP_BEGIN
            const int t = u.pm * 256 + rl, c0 = u.pn * 256 + cl, head = c0 >> 6, w = c0 & 63, b = t >> 11, s = t & 2047;
            const float sc = rskv[t];
            *(u32x4*)(Kb + ((size_t)(b * 8 + head) * SEQ + s) * 96 + w) = pack8(v0 * sc, v1 * sc);
        EPI_LOOP_END
    }
};
struct EpiV {
    bf16* VT; const float* rskv;
    __device__ __forceinline__ void operator()(AccRef acc, const Unit& u, int wr, int wc, int fr, int fq) const {
        EPI_LOOP_BEGIN
            const int f = u.pm * 256 + rl, t0 = u.pn * 256 + cl, b = t0 >> 11, s = t0 & 2047, head = f >> 6, dv = f & 63;
            const f32x4 r0 = *(const f32x4*)(rskv + t0), r1 = *(const f32x4*)(rskv + t0 + 4);
            *(u32x4*)(VT + ((size_t)(b * 8 + head) * 64 + dv) * SEQ + s) = pack8(v0 * r0, v1 * r1);
        EPI_LOOP_END
    }
};
struct EpiOut {
    bf16* Y; const bf16* proj; int pass;
    __device__ __forceinline__ void operator()(AccRef acc, const Unit& u, int wr, int wc, int fr, int fq) const {
        EPI_LOOP_BEGIN
            const int t = u.pm * 256 + rl, c0 = u.pn * 256 + cl;
            const u32x4 gw = *(const u32x4*)(proj + (size_t)t * NPROJ + (pass == 0 ? PGA : PGB) + c0);
            f32x4 g0, g1; unpack8(gw, g0, g1);
#pragma unroll
            for (int j = 0; j < 4; ++j) { g0[j] = sigmoidf_(g0[j]); g1[j] = sigmoidf_(g1[j]); }
            f32x4 a = v0 * g0, d = v1 * g1;
            bf16* yp = Y + (size_t)t * 1024 + c0;
            if (pass == 1) { f32x4 p0, p1; unpack8(*(const u32x4*)yp, p0, p1); a += p0; d += p1; }
            *(u32x4*)yp = pack8(a, d);
        EPI_LOOP_END
    }
};
struct EpiWo {
    float* X; const float* g1;
    __device__ __forceinline__ void operator()(AccRef acc, const Unit& u, int wr, int wc, int fr, int fq) const {
        EPI_LOOP_BEGIN
            const int t = u.pm * 256 + rl, c0 = u.pn * 256 + cl, b = t >> 11;
            const float* gp = g1 + (size_t)b * 6144 + c0; float* xp = X + (size_t)t * 1024 + c0;
            const f32x4 ga = *(const f32x4*)gp, gb = *(const f32x4*)(gp + 4);
            f32x4 xa = *(const f32x4*)xp, xb = *(const f32x4*)(xp + 4);
            xa += ga * v0; xb += gb * v1;
            *(f32x4*)xp = xa; *(f32x4*)(xp + 4) = xb;
        EPI_LOOP_END
    }
};
struct EpiGU {
    bf16* ACT; const float* bgu;
    __device__ __forceinline__ void operator()(AccRef acc, const Unit& u, int wr, int wc, int fr, int fq) const {
#pragma unroll
        for (int ai = 0; ai < 2; ++ai)
#pragma unroll
            for (int m = 0; m < 4; ++m) {
                const int rl = ai * 128 + wr * 64 + m * 16 + fr; const int j0 = u.pn * 128 + wc * 32 + 8 * fq;
                const float* bp = bgu + (size_t)u.e * 2048 + 2 * j0;
                const f32x4 b0 = *(const f32x4*)bp, b1 = *(const f32x4*)(bp + 4), b2 = *(const f32x4*)(bp + 8), b3 = *(const f32x4*)(bp + 12);
                const float bg[8] = {b0[0], b0[2], b1[0], b1[2], b2[0], b2[2], b3[0], b3[2]}, bu[8] = {b0[1], b0[3], b1[1], b1[3], b2[1], b2[3], b3[1], b3[3]};
                float o[8];
#pragma unroll
                for (int j = 0; j < 8; ++j) {
                    float g = acc[ai][0][m][j >> 2][j & 3] + bg[j], up = acc[ai][1][m][j >> 2][j & 3] + bu[j];
                    g = fminf(g, 7.0f); up = fminf(fmaxf(up, -7.0f), 7.0f);
                    o[j] = (up + 1.0f) * g * sigmoidf_(1.702f * g); }
                u32x4 w; w.x = pk2(o[0], o[1]); w.y = pk2(o[2], o[3]); w.z = pk2(o[4], o[5]); w.w = pk2(o[6], o[7]);
                *(u32x4*)(ACT + (size_t)(u.rowbase + rl) * 1024 + j0) = w;
                asm volatile("" ::: "memory");
            }
    }
};
struct EpiDown {
    bf16* YR; const float* bd; const int* list; const float* aw;
    __device__ __forceinline__ void operator()(AccRef acc, const Unit& u, int wr, int wc, int fr, int fq) const {
#pragma unroll
        for (int ai = 0; ai < 2; ++ai)
#pragma unroll
            for (int m = 0; m < 4; ++m) {
                const int rl = ai * 128 + wr * 64 + m * 16 + fr;
                if (rl < u.mrows) {
                    const int a = list[(size_t)u.e * T + u.pm * 256 + rl]; const float w = aw[a];
#pragma unroll
                    for (int bj = 0; bj < 2; ++bj) { const int c0 = u.pn * 256 + bj * 128 + wc * 32 + 8 * fq; const float* bp = bd + (size_t)u.e * 1024 + c0;
                        const f32x4 ba = *(const f32x4*)bp, bb = *(const f32x4*)(bp + 4);
                        *(u32x4*)(YR + (size_t)a * 1024 + c0) = pack8((acc[ai][bj][m][0] + ba) * w, (acc[ai][bj][m][1] + bb) * w); }
                }
                asm volatile("" ::: "memory");
            }
    }
};

enum { MAP_ID = 0, MAP_WIN = 1, MAP_WQ = 2, MAP_WKV = 3, MAP_GU = 4 };
__device__ __forceinline__ int map_row(int kind, int n) {
    if (kind == MAP_WIN) { if (n < 2560) return n; if (n < 2944) return PCQ + (n - 2560); if (n < 3200) return PCKV + (n - 2944); if (n < 3232) return PKPE + (n - 3200); return PGA + (n - 3232); }
    if (kind == MAP_WQ) { const int h = n / 96, j = n - h * 96; if (j < 64) return n; const int r = j - 64, i = r & 15; return h * 96 + 64 + 8 * (i >> 2) + ((r >> 4) << 2) + (i & 3); }
    if (kind == MAP_WKV) { const int h = n >> 7, j = n & 127; return (j < 64) ? (h * 64 + j) : (512 + h * 64 + (j - 64)); }
    if (kind == MAP_GU) { const int j = n >> 1, bj = n & 1; return (j >> 7) * 256 + bj * 128 + (j & 127); }
    return n;
}
__device__ __forceinline__ void conv_item(const float* W, int N, const float* kscale, bf16* WT, int dstK, int koff, int kind, LAS float* scr, int kb, int nb, int lane) {
    const int k0 = 64 * kb, n0 = 32 * nb;
#pragma unroll 8
    for (int i = 0; i < 32; ++i) { const int kk = 2 * i + (lane >> 5); float v = W[(size_t)(k0 + kk) * N + n0 + (lane & 31)]; if (kscale) v *= kscale[k0 + kk]; scr[kk * 33 + (lane & 31)] = v; }
    LDS_WAIT(); asm volatile("" ::: "memory");
    const int c = lane & 7;
#pragma unroll
    for (int j = 0; j < 4; ++j) { const int n = (lane >> 3) + 8 * j; const LAS float* s = scr + (8 * c) * 33 + n;
        u32x4 o; o.x = pk2(s[0 * 33], s[1 * 33]); o.y = pk2(s[2 * 33], s[3 * 33]); o.z = pk2(s[4 * 33], s[5 * 33]); o.w = pk2(s[6 * 33], s[7 * 33]);
        *(u32x4*)(WT + (size_t)map_row(kind, n0 + n) * dstK + koff + k0 + 8 * c) = o; }
    LDS_WAIT(); asm volatile("" ::: "memory");
}
__device__ __forceinline__ void p_prologue(Frame& F) {
    const float* const* in = F.in;
    {
        LAS float* cond = (LAS float*)F.lds;
        LAS float* part = (LAS float*)(F.lds + 32768);
        for (int i = F.tid; i < 8 * 1024; i += 512) { const float v = in[1][i]; cond[i] = v * sigmoidf_(v); }
        __syncthreads();
        for (int it = F.bid; it < DEPTH * 96; it += F.G) {
            const int l = it / 96, n0 = (it % 96) * 64, col = F.tid & 63, kg = F.tid >> 6;
            const float* w = in[3] + (size_t)l * 1024 * 6144 + n0 + col;
            float a[8] = {0.f, 0.f, 0.f, 0.f, 0.f, 0.f, 0.f, 0.f};
            for (int k = kg * 128; k < kg * 128 + 128; ++k) { const float wv = w[(size_t)k * 6144];
#pragma unroll
                for (int b = 0; b < 8; ++b) a[b] += cond[b * 1024 + k] * wv; }
#pragma unroll
            for (int b = 0; b < 8; ++b) part[(kg * 8 + b) * 64 + col] = a[b];
            __syncthreads();
            { const int b = F.tid >> 6; float s = 0.f;
#pragma unroll
              for (int g = 0; g < 8; ++g) s += part[(g * 8 + b) * 64 + col];
              ((float*)(F.ws + WS_MOD))[((size_t)l * 8 + b) * 6144 + n0 + col] = s + in[4][(size_t)l * 6144 + n0 + col]; }
            __syncthreads();
        }
    }
    const int gtid = F.bid * 512 + F.tid, NT_ = F.G * 512;
    for (int i = gtid; i < 1024; i += NT_) {
        float lg[DEPTH], mx = -1e30f; for (int l = 0; l < DEPTH; ++l) { lg[l] = in[8][(size_t)l * 1024 + i]; mx = fmaxf(mx, lg[l]); }
        float s = 0.f; for (int l = 0; l < DEPTH; ++l) { lg[l] = __expf(lg[l] - mx); s += lg[l]; }
        float c = 0.f; float* lb = (float*)(F.ws + WS_LB);
        for (int l = 0; l < DEPTH; ++l) { if (l > 0) c += lg[l] / s; lb[(size_t)l * 1024 + i] = c; }
    }
    for (int i = gtid; i < T * 16; i += NT_) {
        const int t = i >> 4, j = i & 15; const int pos = ((const int*)in[2])[t];
        const double base4[4] = {1.0, 0.5623413251903491, 0.31622776601683794, 0.1778279410038923};
        double f = base4[j & 3]; for (int q = 0; q < (j >> 2); ++q) f *= 0.1;
        const double ang = (double)pos * f; const double n = __builtin_rint(ang * 0.15915494309189535); const float r = (float)(ang - n * 6.283185307179586);
        ((float*)(F.ws + WS_COS))[i] = cosf(r); ((float*)(F.ws + WS_SIN))[i] = sinf(r);
    }
    for (int l = 0; l < DEPTH; ++l) { u32x4* p = (u32x4*)(wl(F.ws, l, WL_IN) + (size_t)5280 * 1024 * 2); for (int i = gtid; i < 96 * 1024 * 2 / 16; i += NT_) p[i] = (u32x4){0u, 0u, 0u, 0u}; }
    {
        LAS float* scr = (LAS float*)(F.lds + F.wave * 16384);
        const int gw = F.bid * NWAVES + F.wave, NGW = F.G * NWAVES;
        constexpr int I_IN = 16 * 165, I_Q = 6 * 24, I_KV = 4 * 32, I_OH = 8 * 32, I_OM = 8 * 32, I_O = 16 * 32, I_GU = 32 * 16 * 64, I_DN = 32 * 16 * 32;
        constexpr int I_LAYER = I_IN + I_Q + I_KV + I_OH + I_OM + I_O + I_GU + I_DN;
        for (int it = gw; it < DEPTH * I_LAYER; it += NGW) {
            const int l = it / I_LAYER; int r = it - l * I_LAYER;
            if (r < I_IN) { conv_item(in[7] + (size_t)l * 1024 * 5280, 5280, nullptr, (bf16*)wl(F.ws, l, WL_IN), 1024, 0, MAP_WIN, scr, r / 165, r % 165, F.lane); continue; } r -= I_IN;
            if (r < I_Q) { conv_item(in[12] + (size_t)l * 384 * 768, 768, in[11] + l * 384, (bf16*)wl(F.ws, l, WL_Q), 384, 0, MAP_WQ, scr, r / 24, r % 24, F.lane); continue; } r -= I_Q;
            if (r < I_KV) { conv_item(in[14] + (size_t)l * 256 * 1024, 1024, in[13] + l * 256, (bf16*)wl(F.ws, l, WL_K), 256, 0, MAP_WKV, scr, r / 32, r % 32, F.lane); continue; } r -= I_KV;
            if (r < I_OH) { conv_item(in[10] + (size_t)l * 512 * 1024, 1024, nullptr, (bf16*)wl(F.ws, l, WL_OUT), 1024, 0, MAP_ID, scr, r / 32, r % 32, F.lane); continue; } r -= I_OH;
            if (r < I_OM) { conv_item(in[15] + (size_t)l * 512 * 1024, 1024, nullptr, (bf16*)wl(F.ws, l, WL_OUT), 1024, 512, MAP_ID, scr, r / 32, r % 32, F.lane); continue; } r -= I_OM;
            if (r < I_O) { conv_item(in[16] + (size_t)l * 1024 * 1024, 1024, nullptr, (bf16*)wl(F.ws, l, WL_O), 1024, 0, MAP_ID, scr, r / 32, r % 32, F.lane); continue; } r -= I_O;
            if (r < I_GU) { const int e = r / (16 * 64), q = r % (16 * 64); conv_item(in[19] + ((size_t)l * 32 + e) * 1024 * 2048, 2048, nullptr, (bf16*)wl(F.ws, l, WL_GU) + (size_t)e * 2048 * 1024, 1024, 0, MAP_GU, scr, q / 64, q % 64, F.lane); continue; } r -= I_GU;
            { const int e = r / (16 * 32), q = r % (16 * 32); conv_item(in[21] + ((size_t)l * 32 + e) * 1024 * 1024, 1024, nullptr, (bf16*)wl(F.ws, l, WL_DN) + (size_t)e * 1024 * 1024, 1024, 0, MAP_ID, scr, q / 32, q % 32, F.lane); }
        }
    }
}

__device__ __forceinline__ void p_norm_mix(Frame& F, int l, bool fin, float* out) {
    const float* const* in = F.in;
    float* X = (float*)(F.ws + WS_X); const float* MOD = (const float*)(F.ws + WS_MOD); const bf16* YR = (const bf16*)(F.ws + WS_YR); bf16* HB = (bf16*)(F.ws + WS_HB);
    const int gw = F.bid * NWAVES + F.wave, NGW = F.G * NWAVES;
    for (int t = gw; t < T; t += NGW) {
        const int b = t >> 11; f32x4 v[4];
        const float* src = (l == 0) ? in[0] + (size_t)t * 1024 : X + (size_t)t * 1024;
#pragma unroll
        for (int j = 0; j < 4; ++j) v[j] = *(const f32x4*)(src + 4 * F.lane + 256 * j);
        if (l > 0) {
            const float* g2 = MOD + ((size_t)(l - 1) * 8 + b) * 6144 + 5 * 1024;
#pragma unroll
            for (int j = 0; j < 4; ++j) { f32x4 s = {0.f, 0.f, 0.f, 0.f};
#pragma unroll
                for (int k = 0; k < 4; ++k) { const u32x2 w = *(const u32x2*)(YR + ((size_t)t * 4 + k) * 1024 + 4 * F.lane + 256 * j); s[0] += bflo(w.x); s[1] += bfhi(w.x); s[2] += bflo(w.y); s[3] += bfhi(w.y); }
                v[j] += *(const f32x4*)(g2 + 4 * F.lane + 256 * j) * s; }
        }
        float ss = 0.f;
#pragma unroll
        for (int j = 0; j < 4; ++j) ss += (v[j][0] * v[j][0] + v[j][1] * v[j][1]) + (v[j][2] * v[j][2] + v[j][3] * v[j][3]);
        const float rs = rsqrtf(wave_sum(ss) * (1.0f / 1024.0f) + EPS);
        if (fin) {
            const float* gn = in[23];
#pragma unroll
            for (int j = 0; j < 4; ++j) { const int d = 4 * F.lane + 256 * j; *(f32x4*)(out + (size_t)t * 1024 + d) = v[j] * rs * *(const f32x4*)(gn + d); }
        } else {
            const float* gn = in[5] + (size_t)l * 1024; const float* sh = MOD + ((size_t)l * 8 + b) * 6144; const float* sc = sh + 1024;
#pragma unroll
            for (int j = 0; j < 4; ++j) { const int d = 4 * F.lane + 256 * j; *(f32x4*)(X + (size_t)t * 1024 + d) = v[j];
                const f32x4 g = *(const f32x4*)(gn + d), s1 = *(const f32x4*)(sc + d), s0 = *(const f32x4*)(sh + d);
                const f32x4 h = v[j] * rs * g * (s1 + 1.0f) + s0; u32x2 w; w.x = pk2(h[0], h[1]); w.y = pk2(h[2], h[3]);
                *(u32x2*)(HB + (size_t)t * 1024 + d) = w; }
        }
    }
}
__device__ __forceinline__ void p_mla_prep(Frame& F) {
    const bf16* PROJ = (const bf16*)(F.ws + WS_PROJ); float* RSQ = (float*)(F.ws + WS_RSQ); float* RSKV = (float*)(F.ws + WS_RSKV); bf16* Kb = (bf16*)(F.ws + WS_K);
    const float* CS = (const float*)(F.ws + WS_COS); const float* SN = (const float*)(F.ws + WS_SIN);
    const int gw = F.bid * NWAVES + F.wave, NGW = F.G * NWAVES;
    for (int t = gw; t < T; t += NGW) {
        const bf16* row = PROJ + (size_t)t * NPROJ;
        float sq = 0.f, skv = 0.f;
#pragma unroll
        for (int j = 0; j < 6; ++j) { const float v = bf2f(row[PCQ + F.lane + 64 * j]); sq += v * v; }
#pragma unroll
        for (int j = 0; j < 4; ++j) { const float v = bf2f(row[PCKV + F.lane + 64 * j]); skv += v * v; }
        sq = wave_sum(sq); skv = wave_sum(skv);
        if (F.lane == 0) { RSQ[t] = rsqrtf(sq * (1.0f / 384.0f) + EPS); RSKV[t] = rsqrtf(skv * (1.0f / 256.0f) + EPS); }
        if (F.lane < 16) {
            const float x1 = bf2f(row[PKPE + F.lane]), x2 = bf2f(row[PKPE + 16 + F.lane]), co = CS[(size_t)t * 16 + F.lane], si = SN[(size_t)t * 16 + F.lane];
            const bf16 o1 = (bf16)(pk2(x1 * co - x2 * si, 0.f) & 0xffffu), o2 = (bf16)(pk2(x2 * co + x1 * si, 0.f) & 0xffffu);
            const int b = t >> 11, s = t & 2047;
#pragma unroll
            for (int h = 0; h < 8; ++h) { bf16* kp = Kb + ((size_t)(b * 8 + h) * SEQ + s) * 96; kp[64 + F.lane] = o1; kp[80 + F.lane] = o2; }
        }
    }
}
__device__ __forceinline__ void p_hgrn_post(Frame& F, int l) {
    const float* OFp = (const float*)(F.ws + WS_OF); const float* OBp = (const float*)(F.ws + WS_OB); const bf16* PROJ = (const bf16*)(F.ws + WS_PROJ); bf16* HA = (bf16*)(F.ws + WS_HA);
    const float* gn = F.in[9] + (size_t)l * 128;
    const int gw = F.bid * NWAVES + F.wave, NGW = F.G * NWAVES;
    for (int t = gw; t < T; t += NGW) {
        const int c = 8 * F.lane;
        f32x4 a0 = *(const f32x4*)(OFp + (size_t)t * 512 + c) + *(const f32x4*)(OBp + (size_t)t * 512 + c), a1 = *(const f32x4*)(OFp + (size_t)t * 512 + c + 4) + *(const f32x4*)(OBp + (size_t)t * 512 + c + 4);
        float ss = (a0[0] * a0[0] + a0[1] * a0[1]) + (a0[2] * a0[2] + a0[3] * a0[3]) + (a1[0] * a1[0] + a1[1] * a1[1]) + (a1[2] * a1[2] + a1[3] * a1[3]);
#pragma unroll
        for (int o = 1; o < 16; o <<= 1) ss += __shfl_xor(ss, o);
        const float rs = rsqrtf(ss * (1.0f / 128.0f) + EPS);
        f32x4 g0, g1; unpack8(*(const u32x4*)(PROJ + (size_t)t * NPROJ + PGT + c), g0, g1);
        const f32x4 n0 = *(const f32x4*)(gn + (c & 127)), n1 = *(const f32x4*)(gn + (c & 127) + 4);
#pragma unroll
        for (int j = 0; j < 4; ++j) { a0[j] = a0[j] * rs * n0[j] * sigmoidf_(g0[j]); a1[j] = a1[j] * rs * n1[j] * sigmoidf_(g1[j]); }
        *(u32x4*)(HA + (size_t)t * 1024 + c) = pack8(a0, a1);
    }
}

__device__ __forceinline__ void scan_unit(Frame& F, int l, int u) {
    const int vq = u & 3, dir = (u >> 2) & 1, hh = (u >> 3) & 3, b = u >> 5;
    const bf16* PROJ = (const bf16*)(F.ws + WS_PROJ); const float* LB = (const float*)(F.ws + WS_LB) + ((size_t)l * 2 + dir) * 512 + hh * 128;
    float* OUT = (float*)(F.ws + (dir ? WS_OB : WS_OF));
    LAS float* sq = (LAS float*)F.lds;
    LAS float* sf = sq + 32 * 128;
    LAS float* sv = sf + 32 * 128;
    LAS float* op = sv + 32 * 32;
    const int v = F.tid & 31, dg = F.tid >> 5;
    float st[8];
#pragma unroll
    for (int j = 0; j < 8; ++j) st[j] = 0.f;
    const int fcol = (dir ? PFB : PFF) + hh * 128;
    for (int blk = 0; blk < SEQ / 32; ++blk) {
        __syncthreads();
        for (int idx = F.tid; idx < 32 * 128; idx += 512) { const int tl = idx >> 7, d = idx & 127; const int s = dir ? (SEQ - 1 - (blk * 32 + tl)) : (blk * 32 + tl);
            const bf16* row = PROJ + (size_t)(b * SEQ + s) * NPROJ;
            const float qv = bf2f(row[PQ + hh * 128 + d]), fv = bf2f(row[fcol + d]), lb = LB[d];
            sq[idx] = qv * sigmoidf_(qv); sf[idx] = lb + (1.0f - lb) * sigmoidf_(fv); }
        for (int idx = F.tid; idx < 32 * 32; idx += 512) { const int tl = idx >> 5, vv = idx & 31; const int s = dir ? (SEQ - 1 - (blk * 32 + tl)) : (blk * 32 + tl);
            sv[idx] = bf2f(PROJ[(size_t)(b * SEQ + s) * NPROJ + PI + hh * 128 + vq * 32 + vv]); }
        __syncthreads();
        for (int tl = 0; tl < 32; ++tl) {
            const f32x4 f0 = *(const LAS f32x4*)(sf + tl * 128 + dg * 8), f1 = *(const LAS f32x4*)(sf + tl * 128 + dg * 8 + 4);
            const f32x4 q0 = *(const LAS f32x4*)(sq + tl * 128 + dg * 8), q1 = *(const LAS f32x4*)(sq + tl * 128 + dg * 8 + 4);
            const float vv = sv[tl * 32 + v]; float o = 0.f;
#pragma unroll
            for (int j = 0; j < 4; ++j) { st[j] = f0[j] * st[j] + (1.0f - f0[j]) * vv; o += q0[j] * st[j]; st[4 + j] = f1[j] * st[4 + j] + (1.0f - f1[j]) * vv; o += q1[j] * st[4 + j]; }
            o += __shfl_xor(o, 32);
            if (F.lane < 32) op[(tl * 8 + F.wave) * 32 + v] = o;
        }
        __syncthreads();
        for (int idx = F.tid; idx < 32 * 32; idx += 512) { const int tl = idx >> 5, vv = idx & 31; float s = 0.f;
#pragma unroll
            for (int w = 0; w < 8; ++w) s += op[(tl * 8 + w) * 32 + vv];
            const int sp = dir ? (SEQ - 1 - (blk * 32 + tl)) : (blk * 32 + tl);
            OUT[(size_t)(b * SEQ + sp) * 512 + hh * 128 + vq * 32 + vv] = s; }
    }
    __syncthreads();
}

#define MFMA32(a, b, c) __builtin_amdgcn_mfma_f32_32x32x16_bf16((a), (b), (c), 0, 0, 0)
constexpr int AT_KROW = 208, AT_VROW = 136, AT_KBYTES = 64 * AT_KROW, AT_BUF = AT_KBYTES + 64 * AT_VROW;
__device__ __forceinline__ void attn_unit(Frame& F, int bh, int q0) {
    const bf16* Q = (const bf16*)(F.ws + WS_Q); const char* Kg = (const char*)(F.ws + WS_K) + (size_t)bh * SEQ * 96 * 2; const char* Vg = (const char*)(F.ws + WS_VT) + (size_t)bh * 64 * SEQ * 2;
    bf16* HA = (bf16*)(F.ws + WS_HA);
    LAS unsigned char* lds = F.lds;
    const int r = F.lane & 31, h = F.lane >> 5;
    bf16x8 qf[6];
    { const bf16* qrow = Q + ((size_t)bh * SEQ + q0 + F.wave * 32 + r) * 96;
#pragma unroll
      for (int ks = 0; ks < 6; ++ks) qf[ks] = *(const bf16x8*)(qrow + 16 * ks + 8 * h); }
    f32x16 o0, o1;
#pragma unroll
    for (int i = 0; i < 16; ++i) { o0[i] = 0.f; o1[i] = 0.f; }
    float mrun = -1e30f, lsum = 0.f;
    const int kc0 = F.tid, kc1 = F.tid + 512; const bool has1 = F.tid < 256;
    const int kl0 = (kc0 / 12) * AT_KROW + (kc0 % 12) * 16, kl1 = (kc1 / 12) * AT_KROW + (kc1 % 12) * 16;
    const int vrow = F.tid >> 3, vpc = F.tid & 7; const int vl = AT_KBYTES + vrow * AT_VROW + vpc * 16;
    u32x4 rk0, rk1 = {0u, 0u, 0u, 0u}, rv;
    __syncthreads();
    rk0 = *(const u32x4*)(Kg + (size_t)kc0 * 16); if (has1) rk1 = *(const u32x4*)(Kg + (size_t)kc1 * 16);
    rv = *(const u32x4*)(Vg + (size_t)vrow * SEQ * 2 + vpc * 16);
    *(LAS u32x4*)(lds + kl0) = rk0; if (has1) *(LAS u32x4*)(lds + kl1) = rk1;
    *(LAS u32x2*)(lds + vl) = (u32x2){rv.x, rv.y}; *(LAS u32x2*)(lds + vl + 8) = (u32x2){rv.z, rv.w};
    __syncthreads();
    for (int j = 0; j < SEQ / 64; ++j) {
        const int buf = (j & 1) * AT_BUF, nbuf = ((j + 1) & 1) * AT_BUF;
        if (j + 1 < SEQ / 64) {
            const char* kg = Kg + (size_t)(j + 1) * 64 * 96 * 2;
            rk0 = *(const u32x4*)(kg + (size_t)kc0 * 16); if (has1) rk1 = *(const u32x4*)(kg + (size_t)kc1 * 16);
            rv = *(const u32x4*)(Vg + (size_t)vrow * SEQ * 2 + (size_t)(j + 1) * 128 + vpc * 16);
        }
        f32x16 s0, s1;
#pragma unroll
        for (int i = 0; i < 16; ++i) { s0[i] = 0.f; s1[i] = 0.f; }
#pragma unroll
        for (int ks = 0; ks < 6; ++ks) {
            const bf16x8 k0 = *(const LAS bf16x8*)(lds + buf + r * AT_KROW + (16 * ks + 8 * h) * 2);
            const bf16x8 k1 = *(const LAS bf16x8*)(lds + buf + (32 + r) * AT_KROW + (16 * ks + 8 * h) * 2);
            s0 = MFMA32(k0, qf[ks], s0); s1 = MFMA32(k1, qf[ks], s1);
        }
        float mx = s0[0];
#pragma unroll
        for (int i = 1; i < 16; ++i) mx = fmaxf(mx, s0[i]);
#pragma unroll
        for (int i = 0; i < 16; ++i) mx = fmaxf(mx, s1[i]);
        mx = fmaxf(mx, __shfl_xor(mx, 32));
        const float mnew = fmaxf(mrun, mx), alpha = exp2f(mrun - mnew); mrun = mnew;
        float ps = 0.f;
#pragma unroll
        for (int i = 0; i < 16; ++i) { s0[i] = exp2f(s0[i] - mnew); s1[i] = exp2f(s1[i] - mnew); ps += s0[i] + s1[i]; }
        lsum = lsum * alpha + ps;
#pragma unroll
        for (int i = 0; i < 16; ++i) { o0[i] *= alpha; o1[i] *= alpha; }
        bf16x8 pf[2][2];
#pragma unroll
        for (int sp = 0; sp < 2; ++sp) {
            u32x4 w0, w1;
            w0.x = pk2(s0[8 * sp + 0], s0[8 * sp + 1]); w0.y = pk2(s0[8 * sp + 2], s0[8 * sp + 3]); w0.z = pk2(s0[8 * sp + 4], s0[8 * sp + 5]); w0.w = pk2(s0[8 * sp + 6], s0[8 * sp + 7]);
            w1.x = pk2(s1[8 * sp + 0], s1[8 * sp + 1]); w1.y = pk2(s1[8 * sp + 2], s1[8 * sp + 3]); w1.z = pk2(s1[8 * sp + 4], s1[8 * sp + 5]); w1.w = pk2(s1[8 * sp + 6], s1[8 * sp + 7]);
            pf[0][sp] = __builtin_bit_cast(bf16x8, w0); pf[1][sp] = __builtin_bit_cast(bf16x8, w1);
        }
#pragma unroll
        for (int kb = 0; kb < 2; ++kb)
#pragma unroll
            for (int sp = 0; sp < 2; ++sp) {
                const int kbase = (32 * kb + 16 * sp + 4 * h) * 2;
                const LAS unsigned char* v0p = lds + buf + AT_KBYTES + r * AT_VROW + kbase;
                const LAS unsigned char* v1p = lds + buf + AT_KBYTES + (32 + r) * AT_VROW + kbase;
                const u32x2 a0 = *(const LAS u32x2*)v0p, a1 = *(const LAS u32x2*)(v0p + 16), c0 = *(const LAS u32x2*)v1p, c1 = *(const LAS u32x2*)(v1p + 16);
                const bf16x8 vf0 = __builtin_bit_cast(bf16x8, ((u32x4){a0.x, a0.y, a1.x, a1.y})), vf1 = __builtin_bit_cast(bf16x8, ((u32x4){c0.x, c0.y, c1.x, c1.y}));
                o0 = MFMA32(vf0, pf[kb][sp], o0); o1 = MFMA32(vf1, pf[kb][sp], o1);
            }
        if (j + 1 < SEQ / 64) {
            *(LAS u32x4*)(lds + nbuf + kl0) = rk0; if (has1) *(LAS u32x4*)(lds + nbuf + kl1) = rk1;
            *(LAS u32x2*)(lds + nbuf + vl) = (u32x2){rv.x, rv.y}; *(LAS u32x2*)(lds + nbuf + vl + 8) = (u32x2){rv.z, rv.w};
        }
        __syncthreads();
    }
    lsum += __shfl_xor(lsum, 32);
    const float inv = 1.0f / lsum;
    const int head = bh & 7, b = bh >> 3;
    bf16* orow = HA + (size_t)(b * SEQ + q0 + F.wave * 32 + r) * 1024 + 512 + head * 64;
#pragma unroll
    for (int i = 0; i < 4; ++i) {
        u32x2 w0, w1;
        w0.x = pk2(o0[4 * i] * inv, o0[4 * i + 1] * inv); w0.y = pk2(o0[4 * i + 2] * inv, o0[4 * i + 3] * inv);
        w1.x = pk2(o1[4 * i] * inv, o1[4 * i + 1] * inv); w1.y = pk2(o1[4 * i + 2] * inv, o1[4 * i + 3] * inv);
        *(u32x2*)(orow + 8 * i + 4 * h) = w0; *(u32x2*)(orow + 32 + 8 * i + 4 * h) = w1;
    }
}

__device__ __forceinline__ void p_router(Frame& F, int l) {
    const float* const* in = F.in;
    const float* X = (const float*)(F.ws + WS_X); const float* MOD = (const float*)(F.ws + WS_MOD); bf16* HB = (bf16*)(F.ws + WS_HB);
    int* LIST = (int*)(F.ws + WS_LIST); float* AW = (float*)(F.ws + WS_AW); unsigned* CNT = (unsigned*)(F.ws + WS_CTL) + CW_CNT + l * 32 * 64;
    LAS unsigned char* lds = F.lds;
    __syncthreads();
    { const float* wr = in[17] + (size_t)l * 1024 * 32;
      for (int q = F.tid; q < 8192; q += 512) { const int k = q >> 3; *(LAS f32x4*)(lds + (size_t)(q + (k >> 2)) * 16) = *(const f32x4*)(wr + (size_t)q * 4); } }
    __syncthreads();
    const float* gn = in[6] + (size_t)l * 1024; const float* br = in[18] + (size_t)l * 32;
    const int gw = F.bid * NWAVES + F.wave, NGW = F.G * NWAVES;
    for (int t = gw; t < T; t += NGW) {
        const int b = t >> 11; f32x4 v[4]; float ss = 0.f;
#pragma unroll
        for (int j = 0; j < 4; ++j) { v[j] = *(const f32x4*)(X + (size_t)t * 1024 + 4 * F.lane + 256 * j); ss += (v[j][0] * v[j][0] + v[j][1] * v[j][1]) + (v[j][2] * v[j][2] + v[j][3] * v[j][3]); }
        const float rs = rsqrtf(wave_sum(ss) * (1.0f / 1024.0f) + EPS);
        const float* sh = MOD + ((size_t)l * 8 + b) * 6144 + 3 * 1024; const float* sc = sh + 1024;
#pragma unroll
        for (int j = 0; j < 4; ++j) { const int d = 4 * F.lane + 256 * j; const f32x4 g = *(const f32x4*)(gn + d), s1 = *(const f32x4*)(sc + d), s0 = *(const f32x4*)(sh + d);
            v[j] = v[j] * rs * g * (s1 + 1.0f) + s0; u32x2 w; w.x = pk2(v[j][0], v[j][1]); w.y = pk2(v[j][2], v[j][3]);
            *(u32x2*)(HB + (size_t)t * 1024 + d) = w; }
        float p[32];
#pragma unroll
        for (int e = 0; e < 32; ++e) p[e] = 0.f;
#pragma unroll
        for (int j = 0; j < 4; ++j)
#pragma unroll
            for (int i = 0; i < 4; ++i) { const int k = 4 * F.lane + 256 * j + i; const LAS unsigned char* wp = lds + (size_t)(k * 8 + (k >> 2)) * 16; const float hv = v[j][i];
#pragma unroll
                for (int c = 0; c < 8; ++c) { const f32x4 w = *(const LAS f32x4*)(wp + c * 16); p[4 * c] += hv * w[0]; p[4 * c + 1] += hv * w[1]; p[4 * c + 2] += hv * w[2]; p[4 * c + 3] += hv * w[3]; }
                __builtin_amdgcn_sched_barrier(0); }
#pragma unroll
        for (int e = 0; e < 16; ++e) { const bool up = (F.lane & 32) != 0; const float keep = up ? p[e + 16] : p[e], send = up ? p[e] : p[e + 16]; p[e] = keep + __shfl_xor(send, 32); }
#pragma unroll
        for (int e = 0; e < 8; ++e) { const bool up = (F.lane & 16) != 0; const float keep = up ? p[e + 8] : p[e], send = up ? p[e] : p[e + 8]; p[e] = keep + __shfl_xor(send, 16); }
#pragma unroll
        for (int e = 0; e < 4; ++e) { const bool up = (F.lane & 8) != 0; const float keep = up ? p[e + 4] : p[e], send = up ? p[e] : p[e + 4]; p[e] = keep + __shfl_xor(send, 8); }
#pragma unroll
        for (int e = 0; e < 2; ++e) { const bool up = (F.lane & 4) != 0; const float keep = up ? p[e + 2] : p[e], send = up ? p[e] : p[e + 2]; p[e] = keep + __shfl_xor(send, 4); }
        { const bool up = (F.lane & 2) != 0; const float keep = up ? p[1] : p[0], send = up ? p[0] : p[1]; p[0] = keep + __shfl_xor(send, 2); }
        float logit = p[0] + __shfl_xor(p[0], 1);
        const int myE = F.lane >> 1; logit += br[myE];
        float tv[4]; int te[4];
#pragma unroll
        for (int k = 0; k < 4; ++k) {
            float bv = logit; int be = myE;
#pragma unroll
            for (int o = 1; o < 64; o <<= 1) { const float ov = __shfl_xor(bv, o); const int oe = __shfl_xor(be, o); if (ov > bv || (ov == bv && oe < be)) { bv = ov; be = oe; } }
            tv[k] = bv; te[k] = be; if (myE == be) logit = -3.0e38f;
        }
        const float e1 = __expf(tv[1] - tv[0]), e2 = __expf(tv[2] - tv[0]), e3 = __expf(tv[3] - tv[0]); const float invs = 1.0f / (1.0f + e1 + e2 + e3);
        if (F.lane < 4) {
            const int ek = F.lane == 0 ? te[0] : F.lane == 1 ? te[1] : F.lane == 2 ? te[2] : te[3];
            const float wk = (F.lane == 0 ? 1.0f : F.lane == 1 ? e1 : F.lane == 2 ? e2 : e3) * invs;
            const unsigned slot = __hip_atomic_fetch_add(CNT + ek * 64, 1u, __ATOMIC_RELAXED, __HIP_MEMORY_SCOPE_AGENT);
            LIST[(size_t)ek * T + slot] = t * 4 + F.lane; AW[t * 4 + F.lane] = wk;
        }
    }
    __syncthreads();
}
__device__ __forceinline__ void moe_tables(Frame& F, int l) {
    LAS int* cnt = (LAS int*)(F.lds + MOE_OFF); LAS int* toff = cnt + 32;
    const unsigned* CNT = (const unsigned*)(F.ws + WS_CTL) + CW_CNT + l * 32 * 64;
    __syncthreads();
    if (F.tid < 32) cnt[F.tid] = (int)__hip_atomic_load(CNT + F.tid * 64, __ATOMIC_RELAXED, __HIP_MEMORY_SCOPE_AGENT);
    __syncthreads();
    if (F.tid == 0) { int s = 0; for (int e = 0; e < 32; ++e) { toff[e] = s; s += (cnt[e] + 255) >> 8; } toff[32] = s; }
    __syncthreads();
}

constexpr int NPH = 11, PH_FINAL = 1 + DEPTH * NPH, PH_TOTAL = PH_FINAL + 1;
__global__ void __launch_bounds__(NWAVES * 64, 2) fwd_kernel(Args args) {
    extern __shared__ __attribute__((aligned(16))) unsigned char lds_raw[];
    Frame F;
    F.lds = (LAS unsigned char*)lds_raw; F.ws = args.ws; F.tid = threadIdx.x; F.lane = F.tid & 63; F.wave = __builtin_amdgcn_readfirstlane(F.tid >> 6); F.G = gridDim.x; F.bid = blockIdx.x; F.in = args.in;
    for (int u = F.tid; u < (LDS_BYTES - LDSCTL_OFF) / 4; u += NWAVES * 64) ((LAS unsigned*)(F.lds + LDSCTL_OFF))[u] = 0u;
    __syncthreads();
    const int lo = args.ph_lo, hi = args.ph_hi;
    XcdBarrier bar; bar.bar = (unsigned*)(F.ws + WS_CTL) + CW_BAR; bar.x = 0; bar.st = nullptr;
    if (hi - lo > 1) bar = xcd_barrier_post((unsigned*)(F.ws + WS_CTL) + CW_BAR, (volatile LAS unsigned*)(F.lds + MISC_OFF) + 8);
#define IN(k) (lo <= (k) && (k) < hi)
#define PROJ ((bf16*)(ws + WS_PROJ))
#define SEAM(k) do { if (IN(k) && IN((k) + 1)) xcd_barrier(bar); } while (0)
    unsigned char* ws = F.ws;
#define PHASE_ENTER() do { unsigned char* w_ = args.ws; asm volatile("" : "+s"(w_)); F.ws = w_; ws = w_; int t_ = threadIdx.x; asm volatile("" : "+v"(t_)); F.tid = t_; F.lane = t_ & 63; F.wave = __builtin_amdgcn_readfirstlane(t_ >> 6); } while (0)
    if (EN(0) && IN(0)) { PHASE_ENTER(); p_prologue(F); SEAM(0); }
    for (int l = 0; l < DEPTH; ++l) {
        const int pb = 1 + l * NPH;
        if (EN(1) && IN(pb + 0)) { PHASE_ENTER(); p_norm_mix(F, l, false, nullptr); SEAM(pb + 0); }
        if (EN(2) && IN(pb + 1)) { PHASE_ENTER();
            pg8::DenseOrder S; S.init(T, NPROJ, F.G, F.bid, ws + WS_HB, 1024, wl(ws, l, WL_IN), 1024);
            EpiProj E{PROJ};
            pg8::gemm_phase(F.lds, 1024, S, E);
            SEAM(pb + 1);
        }
        if (EN(3) && IN(pb + 2)) { PHASE_ENTER(); p_mla_prep(F); SEAM(pb + 2); }
        if (EN(4) && IN(pb + 3)) { PHASE_ENTER();
#ifndef SUBMASK
#define SUBMASK 7
#endif
            if (SUBMASK & 1) { pg8::DenseOrder S; S.init(T, 768, F.G, F.bid, PROJ + PCQ, NPROJ, wl(ws, l, WL_Q), 384);
              EpiQ E{(bf16*)(ws + WS_Q), (const float*)(ws + WS_RSQ), (const float*)(ws + WS_COS), (const float*)(ws + WS_SIN)};
              pg8::gemm_phase(F.lds, 384, S, E); }
            if (SUBMASK & 2) { int z = 0; asm volatile("" : "+s"(z)); pg8::DenseOrder S; S.init(T, 512, F.G, (F.bid + 64 + z) % F.G, PROJ + PCKV + z, NPROJ, wl(ws, l, WL_K) + z, 256);
              EpiK E{(bf16*)(ws + WS_K), (const float*)(ws + WS_RSKV)};
              pg8::gemm_phase(F.lds, 256, S, E); }
            if (SUBMASK & 4) { int z = 0; asm volatile("" : "+s"(z)); pg8::DenseOrder S; S.init(512, T, F.G, (F.bid + 192 + z) % F.G, wl(ws, l, WL_V) + z, 256, PROJ + PCKV + z, NPROJ);
              EpiV E{(bf16*)(ws + WS_VT), (const float*)(ws + WS_RSKV)};
              pg8::gemm_phase(F.lds, 256, S, E); }
            SEAM(pb + 3);
        }
        if (EN(5) && IN(pb + 4)) { PHASE_ENTER();
            for (int u = F.bid; u < 256; u += F.G) scan_unit(F, l, u);
            for (int a = F.bid; a < 512; a += F.G) attn_unit(F, a >> 3, (a & 7) * 256);
            SEAM(pb + 4);
        }
        if (EN(6) && IN(pb + 5)) { PHASE_ENTER(); p_hgrn_post(F, l); SEAM(pb + 5); }
        if (EN(7) && IN(pb + 6)) { PHASE_ENTER();
            if (SUBMASK & 1) { pg8::DenseOrder S; S.init(T, 1024, F.G, F.bid, ws + WS_HA, 1024, wl(ws, l, WL_OUT), 1024);
              EpiOut E{(bf16*)(ws + WS_Y), PROJ, 0};
              pg8::gemm_phase(F.lds, 512, S, E); }
            if (SUBMASK & 2) { pg8::DenseOrder S; S.init(T, 1024, F.G, F.bid, (bf16*)(ws + WS_HA) + 512, 1024, (bf16*)wl(ws, l, WL_OUT) + 512, 1024);
              EpiOut E{(bf16*)(ws + WS_Y), PROJ, 1};
              pg8::gemm_phase(F.lds, 512, S, E); }
            SEAM(pb + 6);
        }
        if (EN(8) && IN(pb + 7)) { PHASE_ENTER();
            pg8::DenseOrder S; S.init(T, 1024, F.G, F.bid, ws + WS_Y, 1024, wl(ws, l, WL_O), 1024);
            EpiWo E{(float*)(ws + WS_X), (const float*)(ws + WS_MOD) + (size_t)l * 8 * 6144 + 2 * 1024};
            pg8::gemm_phase(F.lds, 1024, S, E);
            SEAM(pb + 7);
        }
        if (EN(9) && IN(pb + 8)) { PHASE_ENTER(); p_router(F, l); SEAM(pb + 8); }
        if (EN(10) && IN(pb + 9)) { PHASE_ENTER();
            moe_tables(F, l);
            pg8::MoeOrder<true> S; S.cnt = (const LAS int*)(F.lds + MOE_OFF); S.toff = S.cnt + 32; S.NT = 8; S.G = F.G; S.c = F.bid; S.Abase = (const char*)(ws + WS_HB); S.Bbase = (const char*)wl(ws, l, WL_GU);
            S.b_expert_bytes = (size_t)2048 * 1024 * 2; S.list = (const int*)(ws + WS_LIST); S.lda = 1024; S.ldb = 1024;
            EpiGU E{(bf16*)(ws + WS_ACT), F.in[20] + (size_t)l * 32 * 2048};
            pg8::gemm_phase(F.lds, 1024, S, E);
            SEAM(pb + 9);
        }
        if (EN(11) && IN(pb + 10)) { PHASE_ENTER();
            moe_tables(F, l);
            pg8::MoeOrder<false> S; S.cnt = (const LAS int*)(F.lds + MOE_OFF); S.toff = S.cnt + 32; S.NT = 4; S.G = F.G; S.c = F.bid; S.Abase = (const char*)(ws + WS_ACT); S.Bbase = (const char*)wl(ws, l, WL_DN);
            S.b_expert_bytes = (size_t)1024 * 1024 * 2; S.list = (const int*)(ws + WS_LIST); S.lda = 1024; S.ldb = 1024;
            EpiDown E{(bf16*)(ws + WS_YR), F.in[22] + (size_t)l * 32 * 1024, (const int*)(ws + WS_LIST), (const float*)(ws + WS_AW)};
            pg8::gemm_phase(F.lds, 1024, S, E);
            SEAM(pb + 10);
        }
    }
    if (EN(12) && IN(PH_FINAL)) { PHASE_ENTER(); p_norm_mix(F, DEPTH, true, args.out); }
#undef IN
#undef SEAM
#undef PROJ
#undef PHASE_ENTER
}

extern "C" void kernel_launch(void* const* d_in, const int* in_sizes, int n_in, void* d_out, int out_size, void* d_ws, size_t ws_size, hipStream_t stream) {
    static int grid = 0;
    if (grid == 0) {
        if (n_in != 24 || in_sizes[0] != T * D || out_size != T * D || ws_size < WS_END) { fprintf(stderr, "kernel_launch: unexpected problem (n_in %d, in0 %d, out %d, ws %zu, need %zu)\n", n_in, n_in > 0 ? in_sizes[0] : -1, out_size, ws_size, (size_t)WS_END); grid = -1; return; }
        int dev = 0, cus = 0, per_cu = 0;
        if (hipGetDevice(&dev) != hipSuccess || hipDeviceGetAttribute(&cus, hipDeviceAttributeMultiprocessorCount, dev) != hipSuccess) { grid = -1; return; }
        if (hipFuncSetAttribute((const void*)fwd_kernel, hipFuncAttributeMaxDynamicSharedMemorySize, LDS_BYTES) != hipSuccess) { fprintf(stderr, "kernel_launch: hipFuncSetAttribute failed\n"); grid = -1; return; }
        if (hipOccupancyMaxActiveBlocksPerMultiprocessor(&per_cu, (const void*)fwd_kernel, NWAVES * 64, LDS_BYTES) != hipSuccess || per_cu < 1) { fprintf(stderr, "kernel_launch: occupancy query says %d\n", per_cu); (void)hipGetLastError(); }
        grid = cus;
    }
    if (grid < 0) return;
    if (hipMemsetAsync((char*)d_ws + WS_CTL, 0, CTL_ZERO_BYTES, stream) != hipSuccess) return;
    Args a{};
    for (int i = 0; i < 24; ++i) a.in[i] = (const float*)d_in[i];
    a.out = (float*)d_out; a.ws = (unsigned char*)d_ws;
#if MK_PER_PHASE
    for (int ph = 0; ph < PH_TOTAL; ++ph) { a.ph_lo = ph; a.ph_hi = ph + 1; hipLaunchKernelGGL(fwd_kernel, dim3(grid), dim3(NWAVES * 64), LDS_BYTES, stream, a); }
#else
    a.ph_lo = 0; a.ph_hi = PH_TOTAL; hipLaunchKernelGGL(fwd_kernel, dim3(grid), dim3(NWAVES * 64), LDS_BYTES, stream, a);
#endif
}
```

```cpp
#include <hip/hip_runtime.h>
#include <cstdio>
#include <cstdint>

#ifndef PHASE_MASK
#define PHASE_MASK 0xFFFFu
#endif
#define EN(k) (((PHASE_MASK) >> (k)) & 1u)
#ifndef MK_PER_PHASE
#define MK_PER_PHASE 0
#endif

#define GAS __attribute__((address_space(1)))
#define LAS __attribute__((address_space(3)))
typedef unsigned short bf16;
typedef short bf16x8 __attribute__((ext_vector_type(8)));
typedef float f32x4 __attribute__((ext_vector_type(4)));
typedef float f32x2 __attribute__((ext_vector_type(2)));
typedef float f32x16 __attribute__((ext_vector_type(16)));
typedef unsigned u32x4 __attribute__((ext_vector_type(4)));
typedef unsigned u32x2 __attribute__((ext_vector_type(2)));
typedef __bf16 bfv2 __attribute__((ext_vector_type(2)));

__device__ __forceinline__ unsigned pk2(float lo, float hi) { f32x2 v = {lo, hi}; bfv2 r = __builtin_convertvector(v, bfv2); return __builtin_bit_cast(unsigned, r); }
__device__ __forceinline__ float bf2f(unsigned short b) { return __uint_as_float(((unsigned)b) << 16); }
__device__ __forceinline__ float bflo(unsigned w) { return __uint_as_float(w << 16); }
__device__ __forceinline__ float bfhi(unsigned w) { return __uint_as_float(w & 0xffff0000u); }
__device__ __forceinline__ u32x4 pack8(f32x4 a, f32x4 b) { u32x4 w; w.x = pk2(a[0], a[1]); w.y = pk2(a[2], a[3]); w.z = pk2(b[0], b[1]); w.w = pk2(b[2], b[3]); return w; }
__device__ __forceinline__ void unpack8(u32x4 w, f32x4& a, f32x4& b) { a[0] = bflo(w.x); a[1] = bfhi(w.x); a[2] = bflo(w.y); a[3] = bfhi(w.y); b[0] = bflo(w.z); b[1] = bfhi(w.z); b[2] = bflo(w.w); b[3] = bfhi(w.w); }
__device__ __forceinline__ float sigmoidf_(float x) { return 1.0f / (1.0f + __expf(-x)); }
__device__ __forceinline__ float wave_sum(float v) {
#pragma unroll
    for (int o = 1; o < 64; o <<= 1) v += __shfl_xor(v, o);
    return v;
}
#define LDS_WAIT() asm volatile("s_waitcnt lgkmcnt(0)" ::: "memory")
#define VM_WAIT() asm volatile("s_waitcnt vmcnt(0)" ::: "memory")

#define XB_TMO      128
#define XB_XCNT(j)  (256  + 64 * (j))
#define XB_XSUB(j)  (1280 + 64 * (j))
#define XB_XGEN(j)  (2304 + 64 * (j))
#define XB_TOP      3328
#define XB_TOPGEN   3392
#define XCD_BAR_WORDS 3456
#define XB_SPIN_CAP (1u << 20)

__device__ __forceinline__ unsigned xb_ld(unsigned* p)              { return __hip_atomic_load(p, __ATOMIC_RELAXED, __HIP_MEMORY_SCOPE_AGENT); }
__device__ __forceinline__ unsigned xb_add(unsigned* p, unsigned v) { return __hip_atomic_fetch_add(p, v, __ATOMIC_RELAXED, __HIP_MEMORY_SCOPE_AGENT); }
__device__ __forceinline__ unsigned xb_xcc_id() { return (unsigned)__builtin_amdgcn_s_getreg((3 << 11) | 20) & 0xFu; }
#define XB_SPIN(cond, bar) do { unsigned _sp = 0; while (cond) { __builtin_amdgcn_s_sleep(1); \
    if ((++_sp & 255u) == 0u) { if (xb_ld(&(bar)[XB_TMO])) break; if (_sp > XB_SPIN_CAP) { atomicAdd(&(bar)[XB_TMO], 1u); break; } } } } while (0)

struct XcdBarrier { unsigned* bar; unsigned x; volatile LAS unsigned* st; };

__device__ __forceinline__ XcdBarrier xcd_barrier_post(unsigned* bar, volatile LAS unsigned* st) {
    XcdBarrier b; b.bar = bar; b.x = xb_xcc_id(); b.st = st;
    if (threadIdx.x == 0) (void)xb_add(&bar[XB_XCNT(b.x)], 1u);
    return b;
}
__device__ __forceinline__ void xcd_barrier_complete(unsigned* bar, unsigned x, unsigned& nloc, unsigned& nx) {
    const unsigned G = gridDim.x * gridDim.y * gridDim.z;
    unsigned sum, cnt, mine, sp = 0u;
    for (;;) {
        sum = 0u; cnt = 0u; mine = 0u;
#pragma unroll
        for (unsigned j = 0; j < 16; ++j) { const unsigned c = xb_ld(&bar[XB_XCNT(j)]); sum += c; cnt += (c > 0u) ? 1u : 0u; mine = (j == x) ? c : mine; }
        if (sum == G) break;
        __builtin_amdgcn_s_sleep(1);
        if ((++sp & 255u) == 0u) { if (xb_ld(&bar[XB_TMO])) break; if (sp > XB_SPIN_CAP) { atomicAdd(&bar[XB_TMO], 1u); break; } }
    }
    nloc = mine > 0u ? mine : 1u; nx = cnt > 0u ? cnt : 1u;
}
__device__ __forceinline__ void xcd_barrier(const XcdBarrier& b) {
    asm volatile("s_waitcnt vmcnt(0)" ::: "memory");
    __syncthreads();
    if (threadIdx.x == 0) {
        unsigned* bar = b.bar;
        __builtin_amdgcn_s_waitcnt(0);
        unsigned nloc = b.st[0], nx = b.st[1];
        if (nloc == 0u) { xcd_barrier_complete(bar, b.x, nloc, nx); b.st[0] = nloc; b.st[1] = nx; }
        const unsigned old = xb_add(&bar[XB_XSUB(b.x)], 1u);
        const unsigned gen = old / nloc;
        if (old + 1u == (gen + 1u) * nloc) {
            __builtin_amdgcn_fence(__ATOMIC_RELEASE, "agent");
            asm volatile("s_waitcnt vmcnt(0)" ::: "memory");
            const unsigned og = xb_add(&bar[XB_TOP], 1u);
            const unsigned tg = og / nx;
            if (og + 1u == (tg + 1u) * nx) xb_add(&bar[XB_TOPGEN], 1u);
            else XB_SPIN(xb_ld(&bar[XB_TOPGEN]) == tg, bar);
            __builtin_amdgcn_fence(__ATOMIC_ACQUIRE, "agent");
            xb_add(&bar[XB_XGEN(b.x)], 1u);
            asm volatile("s_waitcnt vmcnt(0)" ::: "memory");
        } else {
            XB_SPIN(xb_ld(&bar[XB_XGEN(b.x)]) == gen, bar);
            __builtin_amdgcn_fence(__ATOMIC_ACQUIRE, "agent");
            asm volatile("s_waitcnt vmcnt(0)" ::: "memory");
        }
    }
    __syncthreads();
}

constexpr int D = 1024, NB = 8, SEQ = 2048, T = NB * SEQ, DEPTH = 4;
constexpr int NPROJ = 5376;
constexpr int PQ = 0, PFF = 512, PFB = 1024, PI = 1536, PGT = 2048, PGA = 2560, PGB = 3584, PCQ = 4608, PCKV = 4992, PKPE = 5248;
constexpr int NE = 32, TOPK = 4, NASSIGN = T * TOPK, ACT_ROWS = NASSIGN + NE * 256;
constexpr float EPS = 1e-6f;
constexpr float QSCALE = 0.10206207261596575f * 1.4426950408889634f;

constexpr size_t MiB = 1u << 20;
constexpr size_t WS_CTL = 0, CTL_ZERO_BYTES = 1 * MiB;
constexpr size_t WS_MOD = 1 * MiB, WS_LB = 2 * MiB, WS_COS = 3 * MiB, WS_SIN = 4 * MiB, WS_RSQ = 5 * MiB, WS_RSKV = 5 * MiB + 65536, WS_AW = 6 * MiB, WS_LIST = 7 * MiB;
constexpr size_t WS_X = 16 * MiB, WS_HB = 80 * MiB, WS_PROJ = 112 * MiB, WS_Q = 280 * MiB, WS_K = 304 * MiB, WS_VT = 328 * MiB, WS_OF = 344 * MiB, WS_OB = 376 * MiB;
constexpr size_t WS_HA = 408 * MiB, WS_Y = 440 * MiB, WS_ACT = 472 * MiB, WS_YR = 616 * MiB, WS_W = 768 * MiB;
constexpr size_t WL_IN = 0, WL_Q = 11 * MiB, WL_K = 12 * MiB, WL_V = 12 * MiB + 256 * 1024, WL_OUT = 13 * MiB, WL_O = 15 * MiB, WL_GU = 17 * MiB, WL_DN = 145 * MiB, WL_STRIDE = 209 * MiB;
constexpr size_t WS_END = WS_W + DEPTH * WL_STRIDE;
static_assert((size_t)T * NPROJ * 2 <= WS_Q - WS_PROJ && (size_t)ACT_ROWS * 1024 * 2 <= WS_YR - WS_ACT && (size_t)NASSIGN * 1024 * 2 <= WS_W - WS_YR, "ws map");
constexpr int CW_BAR = 4096, CW_CNT = 16384;

constexpr int RING_BYTES = 131072;
constexpr int LDSCTL_OFF = 139264, MISC_OFF = LDSCTL_OFF + 320, MOE_OFF = LDSCTL_OFF + 1024;
constexpr int LDS_BYTES = 147456;
constexpr int NWAVES = 8;

namespace pg8 {
constexpr int BM = 256, BK = 64, HALF = 128, HTB = HALF * BK * 2, NXCD = 8, WGM = 8;
__device__ __forceinline__ int lds_byte(int r, int c) { const int st = (r >> 4) * 2 + (c >> 5), rr = r & 15, cc = c & 31, ob = rr * 64 + cc * 2; return st * 1024 + (ob ^ (((ob >> 9) & 1) << 5)); }
__device__ __forceinline__ void stage_rc(int b, int& R, int& C) { const int st = b / 1024, sb = b % 1024, swz = sb ^ (((sb >> 9) & 1) << 5); R = (st >> 1) * 16 + swz / 64; C = (st & 1) * 32 + (swz % 64) / 2; }
__device__ __forceinline__ int perm32(int rho) { const int n = rho >> 4, i = rho & 15; return 8 * (i >> 2) + 4 * n + (i & 3); }

struct Unit { const char* A; const char* B; int pm, pn, e, rowbase, mrows; };

struct DenseOrder {
    static constexpr bool GATHER_A = false;
    int nM, nN, nwg, G, c; const char* Abase; const char* Bbase; int lda, ldb;
    __device__ __forceinline__ void init(int M, int N, int G_, int c_, const void* A, int lda_, const void* B, int ldb_) { nM = M / BM; nN = N / BM; nwg = nM * nN; G = G_; c = c_; Abase = (const char*)A; Bbase = (const char*)B; lda = lda_; ldb = ldb_; }
    __device__ __forceinline__ bool next(int i, Unit& u) const {
        const long L = (long)i * G + c; if (L >= nwg) return false;
        int wgid = (int)L; { const int q = nwg / NXCD, r = nwg % NXCD, xcd = wgid % NXCD, off = wgid / NXCD; wgid = (xcd < r ? xcd * (q + 1) : r * (q + 1) + (xcd - r) * q) + off; }
        const int nig = WGM * nN, gid = wgid / nig, fm = gid * WGM, gsz = (nM - fm) < WGM ? (nM - fm) : WGM;
        u.pm = fm + ((wgid % nig) % gsz); u.pn = (wgid % nig) / gsz; u.e = 0; u.rowbase = 0; u.mrows = 256;
        u.A = Abase + (size_t)u.pm * 256 * lda * 2; u.B = Bbase + (size_t)u.pn * 256 * ldb * 2; return true;
    }
    __device__ __forceinline__ void aoff(const Unit&, const int (&R)[2], const int (&C)[2], unsigned (&v)[2][2]) const {
#pragma unroll
        for (int h = 0; h < 2; ++h)
#pragma unroll
            for (int i = 0; i < 2; ++i) v[h][i] = (unsigned)((128 * h + R[i]) * lda + C[i]) * 2u;
    }
};
template <bool GATHER> struct MoeOrder {
    static constexpr bool GATHER_A = GATHER;
    const LAS int* toff; const LAS int* cnt; int NT, G, c; const char* Abase; const char* Bbase; size_t b_expert_bytes; const int* list; int lda, ldb;
    __device__ __forceinline__ bool next(int i, Unit& u) const {
        const int L = i * G + c; if (L >= toff[NE] * NT) return false;
        int e = 0; while (toff[e + 1] * NT <= L) ++e;
        const int local = L - toff[e] * NT; u.e = e; u.pm = local / NT; u.pn = local % NT; u.rowbase = (toff[e] + u.pm) * 256; u.mrows = cnt[e] - u.pm * 256;
        u.A = GATHER ? Abase : Abase + (size_t)u.rowbase * lda * 2; u.B = Bbase + (size_t)e * b_expert_bytes + (size_t)u.pn * 256 * ldb * 2; return true;
    }
    __device__ __forceinline__ void aoff(const Unit& u, const int (&R)[2], const int (&C)[2], unsigned (&v)[2][2]) const {
#pragma unroll
        for (int h = 0; h < 2; ++h)
#pragma unroll
            for (int i = 0; i < 2; ++i) {
                if (GATHER) { const int rl = 128 * h + R[i]; const int a = list[(size_t)u.e * T + u.pm * 256 + (rl < u.mrows ? rl : 0)]; v[h][i] = (unsigned)((a >> 2) * lda + C[i]) * 2u; }
                else v[h][i] = (unsigned)((128 * h + R[i]) * lda + C[i]) * 2u;
            }
    }
};

template <class Epi, class Sched>
__device__ __forceinline__ void gemm_phase(LAS unsigned char* lds, const int K, const Sched& S, const Epi& E) {
    int tid_ = threadIdx.x; asm volatile("" : "+v"(tid_));
    const int tid = tid_, wid = __builtin_amdgcn_readfirstlane(tid >> 6), lane = tid & 63, wr = wid >> 2, wc = wid & 3, fr = lane & 15, fq = lane >> 4;
    const int nt = K / BK;
    int sR[2], sC[2]; unsigned voffB[2];
#pragma unroll
    for (int i = 0; i < 2; ++i) { stage_rc(tid * 16 + i * 8192, sR[i], sC[i]); const int Rb = (sR[i] & ~31) + perm32(sR[i] & 31); voffB[i] = (unsigned)(Rb * S.ldb + sC[i]) * 2u; }
    constexpr bool GA = Sched::GATHER_A;
    unsigned voffA[2];
#pragma unroll
    for (int i = 0; i < 2; ++i) voffA[i] = (unsigned)(sR[i] * S.lda + sC[i]) * 2u;
    const size_t kstep = (size_t)(BK * 2);
    const size_t hstepB = (size_t)HALF * S.ldb * 2, hstepA = (size_t)HALF * S.lda * 2;
    const unsigned ldsw = (unsigned)wid * 1024u;
    const int aoff = lds_byte(wr * 64 + fr, fq * 8), boff = lds_byte(wc * 32 + fr, fq * 8);
#define PG8_SA(b, h) (((b) * 2 + (h)) * HTB)
#define PG8_SB(b, h) ((4 + (b) * 2 + (h)) * HTB)
#define PG8_STAGE(bufoff, gbase, voff) do { _Pragma("unroll") for (int _i = 0; _i < 2; ++_i) \
        __builtin_amdgcn_global_load_lds((const unsigned*)((const char*)(gbase) + (voff)[_i]), (LAS unsigned*)(lds + (bufoff) + ldsw + _i * 8192), 16, 0, 0); } while (0)
#define PG8_STAGEA(bufoff, gbase, h, nx) do { _Pragma("unroll") for (int _i = 0; _i < 2; ++_i) { \
        const char* _p = GA ? (const char*)(gbase) + ((nx) ? nvA[h][_i] : vA[h][_i]) : (const char*)(gbase) + (size_t)(h) * hstepA + voffA[_i]; \
        __builtin_amdgcn_global_load_lds((const unsigned*)_p, (LAS unsigned*)(lds + (bufoff) + ldsw + _i * 8192), 16, 0, 0); } } while (0)
#define PG8_LDA(dst, b, h) do { _Pragma("unroll") for (int m = 0; m < 4; ++m) _Pragma("unroll") for (int k = 0; k < 2; ++k) dst[m][k] = *(const LAS bf16x8*)(lds + PG8_SA(b, h) + aoff + m * 2048 + k * 1024); } while (0)
#define PG8_LDB(dst, b, h) do { _Pragma("unroll") for (int n = 0; n < 2; ++n) _Pragma("unroll") for (int k = 0; k < 2; ++k) dst[n][k] = *(const LAS bf16x8*)(lds + PG8_SB(b, h) + boff + n * 2048 + k * 1024); } while (0)
#define PG8_MMA(ai, bj, At, Bt) do { __builtin_amdgcn_s_setprio(1); _Pragma("unroll") for (int m = 0; m < 4; ++m) _Pragma("unroll") for (int n = 0; n < 2; ++n) _Pragma("unroll") for (int k = 0; k < 2; ++k) \
        acc[ai][bj][m][n] = __builtin_amdgcn_mfma_f32_16x16x32_bf16(Bt[n][k], At[m][k], acc[ai][bj][m][n], 0, 0, 0); __builtin_amdgcn_s_setprio(0); } while (0)
#define PG8_WAIT_V(n) asm volatile("s_waitcnt vmcnt(" #n ")" ::: "memory")
#define PG8_WAIT_L(n) asm volatile("s_waitcnt lgkmcnt(" #n ")" ::: "memory")
#define PG8_BAR __builtin_amdgcn_s_barrier()
#define PG8_SCHED __builtin_amdgcn_sched_barrier(0)
    Unit cur, nxt; int ui = 0;
    if (!S.next(0, cur)) return;
    f32x4 acc[2][2][4][2];
#pragma unroll
    for (int a = 0; a < 2; ++a)
#pragma unroll
        for (int b = 0; b < 2; ++b)
#pragma unroll
            for (int m = 0; m < 4; ++m)
#pragma unroll
                for (int n = 0; n < 2; ++n) acc[a][b][m][n] = (f32x4){0.f, 0.f, 0.f, 0.f};
    bf16x8 At[4][2], B0[2][2], B1[2][2];
    unsigned vA[2][2], nvA[2][2];
    if constexpr (GA) { S.aoff(cur, sR, sC, vA); }
    const char* cA = cur.A; const char* cB = cur.B;
    PG8_STAGE(PG8_SB(0, 0), cB, voffB); PG8_STAGE(PG8_SB(0, 1), cB + hstepB, voffB); PG8_STAGEA(PG8_SA(0, 0), cA, 0, false); PG8_STAGEA(PG8_SA(0, 1), cA, 1, false);
    if (wr == 1) PG8_BAR;
    PG8_WAIT_V(2); PG8_BAR;
    PG8_STAGE(PG8_SB(1, 0), cB + kstep, voffB); PG8_STAGEA(PG8_SA(1, 0), cA + kstep, 0, false); PG8_STAGE(PG8_SB(1, 1), cB + hstepB + kstep, voffB);
    PG8_WAIT_V(6); PG8_BAR;
    for (;;) {
        const bool has_next = S.next(ui + 1, nxt);
        const char* nA = has_next ? nxt.A : cA; const char* nB = has_next ? nxt.B : cB;
        if constexpr (GA) {
            if (has_next) S.aoff(nxt, sR, sC, nvA);
            else {
#pragma unroll
                for (int h = 0; h < 2; ++h)
#pragma unroll
                    for (int i = 0; i < 2; ++i) nvA[h][i] = vA[h][i]; } }
#pragma unroll 1
        for (int t = 0; t < nt; t += 2) {
            const bool last = (t == nt - 2);
            const char* a1 = cA + (size_t)(t + 1) * kstep;
            const char* a2 = last ? nA : cA + (size_t)(t + 2) * kstep; const char* b2 = last ? nB : cB + (size_t)(t + 2) * kstep;
            const char* a3 = a2 + kstep; const char* b3 = b2 + kstep;
            PG8_LDB(B0, 0, 0); PG8_LDB(B1, 0, 1); PG8_SCHED; PG8_LDA(At, 0, 0); PG8_STAGEA(PG8_SA(1, 1), a1, 1, false);
            PG8_WAIT_V(8); PG8_WAIT_L(0); PG8_BAR; PG8_MMA(0, 0, At, B0); PG8_MMA(0, 1, At, B1); PG8_BAR; PG8_SCHED;
            PG8_LDA(At, 0, 1); PG8_STAGE(PG8_SB(0, 0), b2, voffB); PG8_STAGE(PG8_SB(0, 1), b2 + hstepB, voffB); PG8_STAGEA(PG8_SA(0, 0), a2, 0, last);
            PG8_WAIT_V(8); PG8_WAIT_L(0); PG8_BAR; PG8_MMA(1, 0, At, B0); PG8_MMA(1, 1, At, B1); PG8_BAR; PG8_SCHED;
            PG8_LDB(B0, 1, 0); PG8_LDB(B1, 1, 1); PG8_SCHED; PG8_LDA(At, 1, 0); PG8_STAGEA(PG8_SA(0, 1), a2, 1, last);
            PG8_WAIT_V(8); PG8_WAIT_L(0); PG8_BAR; PG8_MMA(0, 0, At, B0); PG8_MMA(0, 1, At, B1); PG8_BAR; PG8_SCHED;
            PG8_LDA(At, 1, 1); PG8_STAGE(PG8_SB(1, 0), b3, voffB); PG8_STAGE(PG8_SB(1, 1), b3 + hstepB, voffB); PG8_STAGEA(PG8_SA(1, 0), a3, 0, last);
            PG8_WAIT_V(8); PG8_WAIT_L(0); PG8_BAR; PG8_MMA(1, 0, At, B0); PG8_MMA(1, 1, At, B1); PG8_BAR; PG8_SCHED;
        }
        if (wr == 0) PG8_BAR;
        E(acc, cur, wr, wc, fr, fq);
        if (!has_next) break;
#pragma unroll
        for (int a = 0; a < 2; ++a)
#pragma unroll
            for (int b = 0; b < 2; ++b)
#pragma unroll
                for (int m = 0; m < 4; ++m)
#pragma unroll
                    for (int n = 0; n < 2; ++n) acc[a][b][m][n] = (f32x4){0.f, 0.f, 0.f, 0.f};
        cur = nxt; cA = nA; cB = nB; ++ui;
        if constexpr (GA) {
#pragma unroll
            for (int h = 0; h < 2; ++h)
#pragma unroll
                for (int i = 0; i < 2; ++i) vA[h][i] = nvA[h][i]; }
        if (wr == 1) PG8_BAR;
    }
    PG8_WAIT_V(0);
    PG8_BAR;
#undef PG8_SA
#undef PG8_SB
#undef PG8_STAGE
#undef PG8_STAGEA
#undef PG8_LDA
#undef PG8_LDB
#undef PG8_MMA
#undef PG8_WAIT_V
#undef PG8_WAIT_L
#undef PG8_BAR
#undef PG8_SCHED
}
}
using pg8::Unit;
typedef const f32x4 (&AccRef)[2][2][4][2];

struct Args {
    const float* in[24]; float* out; unsigned char* ws; int ph_lo, ph_hi;
};
struct Frame {
    LAS unsigned char* lds; unsigned char* ws; int tid, lane, wave, G, bid;
    const float* const* in;
};
__device__ __forceinline__ unsigned char* wl(unsigned char* ws, int l, size_t off) { return ws + WS_W + (size_t)l * WL_STRIDE + off; }

#define EPI_LOOP_BEGIN _Pragma("unroll") for (int ai = 0; ai < 2; ++ai) _Pragma("unroll") for (int m = 0; m < 4; ++m) { const int rl = ai * 128 + wr * 64 + m * 16 + fr; _Pragma("unroll") for (int bj = 0; bj < 2; ++bj) { const int cl = bj * 128 + wc * 32 + 8 * fq; const f32x4 v0 = acc[ai][bj][m][0], v1 = acc[ai][bj][m][1];
#define EPI_LOOP_END } asm volatile("" ::: "memory"); }

struct EpiProj {
    bf16* O;
    __device__ __forceinline__ void operator()(AccRef acc, const Unit& u, int wr, int wc, int fr, int fq) const {
        EPI_LOOP_BEGIN
            *(u32x4*)(O + (size_t)(u.pm * 256 + rl) * NPROJ + u.pn * 256 + cl) = pack8(v0, v1);
        EPI_LOOP_END
    }
};
struct EpiQ {
    bf16* Q; const float* rsq; const float* cs; const float* sn;
    __device__ __forceinline__ void operator()(AccRef acc, const Unit& u, int wr, int wc, int fr, int fq) const {
        EPI_LOOP_BEGIN
            const int t = u.pm * 256 + rl, c0 = u.pn * 256 + cl, head = c0 / 96, w = c0 - head * 96, b = t >> 11, s = t & 2047;
            const float sc = rsq[t] * QSCALE;
            bf16* qp = Q + ((size_t)(b * 8 + head) * SEQ + s) * 96;
            f32x4 a = v0 * sc, d = v1 * sc;
            if (w < 64) { *(u32x4*)(qp + w) = pack8(a, d); }
            else { const int g = (w - 64) >> 3; const f32x4 co = *(const f32x4*)(cs + (size_t)t * 16 + 4 * g), si = *(const f32x4*)(sn + (size_t)t * 16 + 4 * g);
                const f32x4 o1 = a * co - d * si, o2 = d * co + a * si;
                u32x2 w1, w2; w1.x = pk2(o1[0], o1[1]); w1.y = pk2(o1[2], o1[3]); w2.x = pk2(o2[0], o2[1]); w2.y = pk2(o2[2], o2[3]);
                *(u32x2*)(qp + 64 + 4 * g) = w1; *(u32x2*)(qp + 80 + 4 * g) = w2; }
        EPI_LOOP_END
    }
};
struct EpiK {
    bf16* Kb; const float* rskv;
    __device__ __forceinline__ void operator()(AccRef acc, const Unit& u, int wr, int wc, int fr, int fq) const {
        EPI_LOOP_BEGIN
            const int t = u.pm * 256 + rl, c0 = u.pn * 256 + cl, head = c0 >> 6, w = c0 & 63, b = t >> 11, s = t & 2047;
            const float sc = rskv[t];
            *(u32x4*)(Kb + ((size_t)(b * 8 + head) * SEQ + s) * 96 + w) = pack8(v0 * sc, v1 * sc);
        EPI_LOOP_END
    }
};
struct EpiV {
    bf16* VT; const float* rskv;
    __device__ __forceinline__ void operator()(AccRef acc, const Unit& u, int wr, int wc, int fr, int fq) const {
        EPI_LOOP_BEGIN
            const int f = u.pm * 256 + rl, t0 = u.pn * 256 + cl, b = t0 >> 11, s = t0 & 2047, head = f >> 6, dv = f & 63;
            const f32x4 r0 = *(const f32x4*)(rskv + t0), r1 = *(const f32x4*)(rskv + t0 + 4);
            *(u32x4*)(VT + ((size_t)(b * 8 + head) * 64 + dv) * SEQ + s) = pack8(v0 * r0, v1 * r1);
        EPI_LOOP_END
    }
};
struct EpiOut {
    bf16* Y; const bf16* proj; int pass;
    __device__ __forceinline__ void operator()(AccRef acc, const Unit& u, int wr, int wc, int fr, int fq) const {
        EPI_LOOP_BEGIN
            const int t = u.pm * 256 + rl, c0 = u.pn * 256 + cl;
            const u32x4 gw = *(const u32x4*)(proj + (size_t)t * NPROJ + (pass == 0 ? PGA : PGB) + c0);
            f32x4 g0, g1; unpack8(gw, g0, g1);
#pragma unroll
            for (int j = 0; j < 4; ++j) { g0[j] = sigmoidf_(g0[j]); g1[j] = sigmoidf_(g1[j]); }
            f32x4 a = v0 * g0, d = v1 * g1;
            bf16* yp = Y + (size_t)t * 1024 + c0;
            if (pass == 1) { f32x4 p0, p1; unpack8(*(const u32x4*)yp, p0, p1); a += p0; d += p1; }
            *(u32x4*)yp = pack8(a, d);
        EPI_LOOP_END
    }
};
struct EpiWo {
    float* X; const float* g1;
    __device__ __forceinline__ void operator()(AccRef acc, const Unit& u, int wr, int wc, int fr, int fq) const {
        EPI_LOOP_BEGIN
            const int t = u.pm * 256 + rl, c0 = u.pn * 256 + cl, b = t >> 11;
            const float* gp = g1 + (size_t)b * 6144 + c0; float* xp = X + (size_t)t * 1024 + c0;
            const f32x4 ga = *(const f32x4*)gp, gb = *(const f32x4*)(gp + 4);
            f32x4 xa = *(const f32x4*)xp, xb = *(const f32x4*)(xp + 4);
            xa += ga * v0; xb += gb * v1;
            *(f32x4*)xp = xa; *(f32x4*)(xp + 4) = xb;
        EPI_LOOP_END
    }
};
struct EpiGU {
    bf16* ACT; const float* bgu;
    __device__ __forceinline__ void operator()(AccRef acc, const Unit& u, int wr, int wc, int fr, int fq) const {
#pragma unroll
        for (int ai = 0; ai < 2; ++ai)
#pragma unroll
            for (int m = 0; m < 4; ++m) {
                const int rl = ai * 128 + wr * 64 + m * 16 + fr; const int j0 = u.pn * 128 + wc * 32 + 8 * fq;
                const float* bp = bgu + (size_t)u.e * 2048 + 2 * j0;
                const f32x4 b0 = *(const f32x4*)bp, b1 = *(const f32x4*)(bp + 4), b2 = *(const f32x4*)(bp + 8), b3 = *(const f32x4*)(bp + 12);
                const float bg[8] = {b0[0], b0[2], b1[0], b1[2], b2[0], b2[2], b3[0], b3[2]}, bu[8] = {b0[1], b0[3], b1[1], b1[3], b2[1], b2[3], b3[1], b3[3]};
                float o[8];
#pragma unroll
                for (int j = 0; j < 8; ++j) {
                    float g = acc[ai][0][m][j >> 2][j & 3] + bg[j], up = acc[ai][1][m][j >> 2][j & 3] + bu[j];
                    g = fminf(g, 7.0f); up = fminf(fmaxf(up, -7.0f), 7.0f);
                    o[j] = (up + 1.0f) * g * sigmoidf_(1.702f * g); }
                u32x4 w; w.x = pk2(o[0], o[1]); w.y = pk2(o[2], o[3]); w.z = pk2(o[4], o[5]); w.w = pk2(o[6], o[7]);
                *(u32x4*)(ACT + (size_t)(u.rowbase + rl) * 1024 + j0) = w;
                asm volatile("" ::: "memory");
            }
    }
};
struct EpiDown {
    bf16* YR; const float* bd; const int* list; const float* aw;
    __device__ __forceinline__ void operator()(AccRef acc, const Unit& u, int wr, int wc, int fr, int fq) const {
#pragma unroll
        for (int ai = 0; ai < 2; ++ai)
#pragma unroll
            for (int m = 0; m < 4; ++m) {
                const int rl = ai * 128 + wr * 64 + m * 16 + fr;
                if (rl < u.mrows) {
                    const int a = list[(size_t)u.e * T + u.pm * 256 + rl]; const float w = aw[a];
#pragma unroll
                    for (int bj = 0; bj < 2; ++bj) { const int c0 = u.pn * 256 + bj * 128 + wc * 32 + 8 * fq; const float* bp = bd + (size_t)u.e * 1024 + c0;
                        const f32x4 ba = *(const f32x4*)bp, bb = *(const f32x4*)(bp + 4);
                        *(u32x4*)(YR + (size_t)a * 1024 + c0) = pack8((acc[ai][bj][m][0] + ba) * w, (acc[ai][bj][m][1] + bb) * w); }
                }
                asm volatile("" ::: "memory");
            }
    }
};

enum { MAP_ID = 0, MAP_WIN = 1, MAP_WQ = 2, MAP_WKV = 3, MAP_GU = 4 };
__device__ __forceinline__ int map_row(int kind, int n) {
    if (kind == MAP_WIN) { if (n < 2560) return n; if (n < 2944) return PCQ + (n - 2560); if (n < 3200) return PCKV + (n - 2944); if (n < 3232) return PKPE + (n - 3200); return PGA + (n - 3232); }
    if (kind == MAP_WQ) { const int h = n / 96, j = n - h * 96; if (j < 64) return n; const int r = j - 64, i = r & 15; return h * 96 + 64 + 8 * (i >> 2) + ((r >> 4) << 2) + (i & 3); }
    if (kind == MAP_WKV) { const int h = n >> 7, j = n & 127; return (j < 64) ? (h * 64 + j) : (512 + h * 64 + (j - 64)); }
    if (kind == MAP_GU) { const int j = n >> 1, bj = n & 1; return (j >> 7) * 256 + bj * 128 + (j & 127); }
    return n;
}
__device__ __forceinline__ void conv_item(const float* W, int N, const float* kscale, bf16* WT, int dstK, int koff, int kind, LAS float* scr, int kb, int nb, int lane) {
    const int k0 = 64 * kb, n0 = 32 * nb;
#pragma unroll 8
    for (int i = 0; i < 32; ++i) { const int kk = 2 * i + (lane >> 5); float v = W[(size_t)(k0 + kk) * N + n0 + (lane & 31)]; if (kscale) v *= kscale[k0 + kk]; scr[kk * 33 + (lane & 31)] = v; }
    LDS_WAIT(); asm volatile("" ::: "memory");
    const int c = lane & 7;
#pragma unroll
    for (int j = 0; j < 4; ++j) { const int n = (lane >> 3) + 8 * j; const LAS float* s = scr + (8 * c) * 33 + n;
        u32x4 o; o.x = pk2(s[0 * 33], s[1 * 33]); o.y = pk2(s[2 * 33], s[3 * 33]); o.z = pk2(s[4 * 33], s[5 * 33]); o.w = pk2(s[6 * 33], s[7 * 33]);
        *(u32x4*)(WT + (size_t)map_row(kind, n0 + n) * dstK + koff + k0 + 8 * c) = o; }
    LDS_WAIT(); asm volatile("" ::: "memory");
}
__device__ __forceinline__ void p_prologue(Frame& F) {
    const float* const* in = F.in;
    {
        LAS float* cond = (LAS float*)F.lds;
        LAS float* part = (LAS float*)(F.lds + 32768);
        for (int i = F.tid; i < 8 * 1024; i += 512) { const float v = in[1][i]; cond[i] = v * sigmoidf_(v); }
        __syncthreads();
        for (int it = F.bid; it < DEPTH * 96; it += F.G) {
            const int l = it / 96, n0 = (it % 96) * 64, col = F.tid & 63, kg = F.tid >> 6;
            const float* w = in[3] + (size_t)l * 1024 * 6144 + n0 + col;
            float a[8] = {0.f, 0.f, 0.f, 0.f, 0.f, 0.f, 0.f, 0.f};
            for (int k = kg * 128; k < kg * 128 + 128; ++k) { const float wv = w[(size_t)k * 6144];
#pragma unroll
                for (int b = 0; b < 8; ++b) a[b] += cond[b * 1024 + k] * wv; }
#pragma unroll
            for (int b = 0; b < 8; ++b) part[(kg * 8 + b) * 64 + col] = a[b];
            __syncthreads();
            { const int b = F.tid >> 6; float s = 0.f;
#pragma unroll
              for (int g = 0; g < 8; ++g) s += part[(g * 8 + b) * 64 + col];
              ((float*)(F.ws + WS_MOD))[((size_t)l * 8 + b) * 6144 + n0 + col] = s + in[4][(size_t)l * 6144 + n0 + col]; }
            __syncthreads();
        }
    }
    const int gtid = F.bid * 512 + F.tid, NT_ = F.G * 512;
    for (int i = gtid; i < 1024; i += NT_) {
        float lg[DEPTH], mx = -1e30f; for (int l = 0; l < DEPTH; ++l) { lg[l] = in[8][(size_t)l * 1024 + i]; mx = fmaxf(mx, lg[l]); }
        float s = 0.f; for (int l = 0; l < DEPTH; ++l) { lg[l] = __expf(lg[l] - mx); s += lg[l]; }
        float c = 0.f; float* lb = (float*)(F.ws + WS_LB);
        for (int l = 0; l < DEPTH; ++l) { if (l > 0) c += lg[l] / s; lb[(size_t)l * 1024 + i] = c; }
    }
    for (int i = gtid; i < T * 16; i += NT_) {
        const int t = i >> 4, j = i & 15; const int pos = ((const int*)in[2])[t];
        const double base4[4] = {1.0, 0.5623413251903491, 0.31622776601683794, 0.1778279410038923};
        double f = base4[j & 3]; for (int q = 0; q < (j >> 2); ++q) f *= 0.1;
        const double ang = (double)pos * f; const double n = __builtin_rint(ang * 0.15915494309189535); const float r = (float)(ang - n * 6.283185307179586);
        ((float*)(F.ws + WS_COS))[i] = cosf(r); ((float*)(F.ws + WS_SIN))[i] = sinf(r);
    }
    for (int l = 0; l < DEPTH; ++l) { u32x4* p = (u32x4*)(wl(F.ws, l, WL_IN) + (size_t)5280 * 1024 * 2); for (int i = gtid; i < 96 * 1024 * 2 / 16; i += NT_) p[i] = (u32x4){0u, 0u, 0u, 0u}; }
    {
        LAS float* scr = (LAS float*)(F.lds + F.wave * 16384);
        const int gw = F.bid * NWAVES + F.wave, NGW = F.G * NWAVES;
        constexpr int I_IN = 16 * 165, I_Q = 6 * 24, I_KV = 4 * 32, I_OH = 8 * 32, I_OM = 8 * 32, I_O = 16 * 32, I_GU = 32 * 16 * 64, I_DN = 32 * 16 * 32;
        constexpr int I_LAYER = I_IN + I_Q + I_KV + I_OH + I_OM + I_O + I_GU + I_DN;
        for (int it = gw; it < DEPTH * I_LAYER; it += NGW) {
            const int l = it / I_LAYER; int r = it - l * I_LAYER;
            if (r < I_IN) { conv_item(in[7] + (size_t)l * 1024 * 5280, 5280, nullptr, (bf16*)wl(F.ws, l, WL_IN), 1024, 0, MAP_WIN, scr, r / 165, r % 165, F.lane); continue; } r -= I_IN;
            if (r < I_Q) { conv_item(in[12] + (size_t)l * 384 * 768, 768, in[11] + l * 384, (bf16*)wl(F.ws, l, WL_Q), 384, 0, MAP_WQ, scr, r / 24, r % 24, F.lane); continue; } r -= I_Q;
            if (r < I_KV) { conv_item(in[14] + (size_t)l * 256 * 1024, 1024, in[13] + l * 256, (bf16*)wl(F.ws, l, WL_K), 256, 0, MAP_WKV, scr, r / 32, r % 32, F.lane); continue; } r -= I_KV;
            if (r < I_OH) { conv_item(in[10] + (size_t)l * 512 * 1024, 1024, nullptr, (bf16*)wl(F.ws, l, WL_OUT), 1024, 0, MAP_ID, scr, r / 32, r % 32, F.lane); continue; } r -= I_OH;
            if (r < I_OM) { conv_item(in[15] + (size_t)l * 512 * 1024, 1024, nullptr, (bf16*)wl(F.ws, l, WL_OUT), 1024, 512, MAP_ID, scr, r / 32, r % 32, F.lane); continue; } r -= I_OM;
            if (r < I_O) { conv_item(in[16] + (size_t)l * 1024 * 1024, 1024, nullptr, (bf16*)wl(F.ws, l, WL_O), 1024, 0, MAP_ID, scr, r / 32, r % 32, F.lane); continue; } r -= I_O;
            if (r < I_GU) { const int e = r / (16 * 64), q = r % (16 * 64); conv_item(in[19] + ((size_t)l * 32 + e) * 1024 * 2048, 2048, nullptr, (bf16*)wl(F.ws, l, WL_GU) + (size_t)e * 2048 * 1024, 1024, 0, MAP_GU, scr, q / 64, q % 64, F.lane); continue; } r -= I_GU;
            { const int e = r / (16 * 32), q = r % (16 * 32); conv_item(in[21] + ((size_t)l * 32 + e) * 1024 * 1024, 1024, nullptr, (bf16*)wl(F.ws, l, WL_DN) + (size_t)e * 1024 * 1024, 1024, 0, MAP_ID, scr, q / 32, q % 32, F.lane); }
        }
    }
}

__device__ __forceinline__ void p_norm_mix(Frame& F, int l, bool fin, float* out) {
    const float* const* in = F.in;
    float* X = (float*)(F.ws + WS_X); const float* MOD = (const float*)(F.ws + WS_MOD); const bf16* YR = (const bf16*)(F.ws + WS_YR); bf16* HB = (bf16*)(F.ws + WS_HB);
    const int gw = F.bid * NWAVES + F.wave, NGW = F.G * NWAVES;
    for (int t = gw; t < T; t += NGW) {
        const int b = t >> 11; f32x4 v[4];
        const float* src = (l == 0) ? in[0] + (size_t)t * 1024 : X + (size_t)t * 1024;
#pragma unroll
        for (int j = 0; j < 4; ++j) v[j] = *(const f32x4*)(src + 4 * F.lane + 256 * j);
        if (l > 0) {
            const float* g2 = MOD + ((size_t)(l - 1) * 8 + b) * 6144 + 5 * 1024;
#pragma unroll
            for (int j = 0; j < 4; ++j) { f32x4 s = {0.f, 0.f, 0.f, 0.f};
#pragma unroll
                for (int k = 0; k < 4; ++k) { const u32x2 w = *(const u32x2*)(YR + ((size_t)t * 4 + k) * 1024 + 4 * F.lane + 256 * j); s[0] += bflo(w.x); s[1] += bfhi(w.x); s[2] += bflo(w.y); s[3] += bfhi(w.y); }
                v[j] += *(const f32x4*)(g2 + 4 * F.lane + 256 * j) * s; }
        }
        float ss = 0.f;
#pragma unroll
        for (int j = 0; j < 4; ++j) ss += (v[j][0] * v[j][0] + v[j][1] * v[j][1]) + (v[j][2] * v[j][2] + v[j][3] * v[j][3]);
        const float rs = rsqrtf(wave_sum(ss) * (1.0f / 1024.0f) + EPS);
        if (fin) {
            const float* gn = in[23];
#pragma unroll
            for (int j = 0; j < 4; ++j) { const int d = 4 * F.lane + 256 * j; *(f32x4*)(out + (size_t)t * 1024 + d) = v[j] * rs * *(const f32x4*)(gn + d); }
        } else {
            const float* gn = in[5] + (size_t)l * 1024; const float* sh = MOD + ((size_t)l * 8 + b) * 6144; const float* sc = sh + 1024;
#pragma unroll
            for (int j = 0; j < 4; ++j) { const int d = 4 * F.lane + 256 * j; *(f32x4*)(X + (size_t)t * 1024 + d) = v[j];
                const f32x4 g = *(const f32x4*)(gn + d), s1 = *(const f32x4*)(sc + d), s0 = *(const f32x4*)(sh + d);
                const f32x4 h = v[j] * rs * g * (s1 + 1.0f) + s0; u32x2 w; w.x = pk2(h[0], h[1]); w.y = pk2(h[2], h[3]);
                *(u32x2*)(HB + (size_t)t * 1024 + d) = w; }
        }
    }
}
__device__ __forceinline__ void p_mla_prep(Frame& F) {
    const bf16* PROJ = (const bf16*)(F.ws + WS_PROJ); float* RSQ = (float*)(F.ws + WS_RSQ); float* RSKV = (float*)(F.ws + WS_RSKV); bf16* Kb = (bf16*)(F.ws + WS_K);
    const float* CS = (const float*)(F.ws + WS_COS); const float* SN = (const float*)(F.ws + WS_SIN);
    const int gw = F.bid * NWAVES + F.wave, NGW = F.G * NWAVES;
    for (int t = gw; t < T; t += NGW) {
        const bf16* row = PROJ + (size_t)t * NPROJ;
        float sq = 0.f, skv = 0.f;
#pragma unroll
        for (int j = 0; j < 6; ++j) { const float v = bf2f(row[PCQ + F.lane + 64 * j]); sq += v * v; }
#pragma unroll
        for (int j = 0; j < 4; ++j) { const float v = bf2f(row[PCKV + F.lane + 64 * j]); skv += v * v; }
        sq = wave_sum(sq); skv = wave_sum(skv);
        if (F.lane == 0) { RSQ[t] = rsqrtf(sq * (1.0f / 384.0f) + EPS); RSKV[t] = rsqrtf(skv * (1.0f / 256.0f) + EPS); }
        if (F.lane < 16) {
            const float x1 = bf2f(row[PKPE + F.lane]), x2 = bf2f(row[PKPE + 16 + F.lane]), co = CS[(size_t)t * 16 + F.lane], si = SN[(size_t)t * 16 + F.lane];
            const bf16 o1 = (bf16)(pk2(x1 * co - x2 * si, 0.f) & 0xffffu), o2 = (bf16)(pk2(x2 * co + x1 * si, 0.f) & 0xffffu);
            const int b = t >> 11, s = t & 2047;
#pragma unroll
            for (int h = 0; h < 8; ++h) { bf16* kp = Kb + ((size_t)(b * 8 + h) * SEQ + s) * 96; kp[64 + F.lane] = o1; kp[80 + F.lane] = o2; }
        }
    }
}
__device__ __forceinline__ void p_hgrn_post(Frame& F, int l) {
    const float* OFp = (const float*)(F.ws + WS_OF); const float* OBp = (const float*)(F.ws + WS_OB); const bf16* PROJ = (const bf16*)(F.ws + WS_PROJ); bf16* HA = (bf16*)(F.ws + WS_HA);
    const float* gn = F.in[9] + (size_t)l * 128;
    const int gw = F.bid * NWAVES + F.wave, NGW = F.G * NWAVES;
    for (int t = gw; t < T; t += NGW) {
        const int c = 8 * F.lane;
        f32x4 a0 = *(const f32x4*)(OFp + (size_t)t * 512 + c) + *(const f32x4*)(OBp + (size_t)t * 512 + c), a1 = *(const f32x4*)(OFp + (size_t)t * 512 + c + 4) + *(const f32x4*)(OBp + (size_t)t * 512 + c + 4);
        float ss = (a0[0] * a0[0] + a0[1] * a0[1]) + (a0[2] * a0[2] + a0[3] * a0[3]) + (a1[0] * a1[0] + a1[1] * a1[1]) + (a1[2] * a1[2] + a1[3] * a1[3]);
#pragma unroll
        for (int o = 1; o < 16; o <<= 1) ss += __shfl_xor(ss, o);
        const float rs = rsqrtf(ss * (1.0f / 128.0f) + EPS);
        f32x4 g0, g1; unpack8(*(const u32x4*)(PROJ + (size_t)t * NPROJ + PGT + c), g0, g1);
        const f32x4 n0 = *(const f32x4*)(gn + (c & 127)), n1 = *(const f32x4*)(gn + (c & 127) + 4);
#pragma unroll
        for (int j = 0; j < 4; ++j) { a0[j] = a0[j] * rs * n0[j] * sigmoidf_(g0[j]); a1[j] = a1[j] * rs * n1[j] * sigmoidf_(g1[j]); }
        *(u32x4*)(HA + (size_t)t * 1024 + c) = pack8(a0, a1);
    }
}

__device__ __forceinline__ void scan_unit(Frame& F, int l, int u) {
    const int vq = u & 3, dir = (u >> 2) & 1, hh = (u >> 3) & 3, b = u >> 5;
    const bf16* PROJ = (const bf16*)(F.ws + WS_PROJ); const float* LB = (const float*)(F.ws + WS_LB) + ((size_t)l * 2 + dir) * 512 + hh * 128;
    float* OUT = (float*)(F.ws + (dir ? WS_OB : WS_OF));
    LAS float* sq = (LAS float*)F.lds;
    LAS float* sf = sq + 32 * 128;
    LAS float* sv = sf + 32 * 128;
    LAS float* op = sv + 32 * 32;
    const int v = F.tid & 31, dg = F.tid >> 5;
    float st[8];
#pragma unroll
    for (int j = 0; j < 8; ++j) st[j] = 0.f;
    const int fcol = (dir ? PFB : PFF) + hh * 128;
    for (int blk = 0; blk < SEQ / 32; ++blk) {
        __syncthreads();
        for (int idx = F.tid; idx < 32 * 128; idx += 512) { const int tl = idx >> 7, d = idx & 127; const int s = dir ? (SEQ - 1 - (blk * 32 + tl)) : (blk * 32 + tl);
            const bf16* row = PROJ + (size_t)(b * SEQ + s) * NPROJ;
            const float qv = bf2f(row[PQ + hh * 128 + d]), fv = bf2f(row[fcol + d]), lb = LB[d];
            sq[idx] = qv * sigmoidf_(qv); sf[idx] = lb + (1.0f - lb) * sigmoidf_(fv); }
        for (int idx = F.tid; idx < 32 * 32; idx += 512) { const int tl = idx >> 5, vv = idx & 31; const int s = dir ? (SEQ - 1 - (blk * 32 + tl)) : (blk * 32 + tl);
            sv[idx] = bf2f(PROJ[(size_t)(b * SEQ + s) * NPROJ + PI + hh * 128 + vq * 32 + vv]); }
        __syncthreads();
        for (int tl = 0; tl < 32; ++tl) {
            const f32x4 f0 = *(const LAS f32x4*)(sf + tl * 128 + dg * 8), f1 = *(const LAS f32x4*)(sf + tl * 128 + dg * 8 + 4);
            const f32x4 q0 = *(const LAS f32x4*)(sq + tl * 128 + dg * 8), q1 = *(const LAS f32x4*)(sq + tl * 128 + dg * 8 + 4);
            const float vv = sv[tl * 32 + v]; float o = 0.f;
#pragma unroll
            for (int j = 0; j < 4; ++j) { st[j] = f0[j] * st[j] + (1.0f - f0[j]) * vv; o += q0[j] * st[j]; st[4 + j] = f1[j] * st[4 + j] + (1.0f - f1[j]) * vv; o += q1[j] * st[4 + j]; }
            o += __shfl_xor(o, 32);
            if (F.lane < 32) op[(tl * 8 + F.wave) * 32 + v] = o;
        }
        __syncthreads();
        for (int idx = F.tid; idx < 32 * 32; idx += 512) { const int tl = idx >> 5, vv = idx & 31; float s = 0.f;
#pragma unroll
            for (int w = 0; w < 8; ++w) s += op[(tl * 8 + w) * 32 + vv];
            const int sp = dir ? (SEQ - 1 - (blk * 32 + tl)) : (blk * 32 + tl);
            OUT[(size_t)(b * SEQ + sp) * 512 + hh * 128 + vq * 32 + vv] = s; }
    }
    __syncthreads();
}

#define MFMA32(a, b, c) __builtin_amdgcn_mfma_f32_32x32x16_bf16((a), (b), (c), 0, 0, 0)
constexpr int AT_KROW = 208, AT_VROW = 136, AT_KBYTES = 64 * AT_KROW, AT_BUF = AT_KBYTES + 64 * AT_VROW;
__device__ __forceinline__ void attn_unit(Frame& F, int bh, int q0) {
    const bf16* Q = (const bf16*)(F.ws + WS_Q); const char* Kg = (const char*)(F.ws + WS_K) + (size_t)bh * SEQ * 96 * 2; const char* Vg = (const char*)(F.ws + WS_VT) + (size_t)bh * 64 * SEQ * 2;
    bf16* HA = (bf16*)(F.ws + WS_HA);
    LAS unsigned char* lds = F.lds;
    const int r = F.lane & 31, h = F.lane >> 5;
    bf16x8 qf[6];
    { const bf16* qrow = Q + ((size_t)bh * SEQ + q0 + F.wave * 32 + r) * 96;
#pragma unroll
      for (int ks = 0; ks < 6; ++ks) qf[ks] = *(const bf16x8*)(qrow + 16 * ks + 8 * h); }
    f32x16 o0, o1;
#pragma unroll
    for (int i = 0; i < 16; ++i) { o0[i] = 0.f; o1[i] = 0.f; }
    float mrun = -1e30f, lsum = 0.f;
    const int kc0 = F.tid, kc1 = F.tid + 512; const bool has1 = F.tid < 256;
    const int kl0 = (kc0 / 12) * AT_KROW + (kc0 % 12) * 16, kl1 = (kc1 / 12) * AT_KROW + (kc1 % 12) * 16;
    const int vrow = F.tid >> 3, vpc = F.tid & 7; const int vl = AT_KBYTES + vrow * AT_VROW + vpc * 16;
    u32x4 rk0, rk1 = {0u, 0u, 0u, 0u}, rv;
    __syncthreads();
    rk0 = *(const u32x4*)(Kg + (size_t)kc0 * 16); if (has1) rk1 = *(const u32x4*)(Kg + (size_t)kc1 * 16);
    rv = *(const u32x4*)(Vg + (size_t)vrow * SEQ * 2 + vpc * 16);
    *(LAS u32x4*)(lds + kl0) = rk0; if (has1) *(LAS u32x4*)(lds + kl1) = rk1;
    *(LAS u32x2*)(lds + vl) = (u32x2){rv.x, rv.y}; *(LAS u32x2*)(lds + vl + 8) = (u32x2){rv.z, rv.w};
    __syncthreads();
    for (int j = 0; j < SEQ / 64; ++j) {
        const int buf = (j & 1) * AT_BUF, nbuf = ((j + 1) & 1) * AT_BUF;
        if (j + 1 < SEQ / 64) {
            const char* kg = Kg + (size_t)(j + 1) * 64 * 96 * 2;
            rk0 = *(const u32x4*)(kg + (size_t)kc0 * 16); if (has1) rk1 = *(const u32x4*)(kg + (size_t)kc1 * 16);
            rv = *(const u32x4*)(Vg + (size_t)vrow * SEQ * 2 + (size_t)(j + 1) * 128 + vpc * 16);
        }
        f32x16 s0, s1;
#pragma unroll
        for (int i = 0; i < 16; ++i) { s0[i] = 0.f; s1[i] = 0.f; }
#pragma unroll
        for (int ks = 0; ks < 6; ++ks) {
            const bf16x8 k0 = *(const LAS bf16x8*)(lds + buf + r * AT_KROW + (16 * ks + 8 * h) * 2);
            const bf16x8 k1 = *(const LAS bf16x8*)(lds + buf + (32 + r) * AT_KROW + (16 * ks + 8 * h) * 2);
            s0 = MFMA32(k0, qf[ks], s0); s1 = MFMA32(k1, qf[ks], s1);
        }
        float mx = s0[0];
#pragma unroll
        for (int i = 1; i < 16; ++i) mx = fmaxf(mx, s0[i]);
#pragma unroll
        for (int i = 0; i < 16; ++i) mx = fmaxf(mx, s1[i]);
        mx = fmaxf(mx, __shfl_xor(mx, 32));
        const float mnew = fmaxf(mrun, mx), alpha = exp2f(mrun - mnew); mrun = mnew;
        float ps = 0.f;
#pragma unroll
        for (int i = 0; i < 16; ++i) { s0[i] = exp2f(s0[i] - mnew); s1[i] = exp2f(s1[i] - mnew); ps += s0[i] + s1[i]; }
        lsum = lsum * alpha + ps;
#pragma unroll
        for (int i = 0; i < 16; ++i) { o0[i] *= alpha; o1[i] *= alpha; }
        bf16x8 pf[2][2];
#pragma unroll
        for (int sp = 0; sp < 2; ++sp) {
            u32x4 w0, w1;
            w0.x = pk2(s0[8 * sp + 0], s0[8 * sp + 1]); w0.y = pk2(s0[8 * sp + 2], s0[8 * sp + 3]); w0.z = pk2(s0[8 * sp + 4], s0[8 * sp + 5]); w0.w = pk2(s0[8 * sp + 6], s0[8 * sp + 7]);
            w1.x = pk2(s1[8 * sp + 0], s1[8 * sp + 1]); w1.y = pk2(s1[8 * sp + 2], s1[8 * sp + 3]); w1.z = pk2(s1[8 * sp + 4], s1[8 * sp + 5]); w1.w = pk2(s1[8 * sp + 6], s1[8 * sp + 7]);
            pf[0][sp] = __builtin_bit_cast(bf16x8, w0); pf[1][sp] = __builtin_bit_cast(bf16x8, w1);
        }
#pragma unroll
        for (int kb = 0; kb < 2; ++kb)
#pragma unroll
            for (int sp = 0; sp < 2; ++sp) {
                const int kbase = (32 * kb + 16 * sp + 4 * h) * 2;
                const LAS unsigned char* v0p = lds + buf + AT_KBYTES + r * AT_VROW + kbase;
                const LAS unsigned char* v1p = lds + buf + AT_KBYTES + (32 + r) * AT_VROW + kbase;
                const u32x2 a0 = *(const LAS u32x2*)v0p, a1 = *(const LAS u32x2*)(v0p + 16), c0 = *(const LAS u32x2*)v1p, c1 = *(const LAS u32x2*)(v1p + 16);
                const bf16x8 vf0 = __builtin_bit_cast(bf16x8, ((u32x4){a0.x, a0.y, a1.x, a1.y})), vf1 = __builtin_bit_cast(bf16x8, ((u32x4){c0.x, c0.y, c1.x, c1.y}));
                o0 = MFMA32(vf0, pf[kb][sp], o0); o1 = MFMA32(vf1, pf[kb][sp], o1);
            }
        if (j + 1 < SEQ / 64) {
            *(LAS u32x4*)(lds + nbuf + kl0) = rk0; if (has1) *(LAS u32x4*)(lds + nbuf + kl1) = rk1;
            *(LAS u32x2*)(lds + nbuf + vl) = (u32x2){rv.x, rv.y}; *(LAS u32x2*)(lds + nbuf + vl + 8) = (u32x2){rv.z, rv.w};
        }
        __syncthreads();
    }
    lsum += __shfl_xor(lsum, 32);
    const float inv = 1.0f / lsum;
    const int head = bh & 7, b = bh >> 3;
    bf16* orow = HA + (size_t)(b * SEQ + q0 + F.wave * 32 + r) * 1024 + 512 + head * 64;
#pragma unroll
    for (int i = 0; i < 4; ++i) {
        u32x2 w0, w1;
        w0.x = pk2(o0[4 * i] * inv, o0[4 * i + 1] * inv); w0.y = pk2(o0[4 * i + 2] * inv, o0[4 * i + 3] * inv);
        w1.x = pk2(o1[4 * i] * inv, o1[4 * i + 1] * inv); w1.y = pk2(o1[4 * i + 2] * inv, o1[4 * i + 3] * inv);
        *(u32x2*)(orow + 8 * i + 4 * h) = w0; *(u32x2*)(orow + 32 + 8 * i + 4 * h) = w1;
    }
}

__device__ __forceinline__ void p_router(Frame& F, int l) {
    const float* const* in = F.in;
    const float* X = (const float*)(F.ws + WS_X); const float* MOD = (const float*)(F.ws + WS_MOD); bf16* HB = (bf16*)(F.ws + WS_HB);
    int* LIST = (int*)(F.ws + WS_LIST); float* AW = (float*)(F.ws + WS_AW); unsigned* CNT = (unsigned*)(F.ws + WS_CTL) + CW_CNT + l * 32 * 64;
    LAS unsigned char* lds = F.lds;
    __syncthreads();
    { const float* wr = in[17] + (size_t)l * 1024 * 32;
      for (int q = F.tid; q < 8192; q += 512) { const int k = q >> 3; *(LAS f32x4*)(lds + (size_t)(q + (k >> 2)) * 16) = *(const f32x4*)(wr + (size_t)q * 4); } }
    __syncthreads();
    const float* gn = in[6] + (size_t)l * 1024; const float* br = in[18] + (size_t)l * 32;
    const int gw = F.bid * NWAVES + F.wave, NGW = F.G * NWAVES;
    for (int t = gw; t < T; t += NGW) {
        const int b = t >> 11; f32x4 v[4]; float ss = 0.f;
#pragma unroll
        for (int j = 0; j < 4; ++j) { v[j] = *(const f32x4*)(X + (size_t)t * 1024 + 4 * F.lane + 256 * j); ss += (v[j][0] * v[j][0] + v[j][1] * v[j][1]) + (v[j][2] * v[j][2] + v[j][3] * v[j][3]); }
        const float rs = rsqrtf(wave_sum(ss) * (1.0f / 1024.0f) + EPS);
        const float* sh = MOD + ((size_t)l * 8 + b) * 6144 + 3 * 1024; const float* sc = sh + 1024;
#pragma unroll
        for (int j = 0; j < 4; ++j) { const int d = 4 * F.lane + 256 * j; const f32x4 g = *(const f32x4*)(gn + d), s1 = *(const f32x4*)(sc + d), s0 = *(const f32x4*)(sh + d);
            v[j] = v[j] * rs * g * (s1 + 1.0f) + s0; u32x2 w; w.x = pk2(v[j][0], v[j][1]); w.y = pk2(v[j][2], v[j][3]);
            *(u32x2*)(HB + (size_t)t * 1024 + d) = w; }
        float p[32];
#pragma unroll
        for (int e = 0; e < 32; ++e) p[e] = 0.f;
#pragma unroll
        for (int j = 0; j < 4; ++j)
#pragma unroll
            for (int i = 0; i < 4; ++i) { const int k = 4 * F.lane + 256 * j + i; const LAS unsigned char* wp = lds + (size_t)(k * 8 + (k >> 2)) * 16; const float hv = v[j][i];
#pragma unroll
                for (int c = 0; c < 8; ++c) { const f32x4 w = *(const LAS f32x4*)(wp + c * 16); p[4 * c] += hv * w[0]; p[4 * c + 1] += hv * w[1]; p[4 * c + 2] += hv * w[2]; p[4 * c + 3] += hv * w[3]; }
                __builtin_amdgcn_sched_barrier(0); }
#pragma unroll
        for (int e = 0; e < 16; ++e) { const bool up = (F.lane & 32) != 0; const float keep = up ? p[e + 16] : p[e], send = up ? p[e] : p[e + 16]; p[e] = keep + __shfl_xor(send, 32); }
#pragma unroll
        for (int e = 0; e < 8; ++e) { const bool up = (F.lane & 16) != 0; const float keep = up ? p[e + 8] : p[e], send = up ? p[e] : p[e + 8]; p[e] = keep + __shfl_xor(send, 16); }
#pragma unroll
        for (int e = 0; e < 4; ++e) { const bool up = (F.lane & 8) != 0; const float keep = up ? p[e + 4] : p[e], send = up ? p[e] : p[e + 4]; p[e] = keep + __shfl_xor(send, 8); }
#pragma unroll
        for (int e = 0; e < 2; ++e) { const bool up = (F.lane & 4) != 0; const float keep = up ? p[e + 2] : p[e], send = up ? p[e] : p[e + 2]; p[e] = keep + __shfl_xor(send, 4); }
        { const bool up = (F.lane & 2) != 0; const float keep = up ? p[1] : p[0], send = up ? p[0] : p[1]; p[0] = keep + __shfl_xor(send, 2); }
        float logit = p[0] + __shfl_xor(p[0], 1);
        const int myE = F.lane >> 1; logit += br[myE];
        float tv[4]; int te[4];
#pragma unroll
        for (int k = 0; k < 4; ++k) {
            float bv = logit; int be = myE;
#pragma unroll
            for (int o = 1; o < 64; o <<= 1) { const float ov = __shfl_xor(bv, o); const int oe = __shfl_xor(be, o); if (ov > bv || (ov == bv && oe < be)) { bv = ov; be = oe; } }
            tv[k] = bv; te[k] = be; if (myE == be) logit = -3.0e38f;
        }
        const float e1 = __expf(tv[1] - tv[0]), e2 = __expf(tv[2] - tv[0]), e3 = __expf(tv[3] - tv[0]); const float invs = 1.0f / (1.0f + e1 + e2 + e3);
        if (F.lane < 4) {
            const int ek = F.lane == 0 ? te[0] : F.lane == 1 ? te[1] : F.lane == 2 ? te[2] : te[3];
            const float wk = (F.lane == 0 ? 1.0f : F.lane == 1 ? e1 : F.lane == 2 ? e2 : e3) * invs;
            const unsigned slot = __hip_atomic_fetch_add(CNT + ek * 64, 1u, __ATOMIC_RELAXED, __HIP_MEMORY_SCOPE_AGENT);
            LIST[(size_t)ek * T + slot] = t * 4 + F.lane; AW[t * 4 + F.lane] = wk;
        }
    }
    __syncthreads();
}
__device__ __forceinline__ void moe_tables(Frame& F, int l) {
    LAS int* cnt = (LAS int*)(F.lds + MOE_OFF); LAS int* toff = cnt + 32;
    const unsigned* CNT = (const unsigned*)(F.ws + WS_CTL) + CW_CNT + l * 32 * 64;
    __syncthreads();
    if (F.tid < 32) cnt[F.tid] = (int)__hip_atomic_load(CNT + F.tid * 64, __ATOMIC_RELAXED, __HIP_MEMORY_SCOPE_AGENT);
    __syncthreads();
    if (F.tid == 0) { int s = 0; for (int e = 0; e < 32; ++e) { toff[e] = s; s += (cnt[e] + 255) >> 8; } toff[32] = s; }
    __syncthreads();
}

constexpr int NPH = 11, PH_FINAL = 1 + DEPTH * NPH, PH_TOTAL = PH_FINAL + 1;
__global__ void __launch_bounds__(NWAVES * 64, 2) fwd_kernel(Args args) {
    extern __shared__ __attribute__((aligned(16))) unsigned char lds_raw[];
    Frame F;
    F.lds = (LAS unsigned char*)lds_raw; F.ws = args.ws; F.tid = threadIdx.x; F.lane = F.tid & 63; F.wave = __builtin_amdgcn_readfirstlane(F.tid >> 6); F.G = gridDim.x; F.bid = blockIdx.x; F.in = args.in;
    for (int u = F.tid; u < (LDS_BYTES - LDSCTL_OFF) / 4; u += NWAVES * 64) ((LAS unsigned*)(F.lds + LDSCTL_OFF))[u] = 0u;
    __syncthreads();
    const int lo = args.ph_lo, hi = args.ph_hi;
    XcdBarrier bar; bar.bar = (unsigned*)(F.ws + WS_CTL) + CW_BAR; bar.x = 0; bar.st = nullptr;
    if (hi - lo > 1) bar = xcd_barrier_post((unsigned*)(F.ws + WS_CTL) + CW_BAR, (volatile LAS unsigned*)(F.lds + MISC_OFF) + 8);
#define IN(k) (lo <= (k) && (k) < hi)
#define PROJ ((bf16*)(ws + WS_PROJ))
#define SEAM(k) do { if (IN(k) && IN((k) + 1)) xcd_barrier(bar); } while (0)
    unsigned char* ws = F.ws;
#define PHASE_ENTER() do { unsigned char* w_ = args.ws; asm volatile("" : "+s"(w_)); F.ws = w_; ws = w_; int t_ = threadIdx.x; asm volatile("" : "+v"(t_)); F.tid = t_; F.lane = t_ & 63; F.wave = __builtin_amdgcn_readfirstlane(t_ >> 6); } while (0)
    if (EN(0) && IN(0)) { PHASE_ENTER(); p_prologue(F); SEAM(0); }
    for (int l = 0; l < DEPTH; ++l) {
        const int pb = 1 + l * NPH;
        if (EN(1) && IN(pb + 0)) { PHASE_ENTER(); p_norm_mix(F, l, false, nullptr); SEAM(pb + 0); }
        if (EN(2) && IN(pb + 1)) { PHASE_ENTER();
            pg8::DenseOrder S; S.init(T, NPROJ, F.G, F.bid, ws + WS_HB, 1024, wl(ws, l, WL_IN), 1024);
            EpiProj E{PROJ};
            pg8::gemm_phase(F.lds, 1024, S, E);
            SEAM(pb + 1);
        }
        if (EN(3) && IN(pb + 2)) { PHASE_ENTER(); p_mla_prep(F); SEAM(pb + 2); }
        if (EN(4) && IN(pb + 3)) { PHASE_ENTER();
#ifndef SUBMASK
#define SUBMASK 7
#endif
            if (SUBMASK & 1) { pg8::DenseOrder S; S.init(T, 768, F.G, F.bid, PROJ + PCQ, NPROJ, wl(ws, l, WL_Q), 384);
              EpiQ E{(bf16*)(ws + WS_Q), (const float*)(ws + WS_RSQ), (const float*)(ws + WS_COS), (const float*)(ws + WS_SIN)};
              pg8::gemm_phase(F.lds, 384, S, E); }
            if (SUBMASK & 2) { int z = 0; asm volatile("" : "+s"(z)); pg8::DenseOrder S; S.init(T, 512, F.G, (F.bid + 64 + z) % F.G, PROJ + PCKV + z, NPROJ, wl(ws, l, WL_K) + z, 256);
              EpiK E{(bf16*)(ws + WS_K), (const float*)(ws + WS_RSKV)};
              pg8::gemm_phase(F.lds, 256, S, E); }
            if (SUBMASK & 4) { int z = 0; asm volatile("" : "+s"(z)); pg8::DenseOrder S; S.init(512, T, F.G, (F.bid + 192 + z) % F.G, wl(ws, l, WL_V) + z, 256, PROJ + PCKV + z, NPROJ);
              EpiV E{(bf16*)(ws + WS_VT), (const float*)(ws + WS_RSKV)};
              pg8::gemm_phase(F.lds, 256, S, E); }
            SEAM(pb + 3);
        }
        if (EN(5) && IN(pb + 4)) { PHASE_ENTER();
            for (int u = F.bid; u < 256; u += F.G) scan_unit(F, l, u);
            for (int a = F.bid; a < 512; a += F.G) attn_unit(F, a >> 3, (a & 7) * 256);
            SEAM(pb + 4);
        }
        if (EN(6) && IN(pb + 5)) { PHASE_ENTER(); p_hgrn_post(F, l); SEAM(pb + 5); }
        if (EN(7) && IN(pb + 6)) { PHASE_ENTER();
            if (SUBMASK & 1) { pg8::DenseOrder S; S.init(T, 1024, F.G, F.bid, ws + WS_HA, 1024, wl(ws, l, WL_OUT), 1024);
              EpiOut E{(bf16*)(ws + WS_Y), PROJ, 0};
              pg8::gemm_phase(F.lds, 512, S, E); }
            if (SUBMASK & 2) { pg8::DenseOrder S; S.init(T, 1024, F.G, F.bid, (bf16*)(ws + WS_HA) + 512, 1024, (bf16*)wl(ws, l, WL_OUT) + 512, 1024);
              EpiOut E{(bf16*)(ws + WS_Y), PROJ, 1};
              pg8::gemm_phase(F.lds, 512, S, E); }
            SEAM(pb + 6);
        }
        if (EN(8) && IN(pb + 7)) { PHASE_ENTER();
            pg8::DenseOrder S; S.init(T, 1024, F.G, F.bid, ws + WS_Y, 1024, wl(ws, l, WL_O), 1024);
            EpiWo E{(float*)(ws + WS_X), (const float*)(ws + WS_MOD) + (size_t)l * 8 * 6144 + 2 * 1024};
            pg8::gemm_phase(F.lds, 1024, S, E);
            SEAM(pb + 7);
        }
        if (EN(9) && IN(pb + 8)) { PHASE_ENTER(); p_router(F, l); SEAM(pb + 8); }
        if (EN(10) && IN(pb + 9)) { PHASE_ENTER();
            moe_tables(F, l);
            pg8::MoeOrder<true> S; S.cnt = (const LAS int*)(F.lds + MOE_OFF); S.toff = S.cnt + 32; S.NT = 8; S.G = F.G; S.c = F.bid; S.Abase = (const char*)(ws + WS_HB); S.Bbase = (const char*)wl(ws, l, WL_GU);
            S.b_expert_bytes = (size_t)2048 * 1024 * 2; S.list = (const int*)(ws + WS_LIST); S.lda = 1024; S.ldb = 1024;
            EpiGU E{(bf16*)(ws + WS_ACT), F.in[20] + (size_t)l * 32 * 2048};
            pg8::gemm_phase(F.lds, 1024, S, E);
            SEAM(pb + 9);
        }
        if (EN(11) && IN(pb + 10)) { PHASE_ENTER();
            moe_tables(F, l);
            pg8::MoeOrder<false> S; S.cnt = (const LAS int*)(F.lds + MOE_OFF); S.toff = S.cnt + 32; S.NT = 4; S.G = F.G; S.c = F.bid; S.Abase = (const char*)(ws + WS_ACT); S.Bbase = (const char*)wl(ws, l, WL_DN);
            S.b_expert_bytes = (size_t)1024 * 1024 * 2; S.list = (const int*)(ws + WS_LIST); S.lda = 1024; S.ldb = 1024;
            EpiDown E{(bf16*)(ws + WS_YR), F.in[22] + (size_t)l * 32 * 1024, (const int*)(ws + WS_LIST), (const float*)(ws + WS_AW)};
            pg8::gemm_phase(F.lds, 1024, S, E);
            SEAM(pb + 10);
        }
    }
    if (EN(12) && IN(PH_FINAL)) { PHASE_ENTER(); p_norm_mix(F, DEPTH, true, args.out); }
#undef IN
#undef SEAM
#undef PROJ
#undef PHASE_ENTER
}

extern "C" void kernel_launch(void* const* d_in, const int* in_sizes, int n_in, void* d_out, int out_size, void* d_ws, size_t ws_size, hipStream_t stream) {
    static int grid = 0;
    if (grid == 0) {
        if (n_in != 24 || in_sizes[0] != T * D || out_size != T * D || ws_size < WS_END) { fprintf(stderr, "kernel_launch: unexpected problem (n_in %d, in0 %d, out %d, ws %zu, need %zu)\n", n_in, n_in > 0 ? in_sizes[0] : -1, out_size, ws_size, (size_t)WS_END); grid = -1; return; }
        int dev = 0, cus = 0, per_cu = 0;
        if (hipGetDevice(&dev) != hipSuccess || hipDeviceGetAttribute(&cus, hipDeviceAttributeMultiprocessorCount, dev) != hipSuccess) { grid = -1; return; }
        if (hipFuncSetAttribute((const void*)fwd_kernel, hipFuncAttributeMaxDynamicSharedMemorySize, LDS_BYTES) != hipSuccess) { fprintf(stderr, "kernel_launch: hipFuncSetAttribute failed\n"); grid = -1; return; }
        if (hipOccupancyMaxActiveBlocksPerMultiprocessor(&per_cu, (const void*)fwd_kernel, NWAVES * 64, LDS_BYTES) != hipSuccess || per_cu < 1) { fprintf(stderr, "kernel_launch: occupancy query says %d\n", per_cu); (void)hipGetLastError(); }
        grid = cus;
    }
    if (grid < 0) return;
    if (hipMemsetAsync((char*)d_ws + WS_CTL, 0, CTL_ZERO_BYTES, stream) != hipSuccess) return;
    Args a{};
    for (int i = 0; i < 24; ++i) a.in[i] = (const float*)d_in[i];
    a.out = (float*)d_out; a.ws = (unsigned char*)d_ws;
#if MK_PER_PHASE
    for (int ph = 0; ph < PH_TOTAL; ++ph) { a.ph_lo = ph; a.ph_hi = ph + 1; hipLaunchKernelGGL(fwd_kernel, dim3(grid), dim3(NWAVES * 64), LDS_BYTES, stream, a); }
#else
    a.ph_lo = 0; a.ph_hi = PH_TOTAL; hipLaunchKernelGGL(fwd_kernel, dim3(grid), dim3(NWAVES * 64), LDS_BYTES, stream, a);
#endif
}
```

```cpp
#include <hip/hip_runtime.h>
#include <cstdio>
#include <cstdint>

#ifndef PHASE_MASK
#define PHASE_MASK 0xFFFFu
#endif
#define EN(k) (((PHASE_MASK) >> (k)) & 1u)
#ifndef REP_KIND
#define REP_KIND -1
#endif
#ifndef REP_SUB
#define REP_SUB 3
#endif
#define REPS(k) _Pragma("unroll 1") for (int rep_ = 0; rep_ < ((REP_KIND) == (k) ? 2 : 1); ++rep_)
#ifndef MK_PER_PHASE
#define MK_PER_PHASE 0
#endif

#define GAS __attribute__((address_space(1)))
#define LAS __attribute__((address_space(3)))
typedef unsigned short bf16;
typedef short bf16x8 __attribute__((ext_vector_type(8)));
typedef float f32x4 __attribute__((ext_vector_type(4)));
typedef float f32x2 __attribute__((ext_vector_type(2)));
typedef float f32x16 __attribute__((ext_vector_type(16)));
typedef unsigned u32x4 __attribute__((ext_vector_type(4)));
typedef unsigned u32x2 __attribute__((ext_vector_type(2)));
typedef __bf16 bfv2 __attribute__((ext_vector_type(2)));

__device__ __forceinline__ unsigned pk2(float lo, float hi) { f32x2 v = {lo, hi}; bfv2 r = __builtin_convertvector(v, bfv2); return __builtin_bit_cast(unsigned, r); }
__device__ __forceinline__ float bf2f(unsigned short b) { return __uint_as_float(((unsigned)b) << 16); }
__device__ __forceinline__ float bflo(unsigned w) { return __uint_as_float(w << 16); }
__device__ __forceinline__ float bfhi(unsigned w) { return __uint_as_float(w & 0xffff0000u); }
__device__ __forceinline__ u32x4 pack8(f32x4 a, f32x4 b) { u32x4 w; w.x = pk2(a[0], a[1]); w.y = pk2(a[2], a[3]); w.z = pk2(b[0], b[1]); w.w = pk2(b[2], b[3]); return w; }
__device__ __forceinline__ void unpack8(u32x4 w, f32x4& a, f32x4& b) { a[0] = bflo(w.x); a[1] = bfhi(w.x); a[2] = bflo(w.y); a[3] = bfhi(w.y); b[0] = bflo(w.z); b[1] = bfhi(w.z); b[2] = bflo(w.w); b[3] = bfhi(w.w); }
__device__ __forceinline__ float sigmoidf_(float x) { return 1.0f / (1.0f + __expf(-x)); }
__device__ __forceinline__ float wave_sum(float v) {
#pragma unroll
    for (int o = 1; o < 64; o <<= 1) v += __shfl_xor(v, o);
    return v;
}
#define LDS_WAIT() asm volatile("s_waitcnt lgkmcnt(0)" ::: "memory")
#define VM_WAIT() asm volatile("s_waitcnt vmcnt(0)" ::: "memory")

#define XB_TMO      128
#define XB_XCNT(j)  (256  + 64 * (j))
#define XB_XSUB(j)  (1280 + 64 * (j))
#define XB_XGEN(j)  (2304 + 64 * (j))
#define XB_TOP      3328
#define XB_TOPGEN   3392
#define XCD_BAR_WORDS 3456
#define XB_SPIN_CAP (1u << 20)

__device__ __forceinline__ unsigned xb_ld(unsigned* p)              { return __hip_atomic_load(p, __ATOMIC_RELAXED, __HIP_MEMORY_SCOPE_AGENT); }
__device__ __forceinline__ unsigned xb_add(unsigned* p, unsigned v) { return __hip_atomic_fetch_add(p, v, __ATOMIC_RELAXED, __HIP_MEMORY_SCOPE_AGENT); }
__device__ __forceinline__ unsigned xb_xcc_id() { return (unsigned)__builtin_amdgcn_s_getreg((3 << 11) | 20) & 0xFu; }
#define XB_SPIN(cond, bar) do { unsigned _sp = 0; while (cond) { __builtin_amdgcn_s_sleep(1); \
    if ((++_sp & 255u) == 0u) { if (xb_ld(&(bar)[XB_TMO])) break; if (_sp > XB_SPIN_CAP) { atomicAdd(&(bar)[XB_TMO], 1u); break; } } } } while (0)

struct XcdBarrier { unsigned* bar; unsigned x; volatile LAS unsigned* st; };

__device__ __forceinline__ XcdBarrier xcd_barrier_post(unsigned* bar, volatile LAS unsigned* st) {
    XcdBarrier b; b.bar = bar; b.x = xb_xcc_id(); b.st = st;
    if (threadIdx.x == 0) (void)xb_add(&bar[XB_XCNT(b.x)], 1u);
    return b;
}
__device__ __forceinline__ void xcd_barrier_complete(unsigned* bar, unsigned x, unsigned& nloc, unsigned& nx) {
    const unsigned G = gridDim.x * gridDim.y * gridDim.z;
    unsigned sum, cnt, mine, sp = 0u;
    for (;;) {
        sum = 0u; cnt = 0u; mine = 0u;
#pragma unroll
        for (unsigned j = 0; j < 16; ++j) { const unsigned c = xb_ld(&bar[XB_XCNT(j)]); sum += c; cnt += (c > 0u) ? 1u : 0u; mine = (j == x) ? c : mine; }
        if (sum == G) break;
        __builtin_amdgcn_s_sleep(1);
        if ((++sp & 255u) == 0u) { if (xb_ld(&bar[XB_TMO])) break; if (sp > XB_SPIN_CAP) { atomicAdd(&bar[XB_TMO], 1u); break; } }
    }
    nloc = mine > 0u ? mine : 1u; nx = cnt > 0u ? cnt : 1u;
}
__device__ __forceinline__ void xcd_barrier(const XcdBarrier& b) {
    asm volatile("s_waitcnt vmcnt(0)" ::: "memory");
    __syncthreads();
    if (threadIdx.x == 0) {
        unsigned* bar = b.bar;
        __builtin_amdgcn_s_waitcnt(0);
        unsigned nloc = b.st[0], nx = b.st[1];
        if (nloc == 0u) { xcd_barrier_complete(bar, b.x, nloc, nx); b.st[0] = nloc; b.st[1] = nx; }
        const unsigned old = xb_add(&bar[XB_XSUB(b.x)], 1u);
        const unsigned gen = old / nloc;
        if (old + 1u == (gen + 1u) * nloc) {
            __builtin_amdgcn_fence(__ATOMIC_RELEASE, "agent");
            asm volatile("s_waitcnt vmcnt(0)" ::: "memory");
            const unsigned og = xb_add(&bar[XB_TOP], 1u);
            const unsigned tg = og / nx;
            if (og + 1u == (tg + 1u) * nx) xb_add(&bar[XB_TOPGEN], 1u);
            else XB_SPIN(xb_ld(&bar[XB_TOPGEN]) == tg, bar);
            __builtin_amdgcn_fence(__ATOMIC_ACQUIRE, "agent");
            xb_add(&bar[XB_XGEN(b.x)], 1u);
            asm volatile("s_waitcnt vmcnt(0)" ::: "memory");
        } else {
            XB_SPIN(xb_ld(&bar[XB_XGEN(b.x)]) == gen, bar);
            __builtin_amdgcn_fence(__ATOMIC_ACQUIRE, "agent");
            asm volatile("s_waitcnt vmcnt(0)" ::: "memory");
        }
    }
    __syncthreads();
}

constexpr int D = 1024, NB = 8, SEQ = 2048, T = NB * SEQ, DEPTH = 4;
constexpr int NPROJ = 3328;
constexpr int NHT = 2048;
constexpr int PGT = 0, PGA = 512, PGB = 1536, PCQ = 2560, PCKV = 2944, PKPE = 3200;
constexpr int HQ = 0, HFF = 512, HFB = 1024, HI = 1536;
constexpr int NE = 32, TOPK = 4, NASSIGN = T * TOPK, ACT_ROWS = NASSIGN + NE * 256;
constexpr float EPS = 1e-6f;
constexpr float QSCALE = 0.10206207261596575f * 1.4426950408889634f;

constexpr size_t MiB = 1u << 20;
constexpr size_t WS_CTL = 0, CTL_ZERO_BYTES = 1 * MiB;
constexpr size_t WS_MOD = 1 * MiB, WS_LB = 2 * MiB, WS_COS = 3 * MiB, WS_SIN = 4 * MiB, WS_RSQ = 5 * MiB, WS_RSKV = 5 * MiB + 65536, WS_AW = 6 * MiB, WS_LIST = 7 * MiB;
constexpr size_t WS_X = 16 * MiB, WS_HB = 80 * MiB, WS_PROJ = 112 * MiB, WS_HT = 216 * MiB, WS_Q = 280 * MiB, WS_K = 304 * MiB, WS_VT = 328 * MiB, WS_OF = 344 * MiB, WS_OB = 376 * MiB;
constexpr size_t WS_HA = 408 * MiB, WS_Y = 440 * MiB, WS_ACT = 472 * MiB, WS_YR = 616 * MiB, WS_W = 768 * MiB;
constexpr size_t WL_IN = 0, WL_Q = 11 * MiB, WL_K = 12 * MiB, WL_V = 12 * MiB + 256 * 1024, WL_OUT = 13 * MiB, WL_O = 15 * MiB, WL_GU = 17 * MiB, WL_DN = 145 * MiB, WL_STRIDE = 209 * MiB;
constexpr size_t WS_END = WS_W + DEPTH * WL_STRIDE;
static_assert((size_t)T * NPROJ * 2 <= WS_HT - WS_PROJ && (size_t)NB * NHT * SEQ * 2 <= WS_Q - WS_HT && (size_t)ACT_ROWS * 1024 * 2 <= WS_YR - WS_ACT && (size_t)NASSIGN * 1024 * 2 <= WS_W - WS_YR, "ws map");
constexpr int CW_BAR = 4096, CW_Q = 8192, CW_CNT = 16384;

constexpr int RING_BYTES = 131072;
constexpr int LDSCTL_OFF = 139264, MISC_OFF = LDSCTL_OFF + 320, MOE_OFF = LDSCTL_OFF + 1024;
constexpr int LDS_BYTES = 147456;
constexpr int NWAVES = 8;

namespace pg8 {
constexpr int BM = 256, BK = 64, HALF = 128, HTB = HALF * BK * 2, NXCD = 8, WGM = 8;
__device__ __forceinline__ int lds_byte(int r, int c) { const int st = (r >> 4) * 2 + (c >> 5), rr = r & 15, cc = c & 31, ob = rr * 64 + cc * 2; return st * 1024 + (ob ^ (((ob >> 9) & 1) << 5)); }
__device__ __forceinline__ void stage_rc(int b, int& R, int& C) { const int st = b / 1024, sb = b % 1024, swz = sb ^ (((sb >> 9) & 1) << 5); R = (st >> 1) * 16 + swz / 64; C = (st & 1) * 32 + (swz % 64) / 2; }
__device__ __forceinline__ int perm32(int rho) { const int n = rho >> 4, i = rho & 15; return 8 * (i >> 2) + 4 * n + (i & 3); }

struct Unit { const char* A; const char* B; int pm, pn, e, rowbase, mrows; };

struct DenseOrder {
    static constexpr bool GATHER_A = false;
    int nM, nN, nwg, G, c; const char* Abase; const char* Bbase; int lda, ldb;
    __device__ __forceinline__ void init(int M, int N, int G_, int c_, const void* A, int lda_, const void* B, int ldb_) { nM = M / BM; nN = N / BM; nwg = nM * nN; G = G_; c = c_; Abase = (const char*)A; Bbase = (const char*)B; lda = lda_; ldb = ldb_; }
    __device__ __forceinline__ bool next(int i, Unit& u) const {
        const long L = (long)i * G + c; if (L >= nwg) return false;
        int wgid = (int)L; { const int q = nwg / NXCD, r = nwg % NXCD, xcd = wgid % NXCD, off = wgid / NXCD; wgid = (xcd < r ? xcd * (q + 1) : r * (q + 1) + (xcd - r) * q) + off; }
        const int nig = WGM * nN, gid = wgid / nig, fm = gid * WGM, gsz = (nM - fm) < WGM ? (nM - fm) : WGM;
        u.pm = fm + ((wgid % nig) % gsz); u.pn = (wgid % nig) / gsz; u.e = 0; u.rowbase = 0; u.mrows = 256;
        u.A = Abase + (size_t)u.pm * 256 * lda * 2; u.B = Bbase + (size_t)u.pn * 256 * ldb * 2; return true;
    }
    __device__ __forceinline__ void aoff(const Unit&, const int (&R)[2], const int (&C)[2], unsigned (&v)[2][2]) const {
#pragma unroll
        for (int h = 0; h < 2; ++h)
#pragma unroll
            for (int i = 0; i < 2; ++i) v[h][i] = (unsigned)((128 * h + R[i]) * lda + C[i]) * 2u;
    }
};
template <bool GATHER> struct MoeOrder {
    static constexpr bool GATHER_A = GATHER;
    const LAS int* toff; const LAS int* cnt; int NT, G, c; const char* Abase; const char* Bbase; size_t b_expert_bytes; const int* list; int lda, ldb;
    __device__ __forceinline__ bool next(int i, Unit& u) const {
        const int L = i * G + c; if (L >= toff[NE] * NT) return false;
        int e = 0; while (toff[e + 1] * NT <= L) ++e;
        const int local = L - toff[e] * NT; u.e = e; u.pm = local / NT; u.pn = local % NT; u.rowbase = (toff[e] + u.pm) * 256; u.mrows = cnt[e] - u.pm * 256;
        u.A = GATHER ? Abase : Abase + (size_t)u.rowbase * lda * 2; u.B = Bbase + (size_t)e * b_expert_bytes + (size_t)u.pn * 256 * ldb * 2; return true;
    }
    __device__ __forceinline__ void aoff(const Unit& u, const int (&R)[2], const int (&C)[2], unsigned (&v)[2][2]) const {
#pragma unroll
        for (int h = 0; h < 2; ++h)
#pragma unroll
            for (int i = 0; i < 2; ++i) {
                if (GATHER) { const int rl = 128 * h + R[i]; const int a = list[(size_t)u.e * T + u.pm * 256 + (rl < u.mrows ? rl : 0)]; v[h][i] = (unsigned)((a >> 2) * lda + C[i]) * 2u; }
                else v[h][i] = (unsigned)((128 * h + R[i]) * lda + C[i]) * 2u;
            }
    }
};

template <class Epi, class Sched>
__device__ __forceinline__ void gemm_phase(LAS unsigned char* lds, const int K, const Sched& S, const Epi& E) {
    int tid_ = threadIdx.x; asm volatile("" : "+v"(tid_));
    const int tid = tid_, wid = __builtin_amdgcn_readfirstlane(tid >> 6), lane = tid & 63, wr = wid >> 2, wc = wid & 3, fr = lane & 15, fq = lane >> 4;
    const int nt = K / BK;
    int sR[2], sC[2]; unsigned voffB[2];
#pragma unroll
    for (int i = 0; i < 2; ++i) { stage_rc(tid * 16 + i * 8192, sR[i], sC[i]); const int Rb = (sR[i] & ~31) + perm32(sR[i] & 31); voffB[i] = (unsigned)(Rb * S.ldb + sC[i]) * 2u; }
    constexpr bool GA = Sched::GATHER_A;
    unsigned voffA[2];
#pragma unroll
    for (int i = 0; i < 2; ++i) voffA[i] = (unsigned)(sR[i] * S.lda + sC[i]) * 2u;
    const size_t kstep = (size_t)(BK * 2);
    const size_t hstepB = (size_t)HALF * S.ldb * 2, hstepA = (size_t)HALF * S.lda * 2;
    const unsigned ldsw = (unsigned)wid * 1024u;
    const int aoff = lds_byte(wr * 64 + fr, fq * 8), boff = lds_byte(wc * 32 + fr, fq * 8);
#define PG8_SA(b, h) (((b) * 2 + (h)) * HTB)
#define PG8_SB(b, h) ((4 + (b) * 2 + (h)) * HTB)
#define PG8_STAGE(bufoff, gbase, voff) do { _Pragma("unroll") for (int _i = 0; _i < 2; ++_i) \
        __builtin_amdgcn_global_load_lds((const unsigned*)((const char*)(gbase) + (voff)[_i]), (LAS unsigned*)(lds + (bufoff) + ldsw + _i * 8192), 16, 0, 0); } while (0)
#define PG8_STAGEA(bufoff, gbase, h, nx) do { _Pragma("unroll") for (int _i = 0; _i < 2; ++_i) { \
        const char* _p = GA ? (const char*)(gbase) + ((nx) ? nvA[h][_i] : vA[h][_i]) : (const char*)(gbase) + (size_t)(h) * hstepA + voffA[_i]; \
        __builtin_amdgcn_global_load_lds((const unsigned*)_p, (LAS unsigned*)(lds + (bufoff) + ldsw + _i * 8192), 16, 0, 0); } } while (0)
#define PG8_LDA(dst, b, h) do { _Pragma("unroll") for (int m = 0; m < 4; ++m) _Pragma("unroll") for (int k = 0; k < 2; ++k) dst[m][k] = *(const LAS bf16x8*)(lds + PG8_SA(b, h) + aoff + m * 2048 + k * 1024); } while (0)
#define PG8_LDB(dst, b, h) do { _Pragma("unroll") for (int n = 0; n < 2; ++n) _Pragma("unroll") for (int k = 0; k < 2; ++k) dst[n][k] = *(const LAS bf16x8*)(lds + PG8_SB(b, h) + boff + n * 2048 + k * 1024); } while (0)
#define PG8_MMA(ai, bj, At, Bt) do { __builtin_amdgcn_s_setprio(1); _Pragma("unroll") for (int m = 0; m < 4; ++m) _Pragma("unroll") for (int n = 0; n < 2; ++n) _Pragma("unroll") for (int k = 0; k < 2; ++k) \
        acc[ai][bj][m][n] = __builtin_amdgcn_mfma_f32_16x16x32_bf16(Bt[n][k], At[m][k], acc[ai][bj][m][n], 0, 0, 0); __builtin_amdgcn_s_setprio(0); } while (0)
#define PG8_WAIT_V(n) asm volatile("s_waitcnt vmcnt(" #n ")" ::: "memory")
#define PG8_WAIT_L(n) asm volatile("s_waitcnt lgkmcnt(" #n ")" ::: "memory")
#define PG8_BAR __builtin_amdgcn_s_barrier()
#define PG8_SCHED __builtin_amdgcn_sched_barrier(0)
    Unit cur, nxt; int ui = 0;
    if (!S.next(0, cur)) return;
    f32x4 acc[2][2][4][2];
#pragma unroll
    for (int a = 0; a < 2; ++a)
#pragma unroll
        for (int b = 0; b < 2; ++b)
#pragma unroll
            for (int m = 0; m < 4; ++m)
#pragma unroll
                for (int n = 0; n < 2; ++n) acc[a][b][m][n] = (f32x4){0.f, 0.f, 0.f, 0.f};
    bf16x8 At[4][2], B0[2][2], B1[2][2];
    unsigned vA[2][2], nvA[2][2];
    if constexpr (GA) { S.aoff(cur, sR, sC, vA); }
    const char* cA = cur.A; const char* cB = cur.B;
    PG8_STAGE(PG8_SB(0, 0), cB, voffB); PG8_STAGE(PG8_SB(0, 1), cB + hstepB, voffB); PG8_STAGEA(PG8_SA(0, 0), cA, 0, false); PG8_STAGEA(PG8_SA(0, 1), cA, 1, false);
    if (wr == 1) PG8_BAR;
    PG8_WAIT_V(2); PG8_BAR;
    PG8_STAGE(PG8_SB(1, 0), cB + kstep, voffB); PG8_STAGEA(PG8_SA(1, 0), cA + kstep, 0, false); PG8_STAGE(PG8_SB(1, 1), cB + hstepB + kstep, voffB);
    PG8_WAIT_V(6); PG8_BAR;
    for (;;) {
        const bool has_next = S.next(ui + 1, nxt);
        const char* nA = has_next ? nxt.A : cA; const char* nB = has_next ? nxt.B : cB;
        if constexpr (GA) {
            if (has_next) S.aoff(nxt, sR, sC, nvA);
            else {
#pragma unroll
                for (int h = 0; h < 2; ++h)
#pragma unroll
                    for (int i = 0; i < 2; ++i) nvA[h][i] = vA[h][i]; } }
#pragma unroll 1
        for (int t = 0; t < nt; t += 2) {
            const bool last = (t == nt - 2);
            const char* a1 = cA + (size_t)(t + 1) * kstep;
            const char* a2 = last ? nA : cA + (size_t)(t + 2) * kstep; const char* b2 = last ? nB : cB + (size_t)(t + 2) * kstep;
            const char* a3 = a2 + kstep; const char* b3 = b2 + kstep;
            PG8_LDB(B0, 0, 0); PG8_LDB(B1, 0, 1); PG8_SCHED; PG8_LDA(At, 0, 0); PG8_STAGEA(PG8_SA(1, 1), a1, 1, false);
            PG8_WAIT_V(8); PG8_WAIT_L(0); PG8_BAR; PG8_MMA(0, 0, At, B0); PG8_MMA(0, 1, At, B1); PG8_BAR; PG8_SCHED;
            PG8_LDA(At, 0, 1); PG8_STAGE(PG8_SB(0, 0), b2, voffB); PG8_STAGE(PG8_SB(0, 1), b2 + hstepB, voffB); PG8_STAGEA(PG8_SA(0, 0), a2, 0, last);
            PG8_WAIT_V(8); PG8_WAIT_L(0); PG8_BAR; PG8_MMA(1, 0, At, B0); PG8_MMA(1, 1, At, B1); PG8_BAR; PG8_SCHED;
            PG8_LDB(B0, 1, 0); PG8_LDB(B1, 1, 1); PG8_SCHED; PG8_LDA(At, 1, 0); PG8_STAGEA(PG8_SA(0, 1), a2, 1, last);
            PG8_WAIT_V(8); PG8_WAIT_L(0); PG8_BAR; PG8_MMA(0, 0, At, B0); PG8_MMA(0, 1, At, B1); PG8_BAR; PG8_SCHED;
            PG8_LDA(At, 1, 1); PG8_STAGE(PG8_SB(1, 0), b3, voffB); PG8_STAGE(PG8_SB(1, 1), b3 + hstepB, voffB); PG8_STAGEA(PG8_SA(1, 0), a3, 0, last);
            PG8_WAIT_V(8); PG8_WAIT_L(0); PG8_BAR; PG8_MMA(1, 0, At, B0); PG8_MMA(1, 1, At, B1); PG8_BAR; PG8_SCHED;
        }
        if (wr == 0) PG8_BAR;
        E(acc, cur, wr, wc, fr, fq);
        if (!has_next) break;
#pragma unroll
        for (int a = 0; a < 2; ++a)
#pragma unroll
            for (int b = 0; b < 2; ++b)
#pragma unroll
                for (int m = 0; m < 4; ++m)
#pragma unroll
                    for (int n = 0; n < 2; ++n) acc[a][b][m][n] = (f32x4){0.f, 0.f, 0.f, 0.f};
        cur = nxt; cA = nA; cB = nB; ++ui;
        if constexpr (GA) {
#pragma unroll
            for (int h = 0; h < 2; ++h)
#pragma unroll
                for (int i = 0; i < 2; ++i) vA[h][i] = nvA[h][i]; }
        if (wr == 1) PG8_BAR;
    }
    PG8_WAIT_V(0);
    PG8_BAR;
#undef PG8_SA
#undef PG8_SB
#undef PG8_STAGE
#undef PG8_STAGEA
#undef PG8_LDA
#undef PG8_LDB
#undef PG8_MMA
#undef PG8_WAIT_V
#undef PG8_WAIT_L
#undef PG8_BAR
#undef PG8_SCHED
}
}
using pg8::Unit;
typedef const f32x4 (&AccRef)[2][2][4][2];

struct Args {
    const float* in[24]; float* out; unsigned char* ws; int ph_lo, ph_hi;
};
struct Frame {
    LAS unsigned char* lds; unsigned char* ws; int tid, lane, wave, G, bid;
    const float* const* in;
};
__device__ __forceinline__ unsigned char* wl(unsigned char* ws, int l, size_t off) { return ws + WS_W + (size_t)l * WL_STRIDE + off; }

#define EPI_LOOP_BEGIN _Pragma("unroll") for (int ai = 0; ai < 2; ++ai) _Pragma("unroll") for (int m = 0; m < 4; ++m) { const int rl = ai * 128 + wr * 64 + m * 16 + fr; _Pragma("unroll") for (int bj = 0; bj < 2; ++bj) { const int cl = bj * 128 + wc * 32 + 8 * fq; const f32x4 v0 = acc[ai][bj][m][0], v1 = acc[ai][bj][m][1];
#define EPI_LOOP_END } asm volatile("" ::: "memory"); }

struct EpiProj {
    bf16* O;
    __device__ __forceinline__ void operator()(AccRef acc, const Unit& u, int wr, int wc, int fr, int fq) const {
        EPI_LOOP_BEGIN
            *(u32x4*)(O + (size_t)(u.pm * 256 + rl) * NPROJ + u.pn * 256 + cl) = pack8(v0, v1);
        EPI_LOOP_END
    }
};
struct EpiHT {
    bf16* HT;
    __device__ __forceinline__ void operator()(AccRef acc, const Unit& u, int wr, int wc, int fr, int fq) const {
        EPI_LOOP_BEGIN
            const int f = u.pm * 256 + rl, t0 = u.pn * 256 + cl, b = t0 >> 11, s = t0 & 2047;
            *(u32x4*)(HT + ((size_t)b * NHT + f) * SEQ + s) = pack8(v0, v1);
        EPI_LOOP_END
    }
};
struct EpiQ {
    bf16* Q; const float* rsq; const float* cs; const float* sn;
    __device__ __forceinline__ void operator()(AccRef acc, const Unit& u, int wr, int wc, int fr, int fq) const {
        EPI_LOOP_BEGIN
            const int t = u.pm * 256 + rl, c0 = u.pn * 256 + cl, head = c0 / 96, w = c0 - head * 96, b = t >> 11, s = t & 2047;
            const float sc = rsq[t] * QSCALE;
            bf16* qp = Q + ((size_t)(b * 8 + head) * SEQ + s) * 96;
            f32x4 a = v0 * sc, d = v1 * sc;
            if (w < 64) { *(u32x4*)(qp + w) = pack8(a, d); }
            else { const int g = (w - 64) >> 3; const f32x4 co = *(const f32x4*)(cs + (size_t)t * 16 + 4 * g), si = *(const f32x4*)(sn + (size_t)t * 16 + 4 * g);
                const f32x4 o1 = a * co - d * si, o2 = d * co + a * si;
                u32x2 w1, w2; w1.x = pk2(o1[0], o1[1]); w1.y = pk2(o1[2], o1[3]); w2.x = pk2(o2[0], o2[1]); w2.y = pk2(o2[2], o2[3]);
                *(u32x2*)(qp + 64 + 4 * g) = w1; *(u32x2*)(qp + 80 + 4 * g) = w2; }
        EPI_LOOP_END
    }
};
struct EpiK {
    bf16* Kb; const float* rskv;
    __device__ __forceinline__ void operator()(AccRef acc, const Unit& u, int wr, int wc, int fr, int fq) const {
        EPI_LOOP_BEGIN
            const int t = u.pm * 256 + rl, c0 = u.pn * 256 + cl, head = c0 >> 6, w = c0 & 63, b = t >> 11, s = t & 2047;
            const float sc = rskv[t];
            *(u32x4*)(Kb + ((size_t)(b * 8 + head) * SEQ + s) * 96 + w) = pack8(v0 * sc, v1 * sc);
        EPI_LOOP_END
    }
};
struct EpiV {
    bf16* VT; const float* rskv;
    __device__ __forceinline__ void operator()(AccRef acc, const Unit& u, int wr, int wc, int fr, int fq) const {
        EPI_LOOP_BEGIN
            const int f = u.pm * 256 + rl, t0 = u.pn * 256 + cl, b = t0 >> 11, s = t0 & 2047, head = f >> 6, dv = f & 63;
            const f32x4 r0 = *(const f32x4*)(rskv + t0), r1 = *(const f32x4*)(rskv + t0 + 4);
            *(u32x4*)(VT + ((size_t)(b * 8 + head) * 64 + dv) * SEQ + s) = pack8(v0 * r0, v1 * r1);
        EPI_LOOP_END
    }
};
struct EpiOut {
    bf16* Y; const bf16* proj; int pass;
    __device__ __forceinline__ void operator()(AccRef acc, const Unit& u, int wr, int wc, int fr, int fq) const {
        EPI_LOOP_BEGIN
            const int t = u.pm * 256 + rl, c0 = u.pn * 256 + cl;
            const u32x4 gw = *(const u32x4*)(proj + (size_t)t * NPROJ + (pass == 0 ? PGA : PGB) + c0);
            f32x4 g0, g1; unpack8(gw, g0, g1);
#pragma unroll
            for (int j = 0; j < 4; ++j) { g0[j] = sigmoidf_(g0[j]); g1[j] = sigmoidf_(g1[j]); }
            f32x4 a = v0 * g0, d = v1 * g1;
            bf16* yp = Y + (size_t)t * 1024 + c0;
            if (pass == 1) { f32x4 p0, p1; unpack8(*(const u32x4*)yp, p0, p1); a += p0; d += p1; }
            *(u32x4*)yp = pack8(a, d);
        EPI_LOOP_END
    }
};
struct EpiWo {
    float* X; const float* g1;
    __device__ __forceinline__ void operator()(AccRef acc, const Unit& u, int wr, int wc, int fr, int fq) const {
        EPI_LOOP_BEGIN
            const int t = u.pm * 256 + rl, c0 = u.pn * 256 + cl, b = t >> 11;
            const float* gp = g1 + (size_t)b * 6144 + c0; float* xp = X + (size_t)t * 1024 + c0;
            const f32x4 ga = *(const f32x4*)gp, gb = *(const f32x4*)(gp + 4);
            f32x4 xa = *(const f32x4*)xp, xb = *(const f32x4*)(xp + 4);
            xa += ga * v0; xb += gb * v1;
            *(f32x4*)xp = xa; *(f32x4*)(xp + 4) = xb;
        EPI_LOOP_END
    }
};
struct EpiGU {
    bf16* ACT; const float* bgu;
    __device__ __forceinline__ void operator()(AccRef acc, const Unit& u, int wr, int wc, int fr, int fq) const {
#pragma unroll
        for (int ai = 0; ai < 2; ++ai)
#pragma unroll
            for (int m = 0; m < 4; ++m) {
                const int rl = ai * 128 + wr * 64 + m * 16 + fr; const int j0 = u.pn * 128 + wc * 32 + 8 * fq;
                const float* bp = bgu + (size_t)u.e * 2048 + 2 * j0;
                const f32x4 b0 = *(const f32x4*)bp, b1 = *(const f32x4*)(bp + 4), b2 = *(const f32x4*)(bp + 8), b3 = *(const f32x4*)(bp + 12);
                const float bg[8] = {b0[0], b0[2], b1[0], b1[2], b2[0], b2[2], b3[0], b3[2]}, bu[8] = {b0[1], b0[3], b1[1], b1[3], b2[1], b2[3], b3[1], b3[3]};
                float o[8];
#pragma unroll
                for (int j = 0; j < 8; ++j) {
                    float g = acc[ai][0][m][j >> 2][j & 3] + bg[j], up = acc[ai][1][m][j >> 2][j & 3] + bu[j];
                    g = fminf(g, 7.0f); up = fminf(fmaxf(up, -7.0f), 7.0f);
                    o[j] = (up + 1.0f) * g * sigmoidf_(1.702f * g); }
                u32x4 w; w.x = pk2(o[0], o[1]); w.y = pk2(o[2], o[3]); w.z = pk2(o[4], o[5]); w.w = pk2(o[6], o[7]);
                *(u32x4*)(ACT + (size_t)(u.rowbase + rl) * 1024 + j0) = w;
                asm volatile("" ::: "memory");
            }
    }
};
struct EpiDown {
    bf16* YR; const float* bd; const int* list; const float* aw;
    __device__ __forceinline__ void operator()(AccRef acc, const Unit& u, int wr, int wc, int fr, int fq) const {
#pragma unroll
        for (int ai = 0; ai < 2; ++ai)
#pragma unroll
            for (int m = 0; m < 4; ++m) {
                const int rl = ai * 128 + wr * 64 + m * 16 + fr;
                if (rl < u.mrows) {
                    const int a = list[(size_t)u.e * T + u.pm * 256 + rl]; const float w = aw[a];
#pragma unroll
                    for (int bj = 0; bj < 2; ++bj) { const int c0 = u.pn * 256 + bj * 128 + wc * 32 + 8 * fq; const float* bp = bd + (size_t)u.e * 1024 + c0;
                        const f32x4 ba = *(const f32x4*)bp, bb = *(const f32x4*)(bp + 4);
                        *(u32x4*)(YR + (size_t)a * 1024 + c0) = pack8((acc[ai][bj][m][0] + ba) * w, (acc[ai][bj][m][1] + bb) * w); }
                }
                asm volatile("" ::: "memory");
            }
    }
};

enum { MAP_ID = 0, MAP_WIN = 1, MAP_WQ = 2, MAP_WKV = 3, MAP_GU = 4 };
__device__ __forceinline__ int map_row(int kind, int n) {
    if (kind == MAP_WIN) { if (n < 2560) return n; if (n < 2944) return NHT + PCQ + (n - 2560); if (n < 3200) return NHT + PCKV + (n - 2944); if (n < 3232) return NHT + PKPE + (n - 3200); return NHT + PGA + (n - 3232); }
    if (kind == MAP_WQ) { const int h = n / 96, j = n - h * 96; if (j < 64) return n; const int r = j - 64, i = r & 15; return h * 96 + 64 + 8 * (i >> 2) + ((r >> 4) << 2) + (i & 3); }
    if (kind == MAP_WKV) { const int h = n >> 7, j = n & 127; return (j < 64) ? (h * 64 + j) : (512 + h * 64 + (j - 64)); }
    if (kind == MAP_GU) { const int j = n >> 1, bj = n & 1; return (j >> 7) * 256 + bj * 128 + (j & 127); }
    return n;
}
__device__ __forceinline__ void conv_item(const float* W, int N, const float* kscale, bf16* WT, int dstK, int koff, int kind, LAS float* scr, int kb, int nb, int lane) {
    const int k0 = 64 * kb, n0 = 32 * nb;
#pragma unroll 8
    for (int i = 0; i < 32; ++i) { const int kk = 2 * i + (lane >> 5); float v = W[(size_t)(k0 + kk) * N + n0 + (lane & 31)]; if (kscale) v *= kscale[k0 + kk]; scr[kk * 33 + (lane & 31)] = v; }
    LDS_WAIT(); asm volatile("" ::: "memory");
    const int c = lane & 7;
#pragma unroll
    for (int j = 0; j < 4; ++j) { const int n = (lane >> 3) + 8 * j; const LAS float* s = scr + (8 * c) * 33 + n;
        u32x4 o; o.x = pk2(s[0 * 33], s[1 * 33]); o.y = pk2(s[2 * 33], s[3 * 33]); o.z = pk2(s[4 * 33], s[5 * 33]); o.w = pk2(s[6 * 33], s[7 * 33]);
        *(u32x4*)(WT + (size_t)map_row(kind, n0 + n) * dstK + koff + k0 + 8 * c) = o; }
    LDS_WAIT(); asm volatile("" ::: "memory");
}
__device__ __forceinline__ void p_prologue(Frame& F) {
    const float* const* in = F.in;
    __syncthreads();
    {
        LAS float* cond = (LAS float*)F.lds;
        LAS float* part = (LAS float*)(F.lds + 32768);
        for (int i = F.tid; i < 8 * 1024; i += 512) { const float v = in[1][i]; cond[i] = v * sigmoidf_(v); }
        __syncthreads();
        for (int it = F.bid; it < DEPTH * 96; it += F.G) {
            const int l = it / 96, n0 = (it % 96) * 64, col = F.tid & 63, kg = F.tid >> 6;
            const float* w = in[3] + (size_t)l * 1024 * 6144 + n0 + col;
            float a[8] = {0.f, 0.f, 0.f, 0.f, 0.f, 0.f, 0.f, 0.f};
            for (int k = kg * 128; k < kg * 128 + 128; ++k) { const float wv = w[(size_t)k * 6144];
#pragma unroll
                for (int b = 0; b < 8; ++b) a[b] += cond[b * 1024 + k] * wv; }
#pragma unroll
            for (int b = 0; b < 8; ++b) part[(kg * 8 + b) * 64 + col] = a[b];
            __syncthreads();
            { const int b = F.tid >> 6; float s = 0.f;
#pragma unroll
              for (int g = 0; g < 8; ++g) s += part[(g * 8 + b) * 64 + col];
              ((float*)(F.ws + WS_MOD))[((size_t)l * 8 + b) * 6144 + n0 + col] = s + in[4][(size_t)l * 6144 + n0 + col]; }
            __syncthreads();
        }
    }
    const int gtid = F.bid * 512 + F.tid, NT_ = F.G * 512;
    for (int i = gtid; i < 1024; i += NT_) {
        float lg[DEPTH], mx = -1e30f; for (int l = 0; l < DEPTH; ++l) { lg[l] = in[8][(size_t)l * 1024 + i]; mx = fmaxf(mx, lg[l]); }
        float s = 0.f; for (int l = 0; l < DEPTH; ++l) { lg[l] = __expf(lg[l] - mx); s += lg[l]; }
        float c = 0.f; float* lb = (float*)(F.ws + WS_LB);
        for (int l = 0; l < DEPTH; ++l) { if (l > 0) c += lg[l] / s; lb[(size_t)l * 1024 + i] = c; }
    }
    for (int i = gtid; i < T * 16; i += NT_) {
        const int t = i >> 4, j = i & 15; const int pos = ((const int*)in[2])[t];
        const double base4[4] = {1.0, 0.5623413251903491, 0.31622776601683794, 0.1778279410038923};
        double f = base4[j & 3]; for (int q = 0; q < (j >> 2); ++q) f *= 0.1;
        const double ang = (double)pos * f; const double n = __builtin_rint(ang * 0.15915494309189535); const float r = (float)(ang - n * 6.283185307179586);
        ((float*)(F.ws + WS_COS))[i] = cosf(r); ((float*)(F.ws + WS_SIN))[i] = sinf(r);
    }
    for (int l = 0; l < DEPTH; ++l) { u32x4* p = (u32x4*)(wl(F.ws, l, WL_IN) + (size_t)5280 * 1024 * 2); for (int i = gtid; i < 96 * 1024 * 2 / 16; i += NT_) p[i] = (u32x4){0u, 0u, 0u, 0u}; }
    {
        LAS float* scr = (LAS float*)(F.lds + F.wave * 16384);
        const int gw = F.bid * NWAVES + F.wave, NGW = F.G * NWAVES;
        constexpr int I_IN = 16 * 165, I_Q = 6 * 24, I_KV = 4 * 32, I_OH = 8 * 32, I_OM = 8 * 32, I_O = 16 * 32, I_GU = 32 * 16 * 64, I_DN = 32 * 16 * 32;
        constexpr int I_LAYER = I_IN + I_Q + I_KV + I_OH + I_OM + I_O + I_GU + I_DN;
        for (int it = gw; it < DEPTH * I_LAYER; it += NGW) {
            const int l = it / I_LAYER; int r = it - l * I_LAYER;
            if (r < I_IN) { conv_item(in[7] + (size_t)l * 1024 * 5280, 5280, nullptr, (bf16*)wl(F.ws, l, WL_IN), 1024, 0, MAP_WIN, scr, r / 165, r % 165, F.lane); continue; } r -= I_IN;
            if (r < I_Q) { conv_item(in[12] + (size_t)l * 384 * 768, 768, in[11] + l * 384, (bf16*)wl(F.ws, l, WL_Q), 384, 0, MAP_WQ, scr, r / 24, r % 24, F.lane); continue; } r -= I_Q;
            if (r < I_KV) { conv_item(in[14] + (size_t)l * 256 * 1024, 1024, in[13] + l * 256, (bf16*)wl(F.ws, l, WL_K), 256, 0, MAP_WKV, scr, r / 32, r % 32, F.lane); continue; } r -= I_KV;
            if (r < I_OH) { conv_item(in[10] + (size_t)l * 512 * 1024, 1024, nullptr, (bf16*)wl(F.ws, l, WL_OUT), 1024, 0, MAP_ID, scr, r / 32, r % 32, F.lane); continue; } r -= I_OH;
            if (r < I_OM) { conv_item(in[15] + (size_t)l * 512 * 1024, 1024, nullptr, (bf16*)wl(F.ws, l, WL_OUT), 1024, 512, MAP_ID, scr, r / 32, r % 32, F.lane); continue; } r -= I_OM;
            if (r < I_O) { conv_item(in[16] + (size_t)l * 1024 * 1024, 1024, nullptr, (bf16*)wl(F.ws, l, WL_O), 1024, 0, MAP_ID, scr, r / 32, r % 32, F.lane); continue; } r -= I_O;
            if (r < I_GU) { const int e = r / (16 * 64), q = r % (16 * 64); conv_item(in[19] + ((size_t)l * 32 + e) * 1024 * 2048, 2048, nullptr, (bf16*)wl(F.ws, l, WL_GU) + (size_t)e * 2048 * 1024, 1024, 0, MAP_GU, scr, q / 64, q % 64, F.lane); continue; } r -= I_GU;
            { const int e = r / (16 * 32), q = r % (16 * 32); conv_item(in[21] + ((size_t)l * 32 + e) * 1024 * 1024, 1024, nullptr, (bf16*)wl(F.ws, l, WL_DN) + (size_t)e * 1024 * 1024, 1024, 0, MAP_ID, scr, q / 32, q % 32, F.lane); }
        }
    }
}

__device__ __forceinline__ void p_norm_mix(Frame& F, int l, bool fin, float* out, bool dummy = false) {
    const float* const* in = F.in;
    float* X = (float*)(F.ws + (dummy ? WS_ACT : WS_X)); const float* MOD = (const float*)(F.ws + WS_MOD); const bf16* YR = (const bf16*)(F.ws + WS_YR); bf16* HB = (bf16*)(F.ws + (dummy ? WS_ACT + 64 * MiB : WS_HB));
    const int gw = F.bid * NWAVES + F.wave, NGW = F.G * NWAVES;
    for (int t = gw; t < T; t += NGW) {
        const int b = t >> 11; f32x4 v[4];
        const float* src = (l == 0) ? in[0] + (size_t)t * 1024 : X + (size_t)t * 1024;
#pragma unroll
        for (int j = 0; j < 4; ++j) v[j] = *(const f32x4*)(src + 4 * F.lane + 256 * j);
        if (l > 0) {
            const float* g2 = MOD + ((size_t)(l - 1) * 8 + b) * 6144 + 5 * 1024;
#pragma unroll
            for (int j = 0; j < 4; ++j) { f32x4 s = {0.f, 0.f, 0.f, 0.f};
#pragma unroll
                for (int k = 0; k < 4; ++k) { const u32x2 w = *(const u32x2*)(YR + ((size_t)t * 4 + k) * 1024 + 4 * F.lane + 256 * j); s[0] += bflo(w.x); s[1] += bfhi(w.x); s[2] += bflo(w.y); s[3] += bfhi(w.y); }
                v[j] += *(const f32x4*)(g2 + 4 * F.lane + 256 * j) * s; }
        }
        float ss = 0.f;
#pragma unroll
        for (int j = 0; j < 4; ++j) ss += (v[j][0] * v[j][0] + v[j][1] * v[j][1]) + (v[j][2] * v[j][2] + v[j][3] * v[j][3]);
        const float rs = rsqrtf(wave_sum(ss) * (1.0f / 1024.0f) + EPS);
        if (fin) {
            const float* gn = in[23];
#pragma unroll
            for (int j = 0; j < 4; ++j) { const int d = 4 * F.lane + 256 * j; *(f32x4*)(out + (size_t)t * 1024 + d) = v[j] * rs * *(const f32x4*)(gn + d); }
        } else {
            const float* gn = in[5] + (size_t)l * 1024; const float* sh = MOD + ((size_t)l * 8 + b) * 6144; const float* sc = sh + 1024;
#pragma unroll
            for (int j = 0; j < 4; ++j) { const int d = 4 * F.lane + 256 * j; *(f32x4*)(X + (size_t)t * 1024 + d) = v[j];
                const f32x4 g = *(const f32x4*)(gn + d), s1 = *(const f32x4*)(sc + d), s0 = *(const f32x4*)(sh + d);
                const f32x4 h = v[j] * rs * g * (s1 + 1.0f) + s0; u32x2 w; w.x = pk2(h[0], h[1]); w.y = pk2(h[2], h[3]);
                *(u32x2*)(HB + (size_t)t * 1024 + d) = w; }
        }
    }
}
__device__ __forceinline__ void p_mla_prep(Frame& F) {
    const bf16* PROJ = (const bf16*)(F.ws + WS_PROJ); float* RSQ = (float*)(F.ws + WS_RSQ); float* RSKV = (float*)(F.ws + WS_RSKV); bf16* Kb = (bf16*)(F.ws + WS_K);
    const float* CS = (const float*)(F.ws + WS_COS); const float* SN = (const float*)(F.ws + WS_SIN);
    const int gw = F.bid * NWAVES + F.wave, NGW = F.G * NWAVES;
    for (int t = gw; t < T; t += NGW) {
        const bf16* row = PROJ + (size_t)t * NPROJ;
        float sq = 0.f, skv = 0.f;
#pragma unroll
        for (int j = 0; j < 6; ++j) { const float v = bf2f(row[PCQ + F.lane + 64 * j]); sq += v * v; }
#pragma unroll
        for (int j = 0; j < 4; ++j) { const float v = bf2f(row[PCKV + F.lane + 64 * j]); skv += v * v; }
        sq = wave_sum(sq); skv = wave_sum(skv);
        if (F.lane == 0) { RSQ[t] = rsqrtf(sq * (1.0f / 384.0f) + EPS); RSKV[t] = rsqrtf(skv * (1.0f / 256.0f) + EPS); }
        if (F.lane < 16) {
            const float x1 = bf2f(row[PKPE + F.lane]), x2 = bf2f(row[PKPE + 16 + F.lane]), co = CS[(size_t)t * 16 + F.lane], si = SN[(size_t)t * 16 + F.lane];
            const bf16 o1 = (bf16)(pk2(x1 * co - x2 * si, 0.f) & 0xffffu), o2 = (bf16)(pk2(x2 * co + x1 * si, 0.f) & 0xffffu);
            const int b = t >> 11, s = t & 2047;
#pragma unroll
            for (int h = 0; h < 8; ++h) { bf16* kp = Kb + ((size_t)(b * 8 + h) * SEQ + s) * 96; kp[64 + F.lane] = o1; kp[80 + F.lane] = o2; }
        }
    }
}
__device__ __forceinline__ void p_hgrn_post(Frame& F, int l) {
    const float* OFp = (const float*)(F.ws + WS_OF); const float* OBp = (const float*)(F.ws + WS_OB); const bf16* PROJ = (const bf16*)(F.ws + WS_PROJ); bf16* HA = (bf16*)(F.ws + WS_HA);
    const float* gn = F.in[9] + (size_t)l * 128;
    const int gw = F.bid * NWAVES + F.wave, NGW = F.G * NWAVES;
    for (int t = gw; t < T; t += NGW) {
        const int c = 8 * F.lane;
        f32x4 a0 = *(const f32x4*)(OFp + (size_t)t * 512 + c) + *(const f32x4*)(OBp + (size_t)t * 512 + c), a1 = *(const f32x4*)(OFp + (size_t)t * 512 + c + 4) + *(const f32x4*)(OBp + (size_t)t * 512 + c + 4);
        float ss = (a0[0] * a0[0] + a0[1] * a0[1]) + (a0[2] * a0[2] + a0[3] * a0[3]) + (a1[0] * a1[0] + a1[1] * a1[1]) + (a1[2] * a1[2] + a1[3] * a1[3]);
#pragma unroll
        for (int o = 1; o < 16; o <<= 1) ss += __shfl_xor(ss, o);
        const float rs = rsqrtf(ss * (1.0f / 128.0f) + EPS);
        f32x4 g0, g1; unpack8(*(const u32x4*)(PROJ + (size_t)t * NPROJ + PGT + c), g0, g1);
        const f32x4 n0 = *(const f32x4*)(gn + (c & 127)), n1 = *(const f32x4*)(gn + (c & 127) + 4);
#pragma unroll
        for (int j = 0; j < 4; ++j) { a0[j] = a0[j] * rs * n0[j] * sigmoidf_(g0[j]); a1[j] = a1[j] * rs * n1[j] * sigmoidf_(g1[j]); }
        *(u32x4*)(HA + (size_t)t * 1024 + c) = pack8(a0, a1);
    }
}

__device__ __forceinline__ void scan_unit(Frame& F, int l, int u) {
    const int vq = u & 3, dir = (u >> 2) & 1, hh = (u >> 3) & 3, b = u >> 5;
    const bf16* HTb = (const bf16*)(F.ws + WS_HT) + (size_t)b * NHT * SEQ; const float* LB = (const float*)(F.ws + WS_LB) + ((size_t)l * 2 + dir) * 512 + hh * 128;
    float* OUT = (float*)(F.ws + (dir ? WS_OB : WS_OF));
    LAS float* sq = (LAS float*)F.lds;
    LAS float* sf = sq + 32 * 128;
    LAS float* sv = sf + 32 * 128;
    LAS float* op = sv + 32 * 32;
    const int v = F.tid & 31, dg = F.tid >> 5;
    float st[8];
#pragma unroll
    for (int j = 0; j < 8; ++j) st[j] = 0.f;
    const int fcol = (dir ? HFB : HFF) + hh * 128;
    for (int blk = 0; blk < SEQ / 32; ++blk) {
        __syncthreads();
        for (int idx = F.tid; idx < 32 * 128; idx += 512) { const int tl = idx >> 7, d = idx & 127; const int s = dir ? (SEQ - 1 - (blk * 32 + tl)) : (blk * 32 + tl);
            const float qv = bf2f(HTb[(size_t)(HQ + hh * 128 + d) * SEQ + s]), fv = bf2f(HTb[(size_t)(fcol + d) * SEQ + s]), lb = LB[d];
            sq[idx] = qv * sigmoidf_(qv); sf[idx] = lb + (1.0f - lb) * sigmoidf_(fv); }
        for (int idx = F.tid; idx < 32 * 32; idx += 512) { const int tl = idx >> 5, vv = idx & 31; const int s = dir ? (SEQ - 1 - (blk * 32 + tl)) : (blk * 32 + tl);
            sv[idx] = bf2f(HTb[(size_t)(HI + hh * 128 + vq * 32 + vv) * SEQ + s]); }
        __syncthreads();
        for (int tl = 0; tl < 32; ++tl) {
            const f32x4 f0 = *(const LAS f32x4*)(sf + tl * 128 + dg * 8), f1 = *(const LAS f32x4*)(sf + tl * 128 + dg * 8 + 4);
            const f32x4 q0 = *(const LAS f32x4*)(sq + tl * 128 + dg * 8), q1 = *(const LAS f32x4*)(sq + tl * 128 + dg * 8 + 4);
            const float vv = sv[tl * 32 + v]; float o = 0.f;
#pragma unroll
            for (int j = 0; j < 4; ++j) { st[j] = f0[j] * st[j] + (1.0f - f0[j]) * vv; o += q0[j] * st[j]; st[4 + j] = f1[j] * st[4 + j] + (1.0f - f1[j]) * vv; o += q1[j] * st[4 + j]; }
            o += __shfl_xor(o, 32);
            if (F.lane < 32) op[(tl * 8 + F.wave) * 32 + v] = o;
        }
        __syncthreads();
        for (int idx = F.tid; idx < 32 * 32; idx += 512) { const int tl = idx >> 5, vv = idx & 31; float s = 0.f;
#pragma unroll
            for (int w = 0; w < 8; ++w) s += op[(tl * 8 + w) * 32 + vv];
            const int sp = dir ? (SEQ - 1 - (blk * 32 + tl)) : (blk * 32 + tl);
            OUT[(size_t)(b * SEQ + sp) * 512 + hh * 128 + vq * 32 + vv] = s; }
    }
    __syncthreads();
}

#define MFMA16(a, b, c) __builtin_amdgcn_mfma_f32_16x16x32_bf16((a), (b), (c), 0, 0, 0)
constexpr int SC_QROW = 272, SC_TROW = 144;
constexpr int SC_QT = 0, SC_KT = SC_QT + 64 * SC_QROW, SC_KH = SC_KT + 64 * SC_QROW, SC_VT = SC_KH + 128 * SC_TROW, SC_DEC = SC_VT + 128 * SC_TROW, SC_ZERO = SC_DEC + 4 * 128 * 4, SC_END = SC_ZERO + 64;
__device__ __forceinline__ unsigned rot16(unsigned x) { return (x >> 16) | (x << 16); }
__device__ __forceinline__ void scan_unit2(Frame& F, int l, int u) {
    const int dir = u & 1, hh = (u >> 1) & 3, b = u >> 3;
    const bf16* HTb = (const bf16*)(F.ws + WS_HT) + (size_t)b * NHT * SEQ;
    const bf16* qg = HTb + (size_t)(HQ + hh * 128) * SEQ; const bf16* fg = HTb + (size_t)((dir ? HFB : HFF) + hh * 128) * SEQ; const bf16* vg = HTb + (size_t)(HI + hh * 128) * SEQ;
    float* OUT = (float*)(F.ws + (dir ? WS_OB : WS_OF));
    LAS unsigned char* lds = F.lds;
    const int d = F.tid & 127, si = F.tid >> 7;
    const float lbv = ((const float*)(F.ws + WS_LB))[((size_t)l * 2 + dir) * 512 + hh * 128 + d];
    const int r = F.lane & 15, g = F.lane >> 4, v0 = F.wave * 16;
    f32x4 S[8];
#pragma unroll
    for (int i = 0; i < 8; ++i) S[i] = (f32x4){0.f, 0.f, 0.f, 0.f};
    __syncthreads();
    if (F.tid < 16) *(LAS unsigned*)(lds + SC_ZERO + F.tid * 4) = 0u;
    u32x4 pq[2], pf[2], pv[2];
    const int vrow0 = F.tid >> 3, vmc = F.tid & 7;
    {   const int m0 = dir ? SEQ - 64 : 0; const int mb = dir ? m0 + 48 - 16 * si : m0 + 16 * si;
        pq[0] = *(const u32x4*)(qg + (size_t)d * SEQ + mb); pq[1] = *(const u32x4*)(qg + (size_t)d * SEQ + mb + 8);
        pf[0] = *(const u32x4*)(fg + (size_t)d * SEQ + mb); pf[1] = *(const u32x4*)(fg + (size_t)d * SEQ + mb + 8);
        pv[0] = *(const u32x4*)(vg + (size_t)vrow0 * SEQ + m0 + 8 * vmc); pv[1] = *(const u32x4*)(vg + (size_t)(vrow0 + 64) * SEQ + m0 + 8 * vmc); }
#pragma unroll 1
    for (int c = 0; c < SEQ / 64; ++c) {
        const int m0 = dir ? SEQ - 64 * (c + 1) : 64 * c;
        float rq[16], rf[16];
#pragma unroll
        for (int j = 0; j < 2; ++j) {
            rq[8 * j + 0] = bflo(pq[j].x); rq[8 * j + 1] = bfhi(pq[j].x); rq[8 * j + 2] = bflo(pq[j].y); rq[8 * j + 3] = bfhi(pq[j].y); rq[8 * j + 4] = bflo(pq[j].z); rq[8 * j + 5] = bfhi(pq[j].z); rq[8 * j + 6] = bflo(pq[j].w); rq[8 * j + 7] = bfhi(pq[j].w);
            rf[8 * j + 0] = bflo(pf[j].x); rf[8 * j + 1] = bfhi(pf[j].x); rf[8 * j + 2] = bflo(pf[j].y); rf[8 * j + 3] = bfhi(pf[j].y); rf[8 * j + 4] = bflo(pf[j].z); rf[8 * j + 5] = bfhi(pf[j].z); rf[8 * j + 6] = bflo(pf[j].w); rf[8 * j + 7] = bfhi(pf[j].w); }
        float qt[16], kt[16], E = 1.0f;
#pragma unroll
        for (int k = 0; k < 16; ++k) {
            const float fin = dir ? rf[15 - k] : rf[k], qin = dir ? rq[15 - k] : rq[k];
            const float f = lbv + (1.0f - lbv) * sigmoidf_(fin); E *= f;
            qt[k] = qin * sigmoidf_(qin) * E; kt[k] = (1.0f - f) * __builtin_amdgcn_rcpf(E);
        }
        __syncthreads();
        {   LAS unsigned char* qp = lds + SC_QT + (16 * si) * SC_QROW + d * 2; LAS unsigned char* kp = lds + SC_KT + (16 * si) * SC_QROW + d * 2;
#pragma unroll
            for (int k = 0; k < 16; k += 2) { const unsigned wq = pk2(qt[k], qt[k + 1]), wk = pk2(kt[k], kt[k + 1]);
                *(LAS unsigned short*)(qp + k * SC_QROW) = (unsigned short)wq; *(LAS unsigned short*)(qp + (k + 1) * SC_QROW) = (unsigned short)(wq >> 16);
                *(LAS unsigned short*)(kp + k * SC_QROW) = (unsigned short)wk; *(LAS unsigned short*)(kp + (k + 1) * SC_QROW) = (unsigned short)(wk >> 16); }
            u32x4 h0, h1;
            h0.x = pk2(kt[0] * E, kt[1] * E); h0.y = pk2(kt[2] * E, kt[3] * E); h0.z = pk2(kt[4] * E, kt[5] * E); h0.w = pk2(kt[6] * E, kt[7] * E);
            h1.x = pk2(kt[8] * E, kt[9] * E); h1.y = pk2(kt[10] * E, kt[11] * E); h1.z = pk2(kt[12] * E, kt[13] * E); h1.w = pk2(kt[14] * E, kt[15] * E);
            *(LAS u32x4*)(lds + SC_KH + d * SC_TROW + 32 * si) = h0; *(LAS u32x4*)(lds + SC_KH + d * SC_TROW + 32 * si + 16) = h1;
            *(LAS float*)(lds + SC_DEC + (si * 128 + d) * 4) = E;
#pragma unroll
            for (int j = 0; j < 2; ++j) { u32x4 w = pv[j]; int tl0 = 8 * vmc;
                if (dir) { w = (u32x4){rot16(pv[j].w), rot16(pv[j].z), rot16(pv[j].y), rot16(pv[j].x)}; tl0 = 56 - 8 * vmc; }
                *(LAS u32x4*)(lds + SC_VT + (vrow0 + 64 * j) * SC_TROW + tl0 * 2) = w; }
        }
        if (c + 1 < SEQ / 64) {
            const int m1 = dir ? SEQ - 64 * (c + 2) : 64 * (c + 1); const int mb = dir ? m1 + 48 - 16 * si : m1 + 16 * si;
            pq[0] = *(const u32x4*)(qg + (size_t)d * SEQ + mb); pq[1] = *(const u32x4*)(qg + (size_t)d * SEQ + mb + 8);
            pf[0] = *(const u32x4*)(fg + (size_t)d * SEQ + mb); pf[1] = *(const u32x4*)(fg + (size_t)d * SEQ + mb + 8);
            pv[0] = *(const u32x4*)(vg + (size_t)vrow0 * SEQ + m1 + 8 * vmc); pv[1] = *(const u32x4*)(vg + (size_t)(vrow0 + 64) * SEQ + m1 + 8 * vmc);
        }
        __syncthreads();
#pragma unroll 1
        for (int i = 0; i < 4; ++i) {
            const LAS unsigned char* qrow = lds + SC_QT + (16 * i + r) * SC_QROW; const LAS unsigned char* krow = lds + SC_KT + (16 * i + r) * SC_QROW;
            f32x4 pT = {0.f, 0.f, 0.f, 0.f};
#pragma unroll
            for (int ks = 0; ks < 4; ++ks) pT = MFMA16(*(const LAS bf16x8*)(krow + (32 * ks + 8 * g) * 2), *(const LAS bf16x8*)(qrow + (32 * ks + 8 * g) * 2), pT);
#pragma unroll
            for (int q = 0; q < 4; ++q) pT[q] = (4 * g + q <= r) ? pT[q] : 0.0f;
            const bf16x8 pfrag = __builtin_bit_cast(bf16x8, ((u32x4){pk2(pT[0], pT[1]), pk2(pT[2], pT[3]), 0u, 0u}));
            const u32x2 vt4 = *(const LAS u32x2*)(lds + SC_VT + (v0 + r) * SC_TROW + (16 * i + 4 * g) * 2);
            f32x4 oT = MFMA16(__builtin_bit_cast(bf16x8, ((u32x4){vt4.x, vt4.y, 0u, 0u})), pfrag, ((f32x4){0.f, 0.f, 0.f, 0.f}));
#pragma unroll
            for (int kk = 0; kk < 4; ++kk) {
                const bf16x8 sfrag = __builtin_bit_cast(bf16x8, ((u32x4){pk2(S[2 * kk][0], S[2 * kk][1]), pk2(S[2 * kk][2], S[2 * kk][3]), pk2(S[2 * kk + 1][0], S[2 * kk + 1][1]), pk2(S[2 * kk + 1][2], S[2 * kk + 1][3])}));
                const u32x2 qa = *(const LAS u32x2*)(qrow + (32 * kk + 4 * g) * 2), qb = *(const LAS u32x2*)(qrow + (32 * kk + 16 + 4 * g) * 2);
                oT = MFMA16(sfrag, __builtin_bit_cast(bf16x8, ((u32x4){qa.x, qa.y, qb.x, qb.y})), oT);
            }
            { const int m = dir ? m0 + 63 - 16 * i - r : m0 + 16 * i + r;
              *(f32x4*)(OUT + (size_t)(b * SEQ + m) * 512 + hh * 128 + v0 + 4 * g) = oT; }
            const int zoff = (g < 2) ? 0 : 1;
            const LAS unsigned char* vtp = zoff ? lds + SC_ZERO : lds + SC_VT + (v0 + r) * SC_TROW + (16 * i + 8 * g) * 2;
            const bf16x8 vfrag = *(const LAS bf16x8*)vtp;
#pragma unroll
            for (int dt = 0; dt < 8; ++dt) {
                const f32x4 dec = *(const LAS f32x4*)(lds + SC_DEC + (i * 128 + 16 * dt + 4 * g) * 4);
                const LAS unsigned char* khp = zoff ? lds + SC_ZERO : lds + SC_KH + (16 * dt + r) * SC_TROW + (16 * i + 8 * g) * 2;
                S[dt] = MFMA16(*(const LAS bf16x8*)khp, vfrag, S[dt] * dec);
            }
        }
    }
    __syncthreads();
}

#define MFMA32(a, b, c) __builtin_amdgcn_mfma_f32_32x32x16_bf16((a), (b), (c), 0, 0, 0)
constexpr int AT_KROW = 208, AT_VROW = 136, AT_KBYTES = 64 * AT_KROW, AT_BUF = AT_KBYTES + 64 * AT_VROW;
__device__ __forceinline__ void attn_unit(Frame& F, int bh, int q0) {
    const bf16* Q = (const bf16*)(F.ws + WS_Q); const char* Kg = (const char*)(F.ws + WS_K) + (size_t)bh * SEQ * 96 * 2; const char* Vg = (const char*)(F.ws + WS_VT) + (size_t)bh * 64 * SEQ * 2;
    bf16* HA = (bf16*)(F.ws + WS_HA);
    LAS unsigned char* lds = F.lds;
    const int r = F.lane & 31, h = F.lane >> 5;
    bf16x8 qf[6];
    { const bf16* qrow = Q + ((size_t)bh * SEQ + q0 + F.wave * 32 + r) * 96;
#pragma unroll
      for (int ks = 0; ks < 6; ++ks) qf[ks] = *(const bf16x8*)(qrow + 16 * ks + 8 * h); }
    f32x16 o0, o1;
#pragma unroll
    for (int i = 0; i < 16; ++i) { o0[i] = 0.f; o1[i] = 0.f; }
    float mrun = -1e30f, lsum = 0.f;
    const int kc0 = F.tid, kc1 = F.tid + 512; const bool has1 = F.tid < 256;
    const int kl0 = (kc0 / 12) * AT_KROW + (kc0 % 12) * 16, kl1 = (kc1 / 12) * AT_KROW + (kc1 % 12) * 16;
    const int vrow = F.tid >> 3, vpc = F.tid & 7; const int vl = AT_KBYTES + vrow * AT_VROW + vpc * 16;
    u32x4 rk0, rk1 = {0u, 0u, 0u, 0u}, rv;
    __syncthreads();
    rk0 = *(const u32x4*)(Kg + (size_t)kc0 * 16); if (has1) rk1 = *(const u32x4*)(Kg + (size_t)kc1 * 16);
    rv = *(const u32x4*)(Vg + (size_t)vrow * SEQ * 2 + vpc * 16);
    *(LAS u32x4*)(lds + kl0) = rk0; if (has1) *(LAS u32x4*)(lds + kl1) = rk1;
    *(LAS u32x2*)(lds + vl) = (u32x2){rv.x, rv.y}; *(LAS u32x2*)(lds + vl + 8) = (u32x2){rv.z, rv.w};
    __syncthreads();
    for (int j = 0; j < SEQ / 64; ++j) {
        const int buf = (j & 1) * AT_BUF, nbuf = ((j + 1) & 1) * AT_BUF;
        if (j + 1 < SEQ / 64) {
            const char* kg = Kg + (size_t)(j + 1) * 64 * 96 * 2;
            rk0 = *(const u32x4*)(kg + (size_t)kc0 * 16); if (has1) rk1 = *(const u32x4*)(kg + (size_t)kc1 * 16);
            rv = *(const u32x4*)(Vg + (size_t)vrow * SEQ * 2 + (size_t)(j + 1) * 128 + vpc * 16);
        }
        f32x16 s0, s1;
#pragma unroll
        for (int i = 0; i < 16; ++i) { s0[i] = 0.f; s1[i] = 0.f; }
#pragma unroll
        for (int ks = 0; ks < 6; ++ks) {
            const bf16x8 k0 = *(const LAS bf16x8*)(lds + buf + r * AT_KROW + (16 * ks + 8 * h) * 2);
            const bf16x8 k1 = *(const LAS bf16x8*)(lds + buf + (32 + r) * AT_KROW + (16 * ks + 8 * h) * 2);
            s0 = MFMA32(k0, qf[ks], s0); s1 = MFMA32(k1, qf[ks], s1);
        }
        float mx = s0[0];
#pragma unroll
        for (int i = 1; i < 16; ++i) mx = fmaxf(mx, s0[i]);
#pragma unroll
        for (int i = 0; i < 16; ++i) mx = fmaxf(mx, s1[i]);
        mx = fmaxf(mx, __shfl_xor(mx, 32));
        const float mnew = fmaxf(mrun, mx), alpha = exp2f(mrun - mnew); mrun = mnew;
        float ps = 0.f;
#pragma unroll
        for (int i = 0; i < 16; ++i) { s0[i] = exp2f(s0[i] - mnew); s1[i] = exp2f(s1[i] - mnew); ps += s0[i] + s1[i]; }
        lsum = lsum * alpha + ps;
#pragma unroll
        for (int i = 0; i < 16; ++i) { o0[i] *= alpha; o1[i] *= alpha; }
        bf16x8 pf[2][2];
#pragma unroll
        for (int sp = 0; sp < 2; ++sp) {
            u32x4 w0, w1;
            w0.x = pk2(s0[8 * sp + 0], s0[8 * sp + 1]); w0.y = pk2(s0[8 * sp + 2], s0[8 * sp + 3]); w0.z = pk2(s0[8 * sp + 4], s0[8 * sp + 5]); w0.w = pk2(s0[8 * sp + 6], s0[8 * sp + 7]);
            w1.x = pk2(s1[8 * sp + 0], s1[8 * sp + 1]); w1.y = pk2(s1[8 * sp + 2], s1[8 * sp + 3]); w1.z = pk2(s1[8 * sp + 4], s1[8 * sp + 5]); w1.w = pk2(s1[8 * sp + 6], s1[8 * sp + 7]);
            pf[0][sp] = __builtin_bit_cast(bf16x8, w0); pf[1][sp] = __builtin_bit_cast(bf16x8, w1);
        }
#pragma unroll
        for (int kb = 0; kb < 2; ++kb)
#pragma unroll
            for (int sp = 0; sp < 2; ++sp) {
                const int kbase = (32 * kb + 16 * sp + 4 * h) * 2;
                const LAS unsigned char* v0p = lds + buf + AT_KBYTES + r * AT_VROW + kbase;
                const LAS unsigned char* v1p = lds + buf + AT_KBYTES + (32 + r) * AT_VROW + kbase;
                const u32x2 a0 = *(const LAS u32x2*)v0p, a1 = *(const LAS u32x2*)(v0p + 16), c0 = *(const LAS u32x2*)v1p, c1 = *(const LAS u32x2*)(v1p + 16);
                const bf16x8 vf0 = __builtin_bit_cast(bf16x8, ((u32x4){a0.x, a0.y, a1.x, a1.y})), vf1 = __builtin_bit_cast(bf16x8, ((u32x4){c0.x, c0.y, c1.x, c1.y}));
                o0 = MFMA32(vf0, pf[kb][sp], o0); o1 = MFMA32(vf1, pf[kb][sp], o1);
            }
        if (j + 1 < SEQ / 64) {
            *(LAS u32x4*)(lds + nbuf + kl0) = rk0; if (has1) *(LAS u32x4*)(lds + nbuf + kl1) = rk1;
            *(LAS u32x2*)(lds + nbuf + vl) = (u32x2){rv.x, rv.y}; *(LAS u32x2*)(lds + nbuf + vl + 8) = (u32x2){rv.z, rv.w};
        }
        __syncthreads();
    }
    lsum += __shfl_xor(lsum, 32);
    const float inv = 1.0f / lsum;
    const int head = bh & 7, b = bh >> 3;
    bf16* orow = HA + (size_t)(b * SEQ + q0 + F.wave * 32 + r) * 1024 + 512 + head * 64;
#pragma unroll
    for (int i = 0; i < 4; ++i) {
        u32x2 w0, w1;
        w0.x = pk2(o0[4 * i] * inv, o0[4 * i + 1] * inv); w0.y = pk2(o0[4 * i + 2] * inv, o0[4 * i + 3] * inv);
        w1.x = pk2(o1[4 * i] * inv, o1[4 * i + 1] * inv); w1.y = pk2(o1[4 * i + 2] * inv, o1[4 * i + 3] * inv);
        *(u32x2*)(orow + 8 * i + 4 * h) = w0; *(u32x2*)(orow + 32 + 8 * i + 4 * h) = w1;
    }
}

__device__ __forceinline__ void p_router(Frame& F, int l, bool dummy = false) {
    const float* const* in = F.in;
    const float* X = (const float*)(F.ws + WS_X); const float* MOD = (const float*)(F.ws + WS_MOD); bf16* HB = (bf16*)(F.ws + WS_HB);
    int* LIST = (int*)(F.ws + (dummy ? WS_Y : WS_LIST)); float* AW = (float*)(F.ws + (dummy ? WS_Y + 4 * MiB : WS_AW)); unsigned* CNT = (unsigned*)(F.ws + WS_CTL) + CW_CNT + (l + (dummy ? 4 : 0)) * 32 * 64;
    LAS unsigned char* lds = F.lds;
    __syncthreads();
    { const float* wr = in[17] + (size_t)l * 1024 * 32;
      for (int q = F.tid; q < 8192; q += 512) { const int k = q >> 3; *(LAS f32x4*)(lds + (size_t)(q + (k >> 2)) * 16) = *(const f32x4*)(wr + (size_t)q * 4); } }
    __syncthreads();
    const float* gn = in[6] + (size_t)l * 1024; const float* br = in[18] + (size_t)l * 32;
    const int gw = F.bid * NWAVES + F.wave, NGW = F.G * NWAVES;
    for (int t = gw; t < T; t += NGW) {
        const int b = t >> 11; f32x4 v[4]; float ss = 0.f;
#pragma unroll
        for (int j = 0; j < 4; ++j) { v[j] = *(const f32x4*)(X + (size_t)t * 1024 + 4 * F.lane + 256 * j); ss += (v[j][0] * v[j][0] + v[j][1] * v[j][1]) + (v[j][2] * v[j][2] + v[j][3] * v[j][3]); }
        const float rs = rsqrtf(wave_sum(ss) * (1.0f / 1024.0f) + EPS);
        const float* sh = MOD + ((size_t)l * 8 + b) * 6144 + 3 * 1024; const float* sc = sh + 1024;
#pragma unroll
        for (int j = 0; j < 4; ++j) { const int d = 4 * F.lane + 256 * j; const f32x4 g = *(const f32x4*)(gn + d), s1 = *(const f32x4*)(sc + d), s0 = *(const f32x4*)(sh + d);
            v[j] = v[j] * rs * g * (s1 + 1.0f) + s0; u32x2 w; w.x = pk2(v[j][0], v[j][1]); w.y = pk2(v[j][2], v[j][3]);
            *(u32x2*)(HB + (size_t)t * 1024 + d) = w; }
        float p[32];
#pragma unroll
        for (int e = 0; e < 32; ++e) p[e] = 0.f;
#pragma unroll
        for (int j = 0; j < 4; ++j)
#pragma unroll
            for (int i = 0; i < 4; ++i) { const int k = 4 * F.lane + 256 * j + i; const LAS unsigned char* wp = lds + (size_t)(k * 8 + (k >> 2)) * 16; const float hv = v[j][i];
#pragma unroll
                for (int c = 0; c < 8; ++c) { const f32x4 w = *(const LAS f32x4*)(wp + c * 16); p[4 * c] += hv * w[0]; p[4 * c + 1] += hv * w[1]; p[4 * c + 2] += hv * w[2]; p[4 * c + 3] += hv * w[3]; }
                __builtin_amdgcn_sched_barrier(0); }
#pragma unroll
        for (int e = 0; e < 16; ++e) { const bool up = (F.lane & 32) != 0; const float keep = up ? p[e + 16] : p[e], send = up ? p[e] : p[e + 16]; p[e] = keep + __shfl_xor(send, 32); }
#pragma unroll
        for (int e = 0; e < 8; ++e) { const bool up = (F.lane & 16) != 0; const float keep = up ? p[e + 8] : p[e], send = up ? p[e] : p[e + 8]; p[e] = keep + __shfl_xor(send, 16); }
#pragma unroll
        for (int e = 0; e < 4; ++e) { const bool up = (F.lane & 8) != 0; const float keep = up ? p[e + 4] : p[e], send = up ? p[e] : p[e + 4]; p[e] = keep + __shfl_xor(send, 8); }
#pragma unroll
        for (int e = 0; e < 2; ++e) { const bool up = (F.lane & 4) != 0; const float keep = up ? p[e + 2] : p[e], send = up ? p[e] : p[e + 2]; p[e] = keep + __shfl_xor(send, 4); }
        { const bool up = (F.lane & 2) != 0; const float keep = up ? p[1] : p[0], send = up ? p[0] : p[1]; p[0] = keep + __shfl_xor(send, 2); }
        float logit = p[0] + __shfl_xor(p[0], 1);
        const int myE = F.lane >> 1; logit += br[myE];
        float tv[4]; int te[4];
#pragma unroll
        for (int k = 0; k < 4; ++k) {
            float bv = logit; int be = myE;
#pragma unroll
            for (int o = 1; o < 64; o <<= 1) { const float ov = __shfl_xor(bv, o); const int oe = __shfl_xor(be, o); if (ov > bv || (ov == bv && oe < be)) { bv = ov; be = oe; } }
            tv[k] = bv; te[k] = be; if (myE == be) logit = -3.0e38f;
        }
        const float e1 = __expf(tv[1] - tv[0]), e2 = __expf(tv[2] - tv[0]), e3 = __expf(tv[3] - tv[0]); const float invs = 1.0f / (1.0f + e1 + e2 + e3);
        if (F.lane < 4) {
            const int ek = F.lane == 0 ? te[0] : F.lane == 1 ? te[1] : F.lane == 2 ? te[2] : te[3];
            const float wk = (F.lane == 0 ? 1.0f : F.lane == 1 ? e1 : F.lane == 2 ? e2 : e3) * invs;
            const unsigned slot = __hip_atomic_fetch_add(CNT + ek * 64, 1u, __ATOMIC_RELAXED, __HIP_MEMORY_SCOPE_AGENT);
            LIST[(size_t)ek * T + slot] = t * 4 + F.lane; AW[t * 4 + F.lane] = wk;
        }
    }
    __syncthreads();
}
__device__ __forceinline__ void moe_tables(Frame& F, int l) {
    LAS int* cnt = (LAS int*)(F.lds + MOE_OFF); LAS int* toff = cnt + 32;
    const unsigned* CNT = (const unsigned*)(F.ws + WS_CTL) + CW_CNT + l * 32 * 64;
    __syncthreads();
    if (F.tid < 32) cnt[F.tid] = (int)__hip_atomic_load(CNT + F.tid * 64, __ATOMIC_RELAXED, __HIP_MEMORY_SCOPE_AGENT);
    __syncthreads();
    if (F.tid == 0) { int s = 0; for (int e = 0; e < 32; ++e) { toff[e] = s; s += (cnt[e] + 255) >> 8; } toff[32] = s; }
    __syncthreads();
}

constexpr int NPH = 11, PH_FINAL = 1 + DEPTH * NPH, PH_TOTAL = PH_FINAL + 1;
__global__ void __launch_bounds__(NWAVES * 64, 2) fwd_kernel(Args args) {
    extern __shared__ __attribute__((aligned(16))) unsigned char lds_raw[];
    Frame F;
    F.lds = (LAS unsigned char*)lds_raw; F.ws = args.ws; F.tid = threadIdx.x; F.lane = F.tid & 63; F.wave = __builtin_amdgcn_readfirstlane(F.tid >> 6); F.G = gridDim.x; F.bid = blockIdx.x; F.in = args.in;
    for (int u = F.tid; u < (LDS_BYTES - LDSCTL_OFF) / 4; u += NWAVES * 64) ((LAS unsigned*)(F.lds + LDSCTL_OFF))[u] = 0u;
    __syncthreads();
    const int lo = args.ph_lo, hi = args.ph_hi;
    XcdBarrier bar; bar.bar = (unsigned*)(F.ws + WS_CTL) + CW_BAR; bar.x = 0; bar.st = nullptr;
    if (hi - lo > 1) bar = xcd_barrier_post((unsigned*)(F.ws + WS_CTL) + CW_BAR, (volatile LAS unsigned*)(F.lds + MISC_OFF) + 8);
#define IN(k) (lo <= (k) && (k) < hi)
#define PROJ ((bf16*)(ws + WS_PROJ))
#define SEAM(k) do { if (IN(k) && IN((k) + 1)) xcd_barrier(bar); } while (0)
    unsigned char* ws = F.ws;
#define PHASE_ENTER() do { unsigned char* w_ = args.ws; asm volatile("" : "+s"(w_)); F.ws = w_; ws = w_; int t_ = threadIdx.x; asm volatile("" : "+v"(t_)); F.tid = t_; F.lane = t_ & 63; F.wave = __builtin_amdgcn_readfirstlane(t_ >> 6); } while (0)
    if (EN(0) && IN(0)) { PHASE_ENTER(); REPS(0) { p_prologue(F); } SEAM(0); }
    for (int l = 0; l < DEPTH; ++l) {
        const int pb = 1 + l * NPH;
        if (EN(1) && IN(pb + 0)) { PHASE_ENTER(); if (REP_KIND == 1) p_norm_mix(F, l, false, nullptr, true); p_norm_mix(F, l, false, nullptr); SEAM(pb + 0); }
        if (EN(2) && IN(pb + 1)) { PHASE_ENTER();
            REPS(2) {
            { pg8::DenseOrder S; S.init(T, NPROJ, F.G, F.bid, ws + WS_HB, 1024, (bf16*)wl(ws, l, WL_IN) + (size_t)NHT * 1024, 1024);
              EpiProj E{PROJ};
              pg8::gemm_phase(F.lds, 1024, S, E); }
            { int z = 0; asm volatile("" : "+s"(z)); pg8::DenseOrder S; S.init(NHT, T, F.G, (F.bid + 64 + z) % F.G, wl(ws, l, WL_IN) + z, 1024, ws + WS_HB + z, 1024);
              EpiHT E{(bf16*)(ws + WS_HT)};
              pg8::gemm_phase(F.lds, 1024, S, E); }
            }
            SEAM(pb + 1);
        }
        if (EN(3) && IN(pb + 2)) { PHASE_ENTER(); REPS(3) { p_mla_prep(F); } SEAM(pb + 2); }
        if (EN(4) && IN(pb + 3)) { PHASE_ENTER();
#ifndef SUBMASK
#define SUBMASK 7
#endif
            REPS(4) {
            if (SUBMASK & 1) { pg8::DenseOrder S; S.init(T, 768, F.G, F.bid, PROJ + PCQ, NPROJ, wl(ws, l, WL_Q), 384);
              EpiQ E{(bf16*)(ws + WS_Q), (const float*)(ws + WS_RSQ), (const float*)(ws + WS_COS), (const float*)(ws + WS_SIN)};
              pg8::gemm_phase(F.lds, 384, S, E); }
            if (SUBMASK & 2) { int z = 0; asm volatile("" : "+s"(z)); pg8::DenseOrder S; S.init(T, 512, F.G, (F.bid + 64 + z) % F.G, PROJ + PCKV + z, NPROJ, wl(ws, l, WL_K) + z, 256);
              EpiK E{(bf16*)(ws + WS_K), (const float*)(ws + WS_RSKV)};
              pg8::gemm_phase(F.lds, 256, S, E); }
            if (SUBMASK & 4) { int z = 0; asm volatile("" : "+s"(z)); pg8::DenseOrder S; S.init(512, T, F.G, (F.bid + 192 + z) % F.G, wl(ws, l, WL_V) + z, 256, PROJ + PCKV + z, NPROJ);
              EpiV E{(bf16*)(ws + WS_VT), (const float*)(ws + WS_RSKV)};
              pg8::gemm_phase(F.lds, 256, S, E); }
            }
            SEAM(pb + 3);
        }
        if (EN(5) && IN(pb + 4)) { PHASE_ENTER();
            REPS(5) {
            if (rep_ == 0 || (REP_SUB & 1)) for (int u = F.bid; u < 64; u += F.G) scan_unit2(F, l, u);
            if (rep_ == 0 || (REP_SUB & 2)) {
                unsigned* qctr = (unsigned*)(ws + WS_CTL) + CW_Q + (l * 2 + rep_) * 64; volatile LAS unsigned* misc = (volatile LAS unsigned*)(F.lds + MISC_OFF);
                for (;;) { __syncthreads(); if (F.tid == 0) misc[0] = __hip_atomic_fetch_add(qctr, 1u, __ATOMIC_RELAXED, __HIP_MEMORY_SCOPE_AGENT); __syncthreads();
                    const int a = (int)misc[0]; if (a >= 512) break; attn_unit(F, a >> 3, (a & 7) * 256); }
            }
            }
            SEAM(pb + 4);
        }
        if (EN(6) && IN(pb + 5)) { PHASE_ENTER(); REPS(6) { p_hgrn_post(F, l); } SEAM(pb + 5); }
        if (EN(7) && IN(pb + 6)) { PHASE_ENTER();
            REPS(7) {
            if (SUBMASK & 1) { pg8::DenseOrder S; S.init(T, 1024, F.G, F.bid, ws + WS_HA, 1024, wl(ws, l, WL_OUT), 1024);
              EpiOut E{(bf16*)(ws + WS_Y), PROJ, 0};
              pg8::gemm_phase(F.lds, 512, S, E); }
            if (SUBMASK & 2) { pg8::DenseOrder S; S.init(T, 1024, F.G, F.bid, (bf16*)(ws + WS_HA) + 512, 1024, (bf16*)wl(ws, l, WL_OUT) + 512, 1024);
              EpiOut E{(bf16*)(ws + WS_Y), PROJ, 1};
              pg8::gemm_phase(F.lds, 512, S, E); }
            }
            SEAM(pb + 6);
        }
        if (EN(8) && IN(pb + 7)) { PHASE_ENTER();
            pg8::DenseOrder S; S.init(T, 1024, F.G, F.bid, ws + WS_Y, 1024, wl(ws, l, WL_O), 1024);
            if (REP_KIND == 8) { EpiWo E2{(float*)(ws + WS_ACT), (const float*)(ws + WS_MOD) + (size_t)l * 8 * 6144 + 2 * 1024}; pg8::gemm_phase(F.lds, 1024, S, E2); }
            EpiWo E{(float*)(ws + WS_X), (const float*)(ws + WS_MOD) + (size_t)l * 8 * 6144 + 2 * 1024};
            pg8::gemm_phase(F.lds, 1024, S, E);
            if (REP_KIND == 13) { for (int q = 0; q < 10; ++q) xcd_barrier(bar); }
            SEAM(pb + 7);
        }
        if (EN(9) && IN(pb + 8)) { PHASE_ENTER(); if (REP_KIND == 9) p_router(F, l, true); p_router(F, l); SEAM(pb + 8); }
        if (EN(10) && IN(pb + 9)) { PHASE_ENTER();
            moe_tables(F, l);
            pg8::MoeOrder<true> S; S.cnt = (const LAS int*)(F.lds + MOE_OFF); S.toff = S.cnt + 32; S.NT = 8; S.G = F.G; S.c = F.bid; S.Abase = (const char*)(ws + WS_HB); S.Bbase = (const char*)wl(ws, l, WL_GU);
            S.b_expert_bytes = (size_t)2048 * 1024 * 2; S.list = (const int*)(ws + WS_LIST); S.lda = 1024; S.ldb = 1024;
            EpiGU E{(bf16*)(ws + WS_ACT), F.in[20] + (size_t)l * 32 * 2048};
            REPS(10) { pg8::gemm_phase(F.lds, 1024, S, E); }
            SEAM(pb + 9);
        }
        if (EN(11) && IN(pb + 10)) { PHASE_ENTER();
            moe_tables(F, l);
            pg8::MoeOrder<false> S; S.cnt = (const LAS int*)(F.lds + MOE_OFF); S.toff = S.cnt + 32; S.NT = 4; S.G = F.G; S.c = F.bid; S.Abase = (const char*)(ws + WS_ACT); S.Bbase = (const char*)wl(ws, l, WL_DN);
            S.b_expert_bytes = (size_t)1024 * 1024 * 2; S.list = (const int*)(ws + WS_LIST); S.lda = 1024; S.ldb = 1024;
            EpiDown E{(bf16*)(ws + WS_YR), F.in[22] + (size_t)l * 32 * 1024, (const int*)(ws + WS_LIST), (const float*)(ws + WS_AW)};
            REPS(11) { pg8::gemm_phase(F.lds, 1024, S, E); }
            SEAM(pb + 10);
        }
    }
    if (EN(12) && IN(PH_FINAL)) { PHASE_ENTER(); p_norm_mix(F, DEPTH, true, args.out); }
#undef IN
#undef SEAM
#undef PROJ
#undef PHASE_ENTER
}

extern "C" void kernel_launch(void* const* d_in, const int* in_sizes, int n_in, void* d_out, int out_size, void* d_ws, size_t ws_size, hipStream_t stream) {
    static int grid = 0;
    if (grid == 0) {
        if (n_in != 24 || in_sizes[0] != T * D || out_size != T * D || ws_size < WS_END) { fprintf(stderr, "kernel_launch: unexpected problem (n_in %d, in0 %d, out %d, ws %zu, need %zu)\n", n_in, n_in > 0 ? in_sizes[0] : -1, out_size, ws_size, (size_t)WS_END); grid = -1; return; }
        int dev = 0, cus = 0, per_cu = 0;
        if (hipGetDevice(&dev) != hipSuccess || hipDeviceGetAttribute(&cus, hipDeviceAttributeMultiprocessorCount, dev) != hipSuccess) { grid = -1; return; }
        if (hipFuncSetAttribute((const void*)fwd_kernel, hipFuncAttributeMaxDynamicSharedMemorySize, LDS_BYTES) != hipSuccess) { fprintf(stderr, "kernel_launch: hipFuncSetAttribute failed\n"); grid = -1; return; }
        if (hipOccupancyMaxActiveBlocksPerMultiprocessor(&per_cu, (const void*)fwd_kernel, NWAVES * 64, LDS_BYTES) != hipSuccess || per_cu < 1) { fprintf(stderr, "kernel_launch: occupancy query says %d\n", per_cu); (void)hipGetLastError(); }
        grid = cus;
    }
    if (grid < 0) return;
    if (hipMemsetAsync((char*)d_ws + WS_CTL, 0, CTL_ZERO_BYTES, stream) != hipSuccess) return;
    Args a{};
    for (int i = 0; i < 24; ++i) a.in[i] = (const float*)d_in[i];
    a.out = (float*)d_out; a.ws = (unsigned char*)d_ws;
#if MK_PER_PHASE
    for (int ph = 0; ph < PH_TOTAL; ++ph) { a.ph_lo = ph; a.ph_hi = ph + 1; hipLaunchKernelGGL(fwd_kernel, dim3(grid), dim3(NWAVES * 64), LDS_BYTES, stream, a); }
#else
    a.ph_lo = 0; a.ph_hi = PH_TOTAL; hipLaunchKernelGGL(fwd_kernel, dim3(grid), dim3(NWAVES * 64), LDS_BYTES, stream, a);
#endif
}
```

```cpp
#include <hip/hip_runtime.h>
#include <cstdio>
#include <cstdint>

#ifndef PHASE_MASK
#define PHASE_MASK 0xFFFFu
#endif
#define EN(k) (((PHASE_MASK) >> (k)) & 1u)
#ifndef REP_KIND
#define REP_KIND -1
#endif
#ifndef REP_SUB
#define REP_SUB 3
#endif
#ifndef TIME_KIND
#define TIME_KIND -1
#endif
#ifndef ATTN_REP
#define ATTN_REP 1
#endif
#ifndef SCAN_REP
#define SCAN_REP 1
#endif
#ifndef EPI_REP
#define EPI_REP 1
#endif
#define REPS(k) _Pragma("unroll 1") for (int rep_ = 0; rep_ < ((REP_KIND) == (k) ? 2 : 1); ++rep_)
#ifndef MK_PER_PHASE
#define MK_PER_PHASE 0
#endif

#define GAS __attribute__((address_space(1)))
#define LAS __attribute__((address_space(3)))
typedef unsigned short bf16;
typedef short bf16x8 __attribute__((ext_vector_type(8)));
typedef float f32x4 __attribute__((ext_vector_type(4)));
typedef float f32x2 __attribute__((ext_vector_type(2)));
typedef float f32x16 __attribute__((ext_vector_type(16)));
typedef unsigned u32x4 __attribute__((ext_vector_type(4)));
typedef unsigned u32x2 __attribute__((ext_vector_type(2)));
typedef __bf16 bfv2 __attribute__((ext_vector_type(2)));

__device__ __forceinline__ unsigned pk2(float lo, float hi) { f32x2 v = {lo, hi}; bfv2 r = __builtin_convertvector(v, bfv2); return __builtin_bit_cast(unsigned, r); }
__device__ __forceinline__ float bf2f(unsigned short b) { return __uint_as_float(((unsigned)b) << 16); }
__device__ __forceinline__ float bflo(unsigned w) { return __uint_as_float(w << 16); }
__device__ __forceinline__ float bfhi(unsigned w) { return __uint_as_float(w & 0xffff0000u); }
__device__ __forceinline__ u32x4 pack8(f32x4 a, f32x4 b) { u32x4 w; w.x = pk2(a[0], a[1]); w.y = pk2(a[2], a[3]); w.z = pk2(b[0], b[1]); w.w = pk2(b[2], b[3]); return w; }
__device__ __forceinline__ void unpack8(u32x4 w, f32x4& a, f32x4& b) { a[0] = bflo(w.x); a[1] = bfhi(w.x); a[2] = bflo(w.y); a[3] = bfhi(w.y); b[0] = bflo(w.z); b[1] = bfhi(w.z); b[2] = bflo(w.w); b[3] = bfhi(w.w); }
__device__ __forceinline__ float sigmoidf_(float x) { return 1.0f / (1.0f + __expf(-x)); }
__device__ __forceinline__ float wave_sum(float v) {
#pragma unroll
    for (int o = 1; o < 64; o <<= 1) v += __shfl_xor(v, o);
    return v;
}
#define LDS_WAIT() asm volatile("s_waitcnt lgkmcnt(0)" ::: "memory")
#define VM_WAIT() asm volatile("s_waitcnt vmcnt(0)" ::: "memory")

#define XB_TMO      128
#define XB_XCNT(j)  (256  + 64 * (j))
#define XB_XSUB(j)  (1280 + 64 * (j))
#define XB_XGEN(j)  (2304 + 64 * (j))
#define XB_TOP      3328
#define XB_TOPGEN   3392
#define XCD_BAR_WORDS 3456
#define XB_SPIN_CAP (1u << 20)

__device__ __forceinline__ unsigned xb_ld(unsigned* p)              { return __hip_atomic_load(p, __ATOMIC_RELAXED, __HIP_MEMORY_SCOPE_AGENT); }
__device__ __forceinline__ unsigned xb_add(unsigned* p, unsigned v) { return __hip_atomic_fetch_add(p, v, __ATOMIC_RELAXED, __HIP_MEMORY_SCOPE_AGENT); }
__device__ __forceinline__ unsigned xb_xcc_id() { return (unsigned)__builtin_amdgcn_s_getreg((3 << 11) | 20) & 0xFu; }
#define XB_SPIN(cond, bar) do { unsigned _sp = 0; while (cond) { __builtin_amdgcn_s_sleep(1); \
    if ((++_sp & 255u) == 0u) { if (xb_ld(&(bar)[XB_TMO])) break; if (_sp > XB_SPIN_CAP) { atomicAdd(&(bar)[XB_TMO], 1u); break; } } } } while (0)

struct XcdBarrier { unsigned* bar; unsigned x; volatile LAS unsigned* st; };

__device__ __forceinline__ XcdBarrier xcd_barrier_post(unsigned* bar, volatile LAS unsigned* st) {
    XcdBarrier b; b.bar = bar; b.x = xb_xcc_id(); b.st = st;
    if (threadIdx.x == 0) (void)xb_add(&bar[XB_XCNT(b.x)], 1u);
    return b;
}
__device__ __forceinline__ void xcd_barrier_complete(unsigned* bar, unsigned x, unsigned& nloc, unsigned& nx) {
    const unsigned G = gridDim.x * gridDim.y * gridDim.z;
    unsigned sum, cnt, mine, sp = 0u;
    for (;;) {
        sum = 0u; cnt = 0u; mine = 0u;
#pragma unroll
        for (unsigned j = 0; j < 16; ++j) { const unsigned c = xb_ld(&bar[XB_XCNT(j)]); sum += c; cnt += (c > 0u) ? 1u : 0u; mine = (j == x) ? c : mine; }
        if (sum == G) break;
        __builtin_amdgcn_s_sleep(1);
        if ((++sp & 255u) == 0u) { if (xb_ld(&bar[XB_TMO])) break; if (sp > XB_SPIN_CAP) { atomicAdd(&bar[XB_TMO], 1u); break; } }
    }
    nloc = mine > 0u ? mine : 1u; nx = cnt > 0u ? cnt : 1u;
}
__device__ __forceinline__ void xcd_barrier(const XcdBarrier& b) {
    asm volatile("s_waitcnt vmcnt(0)" ::: "memory");
    __syncthreads();
    if (threadIdx.x == 0) {
        unsigned* bar = b.bar;
        __builtin_amdgcn_s_waitcnt(0);
        unsigned nloc = b.st[0], nx = b.st[1];
        if (nloc == 0u) { xcd_barrier_complete(bar, b.x, nloc, nx); b.st[0] = nloc; b.st[1] = nx; }
        const unsigned old = xb_add(&bar[XB_XSUB(b.x)], 1u);
        const unsigned gen = old / nloc;
        if (old + 1u == (gen + 1u) * nloc) {
            __builtin_amdgcn_fence(__ATOMIC_RELEASE, "agent");
            asm volatile("s_waitcnt vmcnt(0)" ::: "memory");
            const unsigned og = xb_add(&bar[XB_TOP], 1u);
            const unsigned tg = og / nx;
            if (og + 1u == (tg + 1u) * nx) xb_add(&bar[XB_TOPGEN], 1u);
            else XB_SPIN(xb_ld(&bar[XB_TOPGEN]) == tg, bar);
            __builtin_amdgcn_fence(__ATOMIC_ACQUIRE, "agent");
            xb_add(&bar[XB_XGEN(b.x)], 1u);
            asm volatile("s_waitcnt vmcnt(0)" ::: "memory");
        } else {
            XB_SPIN(xb_ld(&bar[XB_XGEN(b.x)]) == gen, bar);
            __builtin_amdgcn_fence(__ATOMIC_ACQUIRE, "agent");
            asm volatile("s_waitcnt vmcnt(0)" ::: "memory");
        }
    }
    __syncthreads();
}

constexpr int D = 1024, NB = 8, SEQ = 2048, T = NB * SEQ, DEPTH = 4;
constexpr int NPROJ = 3328;
constexpr int NHT = 2048;
constexpr int PGT = 0, PGA = 512, PGB = 1536, PCQ = 2560, PCKV = 2944, PKPE = 3200;
constexpr int HQ = 0, HFF = 512, HFB = 1024, HI = 1536;
constexpr int NE = 32, TOPK = 4, NASSIGN = T * TOPK, ACT_ROWS = NASSIGN + NE * 256;
constexpr float EPS = 1e-6f;
constexpr float QSCALE = 0.10206207261596575f * 1.4426950408889634f;

constexpr size_t MiB = 1u << 20;
constexpr size_t WS_CTL = 0, CTL_ZERO_BYTES = 1 * MiB;
constexpr size_t WS_MOD = 1 * MiB, WS_LB = 2 * MiB, WS_COS = 3 * MiB, WS_SIN = 4 * MiB, WS_RSQ = 5 * MiB, WS_RSKV = 5 * MiB + 65536, WS_AW = 6 * MiB, WS_LIST = 7 * MiB;
constexpr size_t WS_X = 16 * MiB, WS_HB = 80 * MiB, WS_PROJ = 112 * MiB, WS_HT = 216 * MiB, WS_Q = 280 * MiB, WS_K = 304 * MiB, WS_VT = 328 * MiB, WS_OF = 344 * MiB, WS_OB = 376 * MiB;
constexpr size_t WS_HA = 408 * MiB, WS_Y = 440 * MiB, WS_ACT = 472 * MiB, WS_YR = 616 * MiB, WS_W = 768 * MiB;
constexpr size_t WL_IN = 0, WL_Q = 11 * MiB, WL_K = 12 * MiB, WL_V = 12 * MiB + 256 * 1024, WL_OUT = 13 * MiB, WL_O = 15 * MiB, WL_GU = 17 * MiB, WL_DN = 145 * MiB, WL_STRIDE = 209 * MiB;
constexpr size_t WS_END = WS_W + DEPTH * WL_STRIDE;
static_assert((size_t)T * NPROJ * 2 <= WS_HT - WS_PROJ && (size_t)NB * NHT * SEQ * 2 <= WS_Q - WS_HT && (size_t)ACT_ROWS * 1024 * 2 <= WS_YR - WS_ACT && (size_t)NASSIGN * 1024 * 2 <= WS_W - WS_YR, "ws map");
constexpr int CW_BAR = 4096, CW_Q = 8192, CW_CNT = 16384;

constexpr int RING_BYTES = 131072;
constexpr int LDSCTL_OFF = 139264, MISC_OFF = LDSCTL_OFF + 320, MOE_OFF = LDSCTL_OFF + 1024;
constexpr int LDS_BYTES = 155648;
constexpr int RT_G_OFF = 143360, RT_S_OFF = 147456;
constexpr int NWAVES = 8;

namespace pg8 {
constexpr int BM = 256, BK = 64, HALF = 128, HTB = HALF * BK * 2, NXCD = 8, WGM = 8;
__device__ __forceinline__ int lds_byte(int r, int c) { const int st = (r >> 4) * 2 + (c >> 5), rr = r & 15, cc = c & 31, ob = rr * 64 + cc * 2; return st * 1024 + (ob ^ (((ob >> 9) & 1) << 5)); }
__device__ __forceinline__ void stage_rc(int b, int& R, int& C) { const int st = b / 1024, sb = b % 1024, swz = sb ^ (((sb >> 9) & 1) << 5); R = (st >> 1) * 16 + swz / 64; C = (st & 1) * 32 + (swz % 64) / 2; }
__device__ __forceinline__ int perm32(int rho) { const int n = rho >> 4, i = rho & 15; return 8 * (i >> 2) + 4 * n + (i & 3); }

struct Unit { const char* A; const char* B; int pm, pn, e, rowbase, mrows; };

struct DenseOrder {
    static constexpr bool GATHER_A = false;
    int nM, nN, nwg, G, c; const char* Abase; const char* Bbase; int lda, ldb;
    __device__ __forceinline__ void init(int M, int N, int G_, int c_, const void* A, int lda_, const void* B, int ldb_) { nM = M / BM; nN = N / BM; nwg = nM * nN; G = G_; c = c_; Abase = (const char*)A; Bbase = (const char*)B; lda = lda_; ldb = ldb_; }
    __device__ __forceinline__ bool next(int i, Unit& u) const {
        const long L = (long)i * G + c; if (L >= nwg) return false;
        int wgid = (int)L; { const int q = nwg / NXCD, r = nwg % NXCD, xcd = wgid % NXCD, off = wgid / NXCD; wgid = (xcd < r ? xcd * (q + 1) : r * (q + 1) + (xcd - r) * q) + off; }
        const int nig = WGM * nN, gid = wgid / nig, fm = gid * WGM, gsz = (nM - fm) < WGM ? (nM - fm) : WGM;
        u.pm = fm + ((wgid % nig) % gsz); u.pn = (wgid % nig) / gsz; u.e = 0; u.rowbase = 0; u.mrows = 256;
        u.A = Abase + (size_t)u.pm * 256 * lda * 2; u.B = Bbase + (size_t)u.pn * 256 * ldb * 2; return true;
    }
    __device__ __forceinline__ void aoff(const Unit&, const int (&R)[2], const int (&C)[2], unsigned (&v)[2][2]) const {
#pragma unroll
        for (int h = 0; h < 2; ++h)
#pragma unroll
            for (int i = 0; i < 2; ++i) v[h][i] = (unsigned)((128 * h + R[i]) * lda + C[i]) * 2u;
    }
};
template <bool GATHER> struct MoeOrder {
    static constexpr bool GATHER_A = GATHER;
    const LAS int* toff; const LAS int* cnt; int NT, G, c; const char* Abase; const char* Bbase; size_t b_expert_bytes; const int* list; int lda, ldb;
    __device__ __forceinline__ bool next(int i, Unit& u) const {
        const int spx = G >> 3, rpx = spx / NT, xcd = c & 7, slot = c >> 3;
        if (slot >= rpx * NT) return false;
        const int R = (i * 8 + xcd) * rpx + slot / NT; if (R >= toff[NE]) return false;
        int e = 0; while (toff[e + 1] <= R) ++e;
        u.e = e; u.pm = R - toff[e]; u.pn = slot % NT; u.rowbase = R * 256; u.mrows = cnt[e] - u.pm * 256;
        u.A = GATHER ? Abase : Abase + (size_t)u.rowbase * lda * 2; u.B = Bbase + (size_t)e * b_expert_bytes + (size_t)u.pn * 256 * ldb * 2; return true;
    }
    __device__ __forceinline__ void aoff(const Unit& u, const int (&R)[2], const int (&C)[2], unsigned (&v)[2][2]) const {
#pragma unroll
        for (int h = 0; h < 2; ++h)
#pragma unroll
            for (int i = 0; i < 2; ++i) {
                if (GATHER) { const int rl = 128 * h + R[i]; const int a = list[(size_t)u.e * T + u.pm * 256 + (rl < u.mrows ? rl : 0)]; v[h][i] = (unsigned)((a >> 2) * lda + C[i]) * 2u; }
                else v[h][i] = (unsigned)((128 * h + R[i]) * lda + C[i]) * 2u;
            }
    }
};

template <class E, class = void> struct has_prep { static constexpr bool value = false; };
template <class E> struct has_prep<E, decltype((void)E::HAS_PREP)> { static constexpr bool value = true; };
template <class E, class = void> struct has_mid { static constexpr bool value = false; };
template <class E> struct has_mid<E, decltype((void)E::HAS_MID)> { static constexpr bool value = true; };
template <class Epi, class Sched>
__device__ __forceinline__ void gemm_phase(LAS unsigned char* lds, const int K, const Sched& S, const Epi& E) {
    int tid_ = threadIdx.x; asm volatile("" : "+v"(tid_));
    const int tid = tid_, wid = __builtin_amdgcn_readfirstlane(tid >> 6), lane = tid & 63, wr = wid >> 2, wc = wid & 3, fr = lane & 15, fq = lane >> 4;
    int nt_ = K / BK; asm volatile("" : "+s"(nt_));
    const int nt = nt_;
    int sR[2], sC[2]; unsigned voffB[2];
#pragma unroll
    for (int i = 0; i < 2; ++i) { stage_rc(tid * 16 + i * 8192, sR[i], sC[i]); const int Rb = (sR[i] & ~31) + perm32(sR[i] & 31); voffB[i] = (unsigned)(Rb * S.ldb + sC[i]) * 2u; }
    constexpr bool GA = Sched::GATHER_A;
    unsigned voffA[2];
#pragma unroll
    for (int i = 0; i < 2; ++i) voffA[i] = (unsigned)(sR[i] * S.lda + sC[i]) * 2u;
    const size_t kstep = (size_t)(BK * 2);
    const size_t hstepB = (size_t)HALF * S.ldb * 2, hstepA = (size_t)HALF * S.lda * 2;
    const unsigned ldsw = (unsigned)wid * 1024u;
    const unsigned ldsbase = (unsigned)__builtin_amdgcn_readfirstlane((int)((unsigned)(size_t)lds + ldsw));
    const int aoff = lds_byte(wr * 64 + fr, fq * 8), boff = lds_byte(wc * 32 + fr, fq * 8);
#define PG8_SA(b, h) (((b) * 2 + (h)) * HTB)
#define PG8_SB(b, h) ((4 + (b) * 2 + (h)) * HTB)
#define PG8_DMA2(ldsaddr, gbase, v0_, v1_) do { unsigned keep_; \
        asm volatile("s_mov_b32 %0, m0\n\ts_mov_b32 m0, %4\n\ts_nop 0\n\tglobal_load_lds_dwordx4 %1, %3\n\ts_add_u32 m0, %4, 0x2000\n\ts_nop 0\n\tglobal_load_lds_dwordx4 %2, %3\n\ts_mov_b32 m0, %0" \
                     : "=&s"(keep_) : "v"(v0_), "v"(v1_), "s"(gbase), "s"(ldsaddr) : "memory", "scc"); } while (0)
#define PG8_STAGE(bufoff, gbase, voff) PG8_DMA2(ldsbase + (unsigned)(bufoff), (const char*)(gbase), (voff)[0], (voff)[1])
#define PG8_STAGEA(bufoff, gbase, h, nx) do { if constexpr (GA) { PG8_DMA2(ldsbase + (unsigned)(bufoff), (const char*)(gbase), ((nx) ? nvA[h][0] : vA[h][0]), ((nx) ? nvA[h][1] : vA[h][1])); } \
        else { PG8_DMA2(ldsbase + (unsigned)(bufoff), (const char*)(gbase) + (size_t)(h) * hstepA, voffA[0], voffA[1]); } } while (0)
#define PG8_LDA(dst, b, h) do { _Pragma("unroll") for (int m = 0; m < 4; ++m) _Pragma("unroll") for (int k = 0; k < 2; ++k) dst[m][k] = *(const LAS bf16x8*)(lds + PG8_SA(b, h) + aoff + m * 2048 + k * 1024); } while (0)
#define PG8_LDB(dst, b, h) do { _Pragma("unroll") for (int n = 0; n < 2; ++n) _Pragma("unroll") for (int k = 0; k < 2; ++k) dst[n][k] = *(const LAS bf16x8*)(lds + PG8_SB(b, h) + boff + n * 2048 + k * 1024); } while (0)
#define PG8_MMA(ai, bj, At, Bt) do { __builtin_amdgcn_s_setprio(1); _Pragma("unroll") for (int m = 0; m < 4; ++m) _Pragma("unroll") for (int n = 0; n < 2; ++n) _Pragma("unroll") for (int k = 0; k < 2; ++k) \
        acc[ai][bj][m][n] = __builtin_amdgcn_mfma_f32_16x16x32_bf16(Bt[n][k], At[m][k], acc[ai][bj][m][n], 0, 0, 0); __builtin_amdgcn_s_setprio(0); } while (0)
#define PG8_WAIT_V(n) asm volatile("s_waitcnt vmcnt(" #n ")" ::: "memory")
#define PG8_WAIT_L(n) asm volatile("s_waitcnt lgkmcnt(" #n ")" ::: "memory")
#define PG8_BAR __builtin_amdgcn_s_barrier()
#define PG8_SCHED __builtin_amdgcn_sched_barrier(0)
    Unit cur, nxt; int ui = 0;
    if (!S.next(0, cur)) return;
    f32x4 acc[2][2][4][2];
#pragma unroll
    for (int a = 0; a < 2; ++a)
#pragma unroll
        for (int b = 0; b < 2; ++b)
#pragma unroll
            for (int m = 0; m < 4; ++m)
#pragma unroll
                for (int n = 0; n < 2; ++n) acc[a][b][m][n] = (f32x4){0.f, 0.f, 0.f, 0.f};
    bf16x8 At[4][2], B0[2][2], B1[2][2];
    unsigned vA[2][2], nvA[2][2];
    if constexpr (GA) { S.aoff(cur, sR, sC, vA); }
    const char* cA = cur.A; const char* cB = cur.B;
    if constexpr (has_prep<Epi>::value) E.prep(cur, wr, fr);
    PG8_STAGE(PG8_SB(0, 0), cB, voffB); PG8_STAGE(PG8_SB(0, 1), cB + hstepB, voffB); PG8_STAGEA(PG8_SA(0, 0), cA, 0, false); PG8_STAGEA(PG8_SA(0, 1), cA, 1, false);
    if (wr == 1) PG8_BAR;
    PG8_WAIT_V(2); PG8_BAR;
    PG8_STAGE(PG8_SB(1, 0), cB + kstep, voffB); PG8_STAGEA(PG8_SA(1, 0), cA + kstep, 0, false); PG8_STAGE(PG8_SB(1, 1), cB + hstepB + kstep, voffB);
    PG8_WAIT_V(6); PG8_BAR;
    for (;;) {
        const bool has_next = S.next(ui + 1, nxt);
        const char* nA = has_next ? nxt.A : cA; const char* nB = has_next ? nxt.B : cB;
        if constexpr (GA) {
            if (has_next) S.aoff(nxt, sR, sC, nvA);
            else {
#pragma unroll
                for (int h = 0; h < 2; ++h)
#pragma unroll
                    for (int i = 0; i < 2; ++i) nvA[h][i] = vA[h][i]; } }
#pragma unroll 1
        for (int t = 0; t < nt; t += 2) {
            const bool last = (t == nt - 2);
            if constexpr (has_mid<Epi>::value) { if (t == Epi::MID_T) E.mid(acc, cur, wr, wc, fr, fq); }
            const char* a1 = cA + (size_t)(t + 1) * kstep;
            const char* a2 = last ? nA : cA + (size_t)(t + 2) * kstep; const char* b2 = last ? nB : cB + (size_t)(t + 2) * kstep;
            const char* a3 = a2 + kstep; const char* b3 = b2 + kstep;
            PG8_LDB(B0, 0, 0); PG8_LDB(B1, 0, 1); PG8_SCHED; PG8_LDA(At, 0, 0); PG8_STAGEA(PG8_SA(1, 1), a1, 1, false);
            PG8_WAIT_V(8); PG8_WAIT_L(0); PG8_BAR; PG8_MMA(0, 0, At, B0); PG8_MMA(0, 1, At, B1); PG8_BAR; PG8_SCHED;
            PG8_LDA(At, 0, 1); PG8_STAGE(PG8_SB(0, 0), b2, voffB); PG8_STAGE(PG8_SB(0, 1), b2 + hstepB, voffB); PG8_STAGEA(PG8_SA(0, 0), a2, 0, last);
            PG8_WAIT_V(8); PG8_WAIT_L(0); PG8_BAR; PG8_MMA(1, 0, At, B0); PG8_MMA(1, 1, At, B1); PG8_BAR; PG8_SCHED;
            PG8_LDB(B0, 1, 0); PG8_LDB(B1, 1, 1); PG8_SCHED; PG8_LDA(At, 1, 0); PG8_STAGEA(PG8_SA(0, 1), a2, 1, last);
            PG8_WAIT_V(8); PG8_WAIT_L(0); PG8_BAR; PG8_MMA(0, 0, At, B0); PG8_MMA(0, 1, At, B1); PG8_BAR; PG8_SCHED;
            PG8_LDA(At, 1, 1); PG8_STAGE(PG8_SB(1, 0), b3, voffB); PG8_STAGE(PG8_SB(1, 1), b3 + hstepB, voffB); PG8_STAGEA(PG8_SA(1, 0), a3, 0, last);
            PG8_WAIT_V(8); PG8_WAIT_L(0); PG8_BAR; PG8_MMA(1, 0, At, B0); PG8_MMA(1, 1, At, B1); PG8_BAR; PG8_SCHED;
        }
        if (wr == 0) PG8_BAR;
        E(acc, cur, wr, wc, fr, fq);
        if constexpr (EPI_REP > 1 && Epi::IDEMPOTENT) { asm volatile("" ::: "memory"); E(acc, cur, wr, wc, fr, fq); }
        if (!has_next) break;
#pragma unroll
        for (int a = 0; a < 2; ++a)
#pragma unroll
            for (int b = 0; b < 2; ++b)
#pragma unroll
                for (int m = 0; m < 4; ++m)
#pragma unroll
                    for (int n = 0; n < 2; ++n) acc[a][b][m][n] = (f32x4){0.f, 0.f, 0.f, 0.f};
        cur = nxt; cA = nA; cB = nB; ++ui;
        if constexpr (has_prep<Epi>::value) E.prep(cur, wr, fr);
        if constexpr (GA) {
#pragma unroll
            for (int h = 0; h < 2; ++h)
#pragma unroll
                for (int i = 0; i < 2; ++i) vA[h][i] = nvA[h][i]; }
        if (wr == 1) PG8_BAR;
    }
    PG8_WAIT_V(0);
    PG8_BAR;
#undef PG8_SA
#undef PG8_SB
#undef PG8_STAGE
#undef PG8_STAGEA
#undef PG8_DMA2
#undef PG8_LDA
#undef PG8_LDB
#undef PG8_MMA
#undef PG8_WAIT_V
#undef PG8_WAIT_L
#undef PG8_BAR
#undef PG8_SCHED
}
}
using pg8::Unit;
typedef const f32x4 (&AccRef)[2][2][4][2];

struct Args {
    const float* in[24]; float* out; unsigned char* ws; int ph_lo, ph_hi;
};
struct Frame {
    LAS unsigned char* lds; unsigned char* ws; int tid, lane, wave, G, bid;
    const float* const* in;
};
__device__ __forceinline__ unsigned char* wl(unsigned char* ws, int l, size_t off) { return ws + WS_W + (size_t)l * WL_STRIDE + off; }

#define EPI_LOOP_BEGIN _Pragma("unroll") for (int ai = 0; ai < 2; ++ai) _Pragma("unroll") for (int m = 0; m < 4; ++m) { const int rl = ai * 128 + wr * 64 + m * 16 + fr; _Pragma("unroll") for (int bj = 0; bj < 2; ++bj) { const int cl = bj * 128 + wc * 32 + 8 * fq; const f32x4 v0 = acc[ai][bj][m][0], v1 = acc[ai][bj][m][1];
#define EPI_LOOP_END } asm volatile("" ::: "memory"); }

struct EpiProj {
    static constexpr bool IDEMPOTENT = (EPI_REP > 2);
    bf16* O;
    __device__ __forceinline__ void operator()(AccRef acc, const Unit& u, int wr, int wc, int fr, int fq) const {
        EPI_LOOP_BEGIN
            *(u32x4*)(O + (size_t)(u.pm * 256 + rl) * NPROJ + u.pn * 256 + cl) = pack8(v0, v1);
        EPI_LOOP_END
    }
};
struct EpiHT {
    static constexpr bool IDEMPOTENT = (EPI_REP > 2);
    bf16* HT;
    __device__ __forceinline__ void operator()(AccRef acc, const Unit& u, int wr, int wc, int fr, int fq) const {
        const int seg = u.pm >> 1;
        EPI_LOOP_BEGIN
            const int f = u.pm * 256 + rl, t0 = u.pn * 256 + cl, b = t0 >> 11, s = t0 & 2047;
            f32x4 a = v0, d = v1;
            if (seg == 0) {
#pragma unroll
                for (int j = 0; j < 4; ++j) { a[j] = a[j] * __builtin_amdgcn_rcpf(1.0f + __builtin_amdgcn_exp2f(-1.4426950408889634f * a[j])); d[j] = d[j] * __builtin_amdgcn_rcpf(1.0f + __builtin_amdgcn_exp2f(-1.4426950408889634f * d[j])); }
            } else if (seg < 3) {
#pragma unroll
                for (int j = 0; j < 4; ++j) { a[j] = __builtin_amdgcn_rcpf(1.0f + __builtin_amdgcn_exp2f(1.4426950408889634f * a[j])); d[j] = __builtin_amdgcn_rcpf(1.0f + __builtin_amdgcn_exp2f(1.4426950408889634f * d[j])); }
            }
            *(u32x4*)(HT + ((size_t)b * NHT + f) * SEQ + s) = pack8(a, d);
        EPI_LOOP_END
    }
};
struct EpiQ {
    static constexpr bool IDEMPOTENT = (EPI_REP > 2);
    bf16* Q; const float* rsq; const float* cs; const float* sn;
    __device__ __forceinline__ void operator()(AccRef acc, const Unit& u, int wr, int wc, int fr, int fq) const {
        EPI_LOOP_BEGIN
            const int t = u.pm * 256 + rl, c0 = u.pn * 256 + cl, head = c0 / 96, w = c0 - head * 96, b = t >> 11, s = t & 2047;
            const float sc = rsq[t] * QSCALE;
            bf16* qp = Q + ((size_t)(b * 8 + head) * SEQ + s) * 96;
            f32x4 a = v0 * sc, d = v1 * sc;
            if (w < 64) { *(u32x4*)(qp + w) = pack8(a, d); }
            else { const int g = (w - 64) >> 3; const f32x4 co = *(const f32x4*)(cs + (size_t)t * 16 + 4 * g), si = *(const f32x4*)(sn + (size_t)t * 16 + 4 * g);
                const f32x4 o1 = a * co - d * si, o2 = d * co + a * si;
                u32x2 w1, w2; w1.x = pk2(o1[0], o1[1]); w1.y = pk2(o1[2], o1[3]); w2.x = pk2(o2[0], o2[1]); w2.y = pk2(o2[2], o2[3]);
                *(u32x2*)(qp + 64 + 4 * g) = w1; *(u32x2*)(qp + 80 + 4 * g) = w2; }
        EPI_LOOP_END
    }
};
struct EpiK {
    static constexpr bool IDEMPOTENT = (EPI_REP > 2);
    bf16* Kb; const float* rskv;
    __device__ __forceinline__ void operator()(AccRef acc, const Unit& u, int wr, int wc, int fr, int fq) const {
        EPI_LOOP_BEGIN
            const int t = u.pm * 256 + rl, c0 = u.pn * 256 + cl, head = c0 >> 6, w = c0 & 63, b = t >> 11, s = t & 2047;
            const float sc = rskv[t];
            *(u32x4*)(Kb + ((size_t)(b * 8 + head) * SEQ + s) * 96 + w) = pack8(v0 * sc, v1 * sc);
        EPI_LOOP_END
    }
};
struct EpiV {
    static constexpr bool IDEMPOTENT = (EPI_REP > 2);
    bf16* VT; const float* rskv;
    __device__ __forceinline__ void operator()(AccRef acc, const Unit& u, int wr, int wc, int fr, int fq) const {
        EPI_LOOP_BEGIN
            const int f = u.pm * 256 + rl, t0 = u.pn * 256 + cl, b = t0 >> 11, s = t0 & 2047, head = f >> 6, dv = f & 63;
            const f32x4 r0 = *(const f32x4*)(rskv + t0), r1 = *(const f32x4*)(rskv + t0 + 4);
            *(u32x4*)(VT + ((size_t)(b * 8 + head) * 64 + dv) * SEQ + s) = pack8(v0 * r0, v1 * r1);
        EPI_LOOP_END
    }
};
struct EpiOut {
    static constexpr bool IDEMPOTENT = false; static constexpr bool HAS_MID = true; static constexpr int MID_T = 8;
    bf16* Y; const bf16* proj;
    __device__ __forceinline__ void mid(f32x4 (&acc)[2][2][4][2], const Unit& u, int wr, int wc, int fr, int fq) const {
        unsigned off0 = (unsigned)((u.pm * 256 + wr * 64 + fr) * NPROJ + u.pn * 256 + wc * 32 + 8 * fq) * 2u;
        asm volatile("" : "+v"(off0));
        const char* gp0 = (const char*)proj;
#pragma unroll
        for (int ai = 0; ai < 2; ++ai)
#pragma unroll
            for (int mp = 0; mp < 2; ++mp) {
                u32x4 ga[2][2], gb[2][2];
#pragma unroll
                for (int mm = 0; mm < 2; ++mm)
#pragma unroll
                    for (int bj = 0; bj < 2; ++bj) { const unsigned o = off0 + (unsigned)(((ai * 128 + (2 * mp + mm) * 16) * NPROJ + bj * 128) * 2); ga[mm][bj] = *(const u32x4*)(gp0 + o + PGA * 2); gb[mm][bj] = *(const u32x4*)(gp0 + o + PGB * 2); }
#pragma unroll
                for (int mm = 0; mm < 2; ++mm)
#pragma unroll
                    for (int bj = 0; bj < 2; ++bj) {
                        f32x4 a0, a1, b0, b1; unpack8(ga[mm][bj], a0, a1); unpack8(gb[mm][bj], b0, b1);
#pragma unroll
                        for (int j = 0; j < 4; ++j) {
                            a0[j] = (1.0f + __builtin_amdgcn_exp2f(-1.4426950408889634f * b0[j])) * __builtin_amdgcn_rcpf(1.0f + __builtin_amdgcn_exp2f(-1.4426950408889634f * a0[j]));
                            a1[j] = (1.0f + __builtin_amdgcn_exp2f(-1.4426950408889634f * b1[j])) * __builtin_amdgcn_rcpf(1.0f + __builtin_amdgcn_exp2f(-1.4426950408889634f * a1[j])); }
                        acc[ai][bj][2 * mp + mm][0] *= a0; acc[ai][bj][2 * mp + mm][1] *= a1;
                    }
                asm volatile("" ::: "memory");
            }
    }
    __device__ __forceinline__ void operator()(AccRef acc, const Unit& u, int wr, int wc, int fr, int fq) const {
        const int c0 = u.pn * 256 + wc * 32 + 8 * fq;
        const bf16* gp = proj + (size_t)(u.pm * 256 + wr * 64 + fr) * NPROJ + PGB + c0;
        bf16* yp = Y + (size_t)(u.pm * 256 + wr * 64 + fr) * 1024 + c0;
#pragma unroll
        for (int ai = 0; ai < 2; ++ai) {
            u32x4 gw[4][2];
#pragma unroll
            for (int m = 0; m < 4; ++m)
#pragma unroll
                for (int bj = 0; bj < 2; ++bj) gw[m][bj] = *(const u32x4*)(gp + (size_t)(ai * 128 + m * 16) * NPROJ + bj * 128);
#pragma unroll
            for (int m = 0; m < 4; ++m)
#pragma unroll
                for (int bj = 0; bj < 2; ++bj) {
                    f32x4 g0, g1; unpack8(gw[m][bj], g0, g1);
#pragma unroll
                    for (int j = 0; j < 4; ++j) { g0[j] = __builtin_amdgcn_rcpf(1.0f + __builtin_amdgcn_exp2f(-1.4426950408889634f * g0[j])); g1[j] = __builtin_amdgcn_rcpf(1.0f + __builtin_amdgcn_exp2f(-1.4426950408889634f * g1[j])); }
                    *(u32x4*)(yp + (size_t)(ai * 128 + m * 16) * 1024 + bj * 128) = pack8(acc[ai][bj][m][0] * g0, acc[ai][bj][m][1] * g1);
                }
            asm volatile("" ::: "memory");
        }
    }
};
struct EpiWo {
    static constexpr bool IDEMPOTENT = false;
    bf16* X; const float* g1;
    __device__ __forceinline__ void operator()(AccRef acc, const Unit& u, int wr, int wc, int fr, int fq) const {
        const int c0 = u.pn * 256 + wc * 32 + 8 * fq, b = (u.pm * 256) >> 11;
        const float* gp = g1 + (size_t)b * 6144 + c0;
        const f32x4 ga0 = *(const f32x4*)gp, gb0 = *(const f32x4*)(gp + 4), ga1 = *(const f32x4*)(gp + 128), gb1 = *(const f32x4*)(gp + 132);
        bf16* xp = X + (size_t)(u.pm * 256 + wr * 64 + fr) * 1024 + c0;
#pragma unroll
        for (int ai = 0; ai < 2; ++ai) {
            u32x4 xv[4][2];
#pragma unroll
            for (int m = 0; m < 4; ++m) { const bf16* p = xp + (size_t)(ai * 128 + m * 16) * 1024; xv[m][0] = *(const u32x4*)p; xv[m][1] = *(const u32x4*)(p + 128); }
#pragma unroll
            for (int m = 0; m < 4; ++m) { bf16* p = xp + (size_t)(ai * 128 + m * 16) * 1024; f32x4 a, d;
                unpack8(xv[m][0], a, d); *(u32x4*)p = pack8(a + ga0 * acc[ai][0][m][0], d + gb0 * acc[ai][0][m][1]);
                unpack8(xv[m][1], a, d); *(u32x4*)(p + 128) = pack8(a + ga1 * acc[ai][1][m][0], d + gb1 * acc[ai][1][m][1]); }
            asm volatile("" ::: "memory");
        }
    }
};
struct EpiGU {
    static constexpr bool IDEMPOTENT = true;
    bf16* ACT; const float* bgu;
    __device__ __forceinline__ void operator()(AccRef acc, const Unit& u, int wr, int wc, int fr, int fq) const {
        const int j0 = u.pn * 128 + wc * 32 + 8 * fq;
        const float* bp = bgu + (size_t)u.e * 2048 + 2 * j0;
        const f32x4 b0 = *(const f32x4*)bp, b1 = *(const f32x4*)(bp + 4), b2 = *(const f32x4*)(bp + 8), b3 = *(const f32x4*)(bp + 12);
        const float bg[8] = {b0[0], b0[2], b1[0], b1[2], b2[0], b2[2], b3[0], b3[2]}, bu[8] = {b0[1], b0[3], b1[1], b1[3], b2[1], b2[3], b3[1], b3[3]};
        bf16* ap = ACT + (size_t)(u.rowbase + wr * 64 + fr) * 1024 + j0;
#pragma unroll
        for (int ai = 0; ai < 2; ++ai)
#pragma unroll
            for (int m = 0; m < 4; ++m) {
                float o[8];
#pragma unroll
                for (int j = 0; j < 8; ++j) {
                    float g = acc[ai][0][m][j >> 2][j & 3] + bg[j], up = acc[ai][1][m][j >> 2][j & 3] + bu[j];
                    g = fminf(g, 7.0f); up = fminf(fmaxf(up, -7.0f), 7.0f);
                    o[j] = (up + 1.0f) * g * __builtin_amdgcn_rcpf(1.0f + __builtin_amdgcn_exp2f(-1.702f * 1.4426950408889634f * g)); }
                u32x4 w; w.x = pk2(o[0], o[1]); w.y = pk2(o[2], o[3]); w.z = pk2(o[4], o[5]); w.w = pk2(o[6], o[7]);
                *(u32x4*)(ap + (size_t)(ai * 128 + m * 16) * 1024) = w;
            }
    }
};
struct EpiDown {
    static constexpr bool IDEMPOTENT = true; static constexpr bool HAS_PREP = true;
    bf16* YR; const float* bd; const int* list; const float* aw;
    mutable int a[8]; mutable float w[8];
    __device__ __forceinline__ void prep(const Unit& u, int wr, int fr) const {
        const int* lp = list + (size_t)u.e * T + u.pm * 256 + wr * 64 + fr;
#pragma unroll
        for (int q = 0; q < 8; ++q) { const int rl = (q >> 2) * 128 + wr * 64 + (q & 3) * 16 + fr; a[q] = (rl < u.mrows) ? lp[(q >> 2) * 128 + (q & 3) * 16] : -1; }
#pragma unroll
        for (int q = 0; q < 8; ++q) w[q] = (a[q] >= 0) ? aw[a[q]] : 0.f;
    }
    __device__ __forceinline__ void operator()(AccRef acc, const Unit& u, int wr, int wc, int fr, int fq) const {
        const int cb = u.pn * 256 + wc * 32 + 8 * fq;
        const float* bp = bd + (size_t)u.e * 1024 + cb;
        const f32x4 ba0 = *(const f32x4*)bp, bb0 = *(const f32x4*)(bp + 4), ba1 = *(const f32x4*)(bp + 128), bb1 = *(const f32x4*)(bp + 132);
#pragma unroll
        for (int q = 0; q < 8; ++q) {
            const int ai = q >> 2, m = q & 3;
            if (a[q] >= 0) { bf16* yp = YR + (size_t)a[q] * 1024 + cb;
                *(u32x4*)yp = pack8((acc[ai][0][m][0] + ba0) * w[q], (acc[ai][0][m][1] + bb0) * w[q]);
                *(u32x4*)(yp + 128) = pack8((acc[ai][1][m][0] + ba1) * w[q], (acc[ai][1][m][1] + bb1) * w[q]); }
        }
    }
};

enum { MAP_ID = 0, MAP_WIN = 1, MAP_WQ = 2, MAP_WKV = 3, MAP_GU = 4 };
__device__ __forceinline__ int map_row(int kind, int n) {
    if (kind == MAP_WIN) { if (n < 2560) return n; if (n < 2944) return NHT + PCQ + (n - 2560); if (n < 3200) return NHT + PCKV + (n - 2944); if (n < 3232) return NHT + PKPE + (n - 3200); return NHT + PGA + (n - 3232); }
    if (kind == MAP_WQ) { const int h = n / 96, j = n - h * 96; if (j < 64) return n; const int r = j - 64, i = r & 15; return h * 96 + 64 + 8 * (i >> 2) + ((r >> 4) << 2) + (i & 3); }
    if (kind == MAP_WKV) { const int h = n >> 7, j = n & 127; return (j < 64) ? (h * 64 + j) : (512 + h * 64 + (j - 64)); }
    if (kind == MAP_GU) { const int j = n >> 1, bj = n & 1; return (j >> 7) * 256 + bj * 128 + (j & 127); }
    return n;
}
__device__ __forceinline__ void conv_item(const float* W, int N, const float* kscale, bf16* WT, int dstK, int koff, int kind, LAS float* scr, int kb, int nb, int lane) {
    const int k0 = 64 * kb, n0 = 32 * nb;
    {
        const int kr = lane >> 3, c4 = (lane & 7) * 4; f32x4 v[8];
#pragma unroll
        for (int i = 0; i < 8; ++i) v[i] = *(const f32x4*)(W + (size_t)(k0 + 8 * i + kr) * N + n0 + c4);
#pragma unroll
        for (int i = 0; i < 8; ++i) { if (kscale) v[i] = v[i] * kscale[k0 + 8 * i + kr]; LAS float* d = scr + (8 * i + kr) * 33 + c4; d[0] = v[i][0]; d[1] = v[i][1]; d[2] = v[i][2]; d[3] = v[i][3]; }
    }
    LDS_WAIT(); asm volatile("" ::: "memory");
    const int c = lane & 7;
#pragma unroll
    for (int j = 0; j < 4; ++j) { const int n = (lane >> 3) + 8 * j; const LAS float* s = scr + (8 * c) * 33 + n;
        u32x4 o; o.x = pk2(s[0 * 33], s[1 * 33]); o.y = pk2(s[2 * 33], s[3 * 33]); o.z = pk2(s[4 * 33], s[5 * 33]); o.w = pk2(s[6 * 33], s[7 * 33]);
        *(u32x4*)(WT + (size_t)map_row(kind, n0 + n) * dstK + koff + k0 + 8 * c) = o; }
    LDS_WAIT(); asm volatile("" ::: "memory");
}
__device__ __forceinline__ void p_prologue(Frame& F) {
    const float* const* in = F.in;
    __syncthreads();
    {
        LAS float* cond = (LAS float*)F.lds;
        LAS float* part = (LAS float*)(F.lds + 32768);
        for (int i = F.tid; i < 8 * 1024; i += 512) { const float v = in[1][i]; cond[i] = v * sigmoidf_(v); }
        __syncthreads();
        for (int it = F.bid; it < DEPTH * 96; it += F.G) {
            const int l = it / 96, n0 = (it % 96) * 64, col = F.tid & 63, kg = F.tid >> 6;
            const float* w = in[3] + (size_t)l * 1024 * 6144 + n0 + col;
            float a[8] = {0.f, 0.f, 0.f, 0.f, 0.f, 0.f, 0.f, 0.f};
            for (int k0 = kg * 128; k0 < kg * 128 + 128; k0 += 16) {
                float wv[16];
#pragma unroll
                for (int q = 0; q < 16; ++q) wv[q] = w[(size_t)(k0 + q) * 6144];
#pragma unroll
                for (int q = 0; q < 16; ++q)
#pragma unroll
                    for (int b = 0; b < 8; ++b) a[b] += cond[b * 1024 + k0 + q] * wv[q]; }
#pragma unroll
            for (int b = 0; b < 8; ++b) part[(kg * 8 + b) * 64 + col] = a[b];
            __syncthreads();
            { const int b = F.tid >> 6; float s = 0.f;
#pragma unroll
              for (int g = 0; g < 8; ++g) s += part[(g * 8 + b) * 64 + col];
              ((float*)(F.ws + WS_MOD))[((size_t)l * 8 + b) * 6144 + n0 + col] = s + in[4][(size_t)l * 6144 + n0 + col]; }
            __syncthreads();
        }
    }
    const int gtid = F.bid * 512 + F.tid, NT_ = F.G * 512;
    for (int i = gtid; i < 1024; i += NT_) {
        float lg[DEPTH], mx = -1e30f; for (int l = 0; l < DEPTH; ++l) { lg[l] = in[8][(size_t)l * 1024 + i]; mx = fmaxf(mx, lg[l]); }
        float s = 0.f; for (int l = 0; l < DEPTH; ++l) { lg[l] = __expf(lg[l] - mx); s += lg[l]; }
        float c = 0.f; float* lb = (float*)(F.ws + WS_LB);
        for (int l = 0; l < DEPTH; ++l) { if (l > 0) c += lg[l] / s; lb[(size_t)l * 1024 + i] = c; }
    }
    for (int i = gtid; i < T * 16; i += NT_) {
        const int t = i >> 4, j = i & 15; const int pos = ((const int*)in[2])[t];
        const double base4[4] = {1.0, 0.5623413251903491, 0.31622776601683794, 0.1778279410038923};
        double f = base4[j & 3]; for (int q = 0; q < (j >> 2); ++q) f *= 0.1;
        const double ang = (double)pos * f; const double n = __builtin_rint(ang * 0.15915494309189535); const float r = (float)(ang - n * 6.283185307179586);
        ((float*)(F.ws + WS_COS))[i] = cosf(r); ((float*)(F.ws + WS_SIN))[i] = sinf(r);
    }
    for (int l = 0; l < DEPTH; ++l) { u32x4* p = (u32x4*)(wl(F.ws, l, WL_IN) + (size_t)5280 * 1024 * 2); for (int i = gtid; i < 96 * 1024 * 2 / 16; i += NT_) p[i] = (u32x4){0u, 0u, 0u, 0u}; }
    {
        LAS float* scr = (LAS float*)(F.lds + F.wave * 16384);
        const int gw = F.bid * NWAVES + F.wave, NGW = F.G * NWAVES;
        constexpr int I_IN = 16 * 165, I_Q = 6 * 24, I_KV = 4 * 32, I_OH = 8 * 32, I_OM = 8 * 32, I_O = 16 * 32, I_GU = 32 * 16 * 64, I_DN = 32 * 16 * 32;
        constexpr int I_LAYER = I_IN + I_Q + I_KV + I_OH + I_OM + I_O + I_GU + I_DN;
        for (int it = gw; it < DEPTH * I_LAYER; it += NGW) {
            const int l = it / I_LAYER; int r = it - l * I_LAYER;
            if (r < I_IN) { conv_item(in[7] + (size_t)l * 1024 * 5280, 5280, nullptr, (bf16*)wl(F.ws, l, WL_IN), 1024, 0, MAP_WIN, scr, r / 165, r % 165, F.lane); continue; } r -= I_IN;
            if (r < I_Q) { conv_item(in[12] + (size_t)l * 384 * 768, 768, in[11] + l * 384, (bf16*)wl(F.ws, l, WL_Q), 384, 0, MAP_WQ, scr, r / 24, r % 24, F.lane); continue; } r -= I_Q;
            if (r < I_KV) { conv_item(in[14] + (size_t)l * 256 * 1024, 1024, in[13] + l * 256, (bf16*)wl(F.ws, l, WL_K), 256, 0, MAP_WKV, scr, r / 32, r % 32, F.lane); continue; } r -= I_KV;
            if (r < I_OH) { conv_item(in[10] + (size_t)l * 512 * 1024, 1024, nullptr, (bf16*)wl(F.ws, l, WL_OUT), 1024, 0, MAP_ID, scr, r / 32, r % 32, F.lane); continue; } r -= I_OH;
            if (r < I_OM) { conv_item(in[15] + (size_t)l * 512 * 1024, 1024, nullptr, (bf16*)wl(F.ws, l, WL_OUT), 1024, 512, MAP_ID, scr, r / 32, r % 32, F.lane); continue; } r -= I_OM;
            if (r < I_O) { conv_item(in[16] + (size_t)l * 1024 * 1024, 1024, nullptr, (bf16*)wl(F.ws, l, WL_O), 1024, 0, MAP_ID, scr, r / 32, r % 32, F.lane); continue; } r -= I_O;
            if (r < I_GU) { const int e = r / (16 * 64), q = r % (16 * 64); conv_item(in[19] + ((size_t)l * 32 + e) * 1024 * 2048, 2048, nullptr, (bf16*)wl(F.ws, l, WL_GU) + (size_t)e * 2048 * 1024, 1024, 0, MAP_GU, scr, q / 64, q % 64, F.lane); continue; } r -= I_GU;
            { const int e = r / (16 * 32), q = r % (16 * 32); conv_item(in[21] + ((size_t)l * 32 + e) * 1024 * 1024, 1024, nullptr, (bf16*)wl(F.ws, l, WL_DN) + (size_t)e * 1024 * 1024, 1024, 0, MAP_ID, scr, q / 32, q % 32, F.lane); }
        }
    }
}

__device__ __forceinline__ void p_norm_mix(Frame& F, int l, bool fin, float* out, bool dummy = false) {
    const float* const* in = F.in;
    bf16* X = (bf16*)(F.ws + (dummy ? WS_ACT : WS_X));
    const float* MOD = (const float*)(F.ws + WS_MOD); const bf16* YR = (const bf16*)(F.ws + WS_YR); bf16* HB = (bf16*)(F.ws + (dummy ? WS_ACT + 64 * MiB : WS_HB));
    const int gw = F.bid * NWAVES + F.wave, NGW = F.G * NWAVES, per_wave = (T + NGW - 1) / NGW;
    f32x4 Gv[4], Sv[4], G2[4]; int bcur = -1;
    for (int q = 0; q < per_wave; ++q) {
        const int t = gw * per_wave + q; if (t >= T) break;
        const int b = t >> 11; f32x4 v[4];
        if (b != bcur) { bcur = b;
            const float* gn = fin ? in[23] : in[5] + (size_t)l * 1024; const float* sh = MOD + ((size_t)(fin ? 0 : l) * 8 + b) * 6144; const float* g2 = MOD + ((size_t)(l > 0 ? l - 1 : 0) * 8 + b) * 6144 + 5 * 1024;
#pragma unroll
            for (int j = 0; j < 4; ++j) { const int d = 4 * F.lane + 256 * j; const f32x4 g = *(const f32x4*)(gn + d);
                Gv[j] = fin ? g : g * (*(const f32x4*)(sh + 1024 + d) + 1.0f); Sv[j] = fin ? (f32x4){0.f, 0.f, 0.f, 0.f} : *(const f32x4*)(sh + d); G2[j] = *(const f32x4*)(g2 + d); } }
        if (l == 0) {
#pragma unroll
            for (int j = 0; j < 4; ++j) v[j] = *(const f32x4*)(in[0] + (size_t)t * 1024 + 4 * F.lane + 256 * j);
        } else {
#pragma unroll
            for (int j = 0; j < 4; ++j) { const u32x2 w = *(const u32x2*)(X + (size_t)t * 1024 + 4 * F.lane + 256 * j); v[j] = (f32x4){bflo(w.x), bfhi(w.x), bflo(w.y), bfhi(w.y)}; }
        }
        if (l > 0) {
#pragma unroll
            for (int j = 0; j < 4; ++j) { f32x4 s = {0.f, 0.f, 0.f, 0.f};
#pragma unroll
                for (int k = 0; k < 4; ++k) { const u32x2 w = *(const u32x2*)(YR + ((size_t)t * 4 + k) * 1024 + 4 * F.lane + 256 * j); s[0] += bflo(w.x); s[1] += bfhi(w.x); s[2] += bflo(w.y); s[3] += bfhi(w.y); }
                v[j] += G2[j] * s; }
        }
        float ss = 0.f;
#pragma unroll
        for (int j = 0; j < 4; ++j) ss += (v[j][0] * v[j][0] + v[j][1] * v[j][1]) + (v[j][2] * v[j][2] + v[j][3] * v[j][3]);
        const float rs = rsqrtf(wave_sum(ss) * (1.0f / 1024.0f) + EPS);
        if (fin) {
#pragma unroll
            for (int j = 0; j < 4; ++j) { const int d = 4 * F.lane + 256 * j; *(f32x4*)(out + (size_t)t * 1024 + d) = v[j] * rs * Gv[j]; }
        } else {
#pragma unroll
            for (int j = 0; j < 4; ++j) { const int d = 4 * F.lane + 256 * j; { u32x2 xw; xw.x = pk2(v[j][0], v[j][1]); xw.y = pk2(v[j][2], v[j][3]); *(u32x2*)(X + (size_t)t * 1024 + d) = xw; }
                const f32x4 h = v[j] * rs * Gv[j] + Sv[j]; u32x2 w; w.x = pk2(h[0], h[1]); w.y = pk2(h[2], h[3]);
                *(u32x2*)(HB + (size_t)t * 1024 + d) = w; }
        }
    }
}
__device__ __forceinline__ void p_mla_prep(Frame& F) {
    const bf16* PROJ = (const bf16*)(F.ws + WS_PROJ); float* RSQ = (float*)(F.ws + WS_RSQ); float* RSKV = (float*)(F.ws + WS_RSKV); bf16* Kb = (bf16*)(F.ws + WS_K);
    const float* CS = (const float*)(F.ws + WS_COS); const float* SN = (const float*)(F.ws + WS_SIN);
    const int gw = F.bid * NWAVES + F.wave, NGW = F.G * NWAVES;
    for (int t = gw; t < T; t += NGW) {
        const bf16* row = PROJ + (size_t)t * NPROJ;
        float sq = 0.f, skv = 0.f;
#pragma unroll
        for (int j = 0; j < 6; ++j) { const float v = bf2f(row[PCQ + F.lane + 64 * j]); sq += v * v; }
#pragma unroll
        for (int j = 0; j < 4; ++j) { const float v = bf2f(row[PCKV + F.lane + 64 * j]); skv += v * v; }
        sq = wave_sum(sq); skv = wave_sum(skv);
        if (F.lane == 0) { RSQ[t] = rsqrtf(sq * (1.0f / 384.0f) + EPS); RSKV[t] = rsqrtf(skv * (1.0f / 256.0f) + EPS); }
        if (F.lane < 16) {
            const float x1 = bf2f(row[PKPE + F.lane]), x2 = bf2f(row[PKPE + 16 + F.lane]), co = CS[(size_t)t * 16 + F.lane], si = SN[(size_t)t * 16 + F.lane];
            const bf16 o1 = (bf16)(pk2(x1 * co - x2 * si, 0.f) & 0xffffu), o2 = (bf16)(pk2(x2 * co + x1 * si, 0.f) & 0xffffu);
            const int b = t >> 11, s = t & 2047;
#pragma unroll
            for (int h = 0; h < 8; ++h) { bf16* kp = Kb + ((size_t)(b * 8 + h) * SEQ + s) * 96; kp[64 + F.lane] = o1; kp[80 + F.lane] = o2; }
        }
    }
}
__device__ __forceinline__ void p_hgrn_post(Frame& F, int l) {
    const bf16* OFp = (const bf16*)(F.ws + WS_OF); const bf16* OBp = (const bf16*)(F.ws + WS_OB); const bf16* PROJ = (const bf16*)(F.ws + WS_PROJ); bf16* HA = (bf16*)(F.ws + WS_HA);
    const float* gn = F.in[9] + (size_t)l * 128;
    const int gw = F.bid * NWAVES + F.wave, NGW = F.G * NWAVES;
    for (int t = gw; t < T; t += NGW) {
        const int c = 8 * F.lane;
        f32x4 a0, a1, b0, b1; unpack8(*(const u32x4*)(OFp + (size_t)t * 512 + c), a0, a1); unpack8(*(const u32x4*)(OBp + (size_t)t * 512 + c), b0, b1); a0 += b0; a1 += b1;
        float ss = (a0[0] * a0[0] + a0[1] * a0[1]) + (a0[2] * a0[2] + a0[3] * a0[3]) + (a1[0] * a1[0] + a1[1] * a1[1]) + (a1[2] * a1[2] + a1[3] * a1[3]);
#pragma unroll
        for (int o = 1; o < 16; o <<= 1) ss += __shfl_xor(ss, o);
        const float rs = rsqrtf(ss * (1.0f / 128.0f) + EPS);
        f32x4 g0, g1; unpack8(*(const u32x4*)(PROJ + (size_t)t * NPROJ + PGT + c), g0, g1);
        const f32x4 n0 = *(const f32x4*)(gn + (c & 127)), n1 = *(const f32x4*)(gn + (c & 127) + 4);
#pragma unroll
        for (int j = 0; j < 4; ++j) { a0[j] = a0[j] * rs * n0[j] * sigmoidf_(g0[j]); a1[j] = a1[j] * rs * n1[j] * sigmoidf_(g1[j]); }
        *(u32x4*)(HA + (size_t)t * 1024 + c) = pack8(a0, a1);
    }
}

#define MFMA16(a, b, c) __builtin_amdgcn_mfma_f32_16x16x32_bf16((a), (b), (c), 0, 0, 0)
constexpr int SC_QROW = 272, SC_TROW = 144;
constexpr int SC_QT = 0, SC_KT = SC_QT + 64 * SC_QROW, SC_KH = SC_KT + 64 * SC_QROW, SC_VT = SC_KH + 128 * SC_TROW, SC_DEC = SC_VT + 128 * SC_TROW, SC_ZERO = SC_DEC + 4 * 128 * 4, SC_END = SC_ZERO + 64;
__device__ __forceinline__ unsigned rot16(unsigned x) { return (x >> 16) | (x << 16); }
constexpr int SC_OX = 73984;
static_assert(SC_OX >= SC_END && SC_OX % 16 == 0 && SC_OX + 32768 <= RING_BYTES, "scan LDS map");
__device__ __forceinline__ void scan_unit2(Frame& F, int l, int u) {
    const int vh = u & 1, dir = (u >> 1) & 1, hh = (u >> 2) & 3, b = u >> 4;
    const bf16* HTb = (const bf16*)(F.ws + WS_HT) + (size_t)b * NHT * SEQ;
    const bf16* qg = HTb + (size_t)(HQ + hh * 128) * SEQ; const bf16* fg = HTb + (size_t)((dir ? HFB : HFF) + hh * 128) * SEQ; const bf16* vg = HTb + (size_t)(HI + hh * 128 + vh * 64) * SEQ;
    bf16* OUT = (bf16*)(F.ws + (dir ? WS_OB : WS_OF));
    LAS unsigned char* lds = F.lds;
    const int d = F.tid & 127, si = F.tid >> 7;
    const float lbv = ((const float*)(F.ws + WS_LB))[((size_t)l * 2 + dir) * 512 + hh * 128 + d];
    const int r = F.lane & 15, g = F.lane >> 4, vt = F.wave & 3, dh = F.wave >> 2;
    const int vcol = hh * 128 + vh * 64 + 16 * vt;
    f32x4 S[4];
#pragma unroll
    for (int i = 0; i < 4; ++i) S[i] = (f32x4){0.f, 0.f, 0.f, 0.f};
    __syncthreads();
    if (F.tid < 16) *(LAS unsigned*)(lds + SC_ZERO + F.tid * 4) = 0u;
    u32x4 pq[2], pf[2], pv;
    const int vrow0 = F.tid >> 3, vmc = F.tid & 7;
    {   const int m0 = dir ? SEQ - 64 : 0; const int mb = dir ? m0 + 48 - 16 * si : m0 + 16 * si;
        pq[0] = *(const u32x4*)(qg + (size_t)d * SEQ + mb); pq[1] = *(const u32x4*)(qg + (size_t)d * SEQ + mb + 8);
        pf[0] = *(const u32x4*)(fg + (size_t)d * SEQ + mb); pf[1] = *(const u32x4*)(fg + (size_t)d * SEQ + mb + 8);
        pv = *(const u32x4*)(vg + (size_t)vrow0 * SEQ + m0 + 8 * vmc); }
    int mprev = 0;
#pragma unroll 1
    for (int c = 0; c <= SEQ / 64; ++c) {
        const bool live = c < SEQ / 64;
        const int m0 = dir ? SEQ - 64 * (c + 1) : 64 * c;
        float qt[16], kt[16], E = 1.0f;
        if (live) {
            float rq[16], rf[16];
#pragma unroll
            for (int j = 0; j < 2; ++j) {
                rq[8 * j + 0] = bflo(pq[j].x); rq[8 * j + 1] = bfhi(pq[j].x); rq[8 * j + 2] = bflo(pq[j].y); rq[8 * j + 3] = bfhi(pq[j].y); rq[8 * j + 4] = bflo(pq[j].z); rq[8 * j + 5] = bfhi(pq[j].z); rq[8 * j + 6] = bflo(pq[j].w); rq[8 * j + 7] = bfhi(pq[j].w);
                rf[8 * j + 0] = bflo(pf[j].x); rf[8 * j + 1] = bfhi(pf[j].x); rf[8 * j + 2] = bflo(pf[j].y); rf[8 * j + 3] = bfhi(pf[j].y); rf[8 * j + 4] = bflo(pf[j].z); rf[8 * j + 5] = bfhi(pf[j].z); rf[8 * j + 6] = bflo(pf[j].w); rf[8 * j + 7] = bfhi(pf[j].w); }
#pragma unroll
            for (int k = 0; k < 16; ++k) {
                const float un = dir ? rf[15 - k] : rf[k], qs = dir ? rq[15 - k] : rq[k];
                const float kk = (1.0f - lbv) * un; E = fmaxf(E * (1.0f - kk), 1e-30f);
                qt[k] = qs * E; kt[k] = kk * __builtin_amdgcn_rcpf(E);
            }
        }
        __syncthreads();
        if (c > 0) {
#pragma unroll
            for (int ii = 0; ii < 2; ++ii) { const int i = 2 * dh + ii;
                const f32x4 a = *(const LAS f32x4*)(lds + SC_OX + (((0 * 4 + vt) * 4 + i) * 64 + F.lane) * 16), bq = *(const LAS f32x4*)(lds + SC_OX + (((1 * 4 + vt) * 4 + i) * 64 + F.lane) * 16);
                const int m = dir ? mprev + 63 - 16 * i - r : mprev + 16 * i + r;
                const f32x4 o = a + bq; u32x2 w; w.x = pk2(o[0], o[1]); w.y = pk2(o[2], o[3]);
                *(u32x2*)(OUT + (size_t)(b * SEQ + m) * 512 + vcol + 4 * g) = w; }
        }
        if (!live) break;
        {   LAS unsigned char* qp = lds + SC_QT + (16 * si) * SC_QROW + d * 2; LAS unsigned char* kp = lds + SC_KT + (16 * si) * SC_QROW + d * 2;
#pragma unroll
            for (int k = 0; k < 16; k += 2) { const unsigned wq = pk2(qt[k], qt[k + 1]), wk = pk2(kt[k], kt[k + 1]);
                *(LAS unsigned short*)(qp + k * SC_QROW) = (unsigned short)wq; *(LAS unsigned short*)(qp + (k + 1) * SC_QROW) = (unsigned short)(wq >> 16);
                *(LAS unsigned short*)(kp + k * SC_QROW) = (unsigned short)wk; *(LAS unsigned short*)(kp + (k + 1) * SC_QROW) = (unsigned short)(wk >> 16); }
            u32x4 h0, h1;
            h0.x = pk2(kt[0] * E, kt[1] * E); h0.y = pk2(kt[2] * E, kt[3] * E); h0.z = pk2(kt[4] * E, kt[5] * E); h0.w = pk2(kt[6] * E, kt[7] * E);
            h1.x = pk2(kt[8] * E, kt[9] * E); h1.y = pk2(kt[10] * E, kt[11] * E); h1.z = pk2(kt[12] * E, kt[13] * E); h1.w = pk2(kt[14] * E, kt[15] * E);
            *(LAS u32x4*)(lds + SC_KH + d * SC_TROW + 32 * si) = h0; *(LAS u32x4*)(lds + SC_KH + d * SC_TROW + 32 * si + 16) = h1;
            *(LAS float*)(lds + SC_DEC + (si * 128 + d) * 4) = E;
            { u32x4 w = pv; int tl0 = 8 * vmc;
              if (dir) { w = (u32x4){rot16(pv.w), rot16(pv.z), rot16(pv.y), rot16(pv.x)}; tl0 = 56 - 8 * vmc; }
              *(LAS u32x4*)(lds + SC_VT + vrow0 * SC_TROW + tl0 * 2) = w; }
        }
        if (c + 1 < SEQ / 64) {
            const int m1 = dir ? SEQ - 64 * (c + 2) : 64 * (c + 1); const int mb = dir ? m1 + 48 - 16 * si : m1 + 16 * si;
            pq[0] = *(const u32x4*)(qg + (size_t)d * SEQ + mb); pq[1] = *(const u32x4*)(qg + (size_t)d * SEQ + mb + 8);
            pf[0] = *(const u32x4*)(fg + (size_t)d * SEQ + mb); pf[1] = *(const u32x4*)(fg + (size_t)d * SEQ + mb + 8);
            pv = *(const u32x4*)(vg + (size_t)vrow0 * SEQ + m1 + 8 * vmc);
        }
        mprev = m0;
        __syncthreads();
        f32x4 oI[2];
#pragma unroll
        for (int ii = 0; ii < 2; ++ii) {
            const int i = 2 * dh + ii;
            const LAS unsigned char* qrow = lds + SC_QT + (16 * i + r) * SC_QROW; const LAS unsigned char* krow = lds + SC_KT + (16 * i + r) * SC_QROW;
            f32x4 pT = {0.f, 0.f, 0.f, 0.f};
#pragma unroll
            for (int ks = 0; ks < 4; ++ks) pT = MFMA16(*(const LAS bf16x8*)(krow + (32 * ks + 8 * g) * 2), *(const LAS bf16x8*)(qrow + (32 * ks + 8 * g) * 2), pT);
#pragma unroll
            for (int q = 0; q < 4; ++q) pT[q] = (4 * g + q <= r) ? pT[q] : 0.0f;
            const bf16x8 pfrag = __builtin_bit_cast(bf16x8, ((u32x4){pk2(pT[0], pT[1]), pk2(pT[2], pT[3]), 0u, 0u}));
            const u32x2 vt4 = *(const LAS u32x2*)(lds + SC_VT + (16 * vt + r) * SC_TROW + (16 * i + 4 * g) * 2);
            oI[ii] = MFMA16(__builtin_bit_cast(bf16x8, ((u32x4){vt4.x, vt4.y, 0u, 0u})), pfrag, ((f32x4){0.f, 0.f, 0.f, 0.f}));
        }
        const bool zl = (g >= 2);
#pragma unroll
        for (int i = 0; i < 4; ++i) {
            const LAS unsigned char* qrow = lds + SC_QT + (16 * i + r) * SC_QROW + (64 * dh) * 2;
            f32x4 o = ((i >> 1) == dh) ? oI[i & 1] : (f32x4){0.f, 0.f, 0.f, 0.f};
#pragma unroll
            for (int kk = 0; kk < 2; ++kk) {
                const bf16x8 sfrag = __builtin_bit_cast(bf16x8, ((u32x4){pk2(S[2 * kk][0], S[2 * kk][1]), pk2(S[2 * kk][2], S[2 * kk][3]), pk2(S[2 * kk + 1][0], S[2 * kk + 1][1]), pk2(S[2 * kk + 1][2], S[2 * kk + 1][3])}));
                const u32x2 qa = *(const LAS u32x2*)(qrow + (32 * kk + 4 * g) * 2), qb = *(const LAS u32x2*)(qrow + (32 * kk + 16 + 4 * g) * 2);
                o = MFMA16(sfrag, __builtin_bit_cast(bf16x8, ((u32x4){qa.x, qa.y, qb.x, qb.y})), o);
            }
            *(LAS f32x4*)(lds + SC_OX + (((dh * 4 + vt) * 4 + i) * 64 + F.lane) * 16) = o;
            const LAS unsigned char* vtp = zl ? lds + SC_ZERO : lds + SC_VT + (16 * vt + r) * SC_TROW + (16 * i + 8 * g) * 2;
            const bf16x8 vfrag = *(const LAS bf16x8*)vtp;
#pragma unroll
            for (int dt = 0; dt < 4; ++dt) {
                const f32x4 dec = *(const LAS f32x4*)(lds + SC_DEC + (i * 128 + 64 * dh + 16 * dt + 4 * g) * 4);
                const LAS unsigned char* khp = zl ? lds + SC_ZERO : lds + SC_KH + (64 * dh + 16 * dt + r) * SC_TROW + (16 * i + 8 * g) * 2;
                S[dt] = MFMA16(*(const LAS bf16x8*)khp, vfrag, S[dt] * dec);
            }
        }
    }
    __syncthreads();
}

#define MFMA32(a, b, c) __builtin_amdgcn_mfma_f32_32x32x16_bf16((a), (b), (c), 0, 0, 0)
constexpr int AT_KROW = 208, AT_VROW = 136, AT_KBYTES = 64 * AT_KROW, AT_BUF = AT_KBYTES + 64 * AT_VROW;
__device__ __forceinline__ void attn_unit(Frame& F, int bh, int q0) {
    const GAS bf16* Q = (const GAS bf16*)(F.ws + WS_Q); const GAS char* Kg = (const GAS char*)(F.ws + WS_K) + (size_t)bh * SEQ * 96 * 2; const GAS char* Vg = (const GAS char*)(F.ws + WS_VT) + (size_t)bh * 64 * SEQ * 2;
    GAS bf16* HA = (GAS bf16*)(F.ws + WS_HA);
    LAS unsigned char* lds = F.lds;
    const int r = F.lane & 31, h = F.lane >> 5;
    bf16x8 qf[6];
    { const GAS bf16* qrow = Q + ((size_t)bh * SEQ + q0 + F.wave * 32 + r) * 96;
#pragma unroll
      for (int ks = 0; ks < 6; ++ks) qf[ks] = *(const GAS bf16x8*)(qrow + 16 * ks + 8 * h); }
    f32x16 o0, o1;
#pragma unroll
    for (int i = 0; i < 16; ++i) { o0[i] = 0.f; o1[i] = 0.f; }
    float mrun = -1e30f, lsum = 0.f;
    const int kc0 = F.tid, kc1 = F.tid + 512; const bool has1 = F.tid < 256;
    const int kl0 = (kc0 / 12) * AT_KROW + (kc0 % 12) * 16, kl1 = (kc1 / 12) * AT_KROW + (kc1 % 12) * 16;
    const int vrow = F.tid >> 3, vpc = F.tid & 7; const int vl = AT_KBYTES + vrow * AT_VROW + vpc * 16;
    u32x4 rk0, rk1 = {0u, 0u, 0u, 0u}, rv;
    __syncthreads();
    rk0 = *(const GAS u32x4*)(Kg + (size_t)kc0 * 16); if (has1) rk1 = *(const GAS u32x4*)(Kg + (size_t)kc1 * 16);
    rv = *(const GAS u32x4*)(Vg + (size_t)vrow * SEQ * 2 + vpc * 16);
    *(LAS u32x4*)(lds + kl0) = rk0; if (has1) *(LAS u32x4*)(lds + kl1) = rk1;
    *(LAS u32x2*)(lds + vl) = (u32x2){rv.x, rv.y}; *(LAS u32x2*)(lds + vl + 8) = (u32x2){rv.z, rv.w};
    __syncthreads();
    for (int j = 0; j < SEQ / 64; ++j) {
        const int buf = (j & 1) * AT_BUF, nbuf = ((j + 1) & 1) * AT_BUF;
        if (j + 1 < SEQ / 64) {
            const GAS char* kg = Kg + (size_t)(j + 1) * 64 * 96 * 2;
            rk0 = *(const GAS u32x4*)(kg + (size_t)kc0 * 16); if (has1) rk1 = *(const GAS u32x4*)(kg + (size_t)kc1 * 16);
            rv = *(const GAS u32x4*)(Vg + (size_t)vrow * SEQ * 2 + (size_t)(j + 1) * 128 + vpc * 16);
        }
        f32x16 s0, s1;
#pragma unroll
        for (int i = 0; i < 16; ++i) { s0[i] = 0.f; s1[i] = 0.f; }
#pragma unroll
        for (int ks = 0; ks < 6; ++ks) {
            const bf16x8 k0 = *(const LAS bf16x8*)(lds + buf + r * AT_KROW + (16 * ks + 8 * h) * 2);
            const bf16x8 k1 = *(const LAS bf16x8*)(lds + buf + (32 + r) * AT_KROW + (16 * ks + 8 * h) * 2);
            s0 = MFMA32(k0, qf[ks], s0); s1 = MFMA32(k1, qf[ks], s1);
        }
        float mx = s0[0];
#pragma unroll
        for (int i = 1; i < 16; ++i) mx = fmaxf(mx, s0[i]);
#pragma unroll
        for (int i = 0; i < 16; ++i) mx = fmaxf(mx, s1[i]);
        mx = fmaxf(mx, __shfl_xor(mx, 32));
        const float mnew = fmaxf(mrun, mx), alpha = __builtin_amdgcn_exp2f(mrun - mnew); mrun = mnew;
        float ps = 0.f;
#pragma unroll
        for (int i = 0; i < 16; ++i) { s0[i] = __builtin_amdgcn_exp2f(s0[i] - mnew); s1[i] = __builtin_amdgcn_exp2f(s1[i] - mnew); ps += s0[i] + s1[i]; }
        lsum = lsum * alpha + ps;
#pragma unroll
        for (int i = 0; i < 16; ++i) { o0[i] *= alpha; o1[i] *= alpha; }
        bf16x8 pf[2][2];
#pragma unroll
        for (int sp = 0; sp < 2; ++sp) {
            u32x4 w0, w1;
            w0.x = pk2(s0[8 * sp + 0], s0[8 * sp + 1]); w0.y = pk2(s0[8 * sp + 2], s0[8 * sp + 3]); w0.z = pk2(s0[8 * sp + 4], s0[8 * sp + 5]); w0.w = pk2(s0[8 * sp + 6], s0[8 * sp + 7]);
            w1.x = pk2(s1[8 * sp + 0], s1[8 * sp + 1]); w1.y = pk2(s1[8 * sp + 2], s1[8 * sp + 3]); w1.z = pk2(s1[8 * sp + 4], s1[8 * sp + 5]); w1.w = pk2(s1[8 * sp + 6], s1[8 * sp + 7]);
            pf[0][sp] = __builtin_bit_cast(bf16x8, w0); pf[1][sp] = __builtin_bit_cast(bf16x8, w1);
        }
#pragma unroll
        for (int kb = 0; kb < 2; ++kb)
#pragma unroll
            for (int sp = 0; sp < 2; ++sp) {
                const int kbase = (32 * kb + 16 * sp + 4 * h) * 2;
                const LAS unsigned char* v0p = lds + buf + AT_KBYTES + r * AT_VROW + kbase;
                const LAS unsigned char* v1p = lds + buf + AT_KBYTES + (32 + r) * AT_VROW + kbase;
                const u32x2 a0 = *(const LAS u32x2*)v0p, a1 = *(const LAS u32x2*)(v0p + 16), c0 = *(const LAS u32x2*)v1p, c1 = *(const LAS u32x2*)(v1p + 16);
                const bf16x8 vf0 = __builtin_bit_cast(bf16x8, ((u32x4){a0.x, a0.y, a1.x, a1.y})), vf1 = __builtin_bit_cast(bf16x8, ((u32x4){c0.x, c0.y, c1.x, c1.y}));
                o0 = MFMA32(vf0, pf[kb][sp], o0); o1 = MFMA32(vf1, pf[kb][sp], o1);
            }
        if (j + 1 < SEQ / 64) {
            *(LAS u32x4*)(lds + nbuf + kl0) = rk0; if (has1) *(LAS u32x4*)(lds + nbuf + kl1) = rk1;
            *(LAS u32x2*)(lds + nbuf + vl) = (u32x2){rv.x, rv.y}; *(LAS u32x2*)(lds + nbuf + vl + 8) = (u32x2){rv.z, rv.w};
        }
        __syncthreads();
    }
    lsum += __shfl_xor(lsum, 32);
    const float inv = 1.0f / lsum;
    const int head = bh & 7, b = bh >> 3;
    GAS bf16* orow = HA + (size_t)(b * SEQ + q0 + F.wave * 32 + r) * 1024 + 512 + head * 64;
#pragma unroll
    for (int i = 0; i < 4; ++i) {
        u32x2 w0, w1;
        w0.x = pk2(o0[4 * i] * inv, o0[4 * i + 1] * inv); w0.y = pk2(o0[4 * i + 2] * inv, o0[4 * i + 3] * inv);
        w1.x = pk2(o1[4 * i] * inv, o1[4 * i + 1] * inv); w1.y = pk2(o1[4 * i + 2] * inv, o1[4 * i + 3] * inv);
        *(GAS u32x2*)(orow + 8 * i + 4 * h) = w0; *(GAS u32x2*)(orow + 32 + 8 * i + 4 * h) = w1;
    }
}

__device__ __forceinline__ void p_router(Frame& F, int l, bool dummy = false) {
    const float* const* in = F.in;
    const bf16* X = (const bf16*)(F.ws + WS_X); const float* MOD = (const float*)(F.ws + WS_MOD); bf16* HB = (bf16*)(F.ws + WS_HB);
    int* LIST = (int*)(F.ws + (dummy ? WS_Y : WS_LIST)); float* AW = (float*)(F.ws + (dummy ? WS_Y + 4 * MiB : WS_AW)); unsigned* CNT = (unsigned*)(F.ws + WS_CTL) + CW_CNT + (l + (dummy ? 4 : 0)) * 32 * 64;
    LAS unsigned char* lds = F.lds;
    __syncthreads();
    { const float* wr = in[17] + (size_t)l * 1024 * 32;
      for (int q = F.tid; q < 8192; q += 512) { const int k = q >> 3; *(LAS f32x4*)(lds + (size_t)(q + (k >> 2)) * 16) = *(const f32x4*)(wr + (size_t)q * 4); } }
    const float* gn = in[6] + (size_t)l * 1024; const float* br = in[18] + (size_t)l * 32;
    const int gw = F.bid * NWAVES + F.wave, NGW = F.G * NWAVES;
    const int wgb = ((F.bid * NWAVES) * ((T + NGW - 1) / NGW) < T ? (F.bid * NWAVES) * ((T + NGW - 1) / NGW) : T - 1) >> 11;
    { const float* sh = MOD + ((size_t)l * 8 + wgb) * 6144 + 3 * 1024;
      for (int d = F.tid; d < 1024; d += 512) { *(LAS float*)(lds + RT_G_OFF + d * 4) = gn[d] * (sh[1024 + d] + 1.0f); *(LAS float*)(lds + RT_S_OFF + d * 4) = sh[d]; } }
    __syncthreads();
    LAS unsigned* lcnt = (LAS unsigned*)(lds + MOE_OFF + 512); LAS unsigned* lbase = lcnt + 32;
    const int per_wave = (T + NGW - 1) / NGW;
    for (int b0 = 0; b0 < per_wave; b0 += 16) {
    int pend_e = 0, pend_a = 0, npend = 0; float pend_w = 0.f;
    u32x2 xn[4];
    {   const int t0 = gw * per_wave + b0; const int tc = t0 < T ? t0 : T - 1;
#pragma unroll
        for (int j = 0; j < 4; ++j) xn[j] = *(const u32x2*)(X + (size_t)tc * 1024 + 4 * F.lane + 256 * j); }
    for (int q_ = 0; q_ < 16; ++q_) {
        const int t = gw * per_wave + b0 + q_; if (b0 + q_ >= per_wave || t >= T) break;
        const int b = t >> 11; f32x4 v[4]; float ss = 0.f;
#pragma unroll
        for (int j = 0; j < 4; ++j) { const u32x2 xw = xn[j]; v[j] = (f32x4){bflo(xw.x), bfhi(xw.x), bflo(xw.y), bfhi(xw.y)}; ss += (v[j][0] * v[j][0] + v[j][1] * v[j][1]) + (v[j][2] * v[j][2] + v[j][3] * v[j][3]); }
        {   const int tn = (t + 1 < T) ? t + 1 : t;
#pragma unroll
            for (int j = 0; j < 4; ++j) xn[j] = *(const u32x2*)(X + (size_t)tn * 1024 + 4 * F.lane + 256 * j); }
        const float rs = rsqrtf(wave_sum(ss) * (1.0f / 1024.0f) + EPS);
#pragma unroll
        for (int j = 0; j < 4; ++j) { const int d = 4 * F.lane + 256 * j; f32x4 Gv, Sv;
            if (b == wgb) { Gv = *(const LAS f32x4*)(lds + RT_G_OFF + d * 4); Sv = *(const LAS f32x4*)(lds + RT_S_OFF + d * 4); }
            else { const float* sh = MOD + ((size_t)l * 8 + b) * 6144 + 3 * 1024; Gv = *(const f32x4*)(gn + d) * (*(const f32x4*)(sh + 1024 + d) + 1.0f); Sv = *(const f32x4*)(sh + d); }
            v[j] = v[j] * rs * Gv + Sv; u32x2 w; w.x = pk2(v[j][0], v[j][1]); w.y = pk2(v[j][2], v[j][3]);
            *(u32x2*)(HB + (size_t)t * 1024 + d) = w; }
        float p[32];
#pragma unroll
        for (int e = 0; e < 32; ++e) p[e] = 0.f;
#define RT_WP(q) (lds + (size_t)((4 * F.lane + 256 * ((q) >> 2) + ((q) & 3)) * 8 + F.lane + 64 * ((q) >> 2)) * 16)
#define RT_LOAD(dst, q) do { const LAS unsigned char* wp_ = RT_WP(q); _Pragma("unroll") for (int c = 0; c < 8; ++c) dst[c] = *(const LAS f32x4*)(wp_ + c * 16); } while (0)
#define RT_FMA(src, q) do { const float hv_ = v[(q) >> 2][(q) & 3]; _Pragma("unroll") for (int c = 0; c < 8; ++c) { p[4 * c] += hv_ * src[c][0]; p[4 * c + 1] += hv_ * src[c][1]; p[4 * c + 2] += hv_ * src[c][2]; p[4 * c + 3] += hv_ * src[c][3]; } } while (0)
        {   f32x4 wa[8], wb[8];
            RT_LOAD(wa, 0);
#pragma unroll
            for (int q = 0; q < 16; q += 2) {
                RT_LOAD(wb, q + 1); __builtin_amdgcn_sched_barrier(0); RT_FMA(wa, q); __builtin_amdgcn_sched_barrier(0);
                if (q + 2 < 16) RT_LOAD(wa, q + 2);
                __builtin_amdgcn_sched_barrier(0); RT_FMA(wb, q + 1); __builtin_amdgcn_sched_barrier(0);
            }
        }
#undef RT_WP
#undef RT_LOAD
#undef RT_FMA
#pragma unroll
        for (int e = 0; e < 16; ++e) { const bool up = (F.lane & 32) != 0; const float keep = up ? p[e + 16] : p[e], send = up ? p[e] : p[e + 16]; p[e] = keep + __shfl_xor(send, 32); }
#pragma unroll
        for (int e = 0; e < 8; ++e) { const bool up = (F.lane & 16) != 0; const float keep = up ? p[e + 8] : p[e], send = up ? p[e] : p[e + 8]; p[e] = keep + __shfl_xor(send, 16); }
#pragma unroll
        for (int e = 0; e < 4; ++e) { const bool up = (F.lane & 8) != 0; const float keep = up ? p[e + 4] : p[e], send = up ? p[e] : p[e + 4]; p[e] = keep + __shfl_xor(send, 8); }
#pragma unroll
        for (int e = 0; e < 2; ++e) { const bool up = (F.lane & 4) != 0; const float keep = up ? p[e + 2] : p[e], send = up ? p[e] : p[e + 2]; p[e] = keep + __shfl_xor(send, 4); }
        { const bool up = (F.lane & 2) != 0; const float keep = up ? p[1] : p[0], send = up ? p[0] : p[1]; p[0] = keep + __shfl_xor(send, 2); }
        float logit = p[0] + __shfl_xor(p[0], 1);
        const int myE = F.lane >> 1; logit += br[myE];
        int rank = 0;
#pragma unroll
        for (int r = 1; r < 32; ++r) { const int oe = (myE + r) & 31; const float ov = __shfl(logit, 2 * oe + (F.lane & 1)); rank += (ov > logit || (ov == logit && oe < myE)) ? 1 : 0; }
        float tv[4]; int te[4];
#pragma unroll
        for (int k = 0; k < 4; ++k) { const unsigned long long mk = __builtin_amdgcn_ballot_w64(rank == k); const int src = __builtin_ctzll(mk); tv[k] = __builtin_bit_cast(float, __builtin_amdgcn_readlane(__builtin_bit_cast(int, logit), src)); te[k] = src >> 1; }
        const float e1 = __expf(tv[1] - tv[0]), e2 = __expf(tv[2] - tv[0]), e3 = __expf(tv[3] - tv[0]); const float invs = 1.0f / (1.0f + e1 + e2 + e3);
        {   const int k = F.lane & 3;
            const int ek = k == 0 ? te[0] : k == 1 ? te[1] : k == 2 ? te[2] : te[3];
            const float wk = (k == 0 ? 1.0f : k == 1 ? e1 : k == 2 ? e2 : e3) * invs;
            if ((F.lane >> 2) == npend) { pend_e = ek; pend_w = wk; pend_a = t * 4 + k; }
            ++npend; }
    }
    __syncthreads();
    if (F.tid < 32) lcnt[F.tid] = 0u;
    __syncthreads();
    unsigned lslot = 0u; const bool have = (F.lane >> 2) < npend;
    if (have) lslot = __hip_atomic_fetch_add(lcnt + pend_e, 1u, __ATOMIC_RELAXED, __HIP_MEMORY_SCOPE_WORKGROUP);
    __syncthreads();
    if (F.tid < 32) { const unsigned c = lcnt[F.tid]; lbase[F.tid] = c ? __hip_atomic_fetch_add(CNT + F.tid * 64, c, __ATOMIC_RELAXED, __HIP_MEMORY_SCOPE_AGENT) : 0u; }
    __syncthreads();
    if (have) { const unsigned slot = lbase[pend_e] + lslot; LIST[(size_t)pend_e * T + slot] = pend_a; AW[pend_a] = pend_w; }
    }
    __syncthreads();
}
__device__ __forceinline__ void moe_tables(Frame& F, int l) {
    LAS int* cnt = (LAS int*)(F.lds + MOE_OFF); LAS int* toff = cnt + 32;
    const unsigned* CNT = (const unsigned*)(F.ws + WS_CTL) + CW_CNT + l * 32 * 64;
    __syncthreads();
    if (F.tid < 32) cnt[F.tid] = (int)__hip_atomic_load(CNT + F.tid * 64, __ATOMIC_RELAXED, __HIP_MEMORY_SCOPE_AGENT);
    __syncthreads();
    if (F.tid == 0) { int s = 0; for (int e = 0; e < 32; ++e) { toff[e] = s; s += (cnt[e] + 255) >> 8; } toff[32] = s; }
    __syncthreads();
}

constexpr int NPH = 11, PH_FINAL = 1 + DEPTH * NPH, PH_TOTAL = PH_FINAL + 1;
__global__ void __launch_bounds__(NWAVES * 64, 2) fwd_kernel(Args args) {
    extern __shared__ __attribute__((aligned(16))) unsigned char lds_raw[];
    Frame F;
    F.lds = (LAS unsigned char*)lds_raw; F.ws = args.ws; F.tid = threadIdx.x; F.lane = F.tid & 63; F.wave = __builtin_amdgcn_readfirstlane(F.tid >> 6); F.G = gridDim.x; F.bid = blockIdx.x; F.in = args.in;
    for (int u = F.tid; u < (LDS_BYTES - LDSCTL_OFF) / 4; u += NWAVES * 64) ((LAS unsigned*)(F.lds + LDSCTL_OFF))[u] = 0u;
    __syncthreads();
    const int lo = args.ph_lo, hi = args.ph_hi;
    const unsigned long long tk0_ = (TIME_KIND == 98) ? __builtin_amdgcn_s_memrealtime() : 0ull;
    XcdBarrier bar; bar.bar = (unsigned*)(F.ws + WS_CTL) + CW_BAR; bar.x = 0; bar.st = nullptr;
    if (hi - lo > 1) bar = xcd_barrier_post((unsigned*)(F.ws + WS_CTL) + CW_BAR, (volatile LAS unsigned*)(F.lds + MISC_OFF) + 8);
#define IN(k) (lo <= (k) && (k) < hi)
#define PROJ ((bf16*)(ws + WS_PROJ))
#define SEAM(k) do { if (IN(k) && IN((k) + 1)) xcd_barrier(bar); } while (0)
#define TSTART(kind) unsigned long long t0_ = (TIME_KIND == (kind) || TIME_KIND == 99) ? __builtin_amdgcn_s_memrealtime() : 0ull
#define TSTALL(kind) do { if (TIME_KIND == (kind) || TIME_KIND == 99) { const unsigned long long t1_ = __builtin_amdgcn_s_memrealtime(); const unsigned long long dt_ = t1_ - t0_; while (__builtin_amdgcn_s_memrealtime() - t1_ < dt_) __builtin_amdgcn_s_sleep(8); } } while (0)
    unsigned char* ws = F.ws;
#define PHASE_ENTER() do { unsigned char* w_ = args.ws; asm volatile("" : "+s"(w_)); F.ws = w_; ws = w_; int t_ = threadIdx.x; asm volatile("" : "+v"(t_)); F.tid = t_; F.lane = t_ & 63; F.wave = __builtin_amdgcn_readfirstlane(t_ >> 6); } while (0)
    if (EN(0) && IN(0)) { PHASE_ENTER(); TSTART(0); REPS(0) { p_prologue(F); } SEAM(0); TSTALL(0); }
    for (int l = 0; l < DEPTH; ++l) {
        const int pb = 1 + l * NPH;
        if (EN(1) && IN(pb + 0)) { PHASE_ENTER(); TSTART(1); if (REP_KIND == 1) p_norm_mix(F, l, false, nullptr, true); p_norm_mix(F, l, false, nullptr); SEAM(pb + 0); TSTALL(1); }
        if (EN(2) && IN(pb + 1)) { PHASE_ENTER(); TSTART(2);
            REPS(2) {
            { pg8::DenseOrder S; S.init(T, NPROJ, F.G, F.bid, ws + WS_HB, 1024, (bf16*)wl(ws, l, WL_IN) + (size_t)NHT * 1024, 1024);
              EpiProj E{PROJ};
              pg8::gemm_phase(F.lds, 1024, S, E); }
            { int z = 0; asm volatile("" : "+s"(z)); pg8::DenseOrder S; S.init(NHT, T, F.G, (F.bid + 64 + z) % F.G, wl(ws, l, WL_IN) + z, 1024, ws + WS_HB + z, 1024);
              EpiHT E{(bf16*)(ws + WS_HT)};
              pg8::gemm_phase(F.lds, 1024, S, E); }
            }
            SEAM(pb + 1); TSTALL(2);
        }
        if (EN(3) && IN(pb + 2)) { PHASE_ENTER(); TSTART(3); REPS(3) { p_mla_prep(F); } SEAM(pb + 2); TSTALL(3); }
        if (EN(4) && IN(pb + 3)) { PHASE_ENTER(); TSTART(4);
#ifndef SUBMASK
#define SUBMASK 7
#endif
            REPS(4) {
            if (SUBMASK & 1) { pg8::DenseOrder S; S.init(T, 768, F.G, F.bid, PROJ + PCQ, NPROJ, wl(ws, l, WL_Q), 384);
              EpiQ E{(bf16*)(ws + WS_Q), (const float*)(ws + WS_RSQ), (const float*)(ws + WS_COS), (const float*)(ws + WS_SIN)};
              pg8::gemm_phase(F.lds, 384, S, E); }
            if (SUBMASK & 2) { int z = 0; asm volatile("" : "+s"(z)); pg8::DenseOrder S; S.init(T, 512, F.G, (F.bid + 64 + z) % F.G, PROJ + PCKV + z, NPROJ, wl(ws, l, WL_K) + z, 256);
              EpiK E{(bf16*)(ws + WS_K), (const float*)(ws + WS_RSKV)};
              pg8::gemm_phase(F.lds, 256, S, E); }
            if (SUBMASK & 4) { int z = 0; asm volatile("" : "+s"(z)); pg8::DenseOrder S; S.init(512, T, F.G, (F.bid + 192 + z) % F.G, wl(ws, l, WL_V) + z, 256, PROJ + PCKV + z, NPROJ);
              EpiV E{(bf16*)(ws + WS_VT), (const float*)(ws + WS_RSKV)};
              pg8::gemm_phase(F.lds, 256, S, E); }
            }
            SEAM(pb + 3); TSTALL(4);
        }
        if (EN(5) && IN(pb + 4)) { PHASE_ENTER(); TSTART(5);
            REPS(5) {
            if (rep_ == 0 || (REP_SUB & 1)) for (int u = F.bid; u < 128 * SCAN_REP; u += F.G) scan_unit2(F, l, u & 127);
            if (rep_ == 0 || (REP_SUB & 2)) {
                unsigned* qctr = (unsigned*)(ws + WS_CTL) + CW_Q + (l * 2 + rep_) * 64; volatile LAS unsigned* misc = (volatile LAS unsigned*)(F.lds + MISC_OFF);
                for (;;) { __syncthreads(); if (F.tid == 0) misc[0] = __hip_atomic_fetch_add(qctr, 1u, __ATOMIC_RELAXED, __HIP_MEMORY_SCOPE_AGENT); __syncthreads();
                    const int a = (int)misc[0]; if (a >= 512 * ATTN_REP) break; attn_unit(F, (a & 511) >> 3, (a & 7) * 256); }
            }
            }
            SEAM(pb + 4); TSTALL(5);
        }
        if (EN(6) && IN(pb + 5)) { PHASE_ENTER(); TSTART(6); REPS(6) { p_hgrn_post(F, l); } SEAM(pb + 5); TSTALL(6); }
        if (EN(7) && IN(pb + 6)) { PHASE_ENTER(); TSTART(7);
            REPS(7) {
            { pg8::DenseOrder S; S.init(T, 1024, F.G, F.bid, ws + WS_HA, 1024, wl(ws, l, WL_OUT), 1024);
              EpiOut E{(bf16*)(ws + WS_Y), PROJ};
              pg8::gemm_phase(F.lds, 1024, S, E); }
            }
            SEAM(pb + 6); TSTALL(7);
        }
        if (EN(8) && IN(pb + 7)) { PHASE_ENTER(); TSTART(8);
            pg8::DenseOrder S; S.init(T, 1024, F.G, F.bid, ws + WS_Y, 1024, wl(ws, l, WL_O), 1024);
            if (REP_KIND == 8) { EpiWo E2{(bf16*)(ws + WS_ACT), (const float*)(ws + WS_MOD) + (size_t)l * 8 * 6144 + 2 * 1024}; pg8::gemm_phase(F.lds, 1024, S, E2); }
            EpiWo E{(bf16*)(ws + WS_X), (const float*)(ws + WS_MOD) + (size_t)l * 8 * 6144 + 2 * 1024};
            pg8::gemm_phase(F.lds, 1024, S, E);
            if (REP_KIND == 13) { for (int q = 0; q < 10; ++q) xcd_barrier(bar); }
            SEAM(pb + 7); TSTALL(8);
        }
        if (EN(9) && IN(pb + 8)) { PHASE_ENTER(); TSTART(9); if (REP_KIND == 9) p_router(F, l, true); p_router(F, l); SEAM(pb + 8); TSTALL(9); }
        if (EN(10) && IN(pb + 9)) { PHASE_ENTER(); TSTART(10);
            moe_tables(F, l);
            pg8::MoeOrder<true> S; S.cnt = (const LAS int*)(F.lds + MOE_OFF); S.toff = S.cnt + 32; S.NT = 8; S.G = F.G; S.c = F.bid; S.Abase = (const char*)(ws + WS_HB); S.Bbase = (const char*)wl(ws, l, WL_GU);
            S.b_expert_bytes = (size_t)2048 * 1024 * 2; S.list = (const int*)(ws + WS_LIST); S.lda = 1024; S.ldb = 1024;
            EpiGU E{(bf16*)(ws + WS_ACT), F.in[20] + (size_t)l * 32 * 2048};
            REPS(10) { pg8::gemm_phase(F.lds, 1024, S, E); }
            SEAM(pb + 9); TSTALL(10);
        }
        if (EN(11) && IN(pb + 10)) { PHASE_ENTER(); TSTART(11);
            moe_tables(F, l);
            pg8::MoeOrder<false> S; S.cnt = (const LAS int*)(F.lds + MOE_OFF); S.toff = S.cnt + 32; S.NT = 4; S.G = F.G; S.c = F.bid; S.Abase = (const char*)(ws + WS_ACT); S.Bbase = (const char*)wl(ws, l, WL_DN);
            S.b_expert_bytes = (size_t)1024 * 1024 * 2; S.list = (const int*)(ws + WS_LIST); S.lda = 1024; S.ldb = 1024;
            EpiDown E{(bf16*)(ws + WS_YR), F.in[22] + (size_t)l * 32 * 1024, (const int*)(ws + WS_LIST), (const float*)(ws + WS_AW)};
            REPS(11) { pg8::gemm_phase(F.lds, 1024, S, E); }
            SEAM(pb + 10); TSTALL(11);
        }
    }
    if (EN(12) && IN(PH_FINAL)) { PHASE_ENTER(); p_norm_mix(F, DEPTH, true, args.out); }
    if (TIME_KIND == 98 && F.bid == 0) { const unsigned long long t1_ = __builtin_amdgcn_s_memrealtime(); const unsigned long long dt_ = t1_ - tk0_; while (__builtin_amdgcn_s_memrealtime() - t1_ < dt_) __builtin_amdgcn_s_sleep(8); }
#undef IN
#undef SEAM
#undef PROJ
#undef PHASE_ENTER
}

extern "C" void kernel_launch(void* const* d_in, const int* in_sizes, int n_in, void* d_out, int out_size, void* d_ws, size_t ws_size, hipStream_t stream) {
    static int grid = 0;
    if (grid == 0) {
        if (n_in != 24 || in_sizes[0] != T * D || out_size != T * D || ws_size < WS_END) { fprintf(stderr, "kernel_launch: unexpected problem (n_in %d, in0 %d, out %d, ws %zu, need %zu)\n", n_in, n_in > 0 ? in_sizes[0] : -1, out_size, ws_size, (size_t)WS_END); grid = -1; return; }
        int dev = 0, cus = 0, per_cu = 0;
        if (hipGetDevice(&dev) != hipSuccess || hipDeviceGetAttribute(&cus, hipDeviceAttributeMultiprocessorCount, dev) != hipSuccess) { grid = -1; return; }
        if (hipFuncSetAttribute((const void*)fwd_kernel, hipFuncAttributeMaxDynamicSharedMemorySize, LDS_BYTES) != hipSuccess) { fprintf(stderr, "kernel_launch: hipFuncSetAttribute failed\n"); grid = -1; return; }
        if (hipOccupancyMaxActiveBlocksPerMultiprocessor(&per_cu, (const void*)fwd_kernel, NWAVES * 64, LDS_BYTES) != hipSuccess || per_cu < 1) { fprintf(stderr, "kernel_launch: occupancy query says %d\n", per_cu); (void)hipGetLastError(); }
        grid = cus - (cus % 8);
        if (grid < 64) { fprintf(stderr, "kernel_launch: only %d CUs\n", cus); grid = -1; return; }
    }
    if (grid < 0) return;
    if (hipMemsetAsync((char*)d_ws + WS_CTL, 0, CTL_ZERO_BYTES, stream) != hipSuccess) return;
    Args a{};
    for (int i = 0; i < 24; ++i) a.in[i] = (const float*)d_in[i];
    a.out = (float*)d_out; a.ws = (unsigned char*)d_ws;
#if MK_PER_PHASE
    for (int ph = 0; ph < PH_TOTAL; ++ph) { a.ph_lo = ph; a.ph_hi = ph + 1; hipLaunchKernelGGL(fwd_kernel, dim3(grid), dim3(NWAVES * 64), LDS_BYTES, stream, a); }
#else
    a.ph_lo = 0; a.ph_hi = PH_TOTAL; hipLaunchKernelGGL(fwd_kernel, dim3(grid), dim3(NWAVES * 64), LDS_BYTES, stream, a);
#endif
}
```

```cpp
#include <hip/hip_runtime.h>
#include <cstdio>
#include <cstdint>

#ifndef PHASE_MASK
#define PHASE_MASK 0xFFFFu
#endif
#define EN(k) (((PHASE_MASK) >> (k)) & 1u)
#ifndef REP_KIND
#define REP_KIND -1
#endif
#ifndef REP_SUB
#define REP_SUB 3
#endif
#ifndef TIME_KIND
#define TIME_KIND -1
#endif
#ifndef ATTN_REP
#define ATTN_REP 1
#endif
#ifndef SCAN_REP
#define SCAN_REP 1
#endif
#ifndef EPI_REP
#define EPI_REP 1
#endif
#define REPS(k) _Pragma("unroll 1") for (int rep_ = 0; rep_ < ((REP_KIND) == (k) ? 2 : 1); ++rep_)
#ifndef MK_PER_PHASE
#define MK_PER_PHASE 0
#endif

#define GAS __attribute__((address_space(1)))
#define LAS __attribute__((address_space(3)))
typedef unsigned short bf16;
typedef short bf16x8 __attribute__((ext_vector_type(8)));
typedef float f32x4 __attribute__((ext_vector_type(4)));
typedef float f32x2 __attribute__((ext_vector_type(2)));
typedef float f32x16 __attribute__((ext_vector_type(16)));
typedef unsigned u32x4 __attribute__((ext_vector_type(4)));
typedef unsigned u32x2 __attribute__((ext_vector_type(2)));
typedef __bf16 bfv2 __attribute__((ext_vector_type(2)));

__device__ __forceinline__ unsigned pk2(float lo, float hi) { f32x2 v = {lo, hi}; bfv2 r = __builtin_convertvector(v, bfv2); return __builtin_bit_cast(unsigned, r); }
__device__ __forceinline__ float bf2f(unsigned short b) { return __uint_as_float(((unsigned)b) << 16); }
__device__ __forceinline__ float bflo(unsigned w) { return __uint_as_float(w << 16); }
__device__ __forceinline__ float bfhi(unsigned w) { return __uint_as_float(w & 0xffff0000u); }
__device__ __forceinline__ u32x4 pack8(f32x4 a, f32x4 b) { u32x4 w; w.x = pk2(a[0], a[1]); w.y = pk2(a[2], a[3]); w.z = pk2(b[0], b[1]); w.w = pk2(b[2], b[3]); return w; }
__device__ __forceinline__ void unpack8(u32x4 w, f32x4& a, f32x4& b) { a[0] = bflo(w.x); a[1] = bfhi(w.x); a[2] = bflo(w.y); a[3] = bfhi(w.y); b[0] = bflo(w.z); b[1] = bfhi(w.z); b[2] = bflo(w.w); b[3] = bfhi(w.w); }
__device__ __forceinline__ float sigmoidf_(float x) { return 1.0f / (1.0f + __expf(-x)); }
__device__ __forceinline__ float wave_sum(float v) {
#pragma unroll
    for (int o = 1; o < 64; o <<= 1) v += __shfl_xor(v, o);
    return v;
}
#define LDS_WAIT() asm volatile("s_waitcnt lgkmcnt(0)" ::: "memory")
#define VM_WAIT() asm volatile("s_waitcnt vmcnt(0)" ::: "memory")

#define XB_TMO      128
#define XB_XCNT(j)  (256  + 64 * (j))
#define XB_XSUB(j)  (1280 + 64 * (j))
#define XB_XGEN(j)  (2304 + 64 * (j))
#define XB_TOP      3328
#define XB_TOPGEN   3392
#define XCD_BAR_WORDS 3456
#define XB_SPIN_CAP (1u << 20)

__device__ __forceinline__ unsigned xb_ld(unsigned* p)              { return __hip_atomic_load(p, __ATOMIC_RELAXED, __HIP_MEMORY_SCOPE_AGENT); }
__device__ __forceinline__ unsigned xb_add(unsigned* p, unsigned v) { return __hip_atomic_fetch_add(p, v, __ATOMIC_RELAXED, __HIP_MEMORY_SCOPE_AGENT); }
__device__ __forceinline__ unsigned xb_xcc_id() { return (unsigned)__builtin_amdgcn_s_getreg((3 << 11) | 20) & 0xFu; }
#define XB_SPIN(cond, bar) do { unsigned _sp = 0; while (cond) { __builtin_amdgcn_s_sleep(1); \
    if ((++_sp & 255u) == 0u) { if (xb_ld(&(bar)[XB_TMO])) break; if (_sp > XB_SPIN_CAP) { atomicAdd(&(bar)[XB_TMO], 1u); break; } } } } while (0)

struct XcdBarrier { unsigned* bar; unsigned x; volatile LAS unsigned* st; };

__device__ __forceinline__ XcdBarrier xcd_barrier_post(unsigned* bar, volatile LAS unsigned* st) {
    XcdBarrier b; b.bar = bar; b.x = xb_xcc_id(); b.st = st;
    if (threadIdx.x == 0) (void)xb_add(&bar[XB_XCNT(b.x)], 1u);
    return b;
}
__device__ __forceinline__ void xcd_barrier_complete(unsigned* bar, unsigned x, unsigned& nloc, unsigned& nx) {
    const unsigned G = gridDim.x * gridDim.y * gridDim.z;
    unsigned sum, cnt, mine, sp = 0u;
    for (;;) {
        sum = 0u; cnt = 0u; mine = 0u;
#pragma unroll
        for (unsigned j = 0; j < 16; ++j) { const unsigned c = xb_ld(&bar[XB_XCNT(j)]); sum += c; cnt += (c > 0u) ? 1u : 0u; mine = (j == x) ? c : mine; }
        if (sum == G) break;
        __builtin_amdgcn_s_sleep(1);
        if ((++sp & 255u) == 0u) { if (xb_ld(&bar[XB_TMO])) break; if (sp > XB_SPIN_CAP) { atomicAdd(&bar[XB_TMO], 1u); break; } }
    }
    nloc = mine > 0u ? mine : 1u; nx = cnt > 0u ? cnt : 1u;
}
__device__ __forceinline__ void xcd_barrier(const XcdBarrier& b) {
    asm volatile("s_waitcnt vmcnt(0)" ::: "memory");
    __syncthreads();
    if (threadIdx.x == 0) {
        unsigned* bar = b.bar;
        __builtin_amdgcn_s_waitcnt(0);
        unsigned nloc = b.st[0], nx = b.st[1];
        if (nloc == 0u) { xcd_barrier_complete(bar, b.x, nloc, nx); b.st[0] = nloc; b.st[1] = nx; }
        const unsigned old = xb_add(&bar[XB_XSUB(b.x)], 1u);
        const unsigned gen = old / nloc;
        if (old + 1u == (gen + 1u) * nloc) {
            __builtin_amdgcn_fence(__ATOMIC_RELEASE, "agent");
            asm volatile("s_waitcnt vmcnt(0)" ::: "memory");
            const unsigned og = xb_add(&bar[XB_TOP], 1u);
            const unsigned tg = og / nx;
            if (og + 1u == (tg + 1u) * nx) xb_add(&bar[XB_TOPGEN], 1u);
            else XB_SPIN(xb_ld(&bar[XB_TOPGEN]) == tg, bar);
            __builtin_amdgcn_fence(__ATOMIC_ACQUIRE, "agent");
            xb_add(&bar[XB_XGEN(b.x)], 1u);
            asm volatile("s_waitcnt vmcnt(0)" ::: "memory");
        } else {
            XB_SPIN(xb_ld(&bar[XB_XGEN(b.x)]) == gen, bar);
            __builtin_amdgcn_fence(__ATOMIC_ACQUIRE, "agent");
            asm volatile("s_waitcnt vmcnt(0)" ::: "memory");
        }
    }
    __syncthreads();
}

constexpr int D = 1024, NB = 8, SEQ = 2048, T = NB * SEQ, DEPTH = 4;
constexpr int NPROJ = 3328;
constexpr int NHT = 2048;
constexpr int PGT = 0, PGA = 512, PGB = 1536, PCQ = 2560, PCKV = 2944, PKPE = 3200;
constexpr int HQ = 0, HFF = 512, HFB = 1024, HI = 1536;
constexpr int NE = 32, TOPK = 4, NASSIGN = T * TOPK, ACT_ROWS = NASSIGN + NE * 256;
constexpr float EPS = 1e-6f;
constexpr float QSCALE = 0.10206207261596575f * 1.4426950408889634f;

constexpr size_t MiB = 1u << 20;
constexpr size_t WS_CTL = 0, CTL_ZERO_BYTES = 1 * MiB;
constexpr size_t WS_MOD = 1 * MiB, WS_LB = 2 * MiB, WS_COS = 3 * MiB, WS_SIN = 4 * MiB, WS_RSQ = 5 * MiB, WS_RSKV = 5 * MiB + 65536, WS_AW = 6 * MiB, WS_LIST = 7 * MiB;
constexpr size_t WS_X = 16 * MiB, WS_HB = 80 * MiB, WS_PROJ = 112 * MiB, WS_HT = 216 * MiB, WS_Q = 280 * MiB, WS_K = 304 * MiB, WS_VT = 328 * MiB, WS_OF = 344 * MiB, WS_OB = 376 * MiB;
constexpr size_t WS_HA = 408 * MiB, WS_Y = 440 * MiB, WS_ACT = 472 * MiB, WS_YR = 616 * MiB, WS_W = 768 * MiB;
constexpr size_t WL_IN = 0, WL_Q = 11 * MiB, WL_K = 12 * MiB, WL_V = 12 * MiB + 256 * 1024, WL_OUT = 13 * MiB, WL_O = 15 * MiB, WL_GU = 17 * MiB, WL_DN = 145 * MiB, WL_STRIDE = 209 * MiB;
constexpr size_t WS_END = WS_W + DEPTH * WL_STRIDE;
static_assert((size_t)T * NPROJ * 2 <= WS_HT - WS_PROJ && (size_t)NB * NHT * SEQ * 2 <= WS_Q - WS_HT && (size_t)ACT_ROWS * 1024 * 2 <= WS_YR - WS_ACT && (size_t)NASSIGN * 1024 * 2 <= WS_W - WS_YR, "ws map");
constexpr int CW_BAR = 4096, CW_Q = 8192, CW_CNT = 16384;

constexpr int RING_BYTES = 131072;
constexpr int LDSCTL_OFF = 139264, MISC_OFF = LDSCTL_OFF + 320, MOE_OFF = LDSCTL_OFF + 1024;
constexpr int LDS_BYTES = 155648;
constexpr int RT_G_OFF = 143360, RT_S_OFF = 147456;
constexpr int NWAVES = 8;

namespace pg8 {
constexpr int BM = 256, BK = 64, HALF = 128, HTB = HALF * BK * 2, NXCD = 8, WGM = 8;
__device__ __forceinline__ int lds_byte(int r, int c) { const int st = (r >> 4) * 2 + (c >> 5), rr = r & 15, cc = c & 31, ob = rr * 64 + cc * 2; return st * 1024 + (ob ^ (((ob >> 9) & 1) << 5)); }
__device__ __forceinline__ void stage_rc(int b, int& R, int& C) { const int st = b / 1024, sb = b % 1024, swz = sb ^ (((sb >> 9) & 1) << 5); R = (st >> 1) * 16 + swz / 64; C = (st & 1) * 32 + (swz % 64) / 2; }
__device__ __forceinline__ int perm32(int rho) { const int n = rho >> 4, i = rho & 15; return 8 * (i >> 2) + 4 * n + (i & 3); }

struct Unit { const char* A; const char* B; int pm, pn, e, rowbase, mrows; };

struct DenseOrder {
    static constexpr bool GATHER_A = false;
    int nM, nN, nwg, G, c; const char* Abase; const char* Bbase; int lda, ldb;
    __device__ __forceinline__ void init(int M, int N, int G_, int c_, const void* A, int lda_, const void* B, int ldb_) { nM = M / BM; nN = N / BM; nwg = nM * nN; G = G_; c = c_; Abase = (const char*)A; Bbase = (const char*)B; lda = lda_; ldb = ldb_; }
    __device__ __forceinline__ bool next(int i, Unit& u) const {
        const long L = (long)i * G + c; if (L >= nwg) return false;
        int wgid = (int)L; { const int q = nwg / NXCD, r = nwg % NXCD, xcd = wgid % NXCD, off = wgid / NXCD; wgid = (xcd < r ? xcd * (q + 1) : r * (q + 1) + (xcd - r) * q) + off; }
        const int nig = WGM * nN, gid = wgid / nig, fm = gid * WGM, gsz = (nM - fm) < WGM ? (nM - fm) : WGM;
        u.pm = fm + ((wgid % nig) % gsz); u.pn = (wgid % nig) / gsz; u.e = 0; u.rowbase = 0; u.mrows = 256;
        u.A = Abase + (size_t)u.pm * 256 * lda * 2; u.B = Bbase + (size_t)u.pn * 256 * ldb * 2; return true;
    }
    __device__ __forceinline__ void aoff(const Unit&, const int (&R)[2], const int (&C)[2], unsigned (&v)[2][2]) const {
#pragma unroll
        for (int h = 0; h < 2; ++h)
#pragma unroll
            for (int i = 0; i < 2; ++i) v[h][i] = (unsigned)((128 * h + R[i]) * lda + C[i]) * 2u;
    }
};
template <bool GATHER> struct MoeOrder {
    static constexpr bool GATHER_A = GATHER;
    const LAS int* toff; const LAS int* cnt; int NT, G, c; const char* Abase; const char* Bbase; size_t b_expert_bytes; const int* list; int lda, ldb;
    __device__ __forceinline__ bool next(int i, Unit& u) const {
        const int spx = G >> 3, rpx = spx / NT, xcd = c & 7, slot = c >> 3;
        if (slot >= rpx * NT) return false;
        const int R = (i * 8 + xcd) * rpx + slot / NT; if (R >= toff[NE]) return false;
        int e = 0; while (toff[e + 1] <= R) ++e;
        u.e = e; u.pm = R - toff[e]; u.pn = slot % NT; u.rowbase = R * 256; u.mrows = cnt[e] - u.pm * 256;
        u.A = GATHER ? Abase : Abase + (size_t)u.rowbase * lda * 2; u.B = Bbase + (size_t)e * b_expert_bytes + (size_t)u.pn * 256 * ldb * 2; return true;
    }
    __device__ __forceinline__ void aoff(const Unit& u, const int (&R)[2], const int (&C)[2], unsigned (&v)[2][2]) const {
#pragma unroll
        for (int h = 0; h < 2; ++h)
#pragma unroll
            for (int i = 0; i < 2; ++i) {
                if (GATHER) { const int rl = 128 * h + R[i]; const int a = list[(size_t)u.e * T + u.pm * 256 + (rl < u.mrows ? rl : 0)]; v[h][i] = (unsigned)((a >> 2) * lda + C[i]) * 2u; }
                else v[h][i] = (unsigned)((128 * h + R[i]) * lda + C[i]) * 2u;
            }
    }
};

template <class E, class = void> struct has_mid { static constexpr bool value = false; };
template <class E> struct has_mid<E, decltype((void)E::HAS_MID)> { static constexpr bool value = true; };
template <class Epi, class Sched>
__device__ __forceinline__ void gemm_phase(LAS unsigned char* lds, const int K, const Sched& S, const Epi& E) {
    int tid_ = threadIdx.x; asm volatile("" : "+v"(tid_));
    const int tid = tid_, wid = __builtin_amdgcn_readfirstlane(tid >> 6), lane = tid & 63, wr = wid >> 2, wc = wid & 3, fr = lane & 15, fq = lane >> 4;
    int nt_ = K / BK; asm volatile("" : "+s"(nt_));
    const int nt = nt_;
    int sR[2], sC[2]; unsigned voffB[2];
#pragma unroll
    for (int i = 0; i < 2; ++i) { stage_rc(tid * 16 + i * 8192, sR[i], sC[i]); const int Rb = (sR[i] & ~31) + perm32(sR[i] & 31); voffB[i] = (unsigned)(Rb * S.ldb + sC[i]) * 2u; }
    constexpr bool GA = Sched::GATHER_A;
    unsigned voffA[2];
#pragma unroll
    for (int i = 0; i < 2; ++i) voffA[i] = (unsigned)(sR[i] * S.lda + sC[i]) * 2u;
    const size_t kstep = (size_t)(BK * 2);
    const size_t hstepB = (size_t)HALF * S.ldb * 2, hstepA = (size_t)HALF * S.lda * 2;
    const unsigned ldsw = (unsigned)wid * 1024u;
    const unsigned ldsbase = (unsigned)__builtin_amdgcn_readfirstlane((int)((unsigned)(size_t)lds + ldsw));
    const int aoff = lds_byte(wr * 64 + fr, fq * 8), boff = lds_byte(wc * 32 + fr, fq * 8);
#define PG8_SA(b, h) (((b) * 2 + (h)) * HTB)
#define PG8_SB(b, h) ((4 + (b) * 2 + (h)) * HTB)
#define PG8_DMA2(ldsaddr, gbase, v0_, v1_) do { unsigned keep_; \
        asm volatile("s_mov_b32 %0, m0\n\ts_mov_b32 m0, %4\n\ts_nop 0\n\tglobal_load_lds_dwordx4 %1, %3\n\ts_add_u32 m0, %4, 0x2000\n\ts_nop 0\n\tglobal_load_lds_dwordx4 %2, %3\n\ts_mov_b32 m0, %0" \
                     : "=&s"(keep_) : "v"(v0_), "v"(v1_), "s"(gbase), "s"(ldsaddr) : "memory", "scc"); } while (0)
#define PG8_STAGE(bufoff, gbase, voff) PG8_DMA2(ldsbase + (unsigned)(bufoff), (const char*)(gbase), (voff)[0], (voff)[1])
#define PG8_STAGEA(bufoff, gbase, h, nx) do { if constexpr (GA) { PG8_DMA2(ldsbase + (unsigned)(bufoff), (const char*)(gbase), ((nx) ? nvA[h][0] : vA[h][0]), ((nx) ? nvA[h][1] : vA[h][1])); } \
        else { PG8_DMA2(ldsbase + (unsigned)(bufoff), (const char*)(gbase) + (size_t)(h) * hstepA, voffA[0], voffA[1]); } } while (0)
#define PG8_LDA(dst, b, h) do { _Pragma("unroll") for (int m = 0; m < 4; ++m) _Pragma("unroll") for (int k = 0; k < 2; ++k) dst[m][k] = *(const LAS bf16x8*)(lds + PG8_SA(b, h) + aoff + m * 2048 + k * 1024); } while (0)
#define PG8_LDB(dst, b, h) do { _Pragma("unroll") for (int n = 0; n < 2; ++n) _Pragma("unroll") for (int k = 0; k < 2; ++k) dst[n][k] = *(const LAS bf16x8*)(lds + PG8_SB(b, h) + boff + n * 2048 + k * 1024); } while (0)
#define PG8_MMA(ai, bj, At, Bt) do { __builtin_amdgcn_s_setprio(1); _Pragma("unroll") for (int m = 0; m < 4; ++m) _Pragma("unroll") for (int n = 0; n < 2; ++n) _Pragma("unroll") for (int k = 0; k < 2; ++k) \
        acc[ai][bj][m][n] = __builtin_amdgcn_mfma_f32_16x16x32_bf16(Bt[n][k], At[m][k], acc[ai][bj][m][n], 0, 0, 0); __builtin_amdgcn_s_setprio(0); } while (0)
#define PG8_WAIT_V(n) asm volatile("s_waitcnt vmcnt(" #n ")" ::: "memory")
#define PG8_WAIT_L(n) asm volatile("s_waitcnt lgkmcnt(" #n ")" ::: "memory")
#define PG8_BAR __builtin_amdgcn_s_barrier()
#define PG8_SCHED __builtin_amdgcn_sched_barrier(0)
    Unit cur, nxt; int ui = 0;
    if (!S.next(0, cur)) return;
    f32x4 acc[2][2][4][2];
#pragma unroll
    for (int a = 0; a < 2; ++a)
#pragma unroll
        for (int b = 0; b < 2; ++b)
#pragma unroll
            for (int m = 0; m < 4; ++m)
#pragma unroll
                for (int n = 0; n < 2; ++n) acc[a][b][m][n] = (f32x4){0.f, 0.f, 0.f, 0.f};
    bf16x8 At[4][2], B0[2][2], B1[2][2];
    unsigned vA[2][2], nvA[2][2];
    if constexpr (GA) { S.aoff(cur, sR, sC, vA); }
    const char* cA = cur.A; const char* cB = cur.B;
    PG8_STAGE(PG8_SB(0, 0), cB, voffB); PG8_STAGE(PG8_SB(0, 1), cB + hstepB, voffB); PG8_STAGEA(PG8_SA(0, 0), cA, 0, false); PG8_STAGEA(PG8_SA(0, 1), cA, 1, false);
    if (wr == 1) PG8_BAR;
    PG8_WAIT_V(2); PG8_BAR;
    PG8_STAGE(PG8_SB(1, 0), cB + kstep, voffB); PG8_STAGEA(PG8_SA(1, 0), cA + kstep, 0, false); PG8_STAGE(PG8_SB(1, 1), cB + hstepB + kstep, voffB);
    PG8_WAIT_V(6); PG8_BAR;
    for (;;) {
        const bool has_next = S.next(ui + 1, nxt);
        const char* nA = has_next ? nxt.A : cA; const char* nB = has_next ? nxt.B : cB;
        if constexpr (GA) {
            if (has_next) S.aoff(nxt, sR, sC, nvA);
            else {
#pragma unroll
                for (int h = 0; h < 2; ++h)
#pragma unroll
                    for (int i = 0; i < 2; ++i) nvA[h][i] = vA[h][i]; } }
#pragma unroll 1
        for (int t = 0; t < nt; t += 2) {
            const bool last = (t == nt - 2);
            if constexpr (has_mid<Epi>::value) { if (t == Epi::MID_T) E.mid(acc, cur, wr, wc, fr, fq); }
            const char* a1 = cA + (size_t)(t + 1) * kstep;
            const char* a2 = last ? nA : cA + (size_t)(t + 2) * kstep; const char* b2 = last ? nB : cB + (size_t)(t + 2) * kstep;
            const char* a3 = a2 + kstep; const char* b3 = b2 + kstep;
            PG8_LDB(B0, 0, 0); PG8_LDB(B1, 0, 1); PG8_SCHED; PG8_LDA(At, 0, 0); PG8_STAGEA(PG8_SA(1, 1), a1, 1, false);
            PG8_WAIT_V(8); PG8_WAIT_L(0); PG8_BAR; PG8_MMA(0, 0, At, B0); PG8_MMA(0, 1, At, B1); PG8_BAR; PG8_SCHED;
            PG8_LDA(At, 0, 1); PG8_STAGE(PG8_SB(0, 0), b2, voffB); PG8_STAGE(PG8_SB(0, 1), b2 + hstepB, voffB); PG8_STAGEA(PG8_SA(0, 0), a2, 0, last);
            PG8_WAIT_V(8); PG8_WAIT_L(0); PG8_BAR; PG8_MMA(1, 0, At, B0); PG8_MMA(1, 1, At, B1); PG8_BAR; PG8_SCHED;
            PG8_LDB(B0, 1, 0); PG8_LDB(B1, 1, 1); PG8_SCHED; PG8_LDA(At, 1, 0); PG8_STAGEA(PG8_SA(0, 1), a2, 1, last);
            PG8_WAIT_V(8); PG8_WAIT_L(0); PG8_BAR; PG8_MMA(0, 0, At, B0); PG8_MMA(0, 1, At, B1); PG8_BAR; PG8_SCHED;
            PG8_LDA(At, 1, 1); PG8_STAGE(PG8_SB(1, 0), b3, voffB); PG8_STAGE(PG8_SB(1, 1), b3 + hstepB, voffB); PG8_STAGEA(PG8_SA(1, 0), a3, 0, last);
            PG8_WAIT_V(8); PG8_WAIT_L(0); PG8_BAR; PG8_MMA(1, 0, At, B0); PG8_MMA(1, 1, At, B1); PG8_BAR; PG8_SCHED;
        }
        if (wr == 0) PG8_BAR;
        E(acc, cur, wr, wc, fr, fq);
        if constexpr (EPI_REP > 1 && Epi::IDEMPOTENT) { asm volatile("" ::: "memory"); E(acc, cur, wr, wc, fr, fq); }
        if (!has_next) break;
#pragma unroll
        for (int a = 0; a < 2; ++a)
#pragma unroll
            for (int b = 0; b < 2; ++b)
#pragma unroll
                for (int m = 0; m < 4; ++m)
#pragma unroll
                    for (int n = 0; n < 2; ++n) acc[a][b][m][n] = (f32x4){0.f, 0.f, 0.f, 0.f};
        cur = nxt; cA = nA; cB = nB; ++ui;
        if constexpr (GA) {
#pragma unroll
            for (int h = 0; h < 2; ++h)
#pragma unroll
                for (int i = 0; i < 2; ++i) vA[h][i] = nvA[h][i]; }
        if (wr == 1) PG8_BAR;
    }
    PG8_WAIT_V(0);
    PG8_BAR;
#undef PG8_SA
#undef PG8_SB
#undef PG8_STAGE
#undef PG8_STAGEA
#undef PG8_DMA2
#undef PG8_LDA
#undef PG8_LDB
#undef PG8_MMA
#undef PG8_WAIT_V
#undef PG8_WAIT_L
#undef PG8_BAR
#undef PG8_SCHED
}
}
using pg8::Unit;
typedef const f32x4 (&AccRef)[2][2][4][2];

struct Args {
    const float* in[24]; float* out; unsigned char* ws; int ph_lo, ph_hi;
};
struct Frame {
    LAS unsigned char* lds; unsigned char* ws; int tid, lane, wave, G, bid;
    const float* const* in;
};
__device__ __forceinline__ unsigned char* wl(unsigned char* ws, int l, size_t off) { return ws + WS_W + (size_t)l * WL_STRIDE + off; }

#define EPI_LOOP_BEGIN _Pragma("unroll") for (int ai = 0; ai < 2; ++ai) _Pragma("unroll") for (int m = 0; m < 4; ++m) { const int rl = ai * 128 + wr * 64 + m * 16 + fr; _Pragma("unroll") for (int bj = 0; bj < 2; ++bj) { const int cl = bj * 128 + wc * 32 + 8 * fq; const f32x4 v0 = acc[ai][bj][m][0], v1 = acc[ai][bj][m][1];
#define EPI_LOOP_END } asm volatile("" ::: "memory"); }

struct EpiProj {
    static constexpr bool IDEMPOTENT = (EPI_REP > 2);
    bf16* O;
    __device__ __forceinline__ void operator()(AccRef acc, const Unit& u, int wr, int wc, int fr, int fq) const {
        EPI_LOOP_BEGIN
            *(u32x4*)(O + (size_t)(u.pm * 256 + rl) * NPROJ + u.pn * 256 + cl) = pack8(v0, v1);
        EPI_LOOP_END
    }
};
struct EpiHT {
    static constexpr bool IDEMPOTENT = (EPI_REP > 2);
    bf16* HT;
    __device__ __forceinline__ void operator()(AccRef acc, const Unit& u, int wr, int wc, int fr, int fq) const {
        const int seg = u.pm >> 1;
        EPI_LOOP_BEGIN
            const int f = u.pm * 256 + rl, t0 = u.pn * 256 + cl, b = t0 >> 11, s = t0 & 2047;
            f32x4 a = v0, d = v1;
            if (seg == 0) {
#pragma unroll
                for (int j = 0; j < 4; ++j) { a[j] = a[j] * __builtin_amdgcn_rcpf(1.0f + __builtin_amdgcn_exp2f(-1.4426950408889634f * a[j])); d[j] = d[j] * __builtin_amdgcn_rcpf(1.0f + __builtin_amdgcn_exp2f(-1.4426950408889634f * d[j])); }
            } else if (seg < 3) {
#pragma unroll
                for (int j = 0; j < 4; ++j) { a[j] = __builtin_amdgcn_rcpf(1.0f + __builtin_amdgcn_exp2f(1.4426950408889634f * a[j])); d[j] = __builtin_amdgcn_rcpf(1.0f + __builtin_amdgcn_exp2f(1.4426950408889634f * d[j])); }
            }
            *(u32x4*)(HT + ((size_t)b * NHT + f) * SEQ + s) = pack8(a, d);
        EPI_LOOP_END
    }
};
struct EpiQ {
    static constexpr bool IDEMPOTENT = (EPI_REP > 2);
    bf16* Q; const float* rsq; const float* cs; const float* sn;
    __device__ __forceinline__ void operator()(AccRef acc, const Unit& u, int wr, int wc, int fr, int fq) const {
        EPI_LOOP_BEGIN
            const int t = u.pm * 256 + rl, c0 = u.pn * 256 + cl, head = c0 / 96, w = c0 - head * 96, b = t >> 11, s = t & 2047;
            const float sc = rsq[t] * QSCALE;
            bf16* qp = Q + ((size_t)(b * 8 + head) * SEQ + s) * 96;
            f32x4 a = v0 * sc, d = v1 * sc;
            if (w < 64) { *(u32x4*)(qp + w) = pack8(a, d); }
            else { const int g = (w - 64) >> 3; const f32x4 co = *(const f32x4*)(cs + (size_t)t * 16 + 4 * g), si = *(const f32x4*)(sn + (size_t)t * 16 + 4 * g);
                const f32x4 o1 = a * co - d * si, o2 = d * co + a * si;
                u32x2 w1, w2; w1.x = pk2(o1[0], o1[1]); w1.y = pk2(o1[2], o1[3]); w2.x = pk2(o2[0], o2[1]); w2.y = pk2(o2[2], o2[3]);
                *(u32x2*)(qp + 64 + 4 * g) = w1; *(u32x2*)(qp + 80 + 4 * g) = w2; }
        EPI_LOOP_END
    }
};
struct EpiK {
    static constexpr bool IDEMPOTENT = (EPI_REP > 2);
    bf16* Kb; const float* rskv;
    __device__ __forceinline__ void operator()(AccRef acc, const Unit& u, int wr, int wc, int fr, int fq) const {
        EPI_LOOP_BEGIN
            const int t = u.pm * 256 + rl, c0 = u.pn * 256 + cl, head = c0 >> 6, w = c0 & 63, b = t >> 11, s = t & 2047;
            const float sc = rskv[t];
            *(u32x4*)(Kb + ((size_t)(b * 8 + head) * SEQ + s) * 96 + w) = pack8(v0 * sc, v1 * sc);
        EPI_LOOP_END
    }
};
struct EpiV {
    static constexpr bool IDEMPOTENT = (EPI_REP > 2);
    bf16* VT; const float* rskv;
    __device__ __forceinline__ void operator()(AccRef acc, const Unit& u, int wr, int wc, int fr, int fq) const {
        EPI_LOOP_BEGIN
            const int f = u.pm * 256 + rl, t0 = u.pn * 256 + cl, b = t0 >> 11, s = t0 & 2047, head = f >> 6, dv = f & 63;
            const f32x4 r0 = *(const f32x4*)(rskv + t0), r1 = *(const f32x4*)(rskv + t0 + 4);
            *(u32x4*)(VT + ((size_t)(b * 8 + head) * 64 + dv) * SEQ + s) = pack8(v0 * r0, v1 * r1);
        EPI_LOOP_END
    }
};
struct EpiOut {
    static constexpr bool IDEMPOTENT = false; static constexpr bool HAS_MID = true; static constexpr int MID_T = 8;
    bf16* Y; const bf16* proj;
    __device__ __forceinline__ void mid(f32x4 (&acc)[2][2][4][2], const Unit& u, int wr, int wc, int fr, int fq) const {
        unsigned off0 = (unsigned)((u.pm * 256 + wr * 64 + fr) * NPROJ + u.pn * 256 + wc * 32 + 8 * fq) * 2u;
        asm volatile("" : "+v"(off0));
        const char* gp0 = (const char*)proj;
#pragma unroll
        for (int ai = 0; ai < 2; ++ai)
#pragma unroll
            for (int mp = 0; mp < 2; ++mp) {
                u32x4 ga[2][2], gb[2][2];
#pragma unroll
                for (int mm = 0; mm < 2; ++mm)
#pragma unroll
                    for (int bj = 0; bj < 2; ++bj) { const unsigned o = off0 + (unsigned)(((ai * 128 + (2 * mp + mm) * 16) * NPROJ + bj * 128) * 2); ga[mm][bj] = *(const u32x4*)(gp0 + o + PGA * 2); gb[mm][bj] = *(const u32x4*)(gp0 + o + PGB * 2); }
#pragma unroll
                for (int mm = 0; mm < 2; ++mm)
#pragma unroll
                    for (int bj = 0; bj < 2; ++bj) {
                        f32x4 a0, a1, b0, b1; unpack8(ga[mm][bj], a0, a1); unpack8(gb[mm][bj], b0, b1);
#pragma unroll
                        for (int j = 0; j < 4; ++j) {
                            a0[j] = (1.0f + __builtin_amdgcn_exp2f(-1.4426950408889634f * b0[j])) * __builtin_amdgcn_rcpf(1.0f + __builtin_amdgcn_exp2f(-1.4426950408889634f * a0[j]));
                            a1[j] = (1.0f + __builtin_amdgcn_exp2f(-1.4426950408889634f * b1[j])) * __builtin_amdgcn_rcpf(1.0f + __builtin_amdgcn_exp2f(-1.4426950408889634f * a1[j])); }
                        acc[ai][bj][2 * mp + mm][0] *= a0; acc[ai][bj][2 * mp + mm][1] *= a1;
                    }
                asm volatile("" ::: "memory");
            }
    }
    __device__ __forceinline__ void operator()(AccRef acc, const Unit& u, int wr, int wc, int fr, int fq) const {
        const int c0 = u.pn * 256 + wc * 32 + 8 * fq;
        const bf16* gp = proj + (size_t)(u.pm * 256 + wr * 64 + fr) * NPROJ + PGB + c0;
        bf16* yp = Y + (size_t)(u.pm * 256 + wr * 64 + fr) * 1024 + c0;
#pragma unroll
        for (int ai = 0; ai < 2; ++ai) {
            u32x4 gw[4][2];
#pragma unroll
            for (int m = 0; m < 4; ++m)
#pragma unroll
                for (int bj = 0; bj < 2; ++bj) gw[m][bj] = *(const u32x4*)(gp + (size_t)(ai * 128 + m * 16) * NPROJ + bj * 128);
#pragma unroll
            for (int m = 0; m < 4; ++m)
#pragma unroll
                for (int bj = 0; bj < 2; ++bj) {
                    f32x4 g0, g1; unpack8(gw[m][bj], g0, g1);
#pragma unroll
                    for (int j = 0; j < 4; ++j) { g0[j] = __builtin_amdgcn_rcpf(1.0f + __builtin_amdgcn_exp2f(-1.4426950408889634f * g0[j])); g1[j] = __builtin_amdgcn_rcpf(1.0f + __builtin_amdgcn_exp2f(-1.4426950408889634f * g1[j])); }
                    *(u32x4*)(yp + (size_t)(ai * 128 + m * 16) * 1024 + bj * 128) = pack8(acc[ai][bj][m][0] * g0, acc[ai][bj][m][1] * g1);
                }
            asm volatile("" ::: "memory");
        }
    }
};
struct EpiWo {
    static constexpr bool IDEMPOTENT = false;
    bf16* X; const float* g1;
    __device__ __forceinline__ void operator()(AccRef acc, const Unit& u, int wr, int wc, int fr, int fq) const {
        const int c0 = u.pn * 256 + wc * 32 + 8 * fq, b = (u.pm * 256) >> 11;
        const float* gp = g1 + (size_t)b * 6144 + c0;
        const f32x4 ga0 = *(const f32x4*)gp, gb0 = *(const f32x4*)(gp + 4), ga1 = *(const f32x4*)(gp + 128), gb1 = *(const f32x4*)(gp + 132);
        bf16* xp = X + (size_t)(u.pm * 256 + wr * 64 + fr) * 1024 + c0;
#pragma unroll
        for (int ai = 0; ai < 2; ++ai) {
            u32x4 xv[4][2];
#pragma unroll
            for (int m = 0; m < 4; ++m) { const bf16* p = xp + (size_t)(ai * 128 + m * 16) * 1024; xv[m][0] = *(const u32x4*)p; xv[m][1] = *(const u32x4*)(p + 128); }
#pragma unroll
            for (int m = 0; m < 4; ++m) { bf16* p = xp + (size_t)(ai * 128 + m * 16) * 1024; f32x4 a, d;
                unpack8(xv[m][0], a, d); *(u32x4*)p = pack8(a + ga0 * acc[ai][0][m][0], d + gb0 * acc[ai][0][m][1]);
                unpack8(xv[m][1], a, d); *(u32x4*)(p + 128) = pack8(a + ga1 * acc[ai][1][m][0], d + gb1 * acc[ai][1][m][1]); }
            asm volatile("" ::: "memory");
        }
    }
};
struct EpiGU {
    static constexpr bool IDEMPOTENT = true;
    bf16* ACT; const float* bgu;
    __device__ __forceinline__ void operator()(AccRef acc, const Unit& u, int wr, int wc, int fr, int fq) const {
        const int j0 = u.pn * 128 + wc * 32 + 8 * fq;
        const float* bp = bgu + (size_t)u.e * 2048 + 2 * j0;
        const f32x4 b0 = *(const f32x4*)bp, b1 = *(const f32x4*)(bp + 4), b2 = *(const f32x4*)(bp + 8), b3 = *(const f32x4*)(bp + 12);
        const float bg[8] = {b0[0], b0[2], b1[0], b1[2], b2[0], b2[2], b3[0], b3[2]}, bu[8] = {b0[1], b0[3], b1[1], b1[3], b2[1], b2[3], b3[1], b3[3]};
        bf16* ap = ACT + (size_t)(u.rowbase + wr * 64 + fr) * 1024 + j0;
#pragma unroll
        for (int ai = 0; ai < 2; ++ai)
#pragma unroll
            for (int m = 0; m < 4; ++m) {
                float o[8];
#pragma unroll
                for (int j = 0; j < 8; ++j) {
                    float g = acc[ai][0][m][j >> 2][j & 3] + bg[j], up = acc[ai][1][m][j >> 2][j & 3] + bu[j];
                    g = fminf(g, 7.0f); up = fminf(fmaxf(up, -7.0f), 7.0f);
                    o[j] = (up + 1.0f) * g * __builtin_amdgcn_rcpf(1.0f + __builtin_amdgcn_exp2f(-1.702f * 1.4426950408889634f * g)); }
                u32x4 w; w.x = pk2(o[0], o[1]); w.y = pk2(o[2], o[3]); w.z = pk2(o[4], o[5]); w.w = pk2(o[6], o[7]);
                *(u32x4*)(ap + (size_t)(ai * 128 + m * 16) * 1024) = w;
            }
    }
};
struct EpiDown {
    static constexpr bool IDEMPOTENT = true;
    bf16* YR; const float* bd; const int* list; const float* aw;
    __device__ __forceinline__ void operator()(AccRef acc, const Unit& u, int wr, int wc, int fr, int fq) const {
        const int cb = u.pn * 256 + wc * 32 + 8 * fq;
        const float* bp = bd + (size_t)u.e * 1024 + cb;
        const f32x4 ba0 = *(const f32x4*)bp, bb0 = *(const f32x4*)(bp + 4), ba1 = *(const f32x4*)(bp + 128), bb1 = *(const f32x4*)(bp + 132);
        int a[8]; float w[8];
        const int* lp = list + (size_t)u.e * T + u.pm * 256 + wr * 64 + fr;
#pragma unroll
        for (int q = 0; q < 8; ++q) { const int rl = (q >> 2) * 128 + wr * 64 + (q & 3) * 16 + fr; a[q] = (rl < u.mrows) ? lp[(q >> 2) * 128 + (q & 3) * 16] : -1; }
#pragma unroll
        for (int q = 0; q < 8; ++q) w[q] = (a[q] >= 0) ? aw[a[q]] : 0.f;
#pragma unroll
        for (int q = 0; q < 8; ++q) {
            const int ai = q >> 2, m = q & 3;
            if (a[q] >= 0) { bf16* yp = YR + (size_t)a[q] * 1024 + cb;
                *(u32x4*)yp = pack8((acc[ai][0][m][0] + ba0) * w[q], (acc[ai][0][m][1] + bb0) * w[q]);
                *(u32x4*)(yp + 128) = pack8((acc[ai][1][m][0] + ba1) * w[q], (acc[ai][1][m][1] + bb1) * w[q]); }
        }
    }
};

enum { MAP_ID = 0, MAP_WIN = 1, MAP_WQ = 2, MAP_WKV = 3, MAP_GU = 4 };
__device__ __forceinline__ int map_row(int kind, int n) {
    if (kind == MAP_WIN) { if (n < 2560) return n; if (n < 2944) return NHT + PCQ + (n - 2560); if (n < 3200) return NHT + PCKV + (n - 2944); if (n < 3232) return NHT + PKPE + (n - 3200); return NHT + PGA + (n - 3232); }
    if (kind == MAP_WQ) { const int h = n / 96, j = n - h * 96; if (j < 64) return n; const int r = j - 64, i = r & 15; return h * 96 + 64 + 8 * (i >> 2) + ((r >> 4) << 2) + (i & 3); }
    if (kind == MAP_WKV) { const int h = n >> 7, j = n & 127; return (j < 64) ? (h * 64 + j) : (512 + h * 64 + (j - 64)); }
    if (kind == MAP_GU) { const int j = n >> 1, bj = n & 1; return (j >> 7) * 256 + bj * 128 + (j & 127); }
    return n;
}
__device__ __forceinline__ void conv_item(const float* W, int N, const float* kscale, bf16* WT, int dstK, int koff, int kind, LAS float* scr, int kb, int nb, int lane) {
    const int k0 = 64 * kb, n0 = 32 * nb;
    {
        const int kr = lane >> 3, c4 = (lane & 7) * 4; f32x4 v[8];
#pragma unroll
        for (int i = 0; i < 8; ++i) v[i] = *(const f32x4*)(W + (size_t)(k0 + 8 * i + kr) * N + n0 + c4);
#pragma unroll
        for (int i = 0; i < 8; ++i) { if (kscale) v[i] = v[i] * kscale[k0 + 8 * i + kr]; LAS float* d = scr + (8 * i + kr) * 33 + c4; d[0] = v[i][0]; d[1] = v[i][1]; d[2] = v[i][2]; d[3] = v[i][3]; }
    }
    LDS_WAIT(); asm volatile("" ::: "memory");
    const int c = lane & 7;
#pragma unroll
    for (int j = 0; j < 4; ++j) { const int n = (lane >> 3) + 8 * j; const LAS float* s = scr + (8 * c) * 33 + n;
        u32x4 o; o.x = pk2(s[0 * 33], s[1 * 33]); o.y = pk2(s[2 * 33], s[3 * 33]); o.z = pk2(s[4 * 33], s[5 * 33]); o.w = pk2(s[6 * 33], s[7 * 33]);
        *(u32x4*)(WT + (size_t)map_row(kind, n0 + n) * dstK + koff + k0 + 8 * c) = o; }
    LDS_WAIT(); asm volatile("" ::: "memory");
}
__device__ __forceinline__ void p_prologue(Frame& F) {
    const float* const* in = F.in;
    __syncthreads();
    {
        LAS float* cond = (LAS float*)F.lds;
        LAS float* part = (LAS float*)(F.lds + 32768);
        for (int i = F.tid; i < 8 * 1024; i += 512) { const float v = in[1][i]; cond[i] = v * sigmoidf_(v); }
        __syncthreads();
        for (int it = F.bid; it < DEPTH * 96; it += F.G) {
            const int l = it / 96, n0 = (it % 96) * 64, col = F.tid & 63, kg = F.tid >> 6;
            const float* w = in[3] + (size_t)l * 1024 * 6144 + n0 + col;
            float a[8] = {0.f, 0.f, 0.f, 0.f, 0.f, 0.f, 0.f, 0.f};
            for (int k0 = kg * 128; k0 < kg * 128 + 128; k0 += 16) {
                float wv[16];
#pragma unroll
                for (int q = 0; q < 16; ++q) wv[q] = w[(size_t)(k0 + q) * 6144];
#pragma unroll
                for (int q = 0; q < 16; ++q)
#pragma unroll
                    for (int b = 0; b < 8; ++b) a[b] += cond[b * 1024 + k0 + q] * wv[q]; }
#pragma unroll
            for (int b = 0; b < 8; ++b) part[(kg * 8 + b) * 64 + col] = a[b];
            __syncthreads();
            { const int b = F.tid >> 6; float s = 0.f;
#pragma unroll
              for (int g = 0; g < 8; ++g) s += part[(g * 8 + b) * 64 + col];
              ((float*)(F.ws + WS_MOD))[((size_t)l * 8 + b) * 6144 + n0 + col] = s + in[4][(size_t)l * 6144 + n0 + col]; }
            __syncthreads();
        }
    }
    const int gtid = F.bid * 512 + F.tid, NT_ = F.G * 512;
    for (int i = gtid; i < 1024; i += NT_) {
        float lg[DEPTH], mx = -1e30f; for (int l = 0; l < DEPTH; ++l) { lg[l] = in[8][(size_t)l * 1024 + i]; mx = fmaxf(mx, lg[l]); }
        float s = 0.f; for (int l = 0; l < DEPTH; ++l) { lg[l] = __expf(lg[l] - mx); s += lg[l]; }
        float c = 0.f; float* lb = (float*)(F.ws + WS_LB);
        for (int l = 0; l < DEPTH; ++l) { if (l > 0) c += lg[l] / s; lb[(size_t)l * 1024 + i] = c; }
    }
    for (int i = gtid; i < T * 16; i += NT_) {
        const int t = i >> 4, j = i & 15; const int pos = ((const int*)in[2])[t];
        const double base4[4] = {1.0, 0.5623413251903491, 0.31622776601683794, 0.1778279410038923};
        double f = base4[j & 3]; for (int q = 0; q < (j >> 2); ++q) f *= 0.1;
        const double ang = (double)pos * f; const double n = __builtin_rint(ang * 0.15915494309189535); const float r = (float)(ang - n * 6.283185307179586);
        ((float*)(F.ws + WS_COS))[i] = cosf(r); ((float*)(F.ws + WS_SIN))[i] = sinf(r);
    }
    for (int l = 0; l < DEPTH; ++l) { u32x4* p = (u32x4*)(wl(F.ws, l, WL_IN) + (size_t)5280 * 1024 * 2); for (int i = gtid; i < 96 * 1024 * 2 / 16; i += NT_) p[i] = (u32x4){0u, 0u, 0u, 0u}; }
    {
        LAS float* scr = (LAS float*)(F.lds + F.wave * 16384);
        const int gw = F.bid * NWAVES + F.wave, NGW = F.G * NWAVES;
        constexpr int I_IN = 16 * 165, I_Q = 6 * 24, I_KV = 4 * 32, I_OH = 8 * 32, I_OM = 8 * 32, I_O = 16 * 32, I_GU = 32 * 16 * 64, I_DN = 32 * 16 * 32;
        constexpr int I_LAYER = I_IN + I_Q + I_KV + I_OH + I_OM + I_O + I_GU + I_DN;
        for (int it = gw; it < DEPTH * I_LAYER; it += NGW) {
            const int l = it / I_LAYER; int r = it - l * I_LAYER;
            if (r < I_IN) { conv_item(in[7] + (size_t)l * 1024 * 5280, 5280, nullptr, (bf16*)wl(F.ws, l, WL_IN), 1024, 0, MAP_WIN, scr, r / 165, r % 165, F.lane); continue; } r -= I_IN;
            if (r < I_Q) { conv_item(in[12] + (size_t)l * 384 * 768, 768, in[11] + l * 384, (bf16*)wl(F.ws, l, WL_Q), 384, 0, MAP_WQ, scr, r / 24, r % 24, F.lane); continue; } r -= I_Q;
            if (r < I_KV) { conv_item(in[14] + (size_t)l * 256 * 1024, 1024, in[13] + l * 256, (bf16*)wl(F.ws, l, WL_K), 256, 0, MAP_WKV, scr, r / 32, r % 32, F.lane); continue; } r -= I_KV;
            if (r < I_OH) { conv_item(in[10] + (size_t)l * 512 * 1024, 1024, nullptr, (bf16*)wl(F.ws, l, WL_OUT), 1024, 0, MAP_ID, scr, r / 32, r % 32, F.lane); continue; } r -= I_OH;
            if (r < I_OM) { conv_item(in[15] + (size_t)l * 512 * 1024, 1024, nullptr, (bf16*)wl(F.ws, l, WL_OUT), 1024, 512, MAP_ID, scr, r / 32, r % 32, F.lane); continue; } r -= I_OM;
            if (r < I_O) { conv_item(in[16] + (size_t)l * 1024 * 1024, 1024, nullptr, (bf16*)wl(F.ws, l, WL_O), 1024, 0, MAP_ID, scr, r / 32, r % 32, F.lane); continue; } r -= I_O;
            if (r < I_GU) { const int e = r / (16 * 64), q = r % (16 * 64); conv_item(in[19] + ((size_t)l * 32 + e) * 1024 * 2048, 2048, nullptr, (bf16*)wl(F.ws, l, WL_GU) + (size_t)e * 2048 * 1024, 1024, 0, MAP_GU, scr, q / 64, q % 64, F.lane); continue; } r -= I_GU;
            { const int e = r / (16 * 32), q = r % (16 * 32); conv_item(in[21] + ((size_t)l * 32 + e) * 1024 * 1024, 1024, nullptr, (bf16*)wl(F.ws, l, WL_DN) + (size_t)e * 1024 * 1024, 1024, 0, MAP_ID, scr, q / 32, q % 32, F.lane); }
        }
    }
}

__device__ __forceinline__ void p_norm_mix(Frame& F, int l, bool fin, float* out, bool dummy = false) {
    const float* const* in = F.in;
    bf16* X = (bf16*)(F.ws + (dummy ? WS_ACT : WS_X));
    const float* MOD = (const float*)(F.ws + WS_MOD); const bf16* YR = (const bf16*)(F.ws + WS_YR); bf16* HB = (bf16*)(F.ws + (dummy ? WS_ACT + 64 * MiB : WS_HB));
    const int gw = F.bid * NWAVES + F.wave, NGW = F.G * NWAVES, per_wave = (T + NGW - 1) / NGW;
    f32x4 Gv[4], Sv[4], G2[4]; int bcur = -1;
    for (int q = 0; q < per_wave; ++q) {
        const int t = gw * per_wave + q; if (t >= T) break;
        const int b = t >> 11; f32x4 v[4];
        if (b != bcur) { bcur = b;
            const float* gn = fin ? in[23] : in[5] + (size_t)l * 1024; const float* sh = MOD + ((size_t)(fin ? 0 : l) * 8 + b) * 6144; const float* g2 = MOD + ((size_t)(l > 0 ? l - 1 : 0) * 8 + b) * 6144 + 5 * 1024;
#pragma unroll
            for (int j = 0; j < 4; ++j) { const int d = 4 * F.lane + 256 * j; const f32x4 g = *(const f32x4*)(gn + d);
                Gv[j] = fin ? g : g * (*(const f32x4*)(sh + 1024 + d) + 1.0f); Sv[j] = fin ? (f32x4){0.f, 0.f, 0.f, 0.f} : *(const f32x4*)(sh + d); G2[j] = *(const f32x4*)(g2 + d); } }
        if (l == 0) {
#pragma unroll
            for (int j = 0; j < 4; ++j) v[j] = *(const f32x4*)(in[0] + (size_t)t * 1024 + 4 * F.lane + 256 * j);
        } else {
#pragma unroll
            for (int j = 0; j < 4; ++j) { const u32x2 w = *(const u32x2*)(X + (size_t)t * 1024 + 4 * F.lane + 256 * j); v[j] = (f32x4){bflo(w.x), bfhi(w.x), bflo(w.y), bfhi(w.y)}; }
        }
        if (l > 0) {
#pragma unroll
            for (int j = 0; j < 4; ++j) { f32x4 s = {0.f, 0.f, 0.f, 0.f};
#pragma unroll
                for (int k = 0; k < 4; ++k) { const u32x2 w = *(const u32x2*)(YR + ((size_t)t * 4 + k) * 1024 + 4 * F.lane + 256 * j); s[0] += bflo(w.x); s[1] += bfhi(w.x); s[2] += bflo(w.y); s[3] += bfhi(w.y); }
                v[j] += G2[j] * s; }
        }
        float ss = 0.f;
#pragma unroll
        for (int j = 0; j < 4; ++j) ss += (v[j][0] * v[j][0] + v[j][1] * v[j][1]) + (v[j][2] * v[j][2] + v[j][3] * v[j][3]);
        const float rs = rsqrtf(wave_sum(ss) * (1.0f / 1024.0f) + EPS);
        if (fin) {
#pragma unroll
            for (int j = 0; j < 4; ++j) { const int d = 4 * F.lane + 256 * j; *(f32x4*)(out + (size_t)t * 1024 + d) = v[j] * rs * Gv[j]; }
        } else {
#pragma unroll
            for (int j = 0; j < 4; ++j) { const int d = 4 * F.lane + 256 * j; { u32x2 xw; xw.x = pk2(v[j][0], v[j][1]); xw.y = pk2(v[j][2], v[j][3]); *(u32x2*)(X + (size_t)t * 1024 + d) = xw; }
                const f32x4 h = v[j] * rs * Gv[j] + Sv[j]; u32x2 w; w.x = pk2(h[0], h[1]); w.y = pk2(h[2], h[3]);
                *(u32x2*)(HB + (size_t)t * 1024 + d) = w; }
        }
    }
}
__device__ __forceinline__ void p_mla_prep(Frame& F) {
    const bf16* PROJ = (const bf16*)(F.ws + WS_PROJ); float* RSQ = (float*)(F.ws + WS_RSQ); float* RSKV = (float*)(F.ws + WS_RSKV); bf16* Kb = (bf16*)(F.ws + WS_K);
    const float* CS = (const float*)(F.ws + WS_COS); const float* SN = (const float*)(F.ws + WS_SIN);
    const int gw = F.bid * NWAVES + F.wave, NGW = F.G * NWAVES;
    for (int t = gw; t < T; t += NGW) {
        const bf16* row = PROJ + (size_t)t * NPROJ;
        float sq = 0.f, skv = 0.f;
#pragma unroll
        for (int j = 0; j < 6; ++j) { const float v = bf2f(row[PCQ + F.lane + 64 * j]); sq += v * v; }
#pragma unroll
        for (int j = 0; j < 4; ++j) { const float v = bf2f(row[PCKV + F.lane + 64 * j]); skv += v * v; }
        sq = wave_sum(sq); skv = wave_sum(skv);
        if (F.lane == 0) { RSQ[t] = rsqrtf(sq * (1.0f / 384.0f) + EPS); RSKV[t] = rsqrtf(skv * (1.0f / 256.0f) + EPS); }
        if (F.lane < 16) {
            const float x1 = bf2f(row[PKPE + F.lane]), x2 = bf2f(row[PKPE + 16 + F.lane]), co = CS[(size_t)t * 16 + F.lane], si = SN[(size_t)t * 16 + F.lane];
            const bf16 o1 = (bf16)(pk2(x1 * co - x2 * si, 0.f) & 0xffffu), o2 = (bf16)(pk2(x2 * co + x1 * si, 0.f) & 0xffffu);
            const int b = t >> 11, s = t & 2047;
#pragma unroll
            for (int h = 0; h < 8; ++h) { bf16* kp = Kb + ((size_t)(b * 8 + h) * SEQ + s) * 96; kp[64 + F.lane] = o1; kp[80 + F.lane] = o2; }
        }
    }
}
__device__ __forceinline__ void p_hgrn_post(Frame& F, int l) {
    const bf16* OFp = (const bf16*)(F.ws + WS_OF); const bf16* OBp = (const bf16*)(F.ws + WS_OB); const bf16* PROJ = (const bf16*)(F.ws + WS_PROJ); bf16* HA = (bf16*)(F.ws + WS_HA);
    const float* gn = F.in[9] + (size_t)l * 128;
    const int gw = F.bid * NWAVES + F.wave, NGW = F.G * NWAVES;
    for (int t = gw; t < T; t += NGW) {
        const int c = 8 * F.lane;
        f32x4 a0, a1, b0, b1; unpack8(*(const u32x4*)(OFp + (size_t)t * 512 + c), a0, a1); unpack8(*(const u32x4*)(OBp + (size_t)t * 512 + c), b0, b1); a0 += b0; a1 += b1;
        float ss = (a0[0] * a0[0] + a0[1] * a0[1]) + (a0[2] * a0[2] + a0[3] * a0[3]) + (a1[0] * a1[0] + a1[1] * a1[1]) + (a1[2] * a1[2] + a1[3] * a1[3]);
#pragma unroll
        for (int o = 1; o < 16; o <<= 1) ss += __shfl_xor(ss, o);
        const float rs = rsqrtf(ss * (1.0f / 128.0f) + EPS);
        f32x4 g0, g1; unpack8(*(const u32x4*)(PROJ + (size_t)t * NPROJ + PGT + c), g0, g1);
        const f32x4 n0 = *(const f32x4*)(gn + (c & 127)), n1 = *(const f32x4*)(gn + (c & 127) + 4);
#pragma unroll
        for (int j = 0; j < 4; ++j) { a0[j] = a0[j] * rs * n0[j] * sigmoidf_(g0[j]); a1[j] = a1[j] * rs * n1[j] * sigmoidf_(g1[j]); }
        *(u32x4*)(HA + (size_t)t * 1024 + c) = pack8(a0, a1);
    }
}

#define MFMA16(a, b, c) __builtin_amdgcn_mfma_f32_16x16x32_bf16((a), (b), (c), 0, 0, 0)
constexpr int SC_QROW = 272, SC_TROW = 144;
constexpr int SC_QT = 0, SC_KT = SC_QT + 64 * SC_QROW, SC_KH = SC_KT + 64 * SC_QROW, SC_VT = SC_KH + 128 * SC_TROW, SC_DEC = SC_VT + 128 * SC_TROW, SC_ZERO = SC_DEC + 4 * 128 * 4, SC_END = SC_ZERO + 64;
__device__ __forceinline__ unsigned rot16(unsigned x) { return (x >> 16) | (x << 16); }
constexpr int SC_OX = 73984;
static_assert(SC_OX >= SC_END && SC_OX % 16 == 0 && SC_OX + 32768 <= RING_BYTES, "scan LDS map");
__device__ __forceinline__ void scan_unit2(Frame& F, int l, int u) {
    const int vh = u & 1, dir = (u >> 1) & 1, hh = (u >> 2) & 3, b = u >> 4;
    const bf16* HTb = (const bf16*)(F.ws + WS_HT) + (size_t)b * NHT * SEQ;
    const bf16* qg = HTb + (size_t)(HQ + hh * 128) * SEQ; const bf16* fg = HTb + (size_t)((dir ? HFB : HFF) + hh * 128) * SEQ; const bf16* vg = HTb + (size_t)(HI + hh * 128 + vh * 64) * SEQ;
    bf16* OUT = (bf16*)(F.ws + (dir ? WS_OB : WS_OF));
    LAS unsigned char* lds = F.lds;
    const int d = F.tid & 127, si = F.tid >> 7;
    const float lbv = ((const float*)(F.ws + WS_LB))[((size_t)l * 2 + dir) * 512 + hh * 128 + d];
    const int r = F.lane & 15, g = F.lane >> 4, vt = F.wave & 3, dh = F.wave >> 2;
    const int vcol = hh * 128 + vh * 64 + 16 * vt;
    f32x4 S[4];
#pragma unroll
    for (int i = 0; i < 4; ++i) S[i] = (f32x4){0.f, 0.f, 0.f, 0.f};
    __syncthreads();
    if (F.tid < 16) *(LAS unsigned*)(lds + SC_ZERO + F.tid * 4) = 0u;
    u32x4 pq[2], pf[2], pv;
    const int vrow0 = F.tid >> 3, vmc = F.tid & 7;
    {   const int m0 = dir ? SEQ - 64 : 0; const int mb = dir ? m0 + 48 - 16 * si : m0 + 16 * si;
        pq[0] = *(const u32x4*)(qg + (size_t)d * SEQ + mb); pq[1] = *(const u32x4*)(qg + (size_t)d * SEQ + mb + 8);
        pf[0] = *(const u32x4*)(fg + (size_t)d * SEQ + mb); pf[1] = *(const u32x4*)(fg + (size_t)d * SEQ + mb + 8);
        pv = *(const u32x4*)(vg + (size_t)vrow0 * SEQ + m0 + 8 * vmc); }
    int mprev = 0;
#pragma unroll 1
    for (int c = 0; c <= SEQ / 64; ++c) {
        const bool live = c < SEQ / 64;
        const int m0 = dir ? SEQ - 64 * (c + 1) : 64 * c;
        float qt[16], kt[16], E = 1.0f;
        if (live) {
            float rq[16], rf[16];
#pragma unroll
            for (int j = 0; j < 2; ++j) {
                rq[8 * j + 0] = bflo(pq[j].x); rq[8 * j + 1] = bfhi(pq[j].x); rq[8 * j + 2] = bflo(pq[j].y); rq[8 * j + 3] = bfhi(pq[j].y); rq[8 * j + 4] = bflo(pq[j].z); rq[8 * j + 5] = bfhi(pq[j].z); rq[8 * j + 6] = bflo(pq[j].w); rq[8 * j + 7] = bfhi(pq[j].w);
                rf[8 * j + 0] = bflo(pf[j].x); rf[8 * j + 1] = bfhi(pf[j].x); rf[8 * j + 2] = bflo(pf[j].y); rf[8 * j + 3] = bfhi(pf[j].y); rf[8 * j + 4] = bflo(pf[j].z); rf[8 * j + 5] = bfhi(pf[j].z); rf[8 * j + 6] = bflo(pf[j].w); rf[8 * j + 7] = bfhi(pf[j].w); }
#pragma unroll
            for (int k = 0; k < 16; ++k) {
                const float un = dir ? rf[15 - k] : rf[k], qs = dir ? rq[15 - k] : rq[k];
                const float kk = (1.0f - lbv) * un; E = fmaxf(E * (1.0f - kk), 1e-30f);
                qt[k] = qs * E; kt[k] = kk * __builtin_amdgcn_rcpf(E);
            }
        }
        __syncthreads();
        if (c > 0) {
#pragma unroll
            for (int ii = 0; ii < 2; ++ii) { const int i = 2 * dh + ii;
                const f32x4 a = *(const LAS f32x4*)(lds + SC_OX + (((0 * 4 + vt) * 4 + i) * 64 + F.lane) * 16), bq = *(const LAS f32x4*)(lds + SC_OX + (((1 * 4 + vt) * 4 + i) * 64 + F.lane) * 16);
                const int m = dir ? mprev + 63 - 16 * i - r : mprev + 16 * i + r;
                const f32x4 o = a + bq; u32x2 w; w.x = pk2(o[0], o[1]); w.y = pk2(o[2], o[3]);
                *(u32x2*)(OUT + (size_t)(b * SEQ + m) * 512 + vcol + 4 * g) = w; }
        }
        if (!live) break;
        {   LAS unsigned char* qp = lds + SC_QT + (16 * si) * SC_QROW + d * 2; LAS unsigned char* kp = lds + SC_KT + (16 * si) * SC_QROW + d * 2;
#pragma unroll
            for (int k = 0; k < 16; k += 2) { const unsigned wq = pk2(qt[k], qt[k + 1]), wk = pk2(kt[k], kt[k + 1]);
                *(LAS unsigned short*)(qp + k * SC_QROW) = (unsigned short)wq; *(LAS unsigned short*)(qp + (k + 1) * SC_QROW) = (unsigned short)(wq >> 16);
                *(LAS unsigned short*)(kp + k * SC_QROW) = (unsigned short)wk; *(LAS unsigned short*)(kp + (k + 1) * SC_QROW) = (unsigned short)(wk >> 16); }
            u32x4 h0, h1;
            h0.x = pk2(kt[0] * E, kt[1] * E); h0.y = pk2(kt[2] * E, kt[3] * E); h0.z = pk2(kt[4] * E, kt[5] * E); h0.w = pk2(kt[6] * E, kt[7] * E);
            h1.x = pk2(kt[8] * E, kt[9] * E); h1.y = pk2(kt[10] * E, kt[11] * E); h1.z = pk2(kt[12] * E, kt[13] * E); h1.w = pk2(kt[14] * E, kt[15] * E);
            *(LAS u32x4*)(lds + SC_KH + d * SC_TROW + 32 * si) = h0; *(LAS u32x4*)(lds + SC_KH + d * SC_TROW + 32 * si + 16) = h1;
            *(LAS float*)(lds + SC_DEC + (si * 128 + d) * 4) = E;
            { u32x4 w = pv; int tl0 = 8 * vmc;
              if (dir) { w = (u32x4){rot16(pv.w), rot16(pv.z), rot16(pv.y), rot16(pv.x)}; tl0 = 56 - 8 * vmc; }
              *(LAS u32x4*)(lds + SC_VT + vrow0 * SC_TROW + tl0 * 2) = w; }
        }
        if (c + 1 < SEQ / 64) {
            const int m1 = dir ? SEQ - 64 * (c + 2) : 64 * (c + 1); const int mb = dir ? m1 + 48 - 16 * si : m1 + 16 * si;
            pq[0] = *(const u32x4*)(qg + (size_t)d * SEQ + mb); pq[1] = *(const u32x4*)(qg + (size_t)d * SEQ + mb + 8);
            pf[0] = *(const u32x4*)(fg + (size_t)d * SEQ + mb); pf[1] = *(const u32x4*)(fg + (size_t)d * SEQ + mb + 8);
            pv = *(const u32x4*)(vg + (size_t)vrow0 * SEQ + m1 + 8 * vmc);
        }
        mprev = m0;
        __syncthreads();
        f32x4 oI[2];
#pragma unroll
        for (int ii = 0; ii < 2; ++ii) {
            const int i = 2 * dh + ii;
            const LAS unsigned char* qrow = lds + SC_QT + (16 * i + r) * SC_QROW; const LAS unsigned char* krow = lds + SC_KT + (16 * i + r) * SC_QROW;
            f32x4 pT = {0.f, 0.f, 0.f, 0.f};
#pragma unroll
            for (int ks = 0; ks < 4; ++ks) pT = MFMA16(*(const LAS bf16x8*)(krow + (32 * ks + 8 * g) * 2), *(const LAS bf16x8*)(qrow + (32 * ks + 8 * g) * 2), pT);
#pragma unroll
            for (int q = 0; q < 4; ++q) pT[q] = (4 * g + q <= r) ? pT[q] : 0.0f;
            const bf16x8 pfrag = __builtin_bit_cast(bf16x8, ((u32x4){pk2(pT[0], pT[1]), pk2(pT[2], pT[3]), 0u, 0u}));
            const u32x2 vt4 = *(const LAS u32x2*)(lds + SC_VT + (16 * vt + r) * SC_TROW + (16 * i + 4 * g) * 2);
            oI[ii] = MFMA16(__builtin_bit_cast(bf16x8, ((u32x4){vt4.x, vt4.y, 0u, 0u})), pfrag, ((f32x4){0.f, 0.f, 0.f, 0.f}));
        }
        const bool zl = (g >= 2);
#pragma unroll
        for (int i = 0; i < 4; ++i) {
            const LAS unsigned char* qrow = lds + SC_QT + (16 * i + r) * SC_QROW + (64 * dh) * 2;
            f32x4 o = ((i >> 1) == dh) ? oI[i & 1] : (f32x4){0.f, 0.f, 0.f, 0.f};
#pragma unroll
            for (int kk = 0; kk < 2; ++kk) {
                const bf16x8 sfrag = __builtin_bit_cast(bf16x8, ((u32x4){pk2(S[2 * kk][0], S[2 * kk][1]), pk2(S[2 * kk][2], S[2 * kk][3]), pk2(S[2 * kk + 1][0], S[2 * kk + 1][1]), pk2(S[2 * kk + 1][2], S[2 * kk + 1][3])}));
                const u32x2 qa = *(const LAS u32x2*)(qrow + (32 * kk + 4 * g) * 2), qb = *(const LAS u32x2*)(qrow + (32 * kk + 16 + 4 * g) * 2);
                o = MFMA16(sfrag, __builtin_bit_cast(bf16x8, ((u32x4){qa.x, qa.y, qb.x, qb.y})), o);
            }
            *(LAS f32x4*)(lds + SC_OX + (((dh * 4 + vt) * 4 + i) * 64 + F.lane) * 16) = o;
            const LAS unsigned char* vtp = zl ? lds + SC_ZERO : lds + SC_VT + (16 * vt + r) * SC_TROW + (16 * i + 8 * g) * 2;
            const bf16x8 vfrag = *(const LAS bf16x8*)vtp;
#pragma unroll
            for (int dt = 0; dt < 4; ++dt) {
                const f32x4 dec = *(const LAS f32x4*)(lds + SC_DEC + (i * 128 + 64 * dh + 16 * dt + 4 * g) * 4);
                const LAS unsigned char* khp = zl ? lds + SC_ZERO : lds + SC_KH + (64 * dh + 16 * dt + r) * SC_TROW + (16 * i + 8 * g) * 2;
                S[dt] = MFMA16(*(const LAS bf16x8*)khp, vfrag, S[dt] * dec);
            }
        }
    }
    __syncthreads();
}

#define MFMA32(a, b, c) __builtin_amdgcn_mfma_f32_32x32x16_bf16((a), (b), (c), 0, 0, 0)
constexpr int AT_KROW = 208, AT_VROW = 136, AT_KBYTES = 64 * AT_KROW, AT_BUF = AT_KBYTES + 64 * AT_VROW;
__device__ __forceinline__ void attn_unit(Frame& F, int bh, int q0) {
    const GAS bf16* Q = (const GAS bf16*)(F.ws + WS_Q); const GAS char* Kg = (const GAS char*)(F.ws + WS_K) + (size_t)bh * SEQ * 96 * 2; const GAS char* Vg = (const GAS char*)(F.ws + WS_VT) + (size_t)bh * 64 * SEQ * 2;
    GAS bf16* HA = (GAS bf16*)(F.ws + WS_HA);
    LAS unsigned char* lds = F.lds;
    const int r = F.lane & 31, h = F.lane >> 5;
    bf16x8 qf[6];
    { const GAS bf16* qrow = Q + ((size_t)bh * SEQ + q0 + F.wave * 32 + r) * 96;
#pragma unroll
      for (int ks = 0; ks < 6; ++ks) qf[ks] = *(const GAS bf16x8*)(qrow + 16 * ks + 8 * h); }
    f32x16 o0, o1;
#pragma unroll
    for (int i = 0; i < 16; ++i) { o0[i] = 0.f; o1[i] = 0.f; }
    float mref = 0.f, lsum = 0.f;
    const int kc0 = F.tid, kc1 = F.tid + 512; const bool has1 = F.tid < 256;
    const int kl0 = (kc0 / 12) * AT_KROW + (kc0 % 12) * 16, kl1 = (kc1 / 12) * AT_KROW + (kc1 % 12) * 16;
    const int vrow = F.tid >> 3, vpc = F.tid & 7; const int vl = AT_KBYTES + vrow * AT_VROW + vpc * 16;
    u32x4 rk0, rk1 = {0u, 0u, 0u, 0u}, rv;
    __syncthreads();
    rk0 = *(const GAS u32x4*)(Kg + (size_t)kc0 * 16); if (has1) rk1 = *(const GAS u32x4*)(Kg + (size_t)kc1 * 16);
    rv = *(const GAS u32x4*)(Vg + (size_t)vrow * SEQ * 2 + vpc * 16);
    *(LAS u32x4*)(lds + kl0) = rk0; if (has1) *(LAS u32x4*)(lds + kl1) = rk1;
    *(LAS u32x2*)(lds + vl) = (u32x2){rv.x, rv.y}; *(LAS u32x2*)(lds + vl + 8) = (u32x2){rv.z, rv.w};
    __syncthreads();
    for (int j = 0; j < SEQ / 64; ++j) {
        const int buf = (j & 1) * AT_BUF, nbuf = ((j + 1) & 1) * AT_BUF;
        if (j + 1 < SEQ / 64) {
            const GAS char* kg = Kg + (size_t)(j + 1) * 64 * 96 * 2;
            rk0 = *(const GAS u32x4*)(kg + (size_t)kc0 * 16); if (has1) rk1 = *(const GAS u32x4*)(kg + (size_t)kc1 * 16);
            rv = *(const GAS u32x4*)(Vg + (size_t)vrow * SEQ * 2 + (size_t)(j + 1) * 128 + vpc * 16);
        }
        f32x16 s0, s1;
#pragma unroll
        for (int i = 0; i < 16; ++i) { s0[i] = -mref; s1[i] = -mref; }
#pragma unroll
        for (int ks = 0; ks < 6; ++ks) {
            const bf16x8 k0 = *(const LAS bf16x8*)(lds + buf + r * AT_KROW + (16 * ks + 8 * h) * 2);
            const bf16x8 k1 = *(const LAS bf16x8*)(lds + buf + (32 + r) * AT_KROW + (16 * ks + 8 * h) * 2);
            s0 = MFMA32(k0, qf[ks], s0); s1 = MFMA32(k1, qf[ks], s1);
        }
        float mx = s0[0];
#pragma unroll
        for (int i = 1; i < 16; ++i) mx = fmaxf(mx, s0[i]);
#pragma unroll
        for (int i = 0; i < 16; ++i) mx = fmaxf(mx, s1[i]);
        mx = fmaxf(mx, __shfl_xor(mx, 32));
        const bool grow = (j == 0) || (mx > 8.0f);
        if (__builtin_amdgcn_ballot_w64(grow) != 0ull) {
            const float dlt = grow ? mx : 0.0f, fsc = __builtin_amdgcn_exp2f(-dlt); mref += dlt; lsum *= fsc;
#pragma unroll
            for (int i = 0; i < 16; ++i) { s0[i] -= dlt; s1[i] -= dlt; o0[i] *= fsc; o1[i] *= fsc; } }
        float ps = 0.f;
#pragma unroll
        for (int i = 0; i < 16; ++i) { s0[i] = __builtin_amdgcn_exp2f(s0[i]); s1[i] = __builtin_amdgcn_exp2f(s1[i]); ps += s0[i] + s1[i]; }
        lsum += ps;
        bf16x8 pf[2][2];
#pragma unroll
        for (int sp = 0; sp < 2; ++sp) {
            u32x4 w0, w1;
            w0.x = pk2(s0[8 * sp + 0], s0[8 * sp + 1]); w0.y = pk2(s0[8 * sp + 2], s0[8 * sp + 3]); w0.z = pk2(s0[8 * sp + 4], s0[8 * sp + 5]); w0.w = pk2(s0[8 * sp + 6], s0[8 * sp + 7]);
            w1.x = pk2(s1[8 * sp + 0], s1[8 * sp + 1]); w1.y = pk2(s1[8 * sp + 2], s1[8 * sp + 3]); w1.z = pk2(s1[8 * sp + 4], s1[8 * sp + 5]); w1.w = pk2(s1[8 * sp + 6], s1[8 * sp + 7]);
            pf[0][sp] = __builtin_bit_cast(bf16x8, w0); pf[1][sp] = __builtin_bit_cast(bf16x8, w1);
        }
#pragma unroll
        for (int kb = 0; kb < 2; ++kb)
#pragma unroll
            for (int sp = 0; sp < 2; ++sp) {
                const int kbase = (32 * kb + 16 * sp + 4 * h) * 2;
                const LAS unsigned char* v0p = lds + buf + AT_KBYTES + r * AT_VROW + kbase;
                const LAS unsigned char* v1p = lds + buf + AT_KBYTES + (32 + r) * AT_VROW + kbase;
                const u32x2 a0 = *(const LAS u32x2*)v0p, a1 = *(const LAS u32x2*)(v0p + 16), c0 = *(const LAS u32x2*)v1p, c1 = *(const LAS u32x2*)(v1p + 16);
                const bf16x8 vf0 = __builtin_bit_cast(bf16x8, ((u32x4){a0.x, a0.y, a1.x, a1.y})), vf1 = __builtin_bit_cast(bf16x8, ((u32x4){c0.x, c0.y, c1.x, c1.y}));
                o0 = MFMA32(vf0, pf[kb][sp], o0); o1 = MFMA32(vf1, pf[kb][sp], o1);
            }
        if (j + 1 < SEQ / 64) {
            *(LAS u32x4*)(lds + nbuf + kl0) = rk0; if (has1) *(LAS u32x4*)(lds + nbuf + kl1) = rk1;
            *(LAS u32x2*)(lds + nbuf + vl) = (u32x2){rv.x, rv.y}; *(LAS u32x2*)(lds + nbuf + vl + 8) = (u32x2){rv.z, rv.w};
        }
        __syncthreads();
    }
    lsum += __shfl_xor(lsum, 32);
    const float inv = 1.0f / lsum;
    const int head = bh & 7, b = bh >> 3;
    GAS bf16* orow = HA + (size_t)(b * SEQ + q0 + F.wave * 32 + r) * 1024 + 512 + head * 64;
#pragma unroll
    for (int i = 0; i < 4; ++i) {
        u32x2 w0, w1;
        w0.x = pk2(o0[4 * i] * inv, o0[4 * i + 1] * inv); w0.y = pk2(o0[4 * i + 2] * inv, o0[4 * i + 3] * inv);
        w1.x = pk2(o1[4 * i] * inv, o1[4 * i + 1] * inv); w1.y = pk2(o1[4 * i + 2] * inv, o1[4 * i + 3] * inv);
        *(GAS u32x2*)(orow + 8 * i + 4 * h) = w0; *(GAS u32x2*)(orow + 32 + 8 * i + 4 * h) = w1;
    }
}

__device__ __forceinline__ void p_router(Frame& F, int l, bool dummy = false) {
    const float* const* in = F.in;
    const bf16* X = (const bf16*)(F.ws + WS_X); const float* MOD = (const float*)(F.ws + WS_MOD); bf16* HB = (bf16*)(F.ws + WS_HB);
    int* LIST = (int*)(F.ws + (dummy ? WS_Y : WS_LIST)); float* AW = (float*)(F.ws + (dummy ? WS_Y + 4 * MiB : WS_AW)); unsigned* CNT = (unsigned*)(F.ws + WS_CTL) + CW_CNT + (l + (dummy ? 4 : 0)) * 32 * 64;
    LAS unsigned char* lds = F.lds;
    __syncthreads();
    { const float* wr = in[17] + (size_t)l * 1024 * 32;
      for (int q = F.tid; q < 8192; q += 512) { const int k = q >> 3; *(LAS f32x4*)(lds + (size_t)(q + (k >> 2)) * 16) = *(const f32x4*)(wr + (size_t)q * 4); } }
    const float* gn = in[6] + (size_t)l * 1024; const float* br = in[18] + (size_t)l * 32;
    const int gw = F.bid * NWAVES + F.wave, NGW = F.G * NWAVES;
    const int wgb = ((F.bid * NWAVES) * ((T + NGW - 1) / NGW) < T ? (F.bid * NWAVES) * ((T + NGW - 1) / NGW) : T - 1) >> 11;
    { const float* sh = MOD + ((size_t)l * 8 + wgb) * 6144 + 3 * 1024;
      for (int d = F.tid; d < 1024; d += 512) { *(LAS float*)(lds + RT_G_OFF + d * 4) = gn[d] * (sh[1024 + d] + 1.0f); *(LAS float*)(lds + RT_S_OFF + d * 4) = sh[d]; } }
    __syncthreads();
    LAS unsigned* lcnt = (LAS unsigned*)(lds + MOE_OFF + 512); LAS unsigned* lbase = lcnt + 32;
    const int per_wave = (T + NGW - 1) / NGW;
    for (int b0 = 0; b0 < per_wave; b0 += 16) {
    int pend_e = 0, pend_a = 0, npend = 0; float pend_w = 0.f;
    u32x2 xn[4];
    {   const int t0 = gw * per_wave + b0; const int tc = t0 < T ? t0 : T - 1;
#pragma unroll
        for (int j = 0; j < 4; ++j) xn[j] = *(const u32x2*)(X + (size_t)tc * 1024 + 4 * F.lane + 256 * j); }
    for (int q_ = 0; q_ < 16; ++q_) {
        const int t = gw * per_wave + b0 + q_; if (b0 + q_ >= per_wave || t >= T) break;
        const int b = t >> 11; f32x4 v[4]; float ss = 0.f;
#pragma unroll
        for (int j = 0; j < 4; ++j) { const u32x2 xw = xn[j]; v[j] = (f32x4){bflo(xw.x), bfhi(xw.x), bflo(xw.y), bfhi(xw.y)}; ss += (v[j][0] * v[j][0] + v[j][1] * v[j][1]) + (v[j][2] * v[j][2] + v[j][3] * v[j][3]); }
        {   const int tn = (t + 1 < T) ? t + 1 : t;
#pragma unroll
            for (int j = 0; j < 4; ++j) xn[j] = *(const u32x2*)(X + (size_t)tn * 1024 + 4 * F.lane + 256 * j); }
        const float rs = rsqrtf(wave_sum(ss) * (1.0f / 1024.0f) + EPS);
#pragma unroll
        for (int j = 0; j < 4; ++j) { const int d = 4 * F.lane + 256 * j; f32x4 Gv, Sv;
            if (b == wgb) { Gv = *(const LAS f32x4*)(lds + RT_G_OFF + d * 4); Sv = *(const LAS f32x4*)(lds + RT_S_OFF + d * 4); }
            else { const float* sh = MOD + ((size_t)l * 8 + b) * 6144 + 3 * 1024; Gv = *(const f32x4*)(gn + d) * (*(const f32x4*)(sh + 1024 + d) + 1.0f); Sv = *(const f32x4*)(sh + d); }
            v[j] = v[j] * rs * Gv + Sv; u32x2 w; w.x = pk2(v[j][0], v[j][1]); w.y = pk2(v[j][2], v[j][3]);
            *(u32x2*)(HB + (size_t)t * 1024 + d) = w; }
        float p[32];
#pragma unroll
        for (int e = 0; e < 32; ++e) p[e] = 0.f;
#define RT_WP(q) (lds + (size_t)((4 * F.lane + 256 * ((q) >> 2) + ((q) & 3)) * 8 + F.lane + 64 * ((q) >> 2)) * 16)
#define RT_LOAD(dst, q) do { const LAS unsigned char* wp_ = RT_WP(q); _Pragma("unroll") for (int c = 0; c < 8; ++c) dst[c] = *(const LAS f32x4*)(wp_ + c * 16); } while (0)
#define RT_FMA(src, q) do { const float hv_ = v[(q) >> 2][(q) & 3]; _Pragma("unroll") for (int c = 0; c < 8; ++c) { p[4 * c] += hv_ * src[c][0]; p[4 * c + 1] += hv_ * src[c][1]; p[4 * c + 2] += hv_ * src[c][2]; p[4 * c + 3] += hv_ * src[c][3]; } } while (0)
        {   f32x4 wa[8], wb[8];
            RT_LOAD(wa, 0);
#pragma unroll
            for (int q = 0; q < 16; q += 2) {
                RT_LOAD(wb, q + 1); __builtin_amdgcn_sched_barrier(0); RT_FMA(wa, q); __builtin_amdgcn_sched_barrier(0);
                if (q + 2 < 16) RT_LOAD(wa, q + 2);
                __builtin_amdgcn_sched_barrier(0); RT_FMA(wb, q + 1); __builtin_amdgcn_sched_barrier(0);
            }
        }
#undef RT_WP
#undef RT_LOAD
#undef RT_FMA
#pragma unroll
        for (int e = 0; e < 16; ++e) { const bool up = (F.lane & 32) != 0; const float keep = up ? p[e + 16] : p[e], send = up ? p[e] : p[e + 16]; p[e] = keep + __shfl_xor(send, 32); }
#pragma unroll
        for (int e = 0; e < 8; ++e) { const bool up = (F.lane & 16) != 0; const float keep = up ? p[e + 8] : p[e], send = up ? p[e] : p[e + 8]; p[e] = keep + __shfl_xor(send, 16); }
#pragma unroll
        for (int e = 0; e < 4; ++e) { const bool up = (F.lane & 8) != 0; const float keep = up ? p[e + 4] : p[e], send = up ? p[e] : p[e + 4]; p[e] = keep + __shfl_xor(send, 8); }
#pragma unroll
        for (int e = 0; e < 2; ++e) { const bool up = (F.lane & 4) != 0; const float keep = up ? p[e + 2] : p[e], send = up ? p[e] : p[e + 2]; p[e] = keep + __shfl_xor(send, 4); }
        { const bool up = (F.lane & 2) != 0; const float keep = up ? p[1] : p[0], send = up ? p[0] : p[1]; p[0] = keep + __shfl_xor(send, 2); }
        float logit = p[0] + __shfl_xor(p[0], 1);
        const int myE = F.lane >> 1; logit += br[myE];
        int rank = 0;
#pragma unroll
        for (int r = 1; r < 32; ++r) { const int oe = (myE + r) & 31; const float ov = __shfl(logit, 2 * oe + (F.lane & 1)); rank += (ov > logit || (ov == logit && oe < myE)) ? 1 : 0; }
        float tv[4]; int te[4];
#pragma unroll
        for (int k = 0; k < 4; ++k) { const unsigned long long mk = __builtin_amdgcn_ballot_w64(rank == k); const int src = __builtin_ctzll(mk); tv[k] = __builtin_bit_cast(float, __builtin_amdgcn_readlane(__builtin_bit_cast(int, logit), src)); te[k] = src >> 1; }
        const float e1 = __expf(tv[1] - tv[0]), e2 = __expf(tv[2] - tv[0]), e3 = __expf(tv[3] - tv[0]); const float invs = 1.0f / (1.0f + e1 + e2 + e3);
        {   const int k = F.lane & 3;
            const int ek = k == 0 ? te[0] : k == 1 ? te[1] : k == 2 ? te[2] : te[3];
            const float wk = (k == 0 ? 1.0f : k == 1 ? e1 : k == 2 ? e2 : e3) * invs;
            if ((F.lane >> 2) == npend) { pend_e = ek; pend_w = wk; pend_a = t * 4 + k; }
            ++npend; }
    }
    __syncthreads();
    if (F.tid < 32) lcnt[F.tid] = 0u;
    __syncthreads();
    unsigned lslot = 0u; const bool have = (F.lane >> 2) < npend;
    if (have) lslot = __hip_atomic_fetch_add(lcnt + pend_e, 1u, __ATOMIC_RELAXED, __HIP_MEMORY_SCOPE_WORKGROUP);
    __syncthreads();
    if (F.tid < 32) { const unsigned c = lcnt[F.tid]; lbase[F.tid] = c ? __hip_atomic_fetch_add(CNT + F.tid * 64, c, __ATOMIC_RELAXED, __HIP_MEMORY_SCOPE_AGENT) : 0u; }
    __syncthreads();
    if (have) { const unsigned slot = lbase[pend_e] + lslot; LIST[(size_t)pend_e * T + slot] = pend_a; AW[pend_a] = pend_w; }
    }
    __syncthreads();
}
__device__ __forceinline__ void moe_tables(Frame& F, int l) {
    LAS int* cnt = (LAS int*)(F.lds + MOE_OFF); LAS int* toff = cnt + 32;
    const unsigned* CNT = (const unsigned*)(F.ws + WS_CTL) + CW_CNT + l * 32 * 64;
    __syncthreads();
    if (F.tid < 32) cnt[F.tid] = (int)__hip_atomic_load(CNT + F.tid * 64, __ATOMIC_RELAXED, __HIP_MEMORY_SCOPE_AGENT);
    __syncthreads();
    if (F.tid == 0) { int s = 0; for (int e = 0; e < 32; ++e) { toff[e] = s; s += (cnt[e] + 255) >> 8; } toff[32] = s; }
    __syncthreads();
}

constexpr int NPH = 11, PH_FINAL = 1 + DEPTH * NPH, PH_TOTAL = PH_FINAL + 1;
__global__ void __launch_bounds__(NWAVES * 64, 2) fwd_kernel(Args args) {
    extern __shared__ __attribute__((aligned(16))) unsigned char lds_raw[];
    Frame F;
    F.lds = (LAS unsigned char*)lds_raw; F.ws = args.ws; F.tid = threadIdx.x; F.lane = F.tid & 63; F.wave = __builtin_amdgcn_readfirstlane(F.tid >> 6); F.G = gridDim.x; F.bid = blockIdx.x; F.in = args.in;
    for (int u = F.tid; u < (LDS_BYTES - LDSCTL_OFF) / 4; u += NWAVES * 64) ((LAS unsigned*)(F.lds + LDSCTL_OFF))[u] = 0u;
    __syncthreads();
    const int lo = args.ph_lo, hi = args.ph_hi;
    const unsigned long long tk0_ = (TIME_KIND == 98) ? __builtin_amdgcn_s_memrealtime() : 0ull;
    XcdBarrier bar; bar.bar = (unsigned*)(F.ws + WS_CTL) + CW_BAR; bar.x = 0; bar.st = nullptr;
    if (hi - lo > 1) bar = xcd_barrier_post((unsigned*)(F.ws + WS_CTL) + CW_BAR, (volatile LAS unsigned*)(F.lds + MISC_OFF) + 8);
#define IN(k) (lo <= (k) && (k) < hi)
#define PROJ ((bf16*)(ws + WS_PROJ))
#define SEAM(k) do { if (IN(k) && IN((k) + 1)) xcd_barrier(bar); } while (0)
#define TSTART(kind) unsigned long long t0_ = (TIME_KIND == (kind) || TIME_KIND == 99) ? __builtin_amdgcn_s_memrealtime() : 0ull
#define TSTALL(kind) do { if (TIME_KIND == (kind) || TIME_KIND == 99) { const unsigned long long t1_ = __builtin_amdgcn_s_memrealtime(); const unsigned long long dt_ = t1_ - t0_; while (__builtin_amdgcn_s_memrealtime() - t1_ < dt_) __builtin_amdgcn_s_sleep(8); } } while (0)
    unsigned char* ws = F.ws;
#define PHASE_ENTER() do { unsigned char* w_ = args.ws; asm volatile("" : "+s"(w_)); F.ws = w_; ws = w_; int t_ = threadIdx.x; asm volatile("" : "+v"(t_)); F.tid = t_; F.lane = t_ & 63; F.wave = __builtin_amdgcn_readfirstlane(t_ >> 6); } while (0)
    if (EN(0) && IN(0)) { PHASE_ENTER(); TSTART(0); REPS(0) { p_prologue(F); } SEAM(0); TSTALL(0); }
    for (int l = 0; l < DEPTH; ++l) {
        const int pb = 1 + l * NPH;
        if (EN(1) && IN(pb + 0)) { PHASE_ENTER(); TSTART(1); if (REP_KIND == 1) p_norm_mix(F, l, false, nullptr, true); p_norm_mix(F, l, false, nullptr); SEAM(pb + 0); TSTALL(1); }
        if (EN(2) && IN(pb + 1)) { PHASE_ENTER(); TSTART(2);
            REPS(2) {
            { pg8::DenseOrder S; S.init(T, NPROJ, F.G, F.bid, ws + WS_HB, 1024, (bf16*)wl(ws, l, WL_IN) + (size_t)NHT * 1024, 1024);
              EpiProj E{PROJ};
              pg8::gemm_phase(F.lds, 1024, S, E); }
            { int z = 0; asm volatile("" : "+s"(z)); pg8::DenseOrder S; S.init(NHT, T, F.G, (F.bid + 64 + z) % F.G, wl(ws, l, WL_IN) + z, 1024, ws + WS_HB + z, 1024);
              EpiHT E{(bf16*)(ws + WS_HT)};
              pg8::gemm_phase(F.lds, 1024, S, E); }
            }
            SEAM(pb + 1); TSTALL(2);
        }
        if (EN(3) && IN(pb + 2)) { PHASE_ENTER(); TSTART(3); REPS(3) { p_mla_prep(F); } SEAM(pb + 2); TSTALL(3); }
        if (EN(4) && IN(pb + 3)) { PHASE_ENTER(); TSTART(4);
#ifndef SUBMASK
#define SUBMASK 7
#endif
            REPS(4) {
            if (SUBMASK & 1) { pg8::DenseOrder S; S.init(T, 768, F.G, F.bid, PROJ + PCQ, NPROJ, wl(ws, l, WL_Q), 384);
              EpiQ E{(bf16*)(ws + WS_Q), (const float*)(ws + WS_RSQ), (const float*)(ws + WS_COS), (const float*)(ws + WS_SIN)};
              pg8::gemm_phase(F.lds, 384, S, E); }
            if (SUBMASK & 2) { int z = 0; asm volatile("" : "+s"(z)); pg8::DenseOrder S; S.init(T, 512, F.G, (F.bid + 64 + z) % F.G, PROJ + PCKV + z, NPROJ, wl(ws, l, WL_K) + z, 256);
              EpiK E{(bf16*)(ws + WS_K), (const float*)(ws + WS_RSKV)};
              pg8::gemm_phase(F.lds, 256, S, E); }
            if (SUBMASK & 4) { int z = 0; asm volatile("" : "+s"(z)); pg8::DenseOrder S; S.init(512, T, F.G, (F.bid + 192 + z) % F.G, wl(ws, l, WL_V) + z, 256, PROJ + PCKV + z, NPROJ);
              EpiV E{(bf16*)(ws + WS_VT), (const float*)(ws + WS_RSKV)};
              pg8::gemm_phase(F.lds, 256, S, E); }
            }
            SEAM(pb + 3); TSTALL(4);
        }
        if (EN(5) && IN(pb + 4)) { PHASE_ENTER(); TSTART(5);
            REPS(5) {
            if (rep_ == 0 || (REP_SUB & 1)) for (int u = F.bid; u < 128 * SCAN_REP; u += F.G) scan_unit2(F, l, u & 127);
            if (rep_ == 0 || (REP_SUB & 2)) {
                unsigned* qctr = (unsigned*)(ws + WS_CTL) + CW_Q + (l * 2 + rep_) * 64; volatile LAS unsigned* misc = (volatile LAS unsigned*)(F.lds + MISC_OFF);
                for (;;) { __syncthreads(); if (F.tid == 0) misc[0] = __hip_atomic_fetch_add(qctr, 1u, __ATOMIC_RELAXED, __HIP_MEMORY_SCOPE_AGENT); __syncthreads();
                    const int a = (int)misc[0]; if (a >= 512 * ATTN_REP) break; attn_unit(F, (a & 511) >> 3, (a & 7) * 256); }
            }
            }
            SEAM(pb + 4); TSTALL(5);
        }
        if (EN(6) && IN(pb + 5)) { PHASE_ENTER(); TSTART(6); REPS(6) { p_hgrn_post(F, l); } SEAM(pb + 5); TSTALL(6); }
        if (EN(7) && IN(pb + 6)) { PHASE_ENTER(); TSTART(7);
            REPS(7) {
            { pg8::DenseOrder S; S.init(T, 1024, F.G, F.bid, ws + WS_HA, 1024, wl(ws, l, WL_OUT), 1024);
              EpiOut E{(bf16*)(ws + WS_Y), PROJ};
              pg8::gemm_phase(F.lds, 1024, S, E); }
            }
            SEAM(pb + 6); TSTALL(7);
        }
        if (EN(8) && IN(pb + 7)) { PHASE_ENTER(); TSTART(8);
            pg8::DenseOrder S; S.init(T, 1024, F.G, F.bid, ws + WS_Y, 1024, wl(ws, l, WL_O), 1024);
            if (REP_KIND == 8) { EpiWo E2{(bf16*)(ws + WS_ACT), (const float*)(ws + WS_MOD) + (size_t)l * 8 * 6144 + 2 * 1024}; pg8::gemm_phase(F.lds, 1024, S, E2); }
            EpiWo E{(bf16*)(ws + WS_X), (const float*)(ws + WS_MOD) + (size_t)l * 8 * 6144 + 2 * 1024};
            pg8::gemm_phase(F.lds, 1024, S, E);
            if (REP_KIND == 13) { for (int q = 0; q < 10; ++q) xcd_barrier(bar); }
            SEAM(pb + 7); TSTALL(8);
        }
        if (EN(9) && IN(pb + 8)) { PHASE_ENTER(); TSTART(9); if (REP_KIND == 9) p_router(F, l, true); p_router(F, l); SEAM(pb + 8); TSTALL(9); }
        if (EN(10) && IN(pb + 9)) { PHASE_ENTER(); TSTART(10);
            moe_tables(F, l);
            pg8::MoeOrder<true> S; S.cnt = (const LAS int*)(F.lds + MOE_OFF); S.toff = S.cnt + 32; S.NT = 8; S.G = F.G; S.c = F.bid; S.Abase = (const char*)(ws + WS_HB); S.Bbase = (const char*)wl(ws, l, WL_GU);
            S.b_expert_bytes = (size_t)2048 * 1024 * 2; S.list = (const int*)(ws + WS_LIST); S.lda = 1024; S.ldb = 1024;
            EpiGU E{(bf16*)(ws + WS_ACT), F.in[20] + (size_t)l * 32 * 2048};
            REPS(10) { pg8::gemm_phase(F.lds, 1024, S, E); }
            SEAM(pb + 9); TSTALL(10);
        }
        if (EN(11) && IN(pb + 10)) { PHASE_ENTER(); TSTART(11);
            moe_tables(F, l);
            pg8::MoeOrder<false> S; S.cnt = (const LAS int*)(F.lds + MOE_OFF); S.toff = S.cnt + 32; S.NT = 4; S.G = F.G; S.c = F.bid; S.Abase = (const char*)(ws + WS_ACT); S.Bbase = (const char*)wl(ws, l, WL_DN);
            S.b_expert_bytes = (size_t)1024 * 1024 * 2; S.list = (const int*)(ws + WS_LIST); S.lda = 1024; S.ldb = 1024;
            EpiDown E{(bf16*)(ws + WS_YR), F.in[22] + (size_t)l * 32 * 1024, (const int*)(ws + WS_LIST), (const float*)(ws + WS_AW)};
            REPS(11) { pg8::gemm_phase(F.lds, 1024, S, E); }
            SEAM(pb + 10); TSTALL(11);
        }
    }
    if (EN(12) && IN(PH_FINAL)) { PHASE_ENTER(); p_norm_mix(F, DEPTH, true, args.out); }
    if (TIME_KIND == 98 && F.bid == 0) { const unsigned long long t1_ = __builtin_amdgcn_s_memrealtime(); const unsigned long long dt_ = t1_ - tk0_; while (__builtin_amdgcn_s_memrealtime() - t1_ < dt_) __builtin_amdgcn_s_sleep(8); }
#undef IN
#undef SEAM
#undef PROJ
#undef PHASE_ENTER
}

extern "C" void kernel_launch(void* const* d_in, const int* in_sizes, int n_in, void* d_out, int out_size, void* d_ws, size_t ws_size, hipStream_t stream) {
    static int grid = 0;
    if (grid == 0) {
        if (n_in != 24 || in_sizes[0] != T * D || out_size != T * D || ws_size < WS_END) { fprintf(stderr, "kernel_launch: unexpected problem (n_in %d, in0 %d, out %d, ws %zu, need %zu)\n", n_in, n_in > 0 ? in_sizes[0] : -1, out_size, ws_size, (size_t)WS_END); grid = -1; return; }
        int dev = 0, cus = 0, per_cu = 0;
        if (hipGetDevice(&dev) != hipSuccess || hipDeviceGetAttribute(&cus, hipDeviceAttributeMultiprocessorCount, dev) != hipSuccess) { grid = -1; return; }
        if (hipFuncSetAttribute((const void*)fwd_kernel, hipFuncAttributeMaxDynamicSharedMemorySize, LDS_BYTES) != hipSuccess) { fprintf(stderr, "kernel_launch: hipFuncSetAttribute failed\n"); grid = -1; return; }
        if (hipOccupancyMaxActiveBlocksPerMultiprocessor(&per_cu, (const void*)fwd_kernel, NWAVES * 64, LDS_BYTES) != hipSuccess || per_cu < 1) { fprintf(stderr, "kernel_launch: occupancy query says %d\n", per_cu); (void)hipGetLastError(); }
        grid = cus - (cus % 8);
        if (grid < 64) { fprintf(stderr, "kernel_launch: only %d CUs\n", cus); grid = -1; return; }
    }
    if (grid < 0) return;
    if (hipMemsetAsync((char*)d_ws + WS_CTL, 0, CTL_ZERO_BYTES, stream) != hipSuccess) return;
    Args a{};
    for (int i = 0; i < 24; ++i) a.in[i] = (const float*)d_in[i];
    a.out = (float*)d_out; a.ws = (unsigned char*)d_ws;
#if MK_PER_PHASE
    for (int ph = 0; ph < PH_TOTAL; ++ph) { a.ph_lo = ph; a.ph_hi = ph + 1; hipLaunchKernelGGL(fwd_kernel, dim3(grid), dim3(NWAVES * 64), LDS_BYTES, stream, a); }
#else
    a.ph_lo = 0; a.ph_hi = PH_TOTAL; hipLaunchKernelGGL(fwd_kernel, dim3(grid), dim3(NWAVES * 64), LDS_BYTES, stream, a);
#endif
}
```

```cpp
#include <hip/hip_runtime.h>
#include <cstdio>
#include <cstdint>

#ifndef PHASE_MASK
#define PHASE_MASK 0xFFFFu
#endif
#define EN(k) (((PHASE_MASK) >> (k)) & 1u)
#ifndef REP_KIND
#define REP_KIND -1
#endif
#ifndef REP_SUB
#define REP_SUB 3
#endif
#ifndef TIME_KIND
#define TIME_KIND -1
#endif
#ifndef ATTN_REP
#define ATTN_REP 1
#endif
#ifndef SCAN_REP
#define SCAN_REP 1
#endif
#ifndef EPI_REP
#define EPI_REP 1
#endif
#define REPS(k) _Pragma("unroll 1") for (int rep_ = 0; rep_ < ((REP_KIND) == (k) ? 2 : 1); ++rep_)
#ifndef MK_PER_PHASE
#define MK_PER_PHASE 0
#endif

#define GAS __attribute__((address_space(1)))
#define LAS __attribute__((address_space(3)))
typedef unsigned short bf16;
typedef short bf16x8 __attribute__((ext_vector_type(8)));
typedef float f32x4 __attribute__((ext_vector_type(4)));
typedef float f32x2 __attribute__((ext_vector_type(2)));
typedef float f32x16 __attribute__((ext_vector_type(16)));
typedef unsigned u32x4 __attribute__((ext_vector_type(4)));
typedef unsigned u32x2 __attribute__((ext_vector_type(2)));
typedef __bf16 bfv2 __attribute__((ext_vector_type(2)));
__device__ __forceinline__ unsigned pk4_fp8(float a, float b, float c, float d) { unsigned w = 0u; w = __builtin_amdgcn_cvt_pk_fp8_f32(a, b, w, false); w = __builtin_amdgcn_cvt_pk_fp8_f32(c, d, w, true); return w; }
constexpr float YR_SCALE = 16.0f, YR_INV = 1.0f / 16.0f;

__device__ __forceinline__ unsigned pk2(float lo, float hi) { f32x2 v = {lo, hi}; bfv2 r = __builtin_convertvector(v, bfv2); return __builtin_bit_cast(unsigned, r); }
__device__ __forceinline__ float bf2f(unsigned short b) { return __uint_as_float(((unsigned)b) << 16); }
__device__ __forceinline__ float bflo(unsigned w) { return __uint_as_float(w << 16); }
__device__ __forceinline__ float bfhi(unsigned w) { return __uint_as_float(w & 0xffff0000u); }
__device__ __forceinline__ u32x4 pack8(f32x4 a, f32x4 b) { u32x4 w; w.x = pk2(a[0], a[1]); w.y = pk2(a[2], a[3]); w.z = pk2(b[0], b[1]); w.w = pk2(b[2], b[3]); return w; }
__device__ __forceinline__ void unpack8(u32x4 w, f32x4& a, f32x4& b) { a[0] = bflo(w.x); a[1] = bfhi(w.x); a[2] = bflo(w.y); a[3] = bfhi(w.y); b[0] = bflo(w.z); b[1] = bfhi(w.z); b[2] = bflo(w.w); b[3] = bfhi(w.w); }
__device__ __forceinline__ float sigmoidf_(float x) { return 1.0f / (1.0f + __expf(-x)); }
__device__ __forceinline__ float wave_sum(float v) {
#pragma unroll
    for (int o = 1; o < 64; o <<= 1) v += __shfl_xor(v, o);
    return v;
}
#define LDS_WAIT() asm volatile("s_waitcnt lgkmcnt(0)" ::: "memory")
#define VM_WAIT() asm volatile("s_waitcnt vmcnt(0)" ::: "memory")

#define XB_TMO      128
#define XB_XCNT(j)  (256  + 64 * (j))
#define XB_XSUB(j)  (1280 + 64 * (j))
#define XB_XGEN(j)  (2304 + 64 * (j))
#define XB_TOP      3328
#define XB_TOPGEN   3392
#define XCD_BAR_WORDS 3456
#define XB_SPIN_CAP (1u << 20)

__device__ __forceinline__ unsigned xb_ld(unsigned* p)              { return __hip_atomic_load(p, __ATOMIC_RELAXED, __HIP_MEMORY_SCOPE_AGENT); }
__device__ __forceinline__ unsigned xb_add(unsigned* p, unsigned v) { return __hip_atomic_fetch_add(p, v, __ATOMIC_RELAXED, __HIP_MEMORY_SCOPE_AGENT); }
__device__ __forceinline__ unsigned xb_xcc_id() { return (unsigned)__builtin_amdgcn_s_getreg((3 << 11) | 20) & 0xFu; }
#define XB_SPIN(cond, bar) do { unsigned _sp = 0; while (cond) { __builtin_amdgcn_s_sleep(1); \
    if ((++_sp & 255u) == 0u) { if (xb_ld(&(bar)[XB_TMO])) break; if (_sp > XB_SPIN_CAP) { atomicAdd(&(bar)[XB_TMO], 1u); break; } } } } while (0)

struct XcdBarrier { unsigned* bar; unsigned x; volatile LAS unsigned* st; };

__device__ __forceinline__ XcdBarrier xcd_barrier_post(unsigned* bar, volatile LAS unsigned* st) {
    XcdBarrier b; b.bar = bar; b.x = xb_xcc_id(); b.st = st;
    if (threadIdx.x == 0) (void)xb_add(&bar[XB_XCNT(b.x)], 1u);
    return b;
}
__device__ __forceinline__ void xcd_barrier_complete(unsigned* bar, unsigned x, unsigned& nloc, unsigned& nx) {
    const unsigned G = gridDim.x * gridDim.y * gridDim.z;
    unsigned sum, cnt, mine, sp = 0u;
    for (;;) {
        sum = 0u; cnt = 0u; mine = 0u;
#pragma unroll
        for (unsigned j = 0; j < 16; ++j) { const unsigned c = xb_ld(&bar[XB_XCNT(j)]); sum += c; cnt += (c > 0u) ? 1u : 0u; mine = (j == x) ? c : mine; }
        if (sum == G) break;
        __builtin_amdgcn_s_sleep(1);
        if ((++sp & 255u) == 0u) { if (xb_ld(&bar[XB_TMO])) break; if (sp > XB_SPIN_CAP) { atomicAdd(&bar[XB_TMO], 1u); break; } }
    }
    nloc = mine > 0u ? mine : 1u; nx = cnt > 0u ? cnt : 1u;
}
__device__ __forceinline__ void xcd_barrier(const XcdBarrier& b) {
    asm volatile("s_waitcnt vmcnt(0)" ::: "memory");
    __syncthreads();
    if (threadIdx.x == 0) {
        unsigned* bar = b.bar;
        __builtin_amdgcn_s_waitcnt(0);
        unsigned nloc = b.st[0], nx = b.st[1];
        if (nloc == 0u) { xcd_barrier_complete(bar, b.x, nloc, nx); b.st[0] = nloc; b.st[1] = nx; }
        const unsigned old = xb_add(&bar[XB_XSUB(b.x)], 1u);
        const unsigned gen = old / nloc;
        if (old + 1u == (gen + 1u) * nloc) {
            __builtin_amdgcn_fence(__ATOMIC_RELEASE, "agent");
            asm volatile("s_waitcnt vmcnt(0)" ::: "memory");
            const unsigned og = xb_add(&bar[XB_TOP], 1u);
            const unsigned tg = og / nx;
            if (og + 1u == (tg + 1u) * nx) xb_add(&bar[XB_TOPGEN], 1u);
            else XB_SPIN(xb_ld(&bar[XB_TOPGEN]) == tg, bar);
            __builtin_amdgcn_fence(__ATOMIC_ACQUIRE, "agent");
            xb_add(&bar[XB_XGEN(b.x)], 1u);
            asm volatile("s_waitcnt vmcnt(0)" ::: "memory");
        } else {
            XB_SPIN(xb_ld(&bar[XB_XGEN(b.x)]) == gen, bar);
            __builtin_amdgcn_fence(__ATOMIC_ACQUIRE, "agent");
            asm volatile("s_waitcnt vmcnt(0)" ::: "memory");
        }
    }
    __syncthreads();
}

constexpr int D = 1024, NB = 8, SEQ = 2048, T = NB * SEQ, DEPTH = 4;
constexpr int NPROJ = 3328;
constexpr int NHT = 2048;
constexpr int PGT = 0, PGA = 512, PGB = 1536, PCQ = 2560, PCKV = 2944, PKPE = 3200;
constexpr int HQ = 0, HFF = 512, HFB = 1024, HI = 1536;
constexpr int NE = 32, TOPK = 4, NASSIGN = T * TOPK, ACT_ROWS = NASSIGN + NE * 256;
constexpr float EPS = 1e-6f;
constexpr float QSCALE = 0.10206207261596575f * 1.4426950408889634f;

constexpr size_t MiB = 1u << 20;
constexpr size_t WS_CTL = 0, CTL_ZERO_BYTES = 1 * MiB;
constexpr size_t WS_MOD = 1 * MiB, WS_LB = 2 * MiB, WS_COS = 3 * MiB, WS_SIN = 4 * MiB, WS_RSQ = 5 * MiB, WS_RSKV = 5 * MiB + 65536, WS_AW = 6 * MiB, WS_LIST = 7 * MiB;
constexpr size_t WS_X = 16 * MiB, WS_HB = 80 * MiB, WS_PROJ = 112 * MiB, WS_HT = 216 * MiB, WS_Q = 280 * MiB, WS_K = 304 * MiB, WS_VT = 328 * MiB, WS_OF = 344 * MiB, WS_OB = 376 * MiB;
constexpr size_t WS_HA = 408 * MiB, WS_Y = 440 * MiB, WS_ACT = 472 * MiB, WS_YR = 616 * MiB, WS_W = 768 * MiB;
constexpr size_t WL_IN = 0, WL_Q = 11 * MiB, WL_K = 12 * MiB, WL_V = 12 * MiB + 256 * 1024, WL_OUT = 13 * MiB, WL_O = 15 * MiB, WL_GU = 17 * MiB, WL_DN = 145 * MiB, WL_STRIDE = 209 * MiB;
constexpr size_t WS_END = WS_W + DEPTH * WL_STRIDE;
static_assert((size_t)T * NPROJ * 2 <= WS_HT - WS_PROJ && (size_t)NB * NHT * SEQ * 2 <= WS_Q - WS_HT && (size_t)ACT_ROWS * 1024 * 2 <= WS_YR - WS_ACT && (size_t)NASSIGN * 1024 * 2 <= WS_W - WS_YR, "ws map");
constexpr int CW_BAR = 4096, CW_Q = 8192, CW_CNT = 16384;

constexpr int RING_BYTES = 131072;
constexpr int LDSCTL_OFF = 139264, MISC_OFF = LDSCTL_OFF + 320, MOE_OFF = LDSCTL_OFF + 1024;
constexpr int LDS_BYTES = 155648;
constexpr int RT_G_OFF = 143360, RT_S_OFF = 147456;
constexpr int NWAVES = 8;

namespace pg8 {
constexpr int BM = 256, BK = 64, HALF = 128, HTB = HALF * BK * 2, NXCD = 8, WGM = 8;
__device__ __forceinline__ int lds_byte(int r, int c) { const int st = (r >> 4) * 2 + (c >> 5), rr = r & 15, cc = c & 31, ob = rr * 64 + cc * 2; return st * 1024 + (ob ^ (((ob >> 9) & 1) << 5)); }
__device__ __forceinline__ void stage_rc(int b, int& R, int& C) { const int st = b / 1024, sb = b % 1024, swz = sb ^ (((sb >> 9) & 1) << 5); R = (st >> 1) * 16 + swz / 64; C = (st & 1) * 32 + (swz % 64) / 2; }
__device__ __forceinline__ int perm32(int rho) { const int n = rho >> 4, i = rho & 15; return 8 * (i >> 2) + 4 * n + (i & 3); }

struct Unit { const char* A; const char* B; int pm, pn, e, rowbase, mrows; };

struct DenseOrder {
    static constexpr bool GATHER_A = false;
    int nM, nN, nwg, G, c; const char* Abase; const char* Bbase; int lda, ldb;
    __device__ __forceinline__ void init(int M, int N, int G_, int c_, const void* A, int lda_, const void* B, int ldb_) { nM = M / BM; nN = N / BM; nwg = nM * nN; G = G_; c = c_; Abase = (const char*)A; Bbase = (const char*)B; lda = lda_; ldb = ldb_; }
    __device__ __forceinline__ bool next(int i, Unit& u) const {
        const long L = (long)i * G + c; if (L >= nwg) return false;
        int wgid = (int)L; { const int q = nwg / NXCD, r = nwg % NXCD, xcd = wgid % NXCD, off = wgid / NXCD; wgid = (xcd < r ? xcd * (q + 1) : r * (q + 1) + (xcd - r) * q) + off; }
        const int nig = WGM * nN, gid = wgid / nig, fm = gid * WGM, gsz = (nM - fm) < WGM ? (nM - fm) : WGM;
        u.pm = fm + ((wgid % nig) % gsz); u.pn = (wgid % nig) / gsz; u.e = 0; u.rowbase = 0; u.mrows = 256;
        u.A = Abase + (size_t)u.pm * 256 * lda * 2; u.B = Bbase + (size_t)u.pn * 256 * ldb * 2; return true;
    }
    __device__ __forceinline__ void aoff(const Unit&, const int (&R)[2], const int (&C)[2], unsigned (&v)[2][2]) const {
#pragma unroll
        for (int h = 0; h < 2; ++h)
#pragma unroll
            for (int i = 0; i < 2; ++i) v[h][i] = (unsigned)((128 * h + R[i]) * lda + C[i]) * 2u;
    }
};
template <bool GATHER> struct MoeOrder {
    static constexpr bool GATHER_A = GATHER;
    const LAS int* toff; const LAS int* cnt; int NT, G, c; const char* Abase; const char* Bbase; size_t b_expert_bytes; const int* list; int lda, ldb;
    __device__ __forceinline__ bool next(int i, Unit& u) const {
        const int spx = G >> 3, rpx = spx / NT, xcd = c & 7, slot = c >> 3;
        if (slot >= rpx * NT) return false;
        const int R = (i * 8 + xcd) * rpx + slot / NT; if (R >= toff[NE]) return false;
        int e = 0; while (toff[e + 1] <= R) ++e;
        u.e = e; u.pm = R - toff[e]; u.pn = slot % NT; u.rowbase = R * 256; u.mrows = cnt[e] - u.pm * 256;
        u.A = GATHER ? Abase : Abase + (size_t)u.rowbase * lda * 2; u.B = Bbase + (size_t)e * b_expert_bytes + (size_t)u.pn * 256 * ldb * 2; return true;
    }
    __device__ __forceinline__ void aoff(const Unit& u, const int (&R)[2], const int (&C)[2], unsigned (&v)[2][2]) const {
#pragma unroll
        for (int h = 0; h < 2; ++h)
#pragma unroll
            for (int i = 0; i < 2; ++i) {
                if (GATHER) { const int rl = 128 * h + R[i]; const int a = list[(size_t)u.e * T + u.pm * 256 + (rl < u.mrows ? rl : 0)]; v[h][i] = (unsigned)((a >> 2) * lda + C[i]) * 2u; }
                else v[h][i] = (unsigned)((128 * h + R[i]) * lda + C[i]) * 2u;
            }
    }
};

template <class E, class = void> struct has_mid { static constexpr bool value = false; };
template <class E> struct has_mid<E, decltype((void)E::HAS_MID)> { static constexpr bool value = true; };
template <class Epi, class Sched>
__device__ __forceinline__ void gemm_phase(LAS unsigned char* lds, const int K, const Sched& S, const Epi& E) {
    int tid_ = threadIdx.x; asm volatile("" : "+v"(tid_));
    const int tid = tid_, wid = __builtin_amdgcn_readfirstlane(tid >> 6), lane = tid & 63, wr = wid >> 2, wc = wid & 3, fr = lane & 15, fq = lane >> 4;
    int nt_ = K / BK; asm volatile("" : "+s"(nt_));
    const int nt = nt_;
    int sR[2], sC[2]; unsigned voffB[2];
#pragma unroll
    for (int i = 0; i < 2; ++i) { stage_rc(tid * 16 + i * 8192, sR[i], sC[i]); const int Rb = (sR[i] & ~31) + perm32(sR[i] & 31); voffB[i] = (unsigned)(Rb * S.ldb + sC[i]) * 2u; }
    constexpr bool GA = Sched::GATHER_A;
    unsigned voffA[2];
#pragma unroll
    for (int i = 0; i < 2; ++i) voffA[i] = (unsigned)(sR[i] * S.lda + sC[i]) * 2u;
    const size_t kstep = (size_t)(BK * 2);
    const size_t hstepB = (size_t)HALF * S.ldb * 2, hstepA = (size_t)HALF * S.lda * 2;
    const unsigned ldsw = (unsigned)wid * 1024u;
    const unsigned ldsbase = (unsigned)__builtin_amdgcn_readfirstlane((int)((unsigned)(size_t)lds + ldsw));
    const int aoff = lds_byte(wr * 64 + fr, fq * 8), boff = lds_byte(wc * 32 + fr, fq * 8);
#define PG8_SA(b, h) (((b) * 2 + (h)) * HTB)
#define PG8_SB(b, h) ((4 + (b) * 2 + (h)) * HTB)
#define PG8_DMA2(ldsaddr, gbase, v0_, v1_) do { unsigned keep_; \
        asm volatile("s_mov_b32 %0, m0\n\ts_mov_b32 m0, %4\n\ts_nop 0\n\tglobal_load_lds_dwordx4 %1, %3\n\ts_add_u32 m0, %4, 0x2000\n\ts_nop 0\n\tglobal_load_lds_dwordx4 %2, %3\n\ts_mov_b32 m0, %0" \
                     : "=&s"(keep_) : "v"(v0_), "v"(v1_), "s"(gbase), "s"(ldsaddr) : "memory", "scc"); } while (0)
#define PG8_STAGE(bufoff, gbase, voff) PG8_DMA2(ldsbase + (unsigned)(bufoff), (const char*)(gbase), (voff)[0], (voff)[1])
#define PG8_STAGEA(bufoff, gbase, h, nx) do { if constexpr (GA) { PG8_DMA2(ldsbase + (unsigned)(bufoff), (const char*)(gbase), ((nx) ? nvA[h][0] : vA[h][0]), ((nx) ? nvA[h][1] : vA[h][1])); } \
        else { PG8_DMA2(ldsbase + (unsigned)(bufoff), (const char*)(gbase) + (size_t)(h) * hstepA, voffA[0], voffA[1]); } } while (0)
#define PG8_LDA(dst, b, h) do { _Pragma("unroll") for (int m = 0; m < 4; ++m) _Pragma("unroll") for (int k = 0; k < 2; ++k) dst[m][k] = *(const LAS bf16x8*)(lds + PG8_SA(b, h) + aoff + m * 2048 + k * 1024); } while (0)
#define PG8_LDB(dst, b, h) do { _Pragma("unroll") for (int n = 0; n < 2; ++n) _Pragma("unroll") for (int k = 0; k < 2; ++k) dst[n][k] = *(const LAS bf16x8*)(lds + PG8_SB(b, h) + boff + n * 2048 + k * 1024); } while (0)
#define PG8_MMA(ai, bj, At, Bt) do { __builtin_amdgcn_s_setprio(1); _Pragma("unroll") for (int m = 0; m < 4; ++m) _Pragma("unroll") for (int n = 0; n < 2; ++n) _Pragma("unroll") for (int k = 0; k < 2; ++k) \
        acc[ai][bj][m][n] = __builtin_amdgcn_mfma_f32_16x16x32_bf16(Bt[n][k], At[m][k], acc[ai][bj][m][n], 0, 0, 0); __builtin_amdgcn_s_setprio(0); } while (0)
#define PG8_WAIT_V(n) asm volatile("s_waitcnt vmcnt(" #n ")" ::: "memory")
#define PG8_WAIT_L(n) asm volatile("s_waitcnt lgkmcnt(" #n ")" ::: "memory")
#define PG8_BAR __builtin_amdgcn_s_barrier()
#define PG8_SCHED __builtin_amdgcn_sched_barrier(0)
    Unit cur, nxt; int ui = 0;
    if (!S.next(0, cur)) return;
    f32x4 acc[2][2][4][2];
#pragma unroll
    for (int a = 0; a < 2; ++a)
#pragma unroll
        for (int b = 0; b < 2; ++b)
#pragma unroll
            for (int m = 0; m < 4; ++m)
#pragma unroll
                for (int n = 0; n < 2; ++n) acc[a][b][m][n] = (f32x4){0.f, 0.f, 0.f, 0.f};
    bf16x8 At[4][2], B0[2][2], B1[2][2];
    unsigned vA[2][2], nvA[2][2];
    if constexpr (GA) { S.aoff(cur, sR, sC, vA); }
    const char* cA = cur.A; const char* cB = cur.B;
    PG8_STAGE(PG8_SB(0, 0), cB, voffB); PG8_STAGE(PG8_SB(0, 1), cB + hstepB, voffB); PG8_STAGEA(PG8_SA(0, 0), cA, 0, false); PG8_STAGEA(PG8_SA(0, 1), cA, 1, false);
    if (wr == 1) PG8_BAR;
    PG8_WAIT_V(2); PG8_BAR;
    PG8_STAGE(PG8_SB(1, 0), cB + kstep, voffB); PG8_STAGEA(PG8_SA(1, 0), cA + kstep, 0, false); PG8_STAGE(PG8_SB(1, 1), cB + hstepB + kstep, voffB);
    PG8_WAIT_V(6); PG8_BAR;
    for (;;) {
        const bool has_next = S.next(ui + 1, nxt);
        const char* nA = has_next ? nxt.A : cA; const char* nB = has_next ? nxt.B : cB;
        if constexpr (GA) {
            if (has_next) S.aoff(nxt, sR, sC, nvA);
            else {
#pragma unroll
                for (int h = 0; h < 2; ++h)
#pragma unroll
                    for (int i = 0; i < 2; ++i) nvA[h][i] = vA[h][i]; } }
#pragma unroll 1
        for (int t = 0; t < nt; t += 2) {
            const bool last = (t == nt - 2);
            if constexpr (has_mid<Epi>::value) { if (t == Epi::MID_T) E.mid(acc, cur, wr, wc, fr, fq); }
            const char* a1 = cA + (size_t)(t + 1) * kstep;
            const char* a2 = last ? nA : cA + (size_t)(t + 2) * kstep; const char* b2 = last ? nB : cB + (size_t)(t + 2) * kstep;
            const char* a3 = a2 + kstep; const char* b3 = b2 + kstep;
            PG8_LDB(B0, 0, 0); PG8_LDB(B1, 0, 1); PG8_SCHED; PG8_LDA(At, 0, 0); PG8_STAGEA(PG8_SA(1, 1), a1, 1, false);
            PG8_WAIT_V(8); PG8_WAIT_L(0); PG8_BAR; PG8_MMA(0, 0, At, B0); PG8_MMA(0, 1, At, B1); PG8_BAR; PG8_SCHED;
            PG8_LDA(At, 0, 1); PG8_STAGE(PG8_SB(0, 0), b2, voffB); PG8_STAGE(PG8_SB(0, 1), b2 + hstepB, voffB); PG8_STAGEA(PG8_SA(0, 0), a2, 0, last);
            PG8_WAIT_V(8); PG8_WAIT_L(0); PG8_BAR; PG8_MMA(1, 0, At, B0); PG8_MMA(1, 1, At, B1); PG8_BAR; PG8_SCHED;
            PG8_LDB(B0, 1, 0); PG8_LDB(B1, 1, 1); PG8_SCHED; PG8_LDA(At, 1, 0); PG8_STAGEA(PG8_SA(0, 1), a2, 1, last);
            PG8_WAIT_V(8); PG8_WAIT_L(0); PG8_BAR; PG8_MMA(0, 0, At, B0); PG8_MMA(0, 1, At, B1); PG8_BAR; PG8_SCHED;
            PG8_LDA(At, 1, 1); PG8_STAGE(PG8_SB(1, 0), b3, voffB); PG8_STAGE(PG8_SB(1, 1), b3 + hstepB, voffB); PG8_STAGEA(PG8_SA(1, 0), a3, 0, last);
            PG8_WAIT_V(8); PG8_WAIT_L(0); PG8_BAR; PG8_MMA(1, 0, At, B0); PG8_MMA(1, 1, At, B1); PG8_BAR; PG8_SCHED;
        }
        if (wr == 0) PG8_BAR;
        E(acc, cur, wr, wc, fr, fq);
        if constexpr (EPI_REP > 1 && Epi::IDEMPOTENT) { asm volatile("" ::: "memory"); E(acc, cur, wr, wc, fr, fq); }
        if (!has_next) break;
#pragma unroll
        for (int a = 0; a < 2; ++a)
#pragma unroll
            for (int b = 0; b < 2; ++b)
#pragma unroll
                for (int m = 0; m < 4; ++m)
#pragma unroll
                    for (int n = 0; n < 2; ++n) acc[a][b][m][n] = (f32x4){0.f, 0.f, 0.f, 0.f};
        cur = nxt; cA = nA; cB = nB; ++ui;
        if constexpr (GA) {
#pragma unroll
            for (int h = 0; h < 2; ++h)
#pragma unroll
                for (int i = 0; i < 2; ++i) vA[h][i] = nvA[h][i]; }
        if (wr == 1) PG8_BAR;
    }
    PG8_WAIT_V(0);
    PG8_BAR;
#undef PG8_SA
#undef PG8_SB
#undef PG8_STAGE
#undef PG8_STAGEA
#undef PG8_DMA2
#undef PG8_LDA
#undef PG8_LDB
#undef PG8_MMA
#undef PG8_WAIT_V
#undef PG8_WAIT_L
#undef PG8_BAR
#undef PG8_SCHED
}
}
using pg8::Unit;
typedef const f32x4 (&AccRef)[2][2][4][2];

struct Args {
    const float* in[24]; float* out; unsigned char* ws; int ph_lo, ph_hi;
};
struct Frame {
    LAS unsigned char* lds; unsigned char* ws; int tid, lane, wave, G, bid;
    const float* const* in;
};
__device__ __forceinline__ unsigned char* wl(unsigned char* ws, int l, size_t off) { return ws + WS_W + (size_t)l * WL_STRIDE + off; }

#define EPI_LOOP_BEGIN _Pragma("unroll") for (int ai = 0; ai < 2; ++ai) _Pragma("unroll") for (int m = 0; m < 4; ++m) { const int rl = ai * 128 + wr * 64 + m * 16 + fr; _Pragma("unroll") for (int bj = 0; bj < 2; ++bj) { const int cl = bj * 128 + wc * 32 + 8 * fq; const f32x4 v0 = acc[ai][bj][m][0], v1 = acc[ai][bj][m][1];
#define EPI_LOOP_END } asm volatile("" ::: "memory"); }

struct EpiProj {
    static constexpr bool IDEMPOTENT = (EPI_REP > 2);
    bf16* O;
    __device__ __forceinline__ void operator()(AccRef acc, const Unit& u, int wr, int wc, int fr, int fq) const {
        EPI_LOOP_BEGIN
            *(u32x4*)(O + (size_t)(u.pm * 256 + rl) * NPROJ + u.pn * 256 + cl) = pack8(v0, v1);
        EPI_LOOP_END
    }
};
struct EpiHT {
    static constexpr bool IDEMPOTENT = (EPI_REP > 2);
    bf16* HT;
    __device__ __forceinline__ void operator()(AccRef acc, const Unit& u, int wr, int wc, int fr, int fq) const {
        const int seg = u.pm >> 1;
        EPI_LOOP_BEGIN
            const int f = u.pm * 256 + rl, t0 = u.pn * 256 + cl, b = t0 >> 11, s = t0 & 2047;
            f32x4 a = v0, d = v1;
            if (seg == 0) {
#pragma unroll
                for (int j = 0; j < 4; ++j) { a[j] = a[j] * __builtin_amdgcn_rcpf(1.0f + __builtin_amdgcn_exp2f(-1.4426950408889634f * a[j])); d[j] = d[j] * __builtin_amdgcn_rcpf(1.0f + __builtin_amdgcn_exp2f(-1.4426950408889634f * d[j])); }
            } else if (seg < 3) {
#pragma unroll
                for (int j = 0; j < 4; ++j) { a[j] = __builtin_amdgcn_rcpf(1.0f + __builtin_amdgcn_exp2f(1.4426950408889634f * a[j])); d[j] = __builtin_amdgcn_rcpf(1.0f + __builtin_amdgcn_exp2f(1.4426950408889634f * d[j])); }
            }
            *(u32x4*)(HT + ((size_t)b * NHT + f) * SEQ + s) = pack8(a, d);
        EPI_LOOP_END
    }
};
struct EpiQ {
    static constexpr bool IDEMPOTENT = (EPI_REP > 2);
    bf16* Q; const float* rsq; const float* cs; const float* sn;
    __device__ __forceinline__ void operator()(AccRef acc, const Unit& u, int wr, int wc, int fr, int fq) const {
        EPI_LOOP_BEGIN
            const int t = u.pm * 256 + rl, c0 = u.pn * 256 + cl, head = c0 / 96, w = c0 - head * 96, b = t >> 11, s = t & 2047;
            const float sc = rsq[t] * QSCALE;
            bf16* qp = Q + ((size_t)(b * 8 + head) * SEQ + s) * 96;
            f32x4 a = v0 * sc, d = v1 * sc;
            if (w < 64) { *(u32x4*)(qp + w) = pack8(a, d); }
            else { const int g = (w - 64) >> 3; const f32x4 co = *(const f32x4*)(cs + (size_t)t * 16 + 4 * g), si = *(const f32x4*)(sn + (size_t)t * 16 + 4 * g);
                const f32x4 o1 = a * co - d * si, o2 = d * co + a * si;
                u32x2 w1, w2; w1.x = pk2(o1[0], o1[1]); w1.y = pk2(o1[2], o1[3]); w2.x = pk2(o2[0], o2[1]); w2.y = pk2(o2[2], o2[3]);
                *(u32x2*)(qp + 64 + 4 * g) = w1; *(u32x2*)(qp + 80 + 4 * g) = w2; }
        EPI_LOOP_END
    }
};
struct EpiK {
    static constexpr bool IDEMPOTENT = (EPI_REP > 2);
    bf16* Kb; const float* rskv;
    __device__ __forceinline__ void operator()(AccRef acc, const Unit& u, int wr, int wc, int fr, int fq) const {
        EPI_LOOP_BEGIN
            const int t = u.pm * 256 + rl, c0 = u.pn * 256 + cl, head = c0 >> 6, w = c0 & 63, b = t >> 11, s = t & 2047;
            const float sc = rskv[t];
            *(u32x4*)(Kb + ((size_t)(b * 8 + head) * SEQ + s) * 96 + w) = pack8(v0 * sc, v1 * sc);
        EPI_LOOP_END
    }
};
struct EpiV {
    static constexpr bool IDEMPOTENT = (EPI_REP > 2);
    bf16* VT; const float* rskv;
    __device__ __forceinline__ void operator()(AccRef acc, const Unit& u, int wr, int wc, int fr, int fq) const {
        EPI_LOOP_BEGIN
            const int f = u.pm * 256 + rl, t0 = u.pn * 256 + cl, b = t0 >> 11, s = t0 & 2047, head = f >> 6, dv = f & 63;
            const f32x4 r0 = *(const f32x4*)(rskv + t0), r1 = *(const f32x4*)(rskv + t0 + 4);
            *(u32x4*)(VT + ((size_t)(b * 8 + head) * 64 + dv) * SEQ + s) = pack8(v0 * r0, v1 * r1);
        EPI_LOOP_END
    }
};
struct EpiOut {
    static constexpr bool IDEMPOTENT = false; static constexpr bool HAS_MID = true; static constexpr int MID_T = 8;
    bf16* Y; const bf16* proj;
    __device__ __forceinline__ void mid(f32x4 (&acc)[2][2][4][2], const Unit& u, int wr, int wc, int fr, int fq) const {
        unsigned off0 = (unsigned)((u.pm * 256 + wr * 64 + fr) * NPROJ + u.pn * 256 + wc * 32 + 8 * fq) * 2u;
        asm volatile("" : "+v"(off0));
        const char* gp0 = (const char*)proj;
#pragma unroll
        for (int ai = 0; ai < 2; ++ai)
#pragma unroll
            for (int mp = 0; mp < 2; ++mp) {
                u32x4 ga[2][2], gb[2][2];
#pragma unroll
                for (int mm = 0; mm < 2; ++mm)
#pragma unroll
                    for (int bj = 0; bj < 2; ++bj) { const unsigned o = off0 + (unsigned)(((ai * 128 + (2 * mp + mm) * 16) * NPROJ + bj * 128) * 2); ga[mm][bj] = *(const u32x4*)(gp0 + o + PGA * 2); gb[mm][bj] = *(const u32x4*)(gp0 + o + PGB * 2); }
#pragma unroll
                for (int mm = 0; mm < 2; ++mm)
#pragma unroll
                    for (int bj = 0; bj < 2; ++bj) {
                        f32x4 a0, a1, b0, b1; unpack8(ga[mm][bj], a0, a1); unpack8(gb[mm][bj], b0, b1);
#pragma unroll
                        for (int j = 0; j < 4; ++j) {
                            a0[j] = (1.0f + __builtin_amdgcn_exp2f(-1.4426950408889634f * b0[j])) * __builtin_amdgcn_rcpf(1.0f + __builtin_amdgcn_exp2f(-1.4426950408889634f * a0[j]));
                            a1[j] = (1.0f + __builtin_amdgcn_exp2f(-1.4426950408889634f * b1[j])) * __builtin_amdgcn_rcpf(1.0f + __builtin_amdgcn_exp2f(-1.4426950408889634f * a1[j])); }
                        acc[ai][bj][2 * mp + mm][0] *= a0; acc[ai][bj][2 * mp + mm][1] *= a1;
                    }
                asm volatile("" ::: "memory");
            }
    }
    __device__ __forceinline__ void operator()(AccRef acc, const Unit& u, int wr, int wc, int fr, int fq) const {
        const int c0 = u.pn * 256 + wc * 32 + 8 * fq;
        const bf16* gp = proj + (size_t)(u.pm * 256 + wr * 64 + fr) * NPROJ + PGB + c0;
        bf16* yp = Y + (size_t)(u.pm * 256 + wr * 64 + fr) * 1024 + c0;
#pragma unroll
        for (int ai = 0; ai < 2; ++ai) {
            u32x4 gw[4][2];
#pragma unroll
            for (int m = 0; m < 4; ++m)
#pragma unroll
                for (int bj = 0; bj < 2; ++bj) gw[m][bj] = *(const u32x4*)(gp + (size_t)(ai * 128 + m * 16) * NPROJ + bj * 128);
#pragma unroll
            for (int m = 0; m < 4; ++m)
#pragma unroll
                for (int bj = 0; bj < 2; ++bj) {
                    f32x4 g0, g1; unpack8(gw[m][bj], g0, g1);
#pragma unroll
                    for (int j = 0; j < 4; ++j) { g0[j] = __builtin_amdgcn_rcpf(1.0f + __builtin_amdgcn_exp2f(-1.4426950408889634f * g0[j])); g1[j] = __builtin_amdgcn_rcpf(1.0f + __builtin_amdgcn_exp2f(-1.4426950408889634f * g1[j])); }
                    *(u32x4*)(yp + (size_t)(ai * 128 + m * 16) * 1024 + bj * 128) = pack8(acc[ai][bj][m][0] * g0, acc[ai][bj][m][1] * g1);
                }
            asm volatile("" ::: "memory");
        }
    }
};
struct EpiWo {
    static constexpr bool IDEMPOTENT = false;
    bf16* X; const float* g1;
    __device__ __forceinline__ void operator()(AccRef acc, const Unit& u, int wr, int wc, int fr, int fq) const {
        const int c0 = u.pn * 256 + wc * 32 + 8 * fq, b = (u.pm * 256) >> 11;
        const float* gp = g1 + (size_t)b * 6144 + c0;
        const f32x4 ga0 = *(const f32x4*)gp, gb0 = *(const f32x4*)(gp + 4), ga1 = *(const f32x4*)(gp + 128), gb1 = *(const f32x4*)(gp + 132);
        bf16* xp = X + (size_t)(u.pm * 256 + wr * 64 + fr) * 1024 + c0;
#pragma unroll
        for (int ai = 0; ai < 2; ++ai) {
            u32x4 xv[4][2];
#pragma unroll
            for (int m = 0; m < 4; ++m) { const bf16* p = xp + (size_t)(ai * 128 + m * 16) * 1024; xv[m][0] = *(const u32x4*)p; xv[m][1] = *(const u32x4*)(p + 128); }
#pragma unroll
            for (int m = 0; m < 4; ++m) { bf16* p = xp + (size_t)(ai * 128 + m * 16) * 1024; f32x4 a, d;
                unpack8(xv[m][0], a, d); *(u32x4*)p = pack8(a + ga0 * acc[ai][0][m][0], d + gb0 * acc[ai][0][m][1]);
                unpack8(xv[m][1], a, d); *(u32x4*)(p + 128) = pack8(a + ga1 * acc[ai][1][m][0], d + gb1 * acc[ai][1][m][1]); }
            asm volatile("" ::: "memory");
        }
    }
};
struct EpiGU {
    static constexpr bool IDEMPOTENT = true;
    bf16* ACT; const float* bgu;
    __device__ __forceinline__ void operator()(AccRef acc, const Unit& u, int wr, int wc, int fr, int fq) const {
        const int j0 = u.pn * 128 + wc * 32 + 8 * fq;
        const float* bp = bgu + (size_t)u.e * 2048 + 2 * j0;
        const f32x4 b0 = *(const f32x4*)bp, b1 = *(const f32x4*)(bp + 4), b2 = *(const f32x4*)(bp + 8), b3 = *(const f32x4*)(bp + 12);
        const float bg[8] = {b0[0], b0[2], b1[0], b1[2], b2[0], b2[2], b3[0], b3[2]}, bu[8] = {b0[1], b0[3], b1[1], b1[3], b2[1], b2[3], b3[1], b3[3]};
        bf16* ap = ACT + (size_t)(u.rowbase + wr * 64 + fr) * 1024 + j0;
#pragma unroll
        for (int ai = 0; ai < 2; ++ai)
#pragma unroll
            for (int m = 0; m < 4; ++m) {
                float o[8];
#pragma unroll
                for (int j = 0; j < 8; ++j) {
                    float g = acc[ai][0][m][j >> 2][j & 3] + bg[j], up = acc[ai][1][m][j >> 2][j & 3] + bu[j];
                    g = fminf(g, 7.0f); up = fminf(fmaxf(up, -7.0f), 7.0f);
                    o[j] = (up + 1.0f) * g * __builtin_amdgcn_rcpf(1.0f + __builtin_amdgcn_exp2f(-1.702f * 1.4426950408889634f * g)); }
                u32x4 w; w.x = pk2(o[0], o[1]); w.y = pk2(o[2], o[3]); w.z = pk2(o[4], o[5]); w.w = pk2(o[6], o[7]);
                *(u32x4*)(ap + (size_t)(ai * 128 + m * 16) * 1024) = w;
            }
    }
};
struct EpiDown {
    static constexpr bool IDEMPOTENT = true;
    unsigned char* YR; const float* bd; const int* list; const float* aw;
    __device__ __forceinline__ void operator()(AccRef acc, const Unit& u, int wr, int wc, int fr, int fq) const {
        const int cb = u.pn * 256 + wc * 32 + 8 * fq;
        const float* bp = bd + (size_t)u.e * 1024 + cb;
        const f32x4 ba0 = *(const f32x4*)bp, bb0 = *(const f32x4*)(bp + 4), ba1 = *(const f32x4*)(bp + 128), bb1 = *(const f32x4*)(bp + 132);
        int a[8]; float w[8];
        const int* lp = list + (size_t)u.e * T + u.pm * 256 + wr * 64 + fr;
#pragma unroll
        for (int q = 0; q < 8; ++q) { const int rl = (q >> 2) * 128 + wr * 64 + (q & 3) * 16 + fr; a[q] = (rl < u.mrows) ? lp[(q >> 2) * 128 + (q & 3) * 16] : -1; }
#pragma unroll
        for (int q = 0; q < 8; ++q) w[q] = (a[q] >= 0) ? aw[a[q]] : 0.f;
#pragma unroll
        for (int q = 0; q < 8; ++q) {
            const int ai = q >> 2, m = q & 3;
            if (a[q] >= 0) { unsigned char* yp = YR + (size_t)a[q] * 1024 + cb;
                const float ws_ = w[q] * YR_SCALE;
                const f32x4 y0 = (acc[ai][0][m][0] + ba0) * ws_, y1 = (acc[ai][0][m][1] + bb0) * ws_, y2 = (acc[ai][1][m][0] + ba1) * ws_, y3 = (acc[ai][1][m][1] + bb1) * ws_;
                *(u32x2*)yp = (u32x2){pk4_fp8(y0[0], y0[1], y0[2], y0[3]), pk4_fp8(y1[0], y1[1], y1[2], y1[3])};
                *(u32x2*)(yp + 128) = (u32x2){pk4_fp8(y2[0], y2[1], y2[2], y2[3]), pk4_fp8(y3[0], y3[1], y3[2], y3[3])}; }
        }
    }
};

enum { MAP_ID = 0, MAP_WIN = 1, MAP_WQ = 2, MAP_WKV = 3, MAP_GU = 4 };
__device__ __forceinline__ int map_row(int kind, int n) {
    if (kind == MAP_WIN) { if (n < 2560) return n; if (n < 2944) return NHT + PCQ + (n - 2560); if (n < 3200) return NHT + PCKV + (n - 2944); if (n < 3232) return NHT + PKPE + (n - 3200); return NHT + PGA + (n - 3232); }
    if (kind == MAP_WQ) { const int h = n / 96, j = n - h * 96; if (j < 64) return n; const int r = j - 64, i = r & 15; return h * 96 + 64 + 8 * (i >> 2) + ((r >> 4) << 2) + (i & 3); }
    if (kind == MAP_WKV) { const int h = n >> 7, j = n & 127; return (j < 64) ? (h * 64 + j) : (512 + h * 64 + (j - 64)); }
    if (kind == MAP_GU) { const int j = n >> 1, bj = n & 1; return (j >> 7) * 256 + bj * 128 + (j & 127); }
    return n;
}
__device__ __forceinline__ void conv_item(const float* W, int N, const float* kscale, bf16* WT, int dstK, int koff, int kind, LAS float* scr, int kb, int nb, int lane) {
    const int k0 = 64 * kb, n0 = 32 * nb;
    {
        const int kr = lane >> 3, c4 = (lane & 7) * 4; f32x4 v[8];
#pragma unroll
        for (int i = 0; i < 8; ++i) v[i] = *(const f32x4*)(W + (size_t)(k0 + 8 * i + kr) * N + n0 + c4);
#pragma unroll
        for (int i = 0; i < 8; ++i) { if (kscale) v[i] = v[i] * kscale[k0 + 8 * i + kr]; LAS float* d = scr + (8 * i + kr) * 33 + c4; d[0] = v[i][0]; d[1] = v[i][1]; d[2] = v[i][2]; d[3] = v[i][3]; }
    }
    LDS_WAIT(); asm volatile("" ::: "memory");
    const int c = lane & 7;
#pragma unroll
    for (int j = 0; j < 4; ++j) { const int n = (lane >> 3) + 8 * j; const LAS float* s = scr + (8 * c) * 33 + n;
        u32x4 o; o.x = pk2(s[0 * 33], s[1 * 33]); o.y = pk2(s[2 * 33], s[3 * 33]); o.z = pk2(s[4 * 33], s[5 * 33]); o.w = pk2(s[6 * 33], s[7 * 33]);
        *(u32x4*)(WT + (size_t)map_row(kind, n0 + n) * dstK + koff + k0 + 8 * c) = o; }
    LDS_WAIT(); asm volatile("" ::: "memory");
}
__device__ __forceinline__ void p_prologue(Frame& F) {
    const float* const* in = F.in;
    __syncthreads();
    {
        LAS float* cond = (LAS float*)F.lds;
        LAS float* part = (LAS float*)(F.lds + 32768);
        for (int i = F.tid; i < 8 * 1024; i += 512) { const float v = in[1][i]; cond[i] = v * sigmoidf_(v); }
        __syncthreads();
        for (int it = F.bid; it < DEPTH * 96; it += F.G) {
            const int l = it / 96, n0 = (it % 96) * 64, col = F.tid & 63, kg = F.tid >> 6;
            const float* w = in[3] + (size_t)l * 1024 * 6144 + n0 + col;
            float a[8] = {0.f, 0.f, 0.f, 0.f, 0.f, 0.f, 0.f, 0.f};
            for (int k0 = kg * 128; k0 < kg * 128 + 128; k0 += 16) {
                float wv[16];
#pragma unroll
                for (int q = 0; q < 16; ++q) wv[q] = w[(size_t)(k0 + q) * 6144];
#pragma unroll
                for (int q = 0; q < 16; ++q)
#pragma unroll
                    for (int b = 0; b < 8; ++b) a[b] += cond[b * 1024 + k0 + q] * wv[q]; }
#pragma unroll
            for (int b = 0; b < 8; ++b) part[(kg * 8 + b) * 64 + col] = a[b];
            __syncthreads();
            { const int b = F.tid >> 6; float s = 0.f;
#pragma unroll
              for (int g = 0; g < 8; ++g) s += part[(g * 8 + b) * 64 + col];
              ((float*)(F.ws + WS_MOD))[((size_t)l * 8 + b) * 6144 + n0 + col] = s + in[4][(size_t)l * 6144 + n0 + col]; }
            __syncthreads();
        }
    }
    const int gtid = F.bid * 512 + F.tid, NT_ = F.G * 512;
    for (int i = gtid; i < 1024; i += NT_) {
        float lg[DEPTH], mx = -1e30f; for (int l = 0; l < DEPTH; ++l) { lg[l] = in[8][(size_t)l * 1024 + i]; mx = fmaxf(mx, lg[l]); }
        float s = 0.f; for (int l = 0; l < DEPTH; ++l) { lg[l] = __expf(lg[l] - mx); s += lg[l]; }
        float c = 0.f; float* lb = (float*)(F.ws + WS_LB);
        for (int l = 0; l < DEPTH; ++l) { if (l > 0) c += lg[l] / s; lb[(size_t)l * 1024 + i] = c; }
    }
    for (int i = gtid; i < T * 16; i += NT_) {
        const int t = i >> 4, j = i & 15; const int pos = ((const int*)in[2])[t];
        const double base4[4] = {1.0, 0.5623413251903491, 0.31622776601683794, 0.1778279410038923};
        double f = base4[j & 3]; for (int q = 0; q < (j >> 2); ++q) f *= 0.1;
        const double ang = (double)pos * f; const double n = __builtin_rint(ang * 0.15915494309189535); const float r = (float)(ang - n * 6.283185307179586);
        ((float*)(F.ws + WS_COS))[i] = cosf(r); ((float*)(F.ws + WS_SIN))[i] = sinf(r);
    }
    for (int l = 0; l < DEPTH; ++l) { u32x4* p = (u32x4*)(wl(F.ws, l, WL_IN) + (size_t)5280 * 1024 * 2); for (int i = gtid; i < 96 * 1024 * 2 / 16; i += NT_) p[i] = (u32x4){0u, 0u, 0u, 0u}; }
    {
        LAS float* scr = (LAS float*)(F.lds + F.wave * 16384);
        const int gw = F.bid * NWAVES + F.wave, NGW = F.G * NWAVES;
        constexpr int I_IN = 16 * 165, I_Q = 6 * 24, I_KV = 4 * 32, I_OH = 8 * 32, I_OM = 8 * 32, I_O = 16 * 32, I_GU = 32 * 16 * 64, I_DN = 32 * 16 * 32;
        constexpr int I_LAYER = I_IN + I_Q + I_KV + I_OH + I_OM + I_O + I_GU + I_DN;
        for (int it = gw; it < DEPTH * I_LAYER; it += NGW) {
            const int l = it / I_LAYER; int r = it - l * I_LAYER;
            if (r < I_IN) { conv_item(in[7] + (size_t)l * 1024 * 5280, 5280, nullptr, (bf16*)wl(F.ws, l, WL_IN), 1024, 0, MAP_WIN, scr, r / 165, r % 165, F.lane); continue; } r -= I_IN;
            if (r < I_Q) { conv_item(in[12] + (size_t)l * 384 * 768, 768, in[11] + l * 384, (bf16*)wl(F.ws, l, WL_Q), 384, 0, MAP_WQ, scr, r / 24, r % 24, F.lane); continue; } r -= I_Q;
            if (r < I_KV) { conv_item(in[14] + (size_t)l * 256 * 1024, 1024, in[13] + l * 256, (bf16*)wl(F.ws, l, WL_K), 256, 0, MAP_WKV, scr, r / 32, r % 32, F.lane); continue; } r -= I_KV;
            if (r < I_OH) { conv_item(in[10] + (size_t)l * 512 * 1024, 1024, nullptr, (bf16*)wl(F.ws, l, WL_OUT), 1024, 0, MAP_ID, scr, r / 32, r % 32, F.lane); continue; } r -= I_OH;
            if (r < I_OM) { conv_item(in[15] + (size_t)l * 512 * 1024, 1024, nullptr, (bf16*)wl(F.ws, l, WL_OUT), 1024, 512, MAP_ID, scr, r / 32, r % 32, F.lane); continue; } r -= I_OM;
            if (r < I_O) { conv_item(in[16] + (size_t)l * 1024 * 1024, 1024, nullptr, (bf16*)wl(F.ws, l, WL_O), 1024, 0, MAP_ID, scr, r / 32, r % 32, F.lane); continue; } r -= I_O;
            if (r < I_GU) { const int e = r / (16 * 64), q = r % (16 * 64); conv_item(in[19] + ((size_t)l * 32 + e) * 1024 * 2048, 2048, nullptr, (bf16*)wl(F.ws, l, WL_GU) + (size_t)e * 2048 * 1024, 1024, 0, MAP_GU, scr, q / 64, q % 64, F.lane); continue; } r -= I_GU;
            { const int e = r / (16 * 32), q = r % (16 * 32); conv_item(in[21] + ((size_t)l * 32 + e) * 1024 * 1024, 1024, nullptr, (bf16*)wl(F.ws, l, WL_DN) + (size_t)e * 1024 * 1024, 1024, 0, MAP_ID, scr, q / 32, q % 32, F.lane); }
        }
    }
}

__device__ __forceinline__ void p_norm_mix(Frame& F, int l, bool fin, float* out, bool dummy = false) {
    const float* const* in = F.in;
    bf16* X = (bf16*)(F.ws + (dummy ? WS_ACT : WS_X));
    const float* MOD = (const float*)(F.ws + WS_MOD); const unsigned char* YR = F.ws + WS_YR; bf16* HB = (bf16*)(F.ws + (dummy ? WS_ACT + 64 * MiB : WS_HB));
    const int gw = F.bid * NWAVES + F.wave, NGW = F.G * NWAVES, per_wave = (T + NGW - 1) / NGW;
    f32x4 Gv[4], Sv[4], G2[4]; int bcur = -1;
    for (int q = 0; q < per_wave; ++q) {
        const int t = gw * per_wave + q; if (t >= T) break;
        const int b = t >> 11; f32x4 v[4];
        if (b != bcur) { bcur = b;
            const float* gn = fin ? in[23] : in[5] + (size_t)l * 1024; const float* sh = MOD + ((size_t)(fin ? 0 : l) * 8 + b) * 6144; const float* g2 = MOD + ((size_t)(l > 0 ? l - 1 : 0) * 8 + b) * 6144 + 5 * 1024;
#pragma unroll
            for (int j = 0; j < 4; ++j) { const int d = 4 * F.lane + 256 * j; const f32x4 g = *(const f32x4*)(gn + d);
                Gv[j] = fin ? g : g * (*(const f32x4*)(sh + 1024 + d) + 1.0f); Sv[j] = fin ? (f32x4){0.f, 0.f, 0.f, 0.f} : *(const f32x4*)(sh + d); G2[j] = *(const f32x4*)(g2 + d); } }
        if (l == 0) {
#pragma unroll
            for (int j = 0; j < 4; ++j) v[j] = *(const f32x4*)(in[0] + (size_t)t * 1024 + 4 * F.lane + 256 * j);
        } else {
#pragma unroll
            for (int j = 0; j < 4; ++j) { const u32x2 w = *(const u32x2*)(X + (size_t)t * 1024 + 4 * F.lane + 256 * j); v[j] = (f32x4){bflo(w.x), bfhi(w.x), bflo(w.y), bfhi(w.y)}; }
        }
        if (l > 0) {
#pragma unroll
            for (int j = 0; j < 4; ++j) { f32x4 s = {0.f, 0.f, 0.f, 0.f};
#pragma unroll
                for (int k = 0; k < 4; ++k) { const unsigned w = *(const unsigned*)(YR + ((size_t)t * 4 + k) * 1024 + 4 * F.lane + 256 * j);
                    s[0] += __builtin_amdgcn_cvt_f32_fp8(w, 0); s[1] += __builtin_amdgcn_cvt_f32_fp8(w, 1); s[2] += __builtin_amdgcn_cvt_f32_fp8(w, 2); s[3] += __builtin_amdgcn_cvt_f32_fp8(w, 3); }
                v[j] += G2[j] * s * YR_INV; }
        }
        float ss = 0.f;
#pragma unroll
        for (int j = 0; j < 4; ++j) ss += (v[j][0] * v[j][0] + v[j][1] * v[j][1]) + (v[j][2] * v[j][2] + v[j][3] * v[j][3]);
        const float rs = rsqrtf(wave_sum(ss) * (1.0f / 1024.0f) + EPS);
        if (fin) {
#pragma unroll
            for (int j = 0; j < 4; ++j) { const int d = 4 * F.lane + 256 * j; *(f32x4*)(out + (size_t)t * 1024 + d) = v[j] * rs * Gv[j]; }
        } else {
#pragma unroll
            for (int j = 0; j < 4; ++j) { const int d = 4 * F.lane + 256 * j; { u32x2 xw; xw.x = pk2(v[j][0], v[j][1]); xw.y = pk2(v[j][2], v[j][3]); *(u32x2*)(X + (size_t)t * 1024 + d) = xw; }
                const f32x4 h = v[j] * rs * Gv[j] + Sv[j]; u32x2 w; w.x = pk2(h[0], h[1]); w.y = pk2(h[2], h[3]);
                *(u32x2*)(HB + (size_t)t * 1024 + d) = w; }
        }
    }
}
__device__ __forceinline__ void p_mla_prep(Frame& F) {
    const bf16* PROJ = (const bf16*)(F.ws + WS_PROJ); float* RSQ = (float*)(F.ws + WS_RSQ); float* RSKV = (float*)(F.ws + WS_RSKV); bf16* Kb = (bf16*)(F.ws + WS_K);
    const float* CS = (const float*)(F.ws + WS_COS); const float* SN = (const float*)(F.ws + WS_SIN);
    const int gw = F.bid * NWAVES + F.wave, NGW = F.G * NWAVES;
    for (int t = gw; t < T; t += NGW) {
        const bf16* row = PROJ + (size_t)t * NPROJ;
        float sq = 0.f, skv = 0.f;
#pragma unroll
        for (int j = 0; j < 6; ++j) { const float v = bf2f(row[PCQ + F.lane + 64 * j]); sq += v * v; }
#pragma unroll
        for (int j = 0; j < 4; ++j) { const float v = bf2f(row[PCKV + F.lane + 64 * j]); skv += v * v; }
        sq = wave_sum(sq); skv = wave_sum(skv);
        if (F.lane == 0) { RSQ[t] = rsqrtf(sq * (1.0f / 384.0f) + EPS); RSKV[t] = rsqrtf(skv * (1.0f / 256.0f) + EPS); }
        if (F.lane < 16) {
            const float x1 = bf2f(row[PKPE + F.lane]), x2 = bf2f(row[PKPE + 16 + F.lane]), co = CS[(size_t)t * 16 + F.lane], si = SN[(size_t)t * 16 + F.lane];
            const bf16 o1 = (bf16)(pk2(x1 * co - x2 * si, 0.f) & 0xffffu), o2 = (bf16)(pk2(x2 * co + x1 * si, 0.f) & 0xffffu);
            const int b = t >> 11, s = t & 2047;
#pragma unroll
            for (int h = 0; h < 8; ++h) { bf16* kp = Kb + ((size_t)(b * 8 + h) * SEQ + s) * 96; kp[64 + F.lane] = o1; kp[80 + F.lane] = o2; }
        }
    }
}
__device__ __forceinline__ void p_hgrn_post(Frame& F, int l) {
    const bf16* OFp = (const bf16*)(F.ws + WS_OF); const bf16* OBp = (const bf16*)(F.ws + WS_OB); const bf16* PROJ = (const bf16*)(F.ws + WS_PROJ); bf16* HA = (bf16*)(F.ws + WS_HA);
    const float* gn = F.in[9] + (size_t)l * 128;
    const int gw = F.bid * NWAVES + F.wave, NGW = F.G * NWAVES;
    for (int t = gw; t < T; t += NGW) {
        const int c = 8 * F.lane;
        f32x4 a0, a1, b0, b1; unpack8(*(const u32x4*)(OFp + (size_t)t * 512 + c), a0, a1); unpack8(*(const u32x4*)(OBp + (size_t)t * 512 + c), b0, b1); a0 += b0; a1 += b1;
        float ss = (a0[0] * a0[0] + a0[1] * a0[1]) + (a0[2] * a0[2] + a0[3] * a0[3]) + (a1[0] * a1[0] + a1[1] * a1[1]) + (a1[2] * a1[2] + a1[3] * a1[3]);
#pragma unroll
        for (int o = 1; o < 16; o <<= 1) ss += __shfl_xor(ss, o);
        const float rs = rsqrtf(ss * (1.0f / 128.0f) + EPS);
        f32x4 g0, g1; unpack8(*(const u32x4*)(PROJ + (size_t)t * NPROJ + PGT + c), g0, g1);
        const f32x4 n0 = *(const f32x4*)(gn + (c & 127)), n1 = *(const f32x4*)(gn + (c & 127) + 4);
#pragma unroll
        for (int j = 0; j < 4; ++j) { a0[j] = a0[j] * rs * n0[j] * sigmoidf_(g0[j]); a1[j] = a1[j] * rs * n1[j] * sigmoidf_(g1[j]); }
        *(u32x4*)(HA + (size_t)t * 1024 + c) = pack8(a0, a1);
    }
}

#define MFMA16(a, b, c) __builtin_amdgcn_mfma_f32_16x16x32_bf16((a), (b), (c), 0, 0, 0)
constexpr int SC_QROW = 272, SC_TROW = 144;
constexpr int SC_QT = 0, SC_KT = SC_QT + 64 * SC_QROW, SC_KH = SC_KT + 64 * SC_QROW, SC_VT = SC_KH + 128 * SC_TROW, SC_DEC = SC_VT + 128 * SC_TROW, SC_ZERO = SC_DEC + 4 * 128 * 4, SC_END = SC_ZERO + 64;
__device__ __forceinline__ unsigned rot16(unsigned x) { return (x >> 16) | (x << 16); }
constexpr int SC_OX = 73984;
static_assert(SC_OX >= SC_END && SC_OX % 16 == 0 && SC_OX + 32768 <= RING_BYTES, "scan LDS map");
__device__ __forceinline__ void scan_unit2(Frame& F, int l, int u) {
    const int vh = u & 1, dir = (u >> 1) & 1, hh = (u >> 2) & 3, b = u >> 4;
    const bf16* HTb = (const bf16*)(F.ws + WS_HT) + (size_t)b * NHT * SEQ;
    const bf16* qg = HTb + (size_t)(HQ + hh * 128) * SEQ; const bf16* fg = HTb + (size_t)((dir ? HFB : HFF) + hh * 128) * SEQ; const bf16* vg = HTb + (size_t)(HI + hh * 128 + vh * 64) * SEQ;
    bf16* OUT = (bf16*)(F.ws + (dir ? WS_OB : WS_OF));
    LAS unsigned char* lds = F.lds;
    const int d = F.tid & 127, si = F.tid >> 7;
    const float lbv = ((const float*)(F.ws + WS_LB))[((size_t)l * 2 + dir) * 512 + hh * 128 + d];
    const int r = F.lane & 15, g = F.lane >> 4, vt = F.wave & 3, dh = F.wave >> 2;
    const int vcol = hh * 128 + vh * 64 + 16 * vt;
    f32x4 S[4];
#pragma unroll
    for (int i = 0; i < 4; ++i) S[i] = (f32x4){0.f, 0.f, 0.f, 0.f};
    __syncthreads();
    if (F.tid < 16) *(LAS unsigned*)(lds + SC_ZERO + F.tid * 4) = 0u;
    u32x4 pq[2], pf[2], pv;
    const int vrow0 = F.tid >> 3, vmc = F.tid & 7;
    {   const int m0 = dir ? SEQ - 64 : 0; const int mb = dir ? m0 + 48 - 16 * si : m0 + 16 * si;
        pq[0] = *(const u32x4*)(qg + (size_t)d * SEQ + mb); pq[1] = *(const u32x4*)(qg + (size_t)d * SEQ + mb + 8);
        pf[0] = *(const u32x4*)(fg + (size_t)d * SEQ + mb); pf[1] = *(const u32x4*)(fg + (size_t)d * SEQ + mb + 8);
        pv = *(const u32x4*)(vg + (size_t)vrow0 * SEQ + m0 + 8 * vmc); }
    int mprev = 0;
#pragma unroll 1
    for (int c = 0; c <= SEQ / 64; ++c) {
        const bool live = c < SEQ / 64;
        const int m0 = dir ? SEQ - 64 * (c + 1) : 64 * c;
        float qt[16], kt[16], E = 1.0f;
        if (live) {
            float rq[16], rf[16];
#pragma unroll
            for (int j = 0; j < 2; ++j) {
                rq[8 * j + 0] = bflo(pq[j].x); rq[8 * j + 1] = bfhi(pq[j].x); rq[8 * j + 2] = bflo(pq[j].y); rq[8 * j + 3] = bfhi(pq[j].y); rq[8 * j + 4] = bflo(pq[j].z); rq[8 * j + 5] = bfhi(pq[j].z); rq[8 * j + 6] = bflo(pq[j].w); rq[8 * j + 7] = bfhi(pq[j].w);
                rf[8 * j + 0] = bflo(pf[j].x); rf[8 * j + 1] = bfhi(pf[j].x); rf[8 * j + 2] = bflo(pf[j].y); rf[8 * j + 3] = bfhi(pf[j].y); rf[8 * j + 4] = bflo(pf[j].z); rf[8 * j + 5] = bfhi(pf[j].z); rf[8 * j + 6] = bflo(pf[j].w); rf[8 * j + 7] = bfhi(pf[j].w); }
#pragma unroll
            for (int k = 0; k < 16; ++k) {
                const float un = dir ? rf[15 - k] : rf[k], qs = dir ? rq[15 - k] : rq[k];
                const float kk = (1.0f - lbv) * un; E = fmaxf(E * (1.0f - kk), 1e-30f);
                qt[k] = qs * E; kt[k] = kk * __builtin_amdgcn_rcpf(E);
            }
        }
        __syncthreads();
        if (c > 0) {
#pragma unroll
            for (int ii = 0; ii < 2; ++ii) { const int i = 2 * dh + ii;
                const f32x4 a = *(const LAS f32x4*)(lds + SC_OX + (((0 * 4 + vt) * 4 + i) * 64 + F.lane) * 16), bq = *(const LAS f32x4*)(lds + SC_OX + (((1 * 4 + vt) * 4 + i) * 64 + F.lane) * 16);
                const int m = dir ? mprev + 63 - 16 * i - r : mprev + 16 * i + r;
                const f32x4 o = a + bq; u32x2 w; w.x = pk2(o[0], o[1]); w.y = pk2(o[2], o[3]);
                *(u32x2*)(OUT + (size_t)(b * SEQ + m) * 512 + vcol + 4 * g) = w; }
        }
        if (!live) break;
        {   LAS unsigned char* qp = lds + SC_QT + (16 * si) * SC_QROW + d * 2; LAS unsigned char* kp = lds + SC_KT + (16 * si) * SC_QROW + d * 2;
#pragma unroll
            for (int k = 0; k < 16; k += 2) { const unsigned wq = pk2(qt[k], qt[k + 1]), wk = pk2(kt[k], kt[k + 1]);
                *(LAS unsigned short*)(qp + k * SC_QROW) = (unsigned short)wq; *(LAS unsigned short*)(qp + (k + 1) * SC_QROW) = (unsigned short)(wq >> 16);
                *(LAS unsigned short*)(kp + k * SC_QROW) = (unsigned short)wk; *(LAS unsigned short*)(kp + (k + 1) * SC_QROW) = (unsigned short)(wk >> 16); }
            u32x4 h0, h1;
            h0.x = pk2(kt[0] * E, kt[1] * E); h0.y = pk2(kt[2] * E, kt[3] * E); h0.z = pk2(kt[4] * E, kt[5] * E); h0.w = pk2(kt[6] * E, kt[7] * E);
            h1.x = pk2(kt[8] * E, kt[9] * E); h1.y = pk2(kt[10] * E, kt[11] * E); h1.z = pk2(kt[12] * E, kt[13] * E); h1.w = pk2(kt[14] * E, kt[15] * E);
            *(LAS u32x4*)(lds + SC_KH + d * SC_TROW + 32 * si) = h0; *(LAS u32x4*)(lds + SC_KH + d * SC_TROW + 32 * si + 16) = h1;
            *(LAS float*)(lds + SC_DEC + (si * 128 + d) * 4) = E;
            { u32x4 w = pv; int tl0 = 8 * vmc;
              if (dir) { w = (u32x4){rot16(pv.w), rot16(pv.z), rot16(pv.y), rot16(pv.x)}; tl0 = 56 - 8 * vmc; }
              *(LAS u32x4*)(lds + SC_VT + vrow0 * SC_TROW + tl0 * 2) = w; }
        }
        if (c + 1 < SEQ / 64) {
            const int m1 = dir ? SEQ - 64 * (c + 2) : 64 * (c + 1); const int mb = dir ? m1 + 48 - 16 * si : m1 + 16 * si;
            pq[0] = *(const u32x4*)(qg + (size_t)d * SEQ + mb); pq[1] = *(const u32x4*)(qg + (size_t)d * SEQ + mb + 8);
            pf[0] = *(const u32x4*)(fg + (size_t)d * SEQ + mb); pf[1] = *(const u32x4*)(fg + (size_t)d * SEQ + mb + 8);
            pv = *(const u32x4*)(vg + (size_t)vrow0 * SEQ + m1 + 8 * vmc);
        }
        mprev = m0;
        __syncthreads();
        f32x4 oI[2];
#pragma unroll
        for (int ii = 0; ii < 2; ++ii) {
            const int i = 2 * dh + ii;
            const LAS unsigned char* qrow = lds + SC_QT + (16 * i + r) * SC_QROW; const LAS unsigned char* krow = lds + SC_KT + (16 * i + r) * SC_QROW;
            f32x4 pT = {0.f, 0.f, 0.f, 0.f};
#pragma unroll
            for (int ks = 0; ks < 4; ++ks) pT = MFMA16(*(const LAS bf16x8*)(krow + (32 * ks + 8 * g) * 2), *(const LAS bf16x8*)(qrow + (32 * ks + 8 * g) * 2), pT);
#pragma unroll
            for (int q = 0; q < 4; ++q) pT[q] = (4 * g + q <= r) ? pT[q] : 0.0f;
            const bf16x8 pfrag = __builtin_bit_cast(bf16x8, ((u32x4){pk2(pT[0], pT[1]), pk2(pT[2], pT[3]), 0u, 0u}));
            const u32x2 vt4 = *(const LAS u32x2*)(lds + SC_VT + (16 * vt + r) * SC_TROW + (16 * i + 4 * g) * 2);
            oI[ii] = MFMA16(__builtin_bit_cast(bf16x8, ((u32x4){vt4.x, vt4.y, 0u, 0u})), pfrag, ((f32x4){0.f, 0.f, 0.f, 0.f}));
        }
        const bool zl = (g >= 2);
#pragma unroll
        for (int i = 0; i < 4; ++i) {
            const LAS unsigned char* qrow = lds + SC_QT + (16 * i + r) * SC_QROW + (64 * dh) * 2;
            f32x4 o = ((i >> 1) == dh) ? oI[i & 1] : (f32x4){0.f, 0.f, 0.f, 0.f};
#pragma unroll
            for (int kk = 0; kk < 2; ++kk) {
                const bf16x8 sfrag = __builtin_bit_cast(bf16x8, ((u32x4){pk2(S[2 * kk][0], S[2 * kk][1]), pk2(S[2 * kk][2], S[2 * kk][3]), pk2(S[2 * kk + 1][0], S[2 * kk + 1][1]), pk2(S[2 * kk + 1][2], S[2 * kk + 1][3])}));
                const u32x2 qa = *(const LAS u32x2*)(qrow + (32 * kk + 4 * g) * 2), qb = *(const LAS u32x2*)(qrow + (32 * kk + 16 + 4 * g) * 2);
                o = MFMA16(sfrag, __builtin_bit_cast(bf16x8, ((u32x4){qa.x, qa.y, qb.x, qb.y})), o);
            }
            *(LAS f32x4*)(lds + SC_OX + (((dh * 4 + vt) * 4 + i) * 64 + F.lane) * 16) = o;
            const LAS unsigned char* vtp = zl ? lds + SC_ZERO : lds + SC_VT + (16 * vt + r) * SC_TROW + (16 * i + 8 * g) * 2;
            const bf16x8 vfrag = *(const LAS bf16x8*)vtp;
#pragma unroll
            for (int dt = 0; dt < 4; ++dt) {
                const f32x4 dec = *(const LAS f32x4*)(lds + SC_DEC + (i * 128 + 64 * dh + 16 * dt + 4 * g) * 4);
                const LAS unsigned char* khp = zl ? lds + SC_ZERO : lds + SC_KH + (64 * dh + 16 * dt + r) * SC_TROW + (16 * i + 8 * g) * 2;
                S[dt] = MFMA16(*(const LAS bf16x8*)khp, vfrag, S[dt] * dec);
            }
        }
    }
    __syncthreads();
}

#define MFMA32(a, b, c) __builtin_amdgcn_mfma_f32_32x32x16_bf16((a), (b), (c), 0, 0, 0)
constexpr int AT_KROW = 208, AT_VROW = 136, AT_KBYTES = 64 * AT_KROW, AT_BUF = AT_KBYTES + 64 * AT_VROW;
__device__ __forceinline__ void attn_unit(Frame& F, int bh, int q0) {
    const GAS bf16* Q = (const GAS bf16*)(F.ws + WS_Q); const GAS char* Kg = (const GAS char*)(F.ws + WS_K) + (size_t)bh * SEQ * 96 * 2; const GAS char* Vg = (const GAS char*)(F.ws + WS_VT) + (size_t)bh * 64 * SEQ * 2;
    GAS bf16* HA = (GAS bf16*)(F.ws + WS_HA);
    LAS unsigned char* lds = F.lds;
    const int r = F.lane & 31, h = F.lane >> 5;
    bf16x8 qf[6];
    { const GAS bf16* qrow = Q + ((size_t)bh * SEQ + q0 + F.wave * 32 + r) * 96;
#pragma unroll
      for (int ks = 0; ks < 6; ++ks) qf[ks] = *(const GAS bf16x8*)(qrow + 16 * ks + 8 * h); }
    f32x16 o0, o1;
#pragma unroll
    for (int i = 0; i < 16; ++i) { o0[i] = 0.f; o1[i] = 0.f; }
    float mref = 0.f, lsum = 0.f;
    const int kc0 = F.tid, kc1 = F.tid + 512; const bool has1 = F.tid < 256;
    const int kl0 = (kc0 / 12) * AT_KROW + (kc0 % 12) * 16, kl1 = (kc1 / 12) * AT_KROW + (kc1 % 12) * 16;
    const int vrow = F.tid >> 3, vpc = F.tid & 7; const int vl = AT_KBYTES + vrow * AT_VROW + vpc * 16;
    u32x4 rk0, rk1 = {0u, 0u, 0u, 0u}, rv;
    __syncthreads();
    rk0 = *(const GAS u32x4*)(Kg + (size_t)kc0 * 16); if (has1) rk1 = *(const GAS u32x4*)(Kg + (size_t)kc1 * 16);
    rv = *(const GAS u32x4*)(Vg + (size_t)vrow * SEQ * 2 + vpc * 16);
    *(LAS u32x4*)(lds + kl0) = rk0; if (has1) *(LAS u32x4*)(lds + kl1) = rk1;
    *(LAS u32x2*)(lds + vl) = (u32x2){rv.x, rv.y}; *(LAS u32x2*)(lds + vl + 8) = (u32x2){rv.z, rv.w};
    __syncthreads();
    for (int j = 0; j < SEQ / 64; ++j) {
        const int buf = (j & 1) * AT_BUF, nbuf = ((j + 1) & 1) * AT_BUF;
        if (j + 1 < SEQ / 64) {
            const GAS char* kg = Kg + (size_t)(j + 1) * 64 * 96 * 2;
            rk0 = *(const GAS u32x4*)(kg + (size_t)kc0 * 16); if (has1) rk1 = *(const GAS u32x4*)(kg + (size_t)kc1 * 16);
            rv = *(const GAS u32x4*)(Vg + (size_t)vrow * SEQ * 2 + (size_t)(j + 1) * 128 + vpc * 16);
        }
        f32x16 s0, s1;
#pragma unroll
        for (int i = 0; i < 16; ++i) { s0[i] = -mref; s1[i] = -mref; }
#pragma unroll
        for (int ks = 0; ks < 6; ++ks) {
            const bf16x8 k0 = *(const LAS bf16x8*)(lds + buf + r * AT_KROW + (16 * ks + 8 * h) * 2);
            const bf16x8 k1 = *(const LAS bf16x8*)(lds + buf + (32 + r) * AT_KROW + (16 * ks + 8 * h) * 2);
            s0 = MFMA32(k0, qf[ks], s0); s1 = MFMA32(k1, qf[ks], s1);
        }
        float mx = s0[0];
#pragma unroll
        for (int i = 1; i < 16; ++i) mx = fmaxf(mx, s0[i]);
#pragma unroll
        for (int i = 0; i < 16; ++i) mx = fmaxf(mx, s1[i]);
        mx = fmaxf(mx, __shfl_xor(mx, 32));
        const bool grow = (j == 0) || (mx > 8.0f);
        if (__builtin_amdgcn_ballot_w64(grow) != 0ull) {
            const float dlt = grow ? mx : 0.0f, fsc = __builtin_amdgcn_exp2f(-dlt); mref += dlt; lsum *= fsc;
#pragma unroll
            for (int i = 0; i < 16; ++i) { s0[i] -= dlt; s1[i] -= dlt; o0[i] *= fsc; o1[i] *= fsc; } }
        float ps = 0.f;
#pragma unroll
        for (int i = 0; i < 16; ++i) { s0[i] = __builtin_amdgcn_exp2f(s0[i]); s1[i] = __builtin_amdgcn_exp2f(s1[i]); ps += s0[i] + s1[i]; }
        lsum += ps;
        bf16x8 pf[2][2];
#pragma unroll
        for (int sp = 0; sp < 2; ++sp) {
            u32x4 w0, w1;
            w0.x = pk2(s0[8 * sp + 0], s0[8 * sp + 1]); w0.y = pk2(s0[8 * sp + 2], s0[8 * sp + 3]); w0.z = pk2(s0[8 * sp + 4], s0[8 * sp + 5]); w0.w = pk2(s0[8 * sp + 6], s0[8 * sp + 7]);
            w1.x = pk2(s1[8 * sp + 0], s1[8 * sp + 1]); w1.y = pk2(s1[8 * sp + 2], s1[8 * sp + 3]); w1.z = pk2(s1[8 * sp + 4], s1[8 * sp + 5]); w1.w = pk2(s1[8 * sp + 6], s1[8 * sp + 7]);
            pf[0][sp] = __builtin_bit_cast(bf16x8, w0); pf[1][sp] = __builtin_bit_cast(bf16x8, w1);
        }
#pragma unroll
        for (int kb = 0; kb < 2; ++kb)
#pragma unroll
            for (int sp = 0; sp < 2; ++sp) {
                const int kbase = (32 * kb + 16 * sp + 4 * h) * 2;
                const LAS unsigned char* v0p = lds + buf + AT_KBYTES + r * AT_VROW + kbase;
                const LAS unsigned char* v1p = lds + buf + AT_KBYTES + (32 + r) * AT_VROW + kbase;
                const u32x2 a0 = *(const LAS u32x2*)v0p, a1 = *(const LAS u32x2*)(v0p + 16), c0 = *(const LAS u32x2*)v1p, c1 = *(const LAS u32x2*)(v1p + 16);
                const bf16x8 vf0 = __builtin_bit_cast(bf16x8, ((u32x4){a0.x, a0.y, a1.x, a1.y})), vf1 = __builtin_bit_cast(bf16x8, ((u32x4){c0.x, c0.y, c1.x, c1.y}));
                o0 = MFMA32(vf0, pf[kb][sp], o0); o1 = MFMA32(vf1, pf[kb][sp], o1);
            }
        if (j + 1 < SEQ / 64) {
            *(LAS u32x4*)(lds + nbuf + kl0) = rk0; if (has1) *(LAS u32x4*)(lds + nbuf + kl1) = rk1;
            *(LAS u32x2*)(lds + nbuf + vl) = (u32x2){rv.x, rv.y}; *(LAS u32x2*)(lds + nbuf + vl + 8) = (u32x2){rv.z, rv.w};
        }
        __syncthreads();
    }
    lsum += __shfl_xor(lsum, 32);
    const float inv = 1.0f / lsum;
    const int head = bh & 7, b = bh >> 3;
    GAS bf16* orow = HA + (size_t)(b * SEQ + q0 + F.wave * 32 + r) * 1024 + 512 + head * 64;
#pragma unroll
    for (int i = 0; i < 4; ++i) {
        u32x2 w0, w1;
        w0.x = pk2(o0[4 * i] * inv, o0[4 * i + 1] * inv); w0.y = pk2(o0[4 * i + 2] * inv, o0[4 * i + 3] * inv);
        w1.x = pk2(o1[4 * i] * inv, o1[4 * i + 1] * inv); w1.y = pk2(o1[4 * i + 2] * inv, o1[4 * i + 3] * inv);
        *(GAS u32x2*)(orow + 8 * i + 4 * h) = w0; *(GAS u32x2*)(orow + 32 + 8 * i + 4 * h) = w1;
    }
}

__device__ __forceinline__ void p_router(Frame& F, int l, bool dummy = false) {
    const float* const* in = F.in;
    const bf16* X = (const bf16*)(F.ws + WS_X); const float* MOD = (const float*)(F.ws + WS_MOD); bf16* HB = (bf16*)(F.ws + WS_HB);
    int* LIST = (int*)(F.ws + (dummy ? WS_Y : WS_LIST)); float* AW = (float*)(F.ws + (dummy ? WS_Y + 4 * MiB : WS_AW)); unsigned* CNT = (unsigned*)(F.ws + WS_CTL) + CW_CNT + (l + (dummy ? 4 : 0)) * 32 * 64;
    LAS unsigned char* lds = F.lds;
    __syncthreads();
    { const float* wr = in[17] + (size_t)l * 1024 * 32;
      for (int q = F.tid; q < 8192; q += 512) { const int k = q >> 3; *(LAS f32x4*)(lds + (size_t)(q + (k >> 2)) * 16) = *(const f32x4*)(wr + (size_t)q * 4); } }
    const float* gn = in[6] + (size_t)l * 1024; const float* br = in[18] + (size_t)l * 32;
    const int gw = F.bid * NWAVES + F.wave, NGW = F.G * NWAVES;
    const int wgb = ((F.bid * NWAVES) * ((T + NGW - 1) / NGW) < T ? (F.bid * NWAVES) * ((T + NGW - 1) / NGW) : T - 1) >> 11;
    { const float* sh = MOD + ((size_t)l * 8 + wgb) * 6144 + 3 * 1024;
      for (int d = F.tid; d < 1024; d += 512) { *(LAS float*)(lds + RT_G_OFF + d * 4) = gn[d] * (sh[1024 + d] + 1.0f); *(LAS float*)(lds + RT_S_OFF + d * 4) = sh[d]; } }
    __syncthreads();
    LAS unsigned* lcnt = (LAS unsigned*)(lds + MOE_OFF + 512); LAS unsigned* lbase = lcnt + 32;
    const int per_wave = (T + NGW - 1) / NGW;
    for (int b0 = 0; b0 < per_wave; b0 += 16) {
    int pend_e = 0, pend_a = 0, npend = 0; float pend_w = 0.f;
    u32x2 xn[4];
    {   const int t0 = gw * per_wave + b0; const int tc = t0 < T ? t0 : T - 1;
#pragma unroll
        for (int j = 0; j < 4; ++j) xn[j] = *(const u32x2*)(X + (size_t)tc * 1024 + 4 * F.lane + 256 * j); }
    for (int q_ = 0; q_ < 16; ++q_) {
        const int t = gw * per_wave + b0 + q_; if (b0 + q_ >= per_wave || t >= T) break;
        const int b = t >> 11; f32x4 v[4]; float ss = 0.f;
#pragma unroll
        for (int j = 0; j < 4; ++j) { const u32x2 xw = xn[j]; v[j] = (f32x4){bflo(xw.x), bfhi(xw.x), bflo(xw.y), bfhi(xw.y)}; ss += (v[j][0] * v[j][0] + v[j][1] * v[j][1]) + (v[j][2] * v[j][2] + v[j][3] * v[j][3]); }
        {   const int tn = (t + 1 < T) ? t + 1 : t;
#pragma unroll
            for (int j = 0; j < 4; ++j) xn[j] = *(const u32x2*)(X + (size_t)tn * 1024 + 4 * F.lane + 256 * j); }
        const float rs = rsqrtf(wave_sum(ss) * (1.0f / 1024.0f) + EPS);
#pragma unroll
        for (int j = 0; j < 4; ++j) { const int d = 4 * F.lane + 256 * j; f32x4 Gv, Sv;
            if (b == wgb) { Gv = *(const LAS f32x4*)(lds + RT_G_OFF + d * 4); Sv = *(const LAS f32x4*)(lds + RT_S_OFF + d * 4); }
            else { const float* sh = MOD + ((size_t)l * 8 + b) * 6144 + 3 * 1024; Gv = *(const f32x4*)(gn + d) * (*(const f32x4*)(sh + 1024 + d) + 1.0f); Sv = *(const f32x4*)(sh + d); }
            v[j] = v[j] * rs * Gv + Sv; u32x2 w; w.x = pk2(v[j][0], v[j][1]); w.y = pk2(v[j][2], v[j][3]);
            *(u32x2*)(HB + (size_t)t * 1024 + d) = w; }
        float p[32];
#pragma unroll
        for (int e = 0; e < 32; ++e) p[e] = 0.f;
#define RT_WP(q) (lds + (size_t)((4 * F.lane + 256 * ((q) >> 2) + ((q) & 3)) * 8 + F.lane + 64 * ((q) >> 2)) * 16)
#define RT_LOAD(dst, q) do { const LAS unsigned char* wp_ = RT_WP(q); _Pragma("unroll") for (int c = 0; c < 8; ++c) dst[c] = *(const LAS f32x4*)(wp_ + c * 16); } while (0)
#define RT_FMA(src, q) do { const float hv_ = v[(q) >> 2][(q) & 3]; _Pragma("unroll") for (int c = 0; c < 8; ++c) { p[4 * c] += hv_ * src[c][0]; p[4 * c + 1] += hv_ * src[c][1]; p[4 * c + 2] += hv_ * src[c][2]; p[4 * c + 3] += hv_ * src[c][3]; } } while (0)
        {   f32x4 wa[8], wb[8];
            RT_LOAD(wa, 0);
#pragma unroll
            for (int q = 0; q < 16; q += 2) {
                RT_LOAD(wb, q + 1); __builtin_amdgcn_sched_barrier(0); RT_FMA(wa, q); __builtin_amdgcn_sched_barrier(0);
                if (q + 2 < 16) RT_LOAD(wa, q + 2);
                __builtin_amdgcn_sched_barrier(0); RT_FMA(wb, q + 1); __builtin_amdgcn_sched_barrier(0);
            }
        }
#undef RT_WP
#undef RT_LOAD
#undef RT_FMA
#pragma unroll
        for (int e = 0; e < 16; ++e) { const bool up = (F.lane & 32) != 0; const float keep = up ? p[e + 16] : p[e], send = up ? p[e] : p[e + 16]; p[e] = keep + __shfl_xor(send, 32); }
#pragma unroll
        for (int e = 0; e < 8; ++e) { const bool up = (F.lane & 16) != 0; const float keep = up ? p[e + 8] : p[e], send = up ? p[e] : p[e + 8]; p[e] = keep + __shfl_xor(send, 16); }
#pragma unroll
        for (int e = 0; e < 4; ++e) { const bool up = (F.lane & 8) != 0; const float keep = up ? p[e + 4] : p[e], send = up ? p[e] : p[e + 4]; p[e] = keep + __shfl_xor(send, 8); }
#pragma unroll
        for (int e = 0; e < 2; ++e) { const bool up = (F.lane & 4) != 0; const float keep = up ? p[e + 2] : p[e], send = up ? p[e] : p[e + 2]; p[e] = keep + __shfl_xor(send, 4); }
        { const bool up = (F.lane & 2) != 0; const float keep = up ? p[1] : p[0], send = up ? p[0] : p[1]; p[0] = keep + __shfl_xor(send, 2); }
        float logit = p[0] + __shfl_xor(p[0], 1);
        const int myE = F.lane >> 1; logit += br[myE];
        int rank = 0;
#pragma unroll
        for (int r = 1; r < 32; ++r) { const int oe = (myE + r) & 31; const float ov = __shfl(logit, 2 * oe + (F.lane & 1)); rank += (ov > logit || (ov == logit && oe < myE)) ? 1 : 0; }
        float tv[4]; int te[4];
#pragma unroll
        for (int k = 0; k < 4; ++k) { const unsigned long long mk = __builtin_amdgcn_ballot_w64(rank == k); const int src = __builtin_ctzll(mk); tv[k] = __builtin_bit_cast(float, __builtin_amdgcn_readlane(__builtin_bit_cast(int, logit), src)); te[k] = src >> 1; }
        const float e1 = __expf(tv[1] - tv[0]), e2 = __expf(tv[2] - tv[0]), e3 = __expf(tv[3] - tv[0]); const float invs = 1.0f / (1.0f + e1 + e2 + e3);
        {   const int k = F.lane & 3;
            const int ek = k == 0 ? te[0] : k == 1 ? te[1] : k == 2 ? te[2] : te[3];
            const float wk = (k == 0 ? 1.0f : k == 1 ? e1 : k == 2 ? e2 : e3) * invs;
            if ((F.lane >> 2) == npend) { pend_e = ek; pend_w = wk; pend_a = t * 4 + k; }
            ++npend; }
    }
    __syncthreads();
    if (F.tid < 32) lcnt[F.tid] = 0u;
    __syncthreads();
    unsigned lslot = 0u; const bool have = (F.lane >> 2) < npend;
    if (have) lslot = __hip_atomic_fetch_add(lcnt + pend_e, 1u, __ATOMIC_RELAXED, __HIP_MEMORY_SCOPE_WORKGROUP);
    __syncthreads();
    if (F.tid < 32) { const unsigned c = lcnt[F.tid]; lbase[F.tid] = c ? __hip_atomic_fetch_add(CNT + F.tid * 64, c, __ATOMIC_RELAXED, __HIP_MEMORY_SCOPE_AGENT) : 0u; }
    __syncthreads();
    if (have) { const unsigned slot = lbase[pend_e] + lslot; LIST[(size_t)pend_e * T + slot] = pend_a; AW[pend_a] = pend_w; }
    }
    __syncthreads();
}
__device__ __forceinline__ void moe_tables(Frame& F, int l) {
    LAS int* cnt = (LAS int*)(F.lds + MOE_OFF); LAS int* toff = cnt + 32;
    const unsigned* CNT = (const unsigned*)(F.ws + WS_CTL) + CW_CNT + l * 32 * 64;
    __syncthreads();
    if (F.tid < 32) cnt[F.tid] = (int)__hip_atomic_load(CNT + F.tid * 64, __ATOMIC_RELAXED, __HIP_MEMORY_SCOPE_AGENT);
    __syncthreads();
    if (F.tid == 0) { int s = 0; for (int e = 0; e < 32; ++e) { toff[e] = s; s += (cnt[e] + 255) >> 8; } toff[32] = s; }
    __syncthreads();
}

constexpr int NPH = 11, PH_FINAL = 1 + DEPTH * NPH, PH_TOTAL = PH_FINAL + 1;
__global__ void __launch_bounds__(NWAVES * 64, 2) fwd_kernel(Args args) {
    extern __shared__ __attribute__((aligned(16))) unsigned char lds_raw[];
    Frame F;
    F.lds = (LAS unsigned char*)lds_raw; F.ws = args.ws; F.tid = threadIdx.x; F.lane = F.tid & 63; F.wave = __builtin_amdgcn_readfirstlane(F.tid >> 6); F.G = gridDim.x; F.bid = blockIdx.x; F.in = args.in;
    for (int u = F.tid; u < (LDS_BYTES - LDSCTL_OFF) / 4; u += NWAVES * 64) ((LAS unsigned*)(F.lds + LDSCTL_OFF))[u] = 0u;
    __syncthreads();
    const int lo = args.ph_lo, hi = args.ph_hi;
    const unsigned long long tk0_ = (TIME_KIND == 98) ? __builtin_amdgcn_s_memrealtime() : 0ull;
    XcdBarrier bar; bar.bar = (unsigned*)(F.ws + WS_CTL) + CW_BAR; bar.x = 0; bar.st = nullptr;
    if (hi - lo > 1) bar = xcd_barrier_post((unsigned*)(F.ws + WS_CTL) + CW_BAR, (volatile LAS unsigned*)(F.lds + MISC_OFF) + 8);
#define IN(k) (lo <= (k) && (k) < hi)
#define PROJ ((bf16*)(ws + WS_PROJ))
#define SEAM(k) do { if (IN(k) && IN((k) + 1)) xcd_barrier(bar); } while (0)
#define TSTART(kind) unsigned long long t0_ = (TIME_KIND == (kind) || TIME_KIND == 99) ? __builtin_amdgcn_s_memrealtime() : 0ull
#define TSTALL(kind) do { if (TIME_KIND == (kind) || TIME_KIND == 99) { const unsigned long long t1_ = __builtin_amdgcn_s_memrealtime(); const unsigned long long dt_ = t1_ - t0_; while (__builtin_amdgcn_s_memrealtime() - t1_ < dt_) __builtin_amdgcn_s_sleep(8); } } while (0)
    unsigned char* ws = F.ws;
#define PHASE_ENTER() do { unsigned char* w_ = args.ws; asm volatile("" : "+s"(w_)); F.ws = w_; ws = w_; int t_ = threadIdx.x; asm volatile("" : "+v"(t_)); F.tid = t_; F.lane = t_ & 63; F.wave = __builtin_amdgcn_readfirstlane(t_ >> 6); } while (0)
    if (EN(0) && IN(0)) { PHASE_ENTER(); TSTART(0); REPS(0) { p_prologue(F); } SEAM(0); TSTALL(0); }
    for (int l = 0; l < DEPTH; ++l) {
        const int pb = 1 + l * NPH;
        if (EN(1) && IN(pb + 0)) { PHASE_ENTER(); TSTART(1); if (REP_KIND == 1) p_norm_mix(F, l, false, nullptr, true); p_norm_mix(F, l, false, nullptr); SEAM(pb + 0); TSTALL(1); }
        if (EN(2) && IN(pb + 1)) { PHASE_ENTER(); TSTART(2);
            REPS(2) {
            { pg8::DenseOrder S; S.init(T, NPROJ, F.G, F.bid, ws + WS_HB, 1024, (bf16*)wl(ws, l, WL_IN) + (size_t)NHT * 1024, 1024);
              EpiProj E{PROJ};
              pg8::gemm_phase(F.lds, 1024, S, E); }
            { int z = 0; asm volatile("" : "+s"(z)); pg8::DenseOrder S; S.init(NHT, T, F.G, (F.bid + 64 + z) % F.G, wl(ws, l, WL_IN) + z, 1024, ws + WS_HB + z, 1024);
              EpiHT E{(bf16*)(ws + WS_HT)};
              pg8::gemm_phase(F.lds, 1024, S, E); }
            }
            SEAM(pb + 1); TSTALL(2);
        }
        if (EN(3) && IN(pb + 2)) { PHASE_ENTER(); TSTART(3); REPS(3) { p_mla_prep(F); } SEAM(pb + 2); TSTALL(3); }
        if (EN(4) && IN(pb + 3)) { PHASE_ENTER(); TSTART(4);
#ifndef SUBMASK
#define SUBMASK 7
#endif
            REPS(4) {
            if (SUBMASK & 1) { pg8::DenseOrder S; S.init(T, 768, F.G, F.bid, PROJ + PCQ, NPROJ, wl(ws, l, WL_Q), 384);
              EpiQ E{(bf16*)(ws + WS_Q), (const float*)(ws + WS_RSQ), (const float*)(ws + WS_COS), (const float*)(ws + WS_SIN)};
              pg8::gemm_phase(F.lds, 384, S, E); }
            if (SUBMASK & 2) { int z = 0; asm volatile("" : "+s"(z)); pg8::DenseOrder S; S.init(T, 512, F.G, (F.bid + 64 + z) % F.G, PROJ + PCKV + z, NPROJ, wl(ws, l, WL_K) + z, 256);
              EpiK E{(bf16*)(ws + WS_K), (const float*)(ws + WS_RSKV)};
              pg8::gemm_phase(F.lds, 256, S, E); }
            if (SUBMASK & 4) { int z = 0; asm volatile("" : "+s"(z)); pg8::DenseOrder S; S.init(512, T, F.G, (F.bid + 192 + z) % F.G, wl(ws, l, WL_V) + z, 256, PROJ + PCKV + z, NPROJ);
              EpiV E{(bf16*)(ws + WS_VT), (const float*)(ws + WS_RSKV)};
              pg8::gemm_phase(F.lds, 256, S, E); }
            }
            SEAM(pb + 3); TSTALL(4);
        }
        if (EN(5) && IN(pb + 4)) { PHASE_ENTER(); TSTART(5);
            REPS(5) {
            if (rep_ == 0 || (REP_SUB & 1)) for (int u = F.bid; u < 128 * SCAN_REP; u += F.G) scan_unit2(F, l, u & 127);
            if (rep_ == 0 || (REP_SUB & 2)) {
                unsigned* qctr = (unsigned*)(ws + WS_CTL) + CW_Q + (l * 2 + rep_) * 64; volatile LAS unsigned* misc = (volatile LAS unsigned*)(F.lds + MISC_OFF);
                for (;;) { __syncthreads(); if (F.tid == 0) misc[0] = __hip_atomic_fetch_add(qctr, 1u, __ATOMIC_RELAXED, __HIP_MEMORY_SCOPE_AGENT); __syncthreads();
                    const int a = (int)misc[0]; if (a >= 512 * ATTN_REP) break; attn_unit(F, (a & 511) >> 3, (a & 7) * 256); }
            }
            }
            SEAM(pb + 4); TSTALL(5);
        }
        if (EN(6) && IN(pb + 5)) { PHASE_ENTER(); TSTART(6); REPS(6) { p_hgrn_post(F, l); } SEAM(pb + 5); TSTALL(6); }
        if (EN(7) && IN(pb + 6)) { PHASE_ENTER(); TSTART(7);
            REPS(7) {
            { pg8::DenseOrder S; S.init(T, 1024, F.G, F.bid, ws + WS_HA, 1024, wl(ws, l, WL_OUT), 1024);
              EpiOut E{(bf16*)(ws + WS_Y), PROJ};
              pg8::gemm_phase(F.lds, 1024, S, E); }
            }
            SEAM(pb + 6); TSTALL(7);
        }
        if (EN(8) && IN(pb + 7)) { PHASE_ENTER(); TSTART(8);
            pg8::DenseOrder S; S.init(T, 1024, F.G, F.bid, ws + WS_Y, 1024, wl(ws, l, WL_O), 1024);
            if (REP_KIND == 8) { EpiWo E2{(bf16*)(ws + WS_ACT), (const float*)(ws + WS_MOD) + (size_t)l * 8 * 6144 + 2 * 1024}; pg8::gemm_phase(F.lds, 1024, S, E2); }
            EpiWo E{(bf16*)(ws + WS_X), (const float*)(ws + WS_MOD) + (size_t)l * 8 * 6144 + 2 * 1024};
            pg8::gemm_phase(F.lds, 1024, S, E);
            if (REP_KIND == 13) { for (int q = 0; q < 10; ++q) xcd_barrier(bar); }
            SEAM(pb + 7); TSTALL(8);
        }
        if (EN(9) && IN(pb + 8)) { PHASE_ENTER(); TSTART(9); if (REP_KIND == 9) p_router(F, l, true); p_router(F, l); SEAM(pb + 8); TSTALL(9); }
        if (EN(10) && IN(pb + 9)) { PHASE_ENTER(); TSTART(10);
            moe_tables(F, l);
            pg8::MoeOrder<true> S; S.cnt = (const LAS int*)(F.lds + MOE_OFF); S.toff = S.cnt + 32; S.NT = 8; S.G = F.G; S.c = F.bid; S.Abase = (const char*)(ws + WS_HB); S.Bbase = (const char*)wl(ws, l, WL_GU);
            S.b_expert_bytes = (size_t)2048 * 1024 * 2; S.list = (const int*)(ws + WS_LIST); S.lda = 1024; S.ldb = 1024;
            EpiGU E{(bf16*)(ws + WS_ACT), F.in[20] + (size_t)l * 32 * 2048};
            REPS(10) { pg8::gemm_phase(F.lds, 1024, S, E); }
            SEAM(pb + 9); TSTALL(10);
        }
        if (EN(11) && IN(pb + 10)) { PHASE_ENTER(); TSTART(11);
            moe_tables(F, l);
            pg8::MoeOrder<false> S; S.cnt = (const LAS int*)(F.lds + MOE_OFF); S.toff = S.cnt + 32; S.NT = 4; S.G = F.G; S.c = F.bid; S.Abase = (const char*)(ws + WS_ACT); S.Bbase = (const char*)wl(ws, l, WL_DN);
            S.b_expert_bytes = (size_t)1024 * 1024 * 2; S.list = (const int*)(ws + WS_LIST); S.lda = 1024; S.ldb = 1024;
            EpiDown E{ws + WS_YR, F.in[22] + (size_t)l * 32 * 1024, (const int*)(ws + WS_LIST), (const float*)(ws + WS_AW)};
            REPS(11) { pg8::gemm_phase(F.lds, 1024, S, E); }
            SEAM(pb + 10); TSTALL(11);
        }
    }
    if (EN(12) && IN(PH_FINAL)) { PHASE_ENTER(); p_norm_mix(F, DEPTH, true, args.out); }
    if (TIME_KIND == 98 && F.bid == 0) { const unsigned long long t1_ = __builtin_amdgcn_s_memrealtime(); const unsigned long long dt_ = t1_ - tk0_; while (__builtin_amdgcn_s_memrealtime() - t1_ < dt_) __builtin_amdgcn_s_sleep(8); }
#undef IN
#undef SEAM
#undef PROJ
#undef PHASE_ENTER
}

extern "C" void kernel_launch(void* const* d_in, const int* in_sizes, int n_in, void* d_out, int out_size, void* d_ws, size_t ws_size, hipStream_t stream) {
    static int grid = 0;
    if (grid == 0) {
        if (n_in != 24 || in_sizes[0] != T * D || out_size != T * D || ws_size < WS_END) { fprintf(stderr, "kernel_launch: unexpected problem (n_in %d, in0 %d, out %d, ws %zu, need %zu)\n", n_in, n_in > 0 ? in_sizes[0] : -1, out_size, ws_size, (size_t)WS_END); grid = -1; return; }
        int dev = 0, cus = 0, per_cu = 0;
        if (hipGetDevice(&dev) != hipSuccess || hipDeviceGetAttribute(&cus, hipDeviceAttributeMultiprocessorCount, dev) != hipSuccess) { grid = -1; return; }
        if (hipFuncSetAttribute((const void*)fwd_kernel, hipFuncAttributeMaxDynamicSharedMemorySize, LDS_BYTES) != hipSuccess) { fprintf(stderr, "kernel_launch: hipFuncSetAttribute failed\n"); grid = -1; return; }
        if (hipOccupancyMaxActiveBlocksPerMultiprocessor(&per_cu, (const void*)fwd_kernel, NWAVES * 64, LDS_BYTES) != hipSuccess || per_cu < 1) { fprintf(stderr, "kernel_launch: occupancy query says %d\n", per_cu); (void)hipGetLastError(); }
        grid = cus - (cus % 8);
        if (grid < 64) { fprintf(stderr, "kernel_launch: only %d CUs\n", cus); grid = -1; return; }
    }
    if (grid < 0) return;
    if (hipMemsetAsync((char*)d_ws + WS_CTL, 0, CTL_ZERO_BYTES, stream) != hipSuccess) return;
    Args a{};
    for (int i = 0; i < 24; ++i) a.in[i] = (const float*)d_in[i];
    a.out = (float*)d_out; a.ws = (unsigned char*)d_ws;
#if MK_PER_PHASE
    for (int ph = 0; ph < PH_TOTAL; ++ph) { a.ph_lo = ph; a.ph_hi = ph + 1; hipLaunchKernelGGL(fwd_kernel, dim3(grid), dim3(NWAVES * 64), LDS_BYTES, stream, a); }
#else
    a.ph_lo = 0; a.ph_hi = PH_TOTAL; hipLaunchKernelGGL(fwd_kernel, dim3(grid), dim3(NWAVES * 64), LDS_BYTES, stream, a);
#endif
}
```

```cpp
#include <hip/hip_runtime.h>
#include <cstdio>
#include <cstdint>

#ifndef RT_DEBUG
#define RT_DEBUG 0
#endif
#ifndef PHASE_MASK
#define PHASE_MASK 0xFFFFu
#endif
#define EN(k) (((PHASE_MASK) >> (k)) & 1u)
#ifndef REP_KIND
#define REP_KIND -1
#endif
#ifndef REP_SUB
#define REP_SUB 3
#endif
#ifndef TIME_MASK
#define TIME_MASK 0xFFFF
#endif
#ifndef TIME_BLOCK
#define TIME_BLOCK 0
#endif
#ifndef TIME_KIND
#define TIME_KIND -1
#endif
#ifndef ATTN_REP
#define ATTN_REP 1
#endif
#ifndef SCAN_REP
#define SCAN_REP 1
#endif
#ifndef EPI_REP
#define EPI_REP 1
#endif
#define REPS(k) _Pragma("unroll 1") for (int rep_ = 0; rep_ < ((REP_KIND) == (k) ? 2 : 1); ++rep_)
#ifndef MK_PER_PHASE
#define MK_PER_PHASE 0
#endif

#define GAS __attribute__((address_space(1)))
#define LAS __attribute__((address_space(3)))
typedef unsigned short bf16;
typedef short bf16x8 __attribute__((ext_vector_type(8)));
typedef float f32x4 __attribute__((ext_vector_type(4)));
typedef float f32x2 __attribute__((ext_vector_type(2)));
typedef float f32x16 __attribute__((ext_vector_type(16)));
typedef unsigned u32x4 __attribute__((ext_vector_type(4)));
typedef unsigned u32x2 __attribute__((ext_vector_type(2)));
typedef __bf16 bfv2 __attribute__((ext_vector_type(2)));
__device__ __forceinline__ unsigned pk4_fp8(float a, float b, float c, float d) { unsigned w = 0u; w = __builtin_amdgcn_cvt_pk_fp8_f32(a, b, w, false); w = __builtin_amdgcn_cvt_pk_fp8_f32(c, d, w, true); return w; }
constexpr float YR_SCALE = 16.0f, YR_INV = 1.0f / 16.0f;

__device__ __forceinline__ unsigned pk2(float lo, float hi) { f32x2 v = {lo, hi}; bfv2 r = __builtin_convertvector(v, bfv2); return __builtin_bit_cast(unsigned, r); }
__device__ __forceinline__ float bf2f(unsigned short b) { return __uint_as_float(((unsigned)b) << 16); }
__device__ __forceinline__ float bflo(unsigned w) { return __uint_as_float(w << 16); }
__device__ __forceinline__ float bfhi(unsigned w) { return __uint_as_float(w & 0xffff0000u); }
__device__ __forceinline__ u32x4 pack8(f32x4 a, f32x4 b) { u32x4 w; w.x = pk2(a[0], a[1]); w.y = pk2(a[2], a[3]); w.z = pk2(b[0], b[1]); w.w = pk2(b[2], b[3]); return w; }
__device__ __forceinline__ void unpack8(u32x4 w, f32x4& a, f32x4& b) { a[0] = bflo(w.x); a[1] = bfhi(w.x); a[2] = bflo(w.y); a[3] = bfhi(w.y); b[0] = bflo(w.z); b[1] = bfhi(w.z); b[2] = bflo(w.w); b[3] = bfhi(w.w); }
__device__ __forceinline__ float sigmoidf_(float x) { return 1.0f / (1.0f + __expf(-x)); }
__device__ __forceinline__ float wave_sum(float v) {
#pragma unroll
    for (int o = 1; o < 64; o <<= 1) v += __shfl_xor(v, o);
    return v;
}
#define LDS_WAIT() asm volatile("s_waitcnt lgkmcnt(0)" ::: "memory")
#define VM_WAIT() asm volatile("s_waitcnt vmcnt(0)" ::: "memory")

#define XB_TMO      128
#define XB_XCNT(j)  (256  + 64 * (j))
#define XB_XSUB(j)  (1280 + 64 * (j))
#define XB_XGEN(j)  (2304 + 64 * (j))
#define XB_TOP      3328
#define XB_TOPGEN   3392
#define XCD_BAR_WORDS 3456
#define XB_SPIN_CAP (1u << 20)

__device__ __forceinline__ unsigned xb_ld(unsigned* p)              { return __hip_atomic_load(p, __ATOMIC_RELAXED, __HIP_MEMORY_SCOPE_AGENT); }
__device__ __forceinline__ unsigned xb_add(unsigned* p, unsigned v) { return __hip_atomic_fetch_add(p, v, __ATOMIC_RELAXED, __HIP_MEMORY_SCOPE_AGENT); }
__device__ __forceinline__ unsigned xb_xcc_id() { return (unsigned)__builtin_amdgcn_s_getreg((3 << 11) | 20) & 0xFu; }
#define XB_SPIN(cond, bar) do { unsigned _sp = 0; while (cond) { __builtin_amdgcn_s_sleep(1); \
    if ((++_sp & 255u) == 0u) { if (xb_ld(&(bar)[XB_TMO])) break; if (_sp > XB_SPIN_CAP) { atomicAdd(&(bar)[XB_TMO], 1u); break; } } } } while (0)

struct XcdBarrier { unsigned* bar; unsigned x; volatile LAS unsigned* st; };

__device__ __forceinline__ XcdBarrier xcd_barrier_post(unsigned* bar, volatile LAS unsigned* st) {
    XcdBarrier b; b.bar = bar; b.x = xb_xcc_id(); b.st = st;
    if (threadIdx.x == 0) (void)xb_add(&bar[XB_XCNT(b.x)], 1u);
    return b;
}
__device__ __forceinline__ void xcd_barrier_complete(unsigned* bar, unsigned x, unsigned& nloc, unsigned& nx) {
    const unsigned G = gridDim.x * gridDim.y * gridDim.z;
    unsigned sum, cnt, mine, sp = 0u;
    for (;;) {
        sum = 0u; cnt = 0u; mine = 0u;
#pragma unroll
        for (unsigned j = 0; j < 16; ++j) { const unsigned c = xb_ld(&bar[XB_XCNT(j)]); sum += c; cnt += (c > 0u) ? 1u : 0u; mine = (j == x) ? c : mine; }
        if (sum == G) break;
        __builtin_amdgcn_s_sleep(1);
        if ((++sp & 255u) == 0u) { if (xb_ld(&bar[XB_TMO])) break; if (sp > XB_SPIN_CAP) { atomicAdd(&bar[XB_TMO], 1u); break; } }
    }
    nloc = mine > 0u ? mine : 1u; nx = cnt > 0u ? cnt : 1u;
}
__device__ __forceinline__ void xcd_barrier(const XcdBarrier& b) {
    asm volatile("s_waitcnt vmcnt(0)" ::: "memory");
    __syncthreads();
    if (threadIdx.x == 0) {
        unsigned* bar = b.bar;
        __builtin_amdgcn_s_waitcnt(0);
        unsigned nloc = b.st[0], nx = b.st[1];
        if (nloc == 0u) { xcd_barrier_complete(bar, b.x, nloc, nx); b.st[0] = nloc; b.st[1] = nx; }
        const unsigned old = xb_add(&bar[XB_XSUB(b.x)], 1u);
        const unsigned gen = old / nloc;
        if (old + 1u == (gen + 1u) * nloc) {
            __builtin_amdgcn_fence(__ATOMIC_RELEASE, "agent");
            asm volatile("s_waitcnt vmcnt(0)" ::: "memory");
            const unsigned og = xb_add(&bar[XB_TOP], 1u);
            const unsigned tg = og / nx;
            if (og + 1u == (tg + 1u) * nx) xb_add(&bar[XB_TOPGEN], 1u);
            else XB_SPIN(xb_ld(&bar[XB_TOPGEN]) == tg, bar);
            __builtin_amdgcn_fence(__ATOMIC_ACQUIRE, "agent");
            xb_add(&bar[XB_XGEN(b.x)], 1u);
            asm volatile("s_waitcnt vmcnt(0)" ::: "memory");
        } else {
            XB_SPIN(xb_ld(&bar[XB_XGEN(b.x)]) == gen, bar);
            __builtin_amdgcn_fence(__ATOMIC_ACQUIRE, "agent");
            asm volatile("s_waitcnt vmcnt(0)" ::: "memory");
        }
    }
    __syncthreads();
}

constexpr int D = 1024, NB = 8, SEQ = 2048, T = NB * SEQ, DEPTH = 4;
constexpr int NPROJ = 3328;
constexpr int NHT = 2048;
constexpr int PGT = 0, PGA = 512, PGB = 1536, PCQ = 2560, PCKV = 2944, PKPE = 3200;
constexpr int HQ = 0, HFF = 512, HFB = 1024, HI = 1536;
constexpr int NE = 32, TOPK = 4, NASSIGN = T * TOPK, ACT_ROWS = NASSIGN + NE * 256;
constexpr float EPS = 1e-6f;
constexpr float QSCALE = 0.10206207261596575f * 1.4426950408889634f;

constexpr size_t MiB = 1u << 20;
constexpr size_t WS_CTL = 0, CTL_ZERO_BYTES = 1 * MiB;
constexpr size_t WS_MOD = 1 * MiB, WS_LB = 2 * MiB, WS_COS = 3 * MiB, WS_SIN = 4 * MiB, WS_RSQ = 5 * MiB, WS_RSKV = 5 * MiB + 65536, WS_AW = 6 * MiB, WS_LIST = 7 * MiB;
constexpr size_t WS_X = 16 * MiB, WS_HB = 80 * MiB, WS_PROJ = 112 * MiB, WS_HT = 216 * MiB, WS_Q = 280 * MiB, WS_K = 304 * MiB, WS_VT = 328 * MiB, WS_OF = 344 * MiB, WS_OB = 376 * MiB;
constexpr size_t WS_HA = 408 * MiB, WS_Y = 440 * MiB, WS_ACT = 472 * MiB, WS_YR = 616 * MiB, WS_W = 768 * MiB;
constexpr size_t WL_IN = 0, WL_Q = 11 * MiB, WL_K = 12 * MiB, WL_V = 12 * MiB + 256 * 1024, WL_OUT = 13 * MiB, WL_O = 15 * MiB, WL_GU = 17 * MiB, WL_DN = 145 * MiB, WL_STRIDE = 209 * MiB;
constexpr size_t WS_END = WS_W + DEPTH * WL_STRIDE;
static_assert((size_t)T * NPROJ * 2 <= WS_HT - WS_PROJ && (size_t)NB * NHT * SEQ * 2 <= WS_Q - WS_HT && (size_t)ACT_ROWS * 1024 * 2 <= WS_YR - WS_ACT && (size_t)NASSIGN * 1024 * 2 <= WS_W - WS_YR, "ws map");
constexpr int CW_BAR = 4096, CW_Q = 8192, CW_CNT = 16384;

constexpr int RING_BYTES = 131072;
constexpr int LDSCTL_OFF = 139264, MISC_OFF = LDSCTL_OFF + 320, MOE_OFF = LDSCTL_OFF + 1024;
constexpr int LDS_BYTES = 155648;
constexpr int RT_G_OFF = 143360, RT_S_OFF = 147456;
constexpr int NWAVES = 8;

namespace pg8 {
constexpr int BM = 256, BK = 64, HALF = 128, HTB = HALF * BK * 2, NXCD = 8, WGM = 8;
__device__ __forceinline__ int lds_byte(int r, int c) { const int st = (r >> 4) * 2 + (c >> 5), rr = r & 15, cc = c & 31, ob = rr * 64 + cc * 2; return st * 1024 + (ob ^ (((ob >> 9) & 1) << 5)); }
__device__ __forceinline__ void stage_rc(int b, int& R, int& C) { const int st = b / 1024, sb = b % 1024, swz = sb ^ (((sb >> 9) & 1) << 5); R = (st >> 1) * 16 + swz / 64; C = (st & 1) * 32 + (swz % 64) / 2; }
__device__ __forceinline__ int perm32(int rho) { const int n = rho >> 4, i = rho & 15; return 8 * (i >> 2) + 4 * n + (i & 3); }

struct Unit { const char* A; const char* B; int pm, pn, e, rowbase, mrows; };

struct DenseOrder {
    static constexpr bool GATHER_A = false;
    int nM, nN, nwg, G, c; const char* Abase; const char* Bbase; int lda, ldb;
    __device__ __forceinline__ void init(int M, int N, int G_, int c_, const void* A, int lda_, const void* B, int ldb_) { nM = M / BM; nN = N / BM; nwg = nM * nN; G = G_; c = c_; Abase = (const char*)A; Bbase = (const char*)B; lda = lda_; ldb = ldb_; }
    __device__ __forceinline__ bool next(int i, Unit& u) const {
        const long L = (long)i * G + c; if (L >= nwg) return false;
        int wgid = (int)L; { const int q = nwg / NXCD, r = nwg % NXCD, xcd = wgid % NXCD, off = wgid / NXCD; wgid = (xcd < r ? xcd * (q + 1) : r * (q + 1) + (xcd - r) * q) + off; }
        const int nig = WGM * nN, gid = wgid / nig, fm = gid * WGM, gsz = (nM - fm) < WGM ? (nM - fm) : WGM;
        u.pm = fm + ((wgid % nig) % gsz); u.pn = (wgid % nig) / gsz; u.e = 0; u.rowbase = 0; u.mrows = 256;
        u.A = Abase + (size_t)u.pm * 256 * lda * 2; u.B = Bbase + (size_t)u.pn * 256 * ldb * 2; return true;
    }
    __device__ __forceinline__ void aoff(const Unit&, const int (&R)[2], const int (&C)[2], unsigned (&v)[2][2]) const {
#pragma unroll
        for (int h = 0; h < 2; ++h)
#pragma unroll
            for (int i = 0; i < 2; ++i) v[h][i] = (unsigned)((128 * h + R[i]) * lda + C[i]) * 2u;
    }
};
template <bool GATHER> struct MoeOrder {
    static constexpr bool GATHER_A = GATHER;
    const LAS int* toff; const LAS int* cnt; int NT, G, c; const char* Abase; const char* Bbase; size_t b_expert_bytes; const int* list; int lda, ldb;
    __device__ __forceinline__ bool next(int i, Unit& u) const {
        const int spx = G >> 3, rpx = spx / NT, xcd = c & 7, slot = c >> 3;
        if (slot >= rpx * NT) return false;
        const int R = (i * 8 + xcd) * rpx + slot / NT; if (R >= toff[NE]) return false;
        int e = 0; while (toff[e + 1] <= R) ++e;
        u.e = e; u.pm = R - toff[e]; u.pn = slot % NT; u.rowbase = R * 256; u.mrows = cnt[e] - u.pm * 256;
        u.A = GATHER ? Abase : Abase + (size_t)u.rowbase * lda * 2; u.B = Bbase + (size_t)e * b_expert_bytes + (size_t)u.pn * 256 * ldb * 2; return true;
    }
    __device__ __forceinline__ void aoff(const Unit& u, const int (&R)[2], const int (&C)[2], unsigned (&v)[2][2]) const {
#pragma unroll
        for (int h = 0; h < 2; ++h)
#pragma unroll
            for (int i = 0; i < 2; ++i) {
                if (GATHER) { const int rl = 128 * h + R[i]; const int a = list[(size_t)u.e * T + u.pm * 256 + (rl < u.mrows ? rl : 0)]; v[h][i] = (unsigned)((a >> 2) * lda + C[i]) * 2u; }
                else v[h][i] = (unsigned)((128 * h + R[i]) * lda + C[i]) * 2u;
            }
    }
};

template <class E, class = void> struct has_mid { static constexpr bool value = false; };
template <class E> struct has_mid<E, decltype((void)E::HAS_MID)> { static constexpr bool value = true; };
template <class Epi, class Sched>
__device__ __forceinline__ void gemm_phase(LAS unsigned char* lds, const int K, const Sched& S, const Epi& E) {
    int tid_ = threadIdx.x; asm volatile("" : "+v"(tid_));
    const int tid = tid_, wid = __builtin_amdgcn_readfirstlane(tid >> 6), lane = tid & 63, wr = wid >> 2, wc = wid & 3, fr = lane & 15, fq = lane >> 4;
    int nt_ = K / BK; asm volatile("" : "+s"(nt_));
    const int nt = nt_;
    int sR[2], sC[2]; unsigned voffB[2];
#pragma unroll
    for (int i = 0; i < 2; ++i) { stage_rc(tid * 16 + i * 8192, sR[i], sC[i]); const int Rb = (sR[i] & ~31) + perm32(sR[i] & 31); voffB[i] = (unsigned)(Rb * S.ldb + sC[i]) * 2u; }
    constexpr bool GA = Sched::GATHER_A;
    unsigned voffA[2];
#pragma unroll
    for (int i = 0; i < 2; ++i) voffA[i] = (unsigned)(sR[i] * S.lda + sC[i]) * 2u;
    const size_t kstep = (size_t)(BK * 2);
    const size_t hstepB = (size_t)HALF * S.ldb * 2, hstepA = (size_t)HALF * S.lda * 2;
    const unsigned ldsw = (unsigned)wid * 1024u;
    const unsigned ldsbase = (unsigned)__builtin_amdgcn_readfirstlane((int)((unsigned)(size_t)lds + ldsw));
    const int aoff = lds_byte(wr * 64 + fr, fq * 8), boff = lds_byte(wc * 32 + fr, fq * 8);
#define PG8_SA(b, h) (((b) * 2 + (h)) * HTB)
#define PG8_SB(b, h) ((4 + (b) * 2 + (h)) * HTB)
#define PG8_DMA2(ldsaddr, gbase, v0_, v1_) do { unsigned keep_; \
        asm volatile("s_mov_b32 %0, m0\n\ts_mov_b32 m0, %4\n\ts_nop 0\n\tglobal_load_lds_dwordx4 %1, %3\n\ts_add_u32 m0, %4, 0x2000\n\ts_nop 0\n\tglobal_load_lds_dwordx4 %2, %3\n\ts_mov_b32 m0, %0" \
                     : "=&s"(keep_) : "v"(v0_), "v"(v1_), "s"(gbase), "s"(ldsaddr) : "memory", "scc"); } while (0)
#define PG8_STAGE(bufoff, gbase, voff) PG8_DMA2(ldsbase + (unsigned)(bufoff), (const char*)(gbase), (voff)[0], (voff)[1])
#define PG8_STAGEA(bufoff, gbase, h, nx) do { if constexpr (GA) { PG8_DMA2(ldsbase + (unsigned)(bufoff), (const char*)(gbase), ((nx) ? nvA[h][0] : vA[h][0]), ((nx) ? nvA[h][1] : vA[h][1])); } \
        else { PG8_DMA2(ldsbase + (unsigned)(bufoff), (const char*)(gbase) + (size_t)(h) * hstepA, voffA[0], voffA[1]); } } while (0)
#define PG8_LDA(dst, b, h) do { _Pragma("unroll") for (int m = 0; m < 4; ++m) _Pragma("unroll") for (int k = 0; k < 2; ++k) dst[m][k] = *(const LAS bf16x8*)(lds + PG8_SA(b, h) + aoff + m * 2048 + k * 1024); } while (0)
#define PG8_LDB(dst, b, h) do { _Pragma("unroll") for (int n = 0; n < 2; ++n) _Pragma("unroll") for (int k = 0; k < 2; ++k) dst[n][k] = *(const LAS bf16x8*)(lds + PG8_SB(b, h) + boff + n * 2048 + k * 1024); } while (0)
#define PG8_MMA(ai, bj, At, Bt) do { __builtin_amdgcn_s_setprio(1); _Pragma("unroll") for (int m = 0; m < 4; ++m) _Pragma("unroll") for (int n = 0; n < 2; ++n) _Pragma("unroll") for (int k = 0; k < 2; ++k) \
        acc[ai][bj][m][n] = __builtin_amdgcn_mfma_f32_16x16x32_bf16(Bt[n][k], At[m][k], acc[ai][bj][m][n], 0, 0, 0); __builtin_amdgcn_s_setprio(0); } while (0)
#define PG8_WAIT_V(n) asm volatile("s_waitcnt vmcnt(" #n ")" ::: "memory")
#define PG8_WAIT_L(n) asm volatile("s_waitcnt lgkmcnt(" #n ")" ::: "memory")
#define PG8_BAR __builtin_amdgcn_s_barrier()
#define PG8_SCHED __builtin_amdgcn_sched_barrier(0)
    Unit cur, nxt; int ui = 0;
    if (!S.next(0, cur)) return;
    f32x4 acc[2][2][4][2];
#pragma unroll
    for (int a = 0; a < 2; ++a)
#pragma unroll
        for (int b = 0; b < 2; ++b)
#pragma unroll
            for (int m = 0; m < 4; ++m)
#pragma unroll
                for (int n = 0; n < 2; ++n) acc[a][b][m][n] = (f32x4){0.f, 0.f, 0.f, 0.f};
    bf16x8 At[4][2], B0[2][2], B1[2][2];
    unsigned vA[2][2], nvA[2][2];
    if constexpr (GA) { S.aoff(cur, sR, sC, vA); }
    const char* cA = cur.A; const char* cB = cur.B;
    PG8_STAGE(PG8_SB(0, 0), cB, voffB); PG8_STAGE(PG8_SB(0, 1), cB + hstepB, voffB); PG8_STAGEA(PG8_SA(0, 0), cA, 0, false); PG8_STAGEA(PG8_SA(0, 1), cA, 1, false);
    if (wr == 1) PG8_BAR;
    PG8_WAIT_V(2); PG8_BAR;
    PG8_STAGE(PG8_SB(1, 0), cB + kstep, voffB); PG8_STAGEA(PG8_SA(1, 0), cA + kstep, 0, false); PG8_STAGE(PG8_SB(1, 1), cB + hstepB + kstep, voffB);
    PG8_WAIT_V(6); PG8_BAR;
    for (;;) {
        const bool has_next = S.next(ui + 1, nxt);
        const char* nA = has_next ? nxt.A : cA; const char* nB = has_next ? nxt.B : cB;
        if constexpr (GA) {
            if (has_next) S.aoff(nxt, sR, sC, nvA);
            else {
#pragma unroll
                for (int h = 0; h < 2; ++h)
#pragma unroll
                    for (int i = 0; i < 2; ++i) nvA[h][i] = vA[h][i]; } }
#pragma unroll 1
        for (int t = 0; t < nt; t += 2) {
            const bool last = (t == nt - 2);
            if constexpr (has_mid<Epi>::value) { if (t == Epi::MID_T) E.mid(acc, cur, wr, wc, fr, fq); }
            const char* a1 = cA + (size_t)(t + 1) * kstep;
            const char* a2 = last ? nA : cA + (size_t)(t + 2) * kstep; const char* b2 = last ? nB : cB + (size_t)(t + 2) * kstep;
            const char* a3 = a2 + kstep; const char* b3 = b2 + kstep;
            PG8_LDB(B0, 0, 0); PG8_LDB(B1, 0, 1); PG8_SCHED; PG8_LDA(At, 0, 0); PG8_STAGEA(PG8_SA(1, 1), a1, 1, false);
            PG8_WAIT_V(8); PG8_WAIT_L(0); PG8_BAR; PG8_MMA(0, 0, At, B0); PG8_MMA(0, 1, At, B1); PG8_BAR; PG8_SCHED;
            PG8_LDA(At, 0, 1); PG8_STAGE(PG8_SB(0, 0), b2, voffB); PG8_STAGE(PG8_SB(0, 1), b2 + hstepB, voffB); PG8_STAGEA(PG8_SA(0, 0), a2, 0, last);
            PG8_WAIT_V(8); PG8_WAIT_L(0); PG8_BAR; PG8_MMA(1, 0, At, B0); PG8_MMA(1, 1, At, B1); PG8_BAR; PG8_SCHED;
            PG8_LDB(B0, 1, 0); PG8_LDB(B1, 1, 1); PG8_SCHED; PG8_LDA(At, 1, 0); PG8_STAGEA(PG8_SA(0, 1), a2, 1, last);
            PG8_WAIT_V(8); PG8_WAIT_L(0); PG8_BAR; PG8_MMA(0, 0, At, B0); PG8_MMA(0, 1, At, B1); PG8_BAR; PG8_SCHED;
            PG8_LDA(At, 1, 1); PG8_STAGE(PG8_SB(1, 0), b3, voffB); PG8_STAGE(PG8_SB(1, 1), b3 + hstepB, voffB); PG8_STAGEA(PG8_SA(1, 0), a3, 0, last);
            PG8_WAIT_V(8); PG8_WAIT_L(0); PG8_BAR; PG8_MMA(1, 0, At, B0); PG8_MMA(1, 1, At, B1); PG8_BAR; PG8_SCHED;
        }
        if (wr == 0) PG8_BAR;
        E(acc, cur, wr, wc, fr, fq);
        if constexpr (EPI_REP > 1 && Epi::IDEMPOTENT) { asm volatile("" ::: "memory"); E(acc, cur, wr, wc, fr, fq); }
        if (!has_next) break;
#pragma unroll
        for (int a = 0; a < 2; ++a)
#pragma unroll
            for (int b = 0; b < 2; ++b)
#pragma unroll
                for (int m = 0; m < 4; ++m)
#pragma unroll
                    for (int n = 0; n < 2; ++n) acc[a][b][m][n] = (f32x4){0.f, 0.f, 0.f, 0.f};
        cur = nxt; cA = nA; cB = nB; ++ui;
        if constexpr (GA) {
#pragma unroll
            for (int h = 0; h < 2; ++h)
#pragma unroll
                for (int i = 0; i < 2; ++i) vA[h][i] = nvA[h][i]; }
        if (wr == 1) PG8_BAR;
    }
    PG8_WAIT_V(0);
    PG8_BAR;
#undef PG8_SA
#undef PG8_SB
#undef PG8_STAGE
#undef PG8_STAGEA
#undef PG8_DMA2
#undef PG8_LDA
#undef PG8_LDB
#undef PG8_MMA
#undef PG8_WAIT_V
#undef PG8_WAIT_L
#undef PG8_BAR
#undef PG8_SCHED
}
}
using pg8::Unit;
typedef const f32x4 (&AccRef)[2][2][4][2];

struct Args {
    const float* in[24]; float* out; unsigned char* ws; int ph_lo, ph_hi;
};
struct Frame {
    LAS unsigned char* lds; unsigned char* ws; int tid, lane, wave, G, bid;
    const float* const* in;
};
__device__ __forceinline__ unsigned char* wl(unsigned char* ws, int l, size_t off) { return ws + WS_W + (size_t)l * WL_STRIDE + off; }

#define EPI_LOOP_BEGIN _Pragma("unroll") for (int ai = 0; ai < 2; ++ai) _Pragma("unroll") for (int m = 0; m < 4; ++m) { const int rl = ai * 128 + wr * 64 + m * 16 + fr; _Pragma("unroll") for (int bj = 0; bj < 2; ++bj) { const int cl = bj * 128 + wc * 32 + 8 * fq; const f32x4 v0 = acc[ai][bj][m][0], v1 = acc[ai][bj][m][1];
#define EPI_LOOP_END } asm volatile("" ::: "memory"); }

struct EpiProj {
    static constexpr bool IDEMPOTENT = (EPI_REP > 2);
    bf16* O;
    __device__ __forceinline__ void operator()(AccRef acc, const Unit& u, int wr, int wc, int fr, int fq) const {
        EPI_LOOP_BEGIN
            *(u32x4*)(O + (size_t)(u.pm * 256 + rl) * NPROJ + u.pn * 256 + cl) = pack8(v0, v1);
        EPI_LOOP_END
    }
};
struct EpiHT {
    static constexpr bool IDEMPOTENT = (EPI_REP > 2);
    bf16* HT;
    __device__ __forceinline__ void operator()(AccRef acc, const Unit& u, int wr, int wc, int fr, int fq) const {
        const int seg = u.pm >> 1;
        EPI_LOOP_BEGIN
            const int f = u.pm * 256 + rl, t0 = u.pn * 256 + cl, b = t0 >> 11, s = t0 & 2047;
            f32x4 a = v0, d = v1;
            if (seg == 0) {
#pragma unroll
                for (int j = 0; j < 4; ++j) { a[j] = a[j] * __builtin_amdgcn_rcpf(1.0f + __builtin_amdgcn_exp2f(-1.4426950408889634f * a[j])); d[j] = d[j] * __builtin_amdgcn_rcpf(1.0f + __builtin_amdgcn_exp2f(-1.4426950408889634f * d[j])); }
            } else if (seg < 3) {
#pragma unroll
                for (int j = 0; j < 4; ++j) { a[j] = __builtin_amdgcn_rcpf(1.0f + __builtin_amdgcn_exp2f(1.4426950408889634f * a[j])); d[j] = __builtin_amdgcn_rcpf(1.0f + __builtin_amdgcn_exp2f(1.4426950408889634f * d[j])); }
            }
            *(u32x4*)(HT + ((size_t)b * NHT + f) * SEQ + s) = pack8(a, d);
        EPI_LOOP_END
    }
};
struct EpiQ {
    static constexpr bool IDEMPOTENT = (EPI_REP > 2);
    bf16* Q; const float* rsq; const float* cs; const float* sn;
    __device__ __forceinline__ void operator()(AccRef acc, const Unit& u, int wr, int wc, int fr, int fq) const {
        EPI_LOOP_BEGIN
            const int t = u.pm * 256 + rl, c0 = u.pn * 256 + cl, head = c0 / 96, w = c0 - head * 96, b = t >> 11, s = t & 2047;
            const float sc = rsq[t] * QSCALE;
            bf16* qp = Q + ((size_t)(b * 8 + head) * SEQ + s) * 96;
            f32x4 a = v0 * sc, d = v1 * sc;
            if (w < 64) { *(u32x4*)(qp + w) = pack8(a, d); }
            else { const int g = (w - 64) >> 3; const f32x4 co = *(const f32x4*)(cs + (size_t)t * 16 + 4 * g), si = *(const f32x4*)(sn + (size_t)t * 16 + 4 * g);
                const f32x4 o1 = a * co - d * si, o2 = d * co + a * si;
                u32x2 w1, w2; w1.x = pk2(o1[0], o1[1]); w1.y = pk2(o1[2], o1[3]); w2.x = pk2(o2[0], o2[1]); w2.y = pk2(o2[2], o2[3]);
                *(u32x2*)(qp + 64 + 4 * g) = w1; *(u32x2*)(qp + 80 + 4 * g) = w2; }
        EPI_LOOP_END
    }
};
struct EpiK {
    static constexpr bool IDEMPOTENT = (EPI_REP > 2);
    bf16* Kb; const float* rskv;
    __device__ __forceinline__ void operator()(AccRef acc, const Unit& u, int wr, int wc, int fr, int fq) const {
        EPI_LOOP_BEGIN
            const int t = u.pm * 256 + rl, c0 = u.pn * 256 + cl, head = c0 >> 6, w = c0 & 63, b = t >> 11, s = t & 2047;
            const float sc = rskv[t];
            *(u32x4*)(Kb + ((size_t)(b * 8 + head) * SEQ + s) * 96 + w) = pack8(v0 * sc, v1 * sc);
        EPI_LOOP_END
    }
};
struct EpiV {
    static constexpr bool IDEMPOTENT = (EPI_REP > 2);
    bf16* VT; const float* rskv;
    __device__ __forceinline__ void operator()(AccRef acc, const Unit& u, int wr, int wc, int fr, int fq) const {
        EPI_LOOP_BEGIN
            const int f = u.pm * 256 + rl, t0 = u.pn * 256 + cl, b = t0 >> 11, s = t0 & 2047, head = f >> 6, dv = f & 63;
            const f32x4 r0 = *(const f32x4*)(rskv + t0), r1 = *(const f32x4*)(rskv + t0 + 4);
            *(u32x4*)(VT + ((size_t)(b * 8 + head) * 64 + dv) * SEQ + s) = pack8(v0 * r0, v1 * r1);
        EPI_LOOP_END
    }
};
struct EpiOut {
    static constexpr bool IDEMPOTENT = false; static constexpr bool HAS_MID = true; static constexpr int MID_T = 8;
    bf16* Y; const bf16* proj;
    __device__ __forceinline__ void mid(f32x4 (&acc)[2][2][4][2], const Unit& u, int wr, int wc, int fr, int fq) const {
        unsigned off0 = (unsigned)((u.pm * 256 + wr * 64 + fr) * NPROJ + u.pn * 256 + wc * 32 + 8 * fq) * 2u;
        asm volatile("" : "+v"(off0));
        const char* gp0 = (const char*)proj;
#pragma unroll
        for (int ai = 0; ai < 2; ++ai)
#pragma unroll
            for (int mp = 0; mp < 2; ++mp) {
                u32x4 ga[2][2], gb[2][2];
#pragma unroll
                for (int mm = 0; mm < 2; ++mm)
#pragma unroll
                    for (int bj = 0; bj < 2; ++bj) { const unsigned o = off0 + (unsigned)(((ai * 128 + (2 * mp + mm) * 16) * NPROJ + bj * 128) * 2); ga[mm][bj] = *(const u32x4*)(gp0 + o + PGA * 2); gb[mm][bj] = *(const u32x4*)(gp0 + o + PGB * 2); }
#pragma unroll
                for (int mm = 0; mm < 2; ++mm)
#pragma unroll
                    for (int bj = 0; bj < 2; ++bj) {
                        f32x4 a0, a1, b0, b1; unpack8(ga[mm][bj], a0, a1); unpack8(gb[mm][bj], b0, b1);
#pragma unroll
                        for (int j = 0; j < 4; ++j) {
                            a0[j] = (1.0f + __builtin_amdgcn_exp2f(-1.4426950408889634f * b0[j])) * __builtin_amdgcn_rcpf(1.0f + __builtin_amdgcn_exp2f(-1.4426950408889634f * a0[j]));
                            a1[j] = (1.0f + __builtin_amdgcn_exp2f(-1.4426950408889634f * b1[j])) * __builtin_amdgcn_rcpf(1.0f + __builtin_amdgcn_exp2f(-1.4426950408889634f * a1[j])); }
                        acc[ai][bj][2 * mp + mm][0] *= a0; acc[ai][bj][2 * mp + mm][1] *= a1;
                    }
                asm volatile("" ::: "memory");
            }
    }
    __device__ __forceinline__ void operator()(AccRef acc, const Unit& u, int wr, int wc, int fr, int fq) const {
        const int c0 = u.pn * 256 + wc * 32 + 8 * fq;
        const bf16* gp = proj + (size_t)(u.pm * 256 + wr * 64 + fr) * NPROJ + PGB + c0;
        bf16* yp = Y + (size_t)(u.pm * 256 + wr * 64 + fr) * 1024 + c0;
#pragma unroll
        for (int ai = 0; ai < 2; ++ai) {
            u32x4 gw[4][2];
#pragma unroll
            for (int m = 0; m < 4; ++m)
#pragma unroll
                for (int bj = 0; bj < 2; ++bj) gw[m][bj] = *(const u32x4*)(gp + (size_t)(ai * 128 + m * 16) * NPROJ + bj * 128);
#pragma unroll
            for (int m = 0; m < 4; ++m)
#pragma unroll
                for (int bj = 0; bj < 2; ++bj) {
                    f32x4 g0, g1; unpack8(gw[m][bj], g0, g1);
#pragma unroll
                    for (int j = 0; j < 4; ++j) { g0[j] = __builtin_amdgcn_rcpf(1.0f + __builtin_amdgcn_exp2f(-1.4426950408889634f * g0[j])); g1[j] = __builtin_amdgcn_rcpf(1.0f + __builtin_amdgcn_exp2f(-1.4426950408889634f * g1[j])); }
                    *(u32x4*)(yp + (size_t)(ai * 128 + m * 16) * 1024 + bj * 128) = pack8(acc[ai][bj][m][0] * g0, acc[ai][bj][m][1] * g1);
                }
            asm volatile("" ::: "memory");
        }
    }
};
struct EpiWo {
    static constexpr bool IDEMPOTENT = false;
    bf16* X; const float* g1;
    __device__ __forceinline__ void operator()(AccRef acc, const Unit& u, int wr, int wc, int fr, int fq) const {
        const int c0 = u.pn * 256 + wc * 32 + 8 * fq, b = (u.pm * 256) >> 11;
        const float* gp = g1 + (size_t)b * 6144 + c0;
        const f32x4 ga0 = *(const f32x4*)gp, gb0 = *(const f32x4*)(gp + 4), ga1 = *(const f32x4*)(gp + 128), gb1 = *(const f32x4*)(gp + 132);
        bf16* xp = X + (size_t)(u.pm * 256 + wr * 64 + fr) * 1024 + c0;
#pragma unroll
        for (int ai = 0; ai < 2; ++ai) {
            u32x4 xv[4][2];
#pragma unroll
            for (int m = 0; m < 4; ++m) { const bf16* p = xp + (size_t)(ai * 128 + m * 16) * 1024; xv[m][0] = *(const u32x4*)p; xv[m][1] = *(const u32x4*)(p + 128); }
#pragma unroll
            for (int m = 0; m < 4; ++m) { bf16* p = xp + (size_t)(ai * 128 + m * 16) * 1024; f32x4 a, d;
                unpack8(xv[m][0], a, d); *(u32x4*)p = pack8(a + ga0 * acc[ai][0][m][0], d + gb0 * acc[ai][0][m][1]);
                unpack8(xv[m][1], a, d); *(u32x4*)(p + 128) = pack8(a + ga1 * acc[ai][1][m][0], d + gb1 * acc[ai][1][m][1]); }
            asm volatile("" ::: "memory");
        }
    }
};
struct EpiGU {
    static constexpr bool IDEMPOTENT = true;
    bf16* ACT; const float* bgu;
    __device__ __forceinline__ void operator()(AccRef acc, const Unit& u, int wr, int wc, int fr, int fq) const {
        const int j0 = u.pn * 128 + wc * 32 + 8 * fq;
        const float* bp = bgu + (size_t)u.e * 2048 + 2 * j0;
        const f32x4 b0 = *(const f32x4*)bp, b1 = *(const f32x4*)(bp + 4), b2 = *(const f32x4*)(bp + 8), b3 = *(const f32x4*)(bp + 12);
        const float bg[8] = {b0[0], b0[2], b1[0], b1[2], b2[0], b2[2], b3[0], b3[2]}, bu[8] = {b0[1], b0[3], b1[1], b1[3], b2[1], b2[3], b3[1], b3[3]};
        bf16* ap = ACT + (size_t)(u.rowbase + wr * 64 + fr) * 1024 + j0;
#pragma unroll
        for (int ai = 0; ai < 2; ++ai)
#pragma unroll
            for (int m = 0; m < 4; ++m) {
                float o[8];
#pragma unroll
                for (int j = 0; j < 8; ++j) {
                    float g = acc[ai][0][m][j >> 2][j & 3] + bg[j], up = acc[ai][1][m][j >> 2][j & 3] + bu[j];
                    g = fminf(g, 7.0f); up = fminf(fmaxf(up, -7.0f), 7.0f);
                    o[j] = (up + 1.0f) * g * __builtin_amdgcn_rcpf(1.0f + __builtin_amdgcn_exp2f(-1.702f * 1.4426950408889634f * g)); }
                u32x4 w; w.x = pk2(o[0], o[1]); w.y = pk2(o[2], o[3]); w.z = pk2(o[4], o[5]); w.w = pk2(o[6], o[7]);
                *(u32x4*)(ap + (size_t)(ai * 128 + m * 16) * 1024) = w;
            }
    }
};
struct EpiDown {
    static constexpr bool IDEMPOTENT = true;
    unsigned char* YR; const float* bd; const int* list; const float* aw;
    __device__ __forceinline__ void operator()(AccRef acc, const Unit& u, int wr, int wc, int fr, int fq) const {
        const int cb = u.pn * 256 + wc * 32 + 8 * fq;
        const float* bp = bd + (size_t)u.e * 1024 + cb;
        const f32x4 ba0 = *(const f32x4*)bp, bb0 = *(const f32x4*)(bp + 4), ba1 = *(const f32x4*)(bp + 128), bb1 = *(const f32x4*)(bp + 132);
        int a[8]; float w[8];
        const int* lp = list + (size_t)u.e * T + u.pm * 256 + wr * 64 + fr;
#pragma unroll
        for (int q = 0; q < 8; ++q) { const int rl = (q >> 2) * 128 + wr * 64 + (q & 3) * 16 + fr; a[q] = (rl < u.mrows) ? lp[(q >> 2) * 128 + (q & 3) * 16] : -1; }
#pragma unroll
        for (int q = 0; q < 8; ++q) w[q] = (a[q] >= 0) ? aw[a[q]] : 0.f;
#pragma unroll
        for (int q = 0; q < 8; ++q) {
            const int ai = q >> 2, m = q & 3;
            if (a[q] >= 0) { unsigned char* yp = YR + (size_t)a[q] * 1024 + cb;
                const float ws_ = w[q] * YR_SCALE;
                const f32x4 y0 = (acc[ai][0][m][0] + ba0) * ws_, y1 = (acc[ai][0][m][1] + bb0) * ws_, y2 = (acc[ai][1][m][0] + ba1) * ws_, y3 = (acc[ai][1][m][1] + bb1) * ws_;
                *(u32x2*)yp = (u32x2){pk4_fp8(y0[0], y0[1], y0[2], y0[3]), pk4_fp8(y1[0], y1[1], y1[2], y1[3])};
                *(u32x2*)(yp + 128) = (u32x2){pk4_fp8(y2[0], y2[1], y2[2], y2[3]), pk4_fp8(y3[0], y3[1], y3[2], y3[3])}; }
        }
    }
};

enum { MAP_ID = 0, MAP_WIN = 1, MAP_WQ = 2, MAP_WKV = 3, MAP_GU = 4 };
__device__ __forceinline__ int map_row(int kind, int n) {
    if (kind == MAP_WIN) { if (n < 2560) return n; if (n < 2944) return NHT + PCQ + (n - 2560); if (n < 3200) return NHT + PCKV + (n - 2944); if (n < 3232) return NHT + PKPE + (n - 3200); return NHT + PGA + (n - 3232); }
    if (kind == MAP_WQ) { const int h = n / 96, j = n - h * 96; if (j < 64) return n; const int r = j - 64, i = r & 15; return h * 96 + 64 + 8 * (i >> 2) + ((r >> 4) << 2) + (i & 3); }
    if (kind == MAP_WKV) { const int h = n >> 7, j = n & 127; return (j < 64) ? (h * 64 + j) : (512 + h * 64 + (j - 64)); }
    if (kind == MAP_GU) { const int j = n >> 1, bj = n & 1; return (j >> 7) * 256 + bj * 128 + (j & 127); }
    return n;
}
__device__ __forceinline__ void conv_item(const float* W, int N, const float* kscale, bf16* WT, int dstK, int koff, int kind, LAS float* scr, int kb, int nb, int lane) {
    const int k0 = 64 * kb, n0 = 32 * nb;
    {
        const int kr = lane >> 3, c4 = (lane & 7) * 4; f32x4 v[8];
#pragma unroll
        for (int i = 0; i < 8; ++i) v[i] = *(const f32x4*)(W + (size_t)(k0 + 8 * i + kr) * N + n0 + c4);
#pragma unroll
        for (int i = 0; i < 8; ++i) { if (kscale) v[i] = v[i] * kscale[k0 + 8 * i + kr]; LAS float* d = scr + (8 * i + kr) * 33 + c4; d[0] = v[i][0]; d[1] = v[i][1]; d[2] = v[i][2]; d[3] = v[i][3]; }
    }
    LDS_WAIT(); asm volatile("" ::: "memory");
    const int c = lane & 7;
#pragma unroll
    for (int j = 0; j < 4; ++j) { const int n = (lane >> 3) + 8 * j; const LAS float* s = scr + (8 * c) * 33 + n;
        u32x4 o; o.x = pk2(s[0 * 33], s[1 * 33]); o.y = pk2(s[2 * 33], s[3 * 33]); o.z = pk2(s[4 * 33], s[5 * 33]); o.w = pk2(s[6 * 33], s[7 * 33]);
        *(u32x4*)(WT + (size_t)map_row(kind, n0 + n) * dstK + koff + k0 + 8 * c) = o; }
    LDS_WAIT(); asm volatile("" ::: "memory");
}
__device__ __forceinline__ void p_prologue(Frame& F) {
    const float* const* in = F.in;
    __syncthreads();
    {
        LAS float* cond = (LAS float*)F.lds;
        LAS float* part = (LAS float*)(F.lds + 32768);
        for (int i = F.tid; i < 8 * 1024; i += 512) { const float v = in[1][i]; cond[i] = v * sigmoidf_(v); }
        __syncthreads();
        for (int it = F.bid; it < DEPTH * 96; it += F.G) {
            const int l = it / 96, n0 = (it % 96) * 64, col = F.tid & 63, kg = F.tid >> 6;
            const float* w = in[3] + (size_t)l * 1024 * 6144 + n0 + col;
            float a[8] = {0.f, 0.f, 0.f, 0.f, 0.f, 0.f, 0.f, 0.f};
            for (int k0 = kg * 128; k0 < kg * 128 + 128; k0 += 16) {
                float wv[16];
#pragma unroll
                for (int q = 0; q < 16; ++q) wv[q] = w[(size_t)(k0 + q) * 6144];
#pragma unroll
                for (int q = 0; q < 16; ++q)
#pragma unroll
                    for (int b = 0; b < 8; ++b) a[b] += cond[b * 1024 + k0 + q] * wv[q]; }
#pragma unroll
            for (int b = 0; b < 8; ++b) part[(kg * 8 + b) * 64 + col] = a[b];
            __syncthreads();
            { const int b = F.tid >> 6; float s = 0.f;
#pragma unroll
              for (int g = 0; g < 8; ++g) s += part[(g * 8 + b) * 64 + col];
              ((float*)(F.ws + WS_MOD))[((size_t)l * 8 + b) * 6144 + n0 + col] = s + in[4][(size_t)l * 6144 + n0 + col]; }
            __syncthreads();
        }
    }
    const int gtid = F.bid * 512 + F.tid, NT_ = F.G * 512;
    for (int i = gtid; i < 1024; i += NT_) {
        float lg[DEPTH], mx = -1e30f; for (int l = 0; l < DEPTH; ++l) { lg[l] = in[8][(size_t)l * 1024 + i]; mx = fmaxf(mx, lg[l]); }
        float s = 0.f; for (int l = 0; l < DEPTH; ++l) { lg[l] = __expf(lg[l] - mx); s += lg[l]; }
        float c = 0.f; float* lb = (float*)(F.ws + WS_LB);
        for (int l = 0; l < DEPTH; ++l) { if (l > 0) c += lg[l] / s; lb[(size_t)l * 1024 + i] = c; }
    }
    for (int i = gtid; i < T * 16; i += NT_) {
        const int t = i >> 4, j = i & 15; const int pos = ((const int*)in[2])[t];
        const double base4[4] = {1.0, 0.5623413251903491, 0.31622776601683794, 0.1778279410038923};
        double f = base4[j & 3]; for (int q = 0; q < (j >> 2); ++q) f *= 0.1;
        const double ang = (double)pos * f; const double n = __builtin_rint(ang * 0.15915494309189535); const float r = (float)(ang - n * 6.283185307179586);
        ((float*)(F.ws + WS_COS))[i] = cosf(r); ((float*)(F.ws + WS_SIN))[i] = sinf(r);
    }
    for (int l = 0; l < DEPTH; ++l) { u32x4* p = (u32x4*)(wl(F.ws, l, WL_IN) + (size_t)5280 * 1024 * 2); for (int i = gtid; i < 96 * 1024 * 2 / 16; i += NT_) p[i] = (u32x4){0u, 0u, 0u, 0u}; }
    {
        LAS float* scr = (LAS float*)(F.lds + F.wave * 16384);
        const int gw = F.bid * NWAVES + F.wave, NGW = F.G * NWAVES;
        constexpr int I_IN = 16 * 165, I_Q = 6 * 24, I_KV = 4 * 32, I_OH = 8 * 32, I_OM = 8 * 32, I_O = 16 * 32, I_GU = 32 * 16 * 64, I_DN = 32 * 16 * 32;
        constexpr int I_LAYER = I_IN + I_Q + I_KV + I_OH + I_OM + I_O + I_GU + I_DN;
        for (int it = gw; it < DEPTH * I_LAYER; it += NGW) {
            const int l = it / I_LAYER; int r = it - l * I_LAYER;
            if (r < I_IN) { conv_item(in[7] + (size_t)l * 1024 * 5280, 5280, nullptr, (bf16*)wl(F.ws, l, WL_IN), 1024, 0, MAP_WIN, scr, r / 165, r % 165, F.lane); continue; } r -= I_IN;
            if (r < I_Q) { conv_item(in[12] + (size_t)l * 384 * 768, 768, in[11] + l * 384, (bf16*)wl(F.ws, l, WL_Q), 384, 0, MAP_WQ, scr, r / 24, r % 24, F.lane); continue; } r -= I_Q;
            if (r < I_KV) { conv_item(in[14] + (size_t)l * 256 * 1024, 1024, in[13] + l * 256, (bf16*)wl(F.ws, l, WL_K), 256, 0, MAP_WKV, scr, r / 32, r % 32, F.lane); continue; } r -= I_KV;
            if (r < I_OH) { conv_item(in[10] + (size_t)l * 512 * 1024, 1024, nullptr, (bf16*)wl(F.ws, l, WL_OUT), 1024, 0, MAP_ID, scr, r / 32, r % 32, F.lane); continue; } r -= I_OH;
            if (r < I_OM) { conv_item(in[15] + (size_t)l * 512 * 1024, 1024, nullptr, (bf16*)wl(F.ws, l, WL_OUT), 1024, 512, MAP_ID, scr, r / 32, r % 32, F.lane); continue; } r -= I_OM;
            if (r < I_O) { conv_item(in[16] + (size_t)l * 1024 * 1024, 1024, nullptr, (bf16*)wl(F.ws, l, WL_O), 1024, 0, MAP_ID, scr, r / 32, r % 32, F.lane); continue; } r -= I_O;
            if (r < I_GU) { const int e = r / (16 * 64), q = r % (16 * 64); conv_item(in[19] + ((size_t)l * 32 + e) * 1024 * 2048, 2048, nullptr, (bf16*)wl(F.ws, l, WL_GU) + (size_t)e * 2048 * 1024, 1024, 0, MAP_GU, scr, q / 64, q % 64, F.lane); continue; } r -= I_GU;
            { const int e = r / (16 * 32), q = r % (16 * 32); conv_item(in[21] + ((size_t)l * 32 + e) * 1024 * 1024, 1024, nullptr, (bf16*)wl(F.ws, l, WL_DN) + (size_t)e * 1024 * 1024, 1024, 0, MAP_ID, scr, q / 32, q % 32, F.lane); }
        }
    }
}

__device__ __forceinline__ void p_norm_mix(Frame& F, int l, bool fin, float* out, bool dummy = false) {
    const float* const* in = F.in;
    bf16* X = (bf16*)(F.ws + (dummy ? WS_ACT : WS_X));
    const float* MOD = (const float*)(F.ws + WS_MOD); const unsigned char* YR = F.ws + WS_YR; bf16* HB = (bf16*)(F.ws + (dummy ? WS_ACT + 64 * MiB : WS_HB));
    const int gw = F.bid * NWAVES + F.wave, NGW = F.G * NWAVES, per_wave = (T + NGW - 1) / NGW;
    f32x4 Gv[4], Sv[4], G2[4]; int bcur = -1;
    for (int q = 0; q < per_wave; ++q) {
        const int t = gw * per_wave + q; if (t >= T) break;
        const int b = t >> 11; f32x4 v[4];
        if (b != bcur) { bcur = b;
            const float* gn = fin ? in[23] : in[5] + (size_t)l * 1024; const float* sh = MOD + ((size_t)(fin ? 0 : l) * 8 + b) * 6144; const float* g2 = MOD + ((size_t)(l > 0 ? l - 1 : 0) * 8 + b) * 6144 + 5 * 1024;
#pragma unroll
            for (int j = 0; j < 4; ++j) { const int d = 4 * F.lane + 256 * j; const f32x4 g = *(const f32x4*)(gn + d);
                Gv[j] = fin ? g : g * (*(const f32x4*)(sh + 1024 + d) + 1.0f); Sv[j] = fin ? (f32x4){0.f, 0.f, 0.f, 0.f} : *(const f32x4*)(sh + d); G2[j] = *(const f32x4*)(g2 + d); } }
        if (l == 0) {
#pragma unroll
            for (int j = 0; j < 4; ++j) v[j] = *(const f32x4*)(in[0] + (size_t)t * 1024 + 4 * F.lane + 256 * j);
        } else {
#pragma unroll
            for (int j = 0; j < 4; ++j) { const u32x2 w = *(const u32x2*)(X + (size_t)t * 1024 + 4 * F.lane + 256 * j); v[j] = (f32x4){bflo(w.x), bfhi(w.x), bflo(w.y), bfhi(w.y)}; }
        }
        if (l > 0) {
#pragma unroll
            for (int j = 0; j < 4; ++j) { f32x4 s = {0.f, 0.f, 0.f, 0.f};
#pragma unroll
                for (int k = 0; k < 4; ++k) { const unsigned w = *(const unsigned*)(YR + ((size_t)t * 4 + k) * 1024 + 4 * F.lane + 256 * j);
                    s[0] += __builtin_amdgcn_cvt_f32_fp8(w, 0); s[1] += __builtin_amdgcn_cvt_f32_fp8(w, 1); s[2] += __builtin_amdgcn_cvt_f32_fp8(w, 2); s[3] += __builtin_amdgcn_cvt_f32_fp8(w, 3); }
                v[j] += G2[j] * s * YR_INV; }
        }
        float ss = 0.f;
#pragma unroll
        for (int j = 0; j < 4; ++j) ss += (v[j][0] * v[j][0] + v[j][1] * v[j][1]) + (v[j][2] * v[j][2] + v[j][3] * v[j][3]);
        const float rs = rsqrtf(wave_sum(ss) * (1.0f / 1024.0f) + EPS);
        if (fin) {
#pragma unroll
            for (int j = 0; j < 4; ++j) { const int d = 4 * F.lane + 256 * j; *(f32x4*)(out + (size_t)t * 1024 + d) = v[j] * rs * Gv[j]; }
        } else {
#pragma unroll
            for (int j = 0; j < 4; ++j) { const int d = 4 * F.lane + 256 * j; { u32x2 xw; xw.x = pk2(v[j][0], v[j][1]); xw.y = pk2(v[j][2], v[j][3]); *(u32x2*)(X + (size_t)t * 1024 + d) = xw; }
                const f32x4 h = v[j] * rs * Gv[j] + Sv[j]; u32x2 w; w.x = pk2(h[0], h[1]); w.y = pk2(h[2], h[3]);
                *(u32x2*)(HB + (size_t)t * 1024 + d) = w; }
        }
    }
}
__device__ __forceinline__ void p_mla_prep(Frame& F) {
    const bf16* PROJ = (const bf16*)(F.ws + WS_PROJ); float* RSQ = (float*)(F.ws + WS_RSQ); float* RSKV = (float*)(F.ws + WS_RSKV); bf16* Kb = (bf16*)(F.ws + WS_K);
    const float* CS = (const float*)(F.ws + WS_COS); const float* SN = (const float*)(F.ws + WS_SIN);
    const int gw = F.bid * NWAVES + F.wave, NGW = F.G * NWAVES;
    for (int t = gw; t < T; t += NGW) {
        const bf16* row = PROJ + (size_t)t * NPROJ;
        float sq = 0.f, skv = 0.f;
#pragma unroll
        for (int j = 0; j < 6; ++j) { const float v = bf2f(row[PCQ + F.lane + 64 * j]); sq += v * v; }
#pragma unroll
        for (int j = 0; j < 4; ++j) { const float v = bf2f(row[PCKV + F.lane + 64 * j]); skv += v * v; }
        sq = wave_sum(sq); skv = wave_sum(skv);
        if (F.lane == 0) { RSQ[t] = rsqrtf(sq * (1.0f / 384.0f) + EPS); RSKV[t] = rsqrtf(skv * (1.0f / 256.0f) + EPS); }
        if (F.lane < 16) {
            const float x1 = bf2f(row[PKPE + F.lane]), x2 = bf2f(row[PKPE + 16 + F.lane]), co = CS[(size_t)t * 16 + F.lane], si = SN[(size_t)t * 16 + F.lane];
            const bf16 o1 = (bf16)(pk2(x1 * co - x2 * si, 0.f) & 0xffffu), o2 = (bf16)(pk2(x2 * co + x1 * si, 0.f) & 0xffffu);
            const int b = t >> 11, s = t & 2047;
#pragma unroll
            for (int h = 0; h < 8; ++h) { bf16* kp = Kb + ((size_t)(b * 8 + h) * SEQ + s) * 96; kp[64 + F.lane] = o1; kp[80 + F.lane] = o2; }
        }
    }
}
__device__ __forceinline__ void p_hgrn_post(Frame& F, int l) {
    const bf16* OFp = (const bf16*)(F.ws + WS_OF); const bf16* OBp = (const bf16*)(F.ws + WS_OB); const bf16* PROJ = (const bf16*)(F.ws + WS_PROJ); bf16* HA = (bf16*)(F.ws + WS_HA);
    const float* gn = F.in[9] + (size_t)l * 128;
    const int gw = F.bid * NWAVES + F.wave, NGW = F.G * NWAVES;
    for (int t = gw; t < T; t += NGW) {
        const int c = 8 * F.lane;
        f32x4 a0, a1, b0, b1; unpack8(*(const u32x4*)(OFp + (size_t)t * 512 + c), a0, a1); unpack8(*(const u32x4*)(OBp + (size_t)t * 512 + c), b0, b1); a0 += b0; a1 += b1;
        float ss = (a0[0] * a0[0] + a0[1] * a0[1]) + (a0[2] * a0[2] + a0[3] * a0[3]) + (a1[0] * a1[0] + a1[1] * a1[1]) + (a1[2] * a1[2] + a1[3] * a1[3]);
#pragma unroll
        for (int o = 1; o < 16; o <<= 1) ss += __shfl_xor(ss, o);
        const float rs = rsqrtf(ss * (1.0f / 128.0f) + EPS);
        f32x4 g0, g1; unpack8(*(const u32x4*)(PROJ + (size_t)t * NPROJ + PGT + c), g0, g1);
        const f32x4 n0 = *(const f32x4*)(gn + (c & 127)), n1 = *(const f32x4*)(gn + (c & 127) + 4);
#pragma unroll
        for (int j = 0; j < 4; ++j) { a0[j] = a0[j] * rs * n0[j] * sigmoidf_(g0[j]); a1[j] = a1[j] * rs * n1[j] * sigmoidf_(g1[j]); }
        *(u32x4*)(HA + (size_t)t * 1024 + c) = pack8(a0, a1);
    }
}

#define MFMA16(a, b, c) __builtin_amdgcn_mfma_f32_16x16x32_bf16((a), (b), (c), 0, 0, 0)
constexpr int SC_QROW = 272, SC_TROW = 144;
constexpr int SC_QT = 0, SC_KT = SC_QT + 64 * SC_QROW, SC_KH = SC_KT + 64 * SC_QROW, SC_VT = SC_KH + 128 * SC_TROW, SC_DEC = SC_VT + 128 * SC_TROW, SC_ZERO = SC_DEC + 4 * 128 * 4, SC_END = SC_ZERO + 64;
__device__ __forceinline__ unsigned rot16(unsigned x) { return (x >> 16) | (x << 16); }
constexpr int SC_OX = 73984;
static_assert(SC_OX >= SC_END && SC_OX % 16 == 0 && SC_OX + 32768 <= RING_BYTES, "scan LDS map");
__device__ __forceinline__ void scan_unit2(Frame& F, int l, int u) {
    const int vh = u & 1, dir = (u >> 1) & 1, hh = (u >> 2) & 3, b = u >> 4;
    const bf16* HTb = (const bf16*)(F.ws + WS_HT) + (size_t)b * NHT * SEQ;
    const bf16* qg = HTb + (size_t)(HQ + hh * 128) * SEQ; const bf16* fg = HTb + (size_t)((dir ? HFB : HFF) + hh * 128) * SEQ; const bf16* vg = HTb + (size_t)(HI + hh * 128 + vh * 64) * SEQ;
    bf16* OUT = (bf16*)(F.ws + (dir ? WS_OB : WS_OF));
    LAS unsigned char* lds = F.lds;
    const int d = F.tid & 127, si = F.tid >> 7;
    const float lbv = ((const float*)(F.ws + WS_LB))[((size_t)l * 2 + dir) * 512 + hh * 128 + d];
    const int r = F.lane & 15, g = F.lane >> 4, vt = F.wave & 3, dh = F.wave >> 2;
    const int vcol = hh * 128 + vh * 64 + 16 * vt;
    f32x4 S[4];
#pragma unroll
    for (int i = 0; i < 4; ++i) S[i] = (f32x4){0.f, 0.f, 0.f, 0.f};
    __syncthreads();
    if (F.tid < 16) *(LAS unsigned*)(lds + SC_ZERO + F.tid * 4) = 0u;
    u32x4 pq[2], pf[2], pv;
    const int vrow0 = F.tid >> 3, vmc = F.tid & 7;
    {   const int m0 = dir ? SEQ - 64 : 0; const int mb = dir ? m0 + 48 - 16 * si : m0 + 16 * si;
        pq[0] = *(const u32x4*)(qg + (size_t)d * SEQ + mb); pq[1] = *(const u32x4*)(qg + (size_t)d * SEQ + mb + 8);
        pf[0] = *(const u32x4*)(fg + (size_t)d * SEQ + mb); pf[1] = *(const u32x4*)(fg + (size_t)d * SEQ + mb + 8);
        pv = *(const u32x4*)(vg + (size_t)vrow0 * SEQ + m0 + 8 * vmc); }
    int mprev = 0;
#pragma unroll 1
    for (int c = 0; c <= SEQ / 64; ++c) {
        const bool live = c < SEQ / 64;
        const int m0 = dir ? SEQ - 64 * (c + 1) : 64 * c;
        float qt[16], kt[16], E = 1.0f;
        if (live) {
            float rq[16], rf[16];
#pragma unroll
            for (int j = 0; j < 2; ++j) {
                rq[8 * j + 0] = bflo(pq[j].x); rq[8 * j + 1] = bfhi(pq[j].x); rq[8 * j + 2] = bflo(pq[j].y); rq[8 * j + 3] = bfhi(pq[j].y); rq[8 * j + 4] = bflo(pq[j].z); rq[8 * j + 5] = bfhi(pq[j].z); rq[8 * j + 6] = bflo(pq[j].w); rq[8 * j + 7] = bfhi(pq[j].w);
                rf[8 * j + 0] = bflo(pf[j].x); rf[8 * j + 1] = bfhi(pf[j].x); rf[8 * j + 2] = bflo(pf[j].y); rf[8 * j + 3] = bfhi(pf[j].y); rf[8 * j + 4] = bflo(pf[j].z); rf[8 * j + 5] = bfhi(pf[j].z); rf[8 * j + 6] = bflo(pf[j].w); rf[8 * j + 7] = bfhi(pf[j].w); }
#pragma unroll
            for (int k = 0; k < 16; ++k) {
                const float un = dir ? rf[15 - k] : rf[k], qs = dir ? rq[15 - k] : rq[k];
                const float kk = (1.0f - lbv) * un; E = fmaxf(E * (1.0f - kk), 1e-30f);
                qt[k] = qs * E; kt[k] = kk * __builtin_amdgcn_rcpf(E);
            }
        }
        __syncthreads();
        if (c > 0) {
#pragma unroll
            for (int ii = 0; ii < 2; ++ii) { const int i = 2 * dh + ii;
                const f32x4 a = *(const LAS f32x4*)(lds + SC_OX + (((0 * 4 + vt) * 4 + i) * 64 + F.lane) * 16), bq = *(const LAS f32x4*)(lds + SC_OX + (((1 * 4 + vt) * 4 + i) * 64 + F.lane) * 16);
                const int m = dir ? mprev + 63 - 16 * i - r : mprev + 16 * i + r;
                const f32x4 o = a + bq; u32x2 w; w.x = pk2(o[0], o[1]); w.y = pk2(o[2], o[3]);
                *(u32x2*)(OUT + (size_t)(b * SEQ + m) * 512 + vcol + 4 * g) = w; }
        }
        if (!live) break;
        {   LAS unsigned char* qp = lds + SC_QT + (16 * si) * SC_QROW + d * 2; LAS unsigned char* kp = lds + SC_KT + (16 * si) * SC_QROW + d * 2;
#pragma unroll
            for (int k = 0; k < 16; k += 2) { const unsigned wq = pk2(qt[k], qt[k + 1]), wk = pk2(kt[k], kt[k + 1]);
                *(LAS unsigned short*)(qp + k * SC_QROW) = (unsigned short)wq; *(LAS unsigned short*)(qp + (k + 1) * SC_QROW) = (unsigned short)(wq >> 16);
                *(LAS unsigned short*)(kp + k * SC_QROW) = (unsigned short)wk; *(LAS unsigned short*)(kp + (k + 1) * SC_QROW) = (unsigned short)(wk >> 16); }
            u32x4 h0, h1;
            h0.x = pk2(kt[0] * E, kt[1] * E); h0.y = pk2(kt[2] * E, kt[3] * E); h0.z = pk2(kt[4] * E, kt[5] * E); h0.w = pk2(kt[6] * E, kt[7] * E);
            h1.x = pk2(kt[8] * E, kt[9] * E); h1.y = pk2(kt[10] * E, kt[11] * E); h1.z = pk2(kt[12] * E, kt[13] * E); h1.w = pk2(kt[14] * E, kt[15] * E);
            *(LAS u32x4*)(lds + SC_KH + d * SC_TROW + 32 * si) = h0; *(LAS u32x4*)(lds + SC_KH + d * SC_TROW + 32 * si + 16) = h1;
            *(LAS float*)(lds + SC_DEC + (si * 128 + d) * 4) = E;
            { u32x4 w = pv; int tl0 = 8 * vmc;
              if (dir) { w = (u32x4){rot16(pv.w), rot16(pv.z), rot16(pv.y), rot16(pv.x)}; tl0 = 56 - 8 * vmc; }
              *(LAS u32x4*)(lds + SC_VT + vrow0 * SC_TROW + tl0 * 2) = w; }
        }
        if (c + 1 < SEQ / 64) {
            const int m1 = dir ? SEQ - 64 * (c + 2) : 64 * (c + 1); const int mb = dir ? m1 + 48 - 16 * si : m1 + 16 * si;
            pq[0] = *(const u32x4*)(qg + (size_t)d * SEQ + mb); pq[1] = *(const u32x4*)(qg + (size_t)d * SEQ + mb + 8);
            pf[0] = *(const u32x4*)(fg + (size_t)d * SEQ + mb); pf[1] = *(const u32x4*)(fg + (size_t)d * SEQ + mb + 8);
            pv = *(const u32x4*)(vg + (size_t)vrow0 * SEQ + m1 + 8 * vmc);
        }
        mprev = m0;
        __syncthreads();
        f32x4 oI[2];
#pragma unroll
        for (int ii = 0; ii < 2; ++ii) {
            const int i = 2 * dh + ii;
            const LAS unsigned char* qrow = lds + SC_QT + (16 * i + r) * SC_QROW; const LAS unsigned char* krow = lds + SC_KT + (16 * i + r) * SC_QROW;
            f32x4 pT = {0.f, 0.f, 0.f, 0.f};
#pragma unroll
            for (int ks = 0; ks < 4; ++ks) pT = MFMA16(*(const LAS bf16x8*)(krow + (32 * ks + 8 * g) * 2), *(const LAS bf16x8*)(qrow + (32 * ks + 8 * g) * 2), pT);
#pragma unroll
            for (int q = 0; q < 4; ++q) pT[q] = (4 * g + q <= r) ? pT[q] : 0.0f;
            const bf16x8 pfrag = __builtin_bit_cast(bf16x8, ((u32x4){pk2(pT[0], pT[1]), pk2(pT[2], pT[3]), 0u, 0u}));
            const u32x2 vt4 = *(const LAS u32x2*)(lds + SC_VT + (16 * vt + r) * SC_TROW + (16 * i + 4 * g) * 2);
            oI[ii] = MFMA16(__builtin_bit_cast(bf16x8, ((u32x4){vt4.x, vt4.y, 0u, 0u})), pfrag, ((f32x4){0.f, 0.f, 0.f, 0.f}));
        }
        const bool zl = (g >= 2);
#pragma unroll
        for (int i = 0; i < 4; ++i) {
            const LAS unsigned char* qrow = lds + SC_QT + (16 * i + r) * SC_QROW + (64 * dh) * 2;
            f32x4 o = ((i >> 1) == dh) ? oI[i & 1] : (f32x4){0.f, 0.f, 0.f, 0.f};
#pragma unroll
            for (int kk = 0; kk < 2; ++kk) {
                const bf16x8 sfrag = __builtin_bit_cast(bf16x8, ((u32x4){pk2(S[2 * kk][0], S[2 * kk][1]), pk2(S[2 * kk][2], S[2 * kk][3]), pk2(S[2 * kk + 1][0], S[2 * kk + 1][1]), pk2(S[2 * kk + 1][2], S[2 * kk + 1][3])}));
                const u32x2 qa = *(const LAS u32x2*)(qrow + (32 * kk + 4 * g) * 2), qb = *(const LAS u32x2*)(qrow + (32 * kk + 16 + 4 * g) * 2);
                o = MFMA16(sfrag, __builtin_bit_cast(bf16x8, ((u32x4){qa.x, qa.y, qb.x, qb.y})), o);
            }
            *(LAS f32x4*)(lds + SC_OX + (((dh * 4 + vt) * 4 + i) * 64 + F.lane) * 16) = o;
            const LAS unsigned char* vtp = zl ? lds + SC_ZERO : lds + SC_VT + (16 * vt + r) * SC_TROW + (16 * i + 8 * g) * 2;
            const bf16x8 vfrag = *(const LAS bf16x8*)vtp;
#pragma unroll
            for (int dt = 0; dt < 4; ++dt) {
                const f32x4 dec = *(const LAS f32x4*)(lds + SC_DEC + (i * 128 + 64 * dh + 16 * dt + 4 * g) * 4);
                const LAS unsigned char* khp = zl ? lds + SC_ZERO : lds + SC_KH + (64 * dh + 16 * dt + r) * SC_TROW + (16 * i + 8 * g) * 2;
                S[dt] = MFMA16(*(const LAS bf16x8*)khp, vfrag, S[dt] * dec);
            }
        }
    }
    __syncthreads();
}

#define MFMA32(a, b, c) __builtin_amdgcn_mfma_f32_32x32x16_bf16((a), (b), (c), 0, 0, 0)
constexpr int AT_KROW = 208, AT_VROW = 136, AT_KBYTES = 64 * AT_KROW, AT_BUF = AT_KBYTES + 64 * AT_VROW;
__device__ __forceinline__ void attn_unit(Frame& F, int bh, int q0) {
    const GAS bf16* Q = (const GAS bf16*)(F.ws + WS_Q); const GAS char* Kg = (const GAS char*)(F.ws + WS_K) + (size_t)bh * SEQ * 96 * 2; const GAS char* Vg = (const GAS char*)(F.ws + WS_VT) + (size_t)bh * 64 * SEQ * 2;
    GAS bf16* HA = (GAS bf16*)(F.ws + WS_HA);
    LAS unsigned char* lds = F.lds;
    const int r = F.lane & 31, h = F.lane >> 5;
    bf16x8 qf[6];
    { const GAS bf16* qrow = Q + ((size_t)bh * SEQ + q0 + F.wave * 32 + r) * 96;
#pragma unroll
      for (int ks = 0; ks < 6; ++ks) qf[ks] = *(const GAS bf16x8*)(qrow + 16 * ks + 8 * h); }
    f32x16 o0, o1;
#pragma unroll
    for (int i = 0; i < 16; ++i) { o0[i] = 0.f; o1[i] = 0.f; }
    float mref = 0.f, lsum = 0.f;
    const int kc0 = F.tid, kc1 = F.tid + 512; const bool has1 = F.tid < 256;
    const int kl0 = (kc0 / 12) * AT_KROW + (kc0 % 12) * 16, kl1 = (kc1 / 12) * AT_KROW + (kc1 % 12) * 16;
    const int vrow = F.tid >> 3, vpc = F.tid & 7; const int vl = AT_KBYTES + vrow * AT_VROW + vpc * 16;
    u32x4 rk0, rk1 = {0u, 0u, 0u, 0u}, rv;
    __syncthreads();
    rk0 = *(const GAS u32x4*)(Kg + (size_t)kc0 * 16); if (has1) rk1 = *(const GAS u32x4*)(Kg + (size_t)kc1 * 16);
    rv = *(const GAS u32x4*)(Vg + (size_t)vrow * SEQ * 2 + vpc * 16);
    *(LAS u32x4*)(lds + kl0) = rk0; if (has1) *(LAS u32x4*)(lds + kl1) = rk1;
    *(LAS u32x2*)(lds + vl) = (u32x2){rv.x, rv.y}; *(LAS u32x2*)(lds + vl + 8) = (u32x2){rv.z, rv.w};
    __syncthreads();
    for (int j = 0; j < SEQ / 64; ++j) {
        const int buf = (j & 1) * AT_BUF, nbuf = ((j + 1) & 1) * AT_BUF;
        if (j + 1 < SEQ / 64) {
            const GAS char* kg = Kg + (size_t)(j + 1) * 64 * 96 * 2;
            rk0 = *(const GAS u32x4*)(kg + (size_t)kc0 * 16); if (has1) rk1 = *(const GAS u32x4*)(kg + (size_t)kc1 * 16);
            rv = *(const GAS u32x4*)(Vg + (size_t)vrow * SEQ * 2 + (size_t)(j + 1) * 128 + vpc * 16);
        }
        f32x16 s0, s1;
#pragma unroll
        for (int i = 0; i < 16; ++i) { s0[i] = -mref; s1[i] = -mref; }
#pragma unroll
        for (int ks = 0; ks < 6; ++ks) {
            const bf16x8 k0 = *(const LAS bf16x8*)(lds + buf + r * AT_KROW + (16 * ks + 8 * h) * 2);
            const bf16x8 k1 = *(const LAS bf16x8*)(lds + buf + (32 + r) * AT_KROW + (16 * ks + 8 * h) * 2);
            s0 = MFMA32(k0, qf[ks], s0); s1 = MFMA32(k1, qf[ks], s1);
        }
        float mx = s0[0];
#pragma unroll
        for (int i = 1; i < 16; ++i) mx = fmaxf(mx, s0[i]);
#pragma unroll
        for (int i = 0; i < 16; ++i) mx = fmaxf(mx, s1[i]);
        mx = fmaxf(mx, __shfl_xor(mx, 32));
        const bool grow = (j == 0) || (mx > 8.0f);
        if (__builtin_amdgcn_ballot_w64(grow) != 0ull) {
            const float dlt = grow ? mx : 0.0f, fsc = __builtin_amdgcn_exp2f(-dlt); mref += dlt; lsum *= fsc;
#pragma unroll
            for (int i = 0; i < 16; ++i) { s0[i] -= dlt; s1[i] -= dlt; o0[i] *= fsc; o1[i] *= fsc; } }
        float ps = 0.f;
#pragma unroll
        for (int i = 0; i < 16; ++i) { s0[i] = __builtin_amdgcn_exp2f(s0[i]); s1[i] = __builtin_amdgcn_exp2f(s1[i]); ps += s0[i] + s1[i]; }
        lsum += ps;
        bf16x8 pf[2][2];
#pragma unroll
        for (int sp = 0; sp < 2; ++sp) {
            u32x4 w0, w1;
            w0.x = pk2(s0[8 * sp + 0], s0[8 * sp + 1]); w0.y = pk2(s0[8 * sp + 2], s0[8 * sp + 3]); w0.z = pk2(s0[8 * sp + 4], s0[8 * sp + 5]); w0.w = pk2(s0[8 * sp + 6], s0[8 * sp + 7]);
            w1.x = pk2(s1[8 * sp + 0], s1[8 * sp + 1]); w1.y = pk2(s1[8 * sp + 2], s1[8 * sp + 3]); w1.z = pk2(s1[8 * sp + 4], s1[8 * sp + 5]); w1.w = pk2(s1[8 * sp + 6], s1[8 * sp + 7]);
            pf[0][sp] = __builtin_bit_cast(bf16x8, w0); pf[1][sp] = __builtin_bit_cast(bf16x8, w1);
        }
#pragma unroll
        for (int kb = 0; kb < 2; ++kb)
#pragma unroll
            for (int sp = 0; sp < 2; ++sp) {
                const int kbase = (32 * kb + 16 * sp + 4 * h) * 2;
                const LAS unsigned char* v0p = lds + buf + AT_KBYTES + r * AT_VROW + kbase;
                const LAS unsigned char* v1p = lds + buf + AT_KBYTES + (32 + r) * AT_VROW + kbase;
                const u32x2 a0 = *(const LAS u32x2*)v0p, a1 = *(const LAS u32x2*)(v0p + 16), c0 = *(const LAS u32x2*)v1p, c1 = *(const LAS u32x2*)(v1p + 16);
                const bf16x8 vf0 = __builtin_bit_cast(bf16x8, ((u32x4){a0.x, a0.y, a1.x, a1.y})), vf1 = __builtin_bit_cast(bf16x8, ((u32x4){c0.x, c0.y, c1.x, c1.y}));
                o0 = MFMA32(vf0, pf[kb][sp], o0); o1 = MFMA32(vf1, pf[kb][sp], o1);
            }
        if (j + 1 < SEQ / 64) {
            *(LAS u32x4*)(lds + nbuf + kl0) = rk0; if (has1) *(LAS u32x4*)(lds + nbuf + kl1) = rk1;
            *(LAS u32x2*)(lds + nbuf + vl) = (u32x2){rv.x, rv.y}; *(LAS u32x2*)(lds + nbuf + vl + 8) = (u32x2){rv.z, rv.w};
        }
        __syncthreads();
    }
    lsum += __shfl_xor(lsum, 32);
    const float inv = 1.0f / lsum;
    const int head = bh & 7, b = bh >> 3;
    GAS bf16* orow = HA + (size_t)(b * SEQ + q0 + F.wave * 32 + r) * 1024 + 512 + head * 64;
#pragma unroll
    for (int i = 0; i < 4; ++i) {
        u32x2 w0, w1;
        w0.x = pk2(o0[4 * i] * inv, o0[4 * i + 1] * inv); w0.y = pk2(o0[4 * i + 2] * inv, o0[4 * i + 3] * inv);
        w1.x = pk2(o1[4 * i] * inv, o1[4 * i + 1] * inv); w1.y = pk2(o1[4 * i + 2] * inv, o1[4 * i + 3] * inv);
        *(GAS u32x2*)(orow + 8 * i + 4 * h) = w0; *(GAS u32x2*)(orow + 32 + 8 * i + 4 * h) = w1;
    }
}

constexpr int RTW_LO = 65536, RT_EX = 131072, RT_CP = 151552, RT_CE = 153600, RT_SS = 153728;
static_assert(RT_EX + 8192 <= LDSCTL_OFF && RT_SS + 512 <= LDS_BYTES && RT_S_OFF + 4096 <= RT_CP, "router LDS map");
__device__ __forceinline__ int rt_f(int e) { return ((e >> 2) & 3) | (((e ^ (e >> 4)) & 1) << 2) | (((e >> 1) & 1) << 3); }
__device__ __forceinline__ void p_router(Frame& F, int l, bool dummy = false) {
    const float* const* in = F.in;
    const bf16* X = (const bf16*)(F.ws + WS_X); const float* MOD = (const float*)(F.ws + WS_MOD); bf16* HB = (bf16*)(F.ws + WS_HB);
    int* LIST = (int*)(F.ws + (dummy ? WS_Y : WS_LIST)); float* AW = (float*)(F.ws + (dummy ? WS_Y + 4 * MiB : WS_AW)); unsigned* CNT = (unsigned*)(F.ws + WS_CTL) + CW_CNT + (l + (dummy ? 4 : 0)) * 32 * 64;
    LAS unsigned char* lds = F.lds;
    const float* wr = in[17] + (size_t)l * 1024 * 32; const float* gn = in[6] + (size_t)l * 1024; const float* br = in[18] + (size_t)l * 32;
    LAS unsigned* lcnt = (LAS unsigned*)(lds + MOE_OFF + 512); LAS unsigned* lbase = lcnt + 32;
    int cur_b = -1;
    for (int tile = F.bid; tile < T / 64; tile += F.G) {
        int tid = F.tid; asm volatile("" : "+v"(tid));
        const int lane = tid & 63, wv = tid >> 6, r = lane & 15, g = lane >> 4, tt = wv & 3, kh = wv >> 2;
        const int b = tile >> 5; const int t = tile * 64 + 16 * tt + r;
        u32x4 xf[16];
        {   const bf16* xrow = X + (size_t)t * 1024 + kh * 512 + 8 * g;
#pragma unroll
            for (int ks = 0; ks < 16; ++ks) xf[ks] = *(const u32x4*)(xrow + 32 * ks); }
        __syncthreads();
        if (b != cur_b) {
            cur_b = b;
            const float* sh = MOD + ((size_t)l * 8 + b) * 6144 + 3 * 1024;
            for (int d = tid; d < 1024; d += 512) { *(LAS float*)(lds + RT_G_OFF + d * 4) = gn[d] * (sh[1024 + d] + 1.0f); *(LAS float*)(lds + RT_S_OFF + d * 4) = sh[d]; }
            __syncthreads();
#pragma unroll 2
            for (int q = tid; q < 4096; q += 512) {
                const int kp = q >> 3, c = q & 7;
                const f32x4 w0 = *(const f32x4*)(wr + (size_t)(2 * kp) * 32 + 4 * c), w1 = *(const f32x4*)(wr + (size_t)(2 * kp + 1) * 32 + 4 * c);
                const float g0 = *(const LAS float*)(lds + RT_G_OFF + (2 * kp) * 4), g1 = *(const LAS float*)(lds + RT_G_OFF + (2 * kp + 1) * 4);
#pragma unroll
                for (int j = 0; j < 4; ++j) { const int e = 4 * c + j; const float a0 = w0[j] * g0, a1 = w1[j] * g1;
                    const unsigned hi = pk2(a0, a1); const unsigned lo = pk2(a0 - bflo(hi), a1 - bfhi(hi));
                    const int off = e * 2048 + (((kp >> 2) ^ rt_f(e)) << 4) + (kp & 3) * 4;
                    *(LAS unsigned*)(lds + off) = hi; *(LAS unsigned*)(lds + RTW_LO + off) = lo; }
            }
            {   const int e = tid & 31, kg = tid >> 5; float cp = 0.f;
#pragma unroll 8
                for (int i = 0; i < 64; ++i) { const int k = kg * 64 + i; cp += *(const LAS float*)(lds + RT_S_OFF + k * 4) * wr[(size_t)k * 32 + e]; }
                *(LAS float*)(lds + RT_CP + (kg * 32 + e) * 4) = cp; }
            __syncthreads();
            if (tid < 32) { float sc = br[tid];
#pragma unroll
                for (int kg = 0; kg < 16; ++kg) sc += *(const LAS float*)(lds + RT_CP + (kg * 32 + tid) * 4);
                *(LAS float*)(lds + RT_CE + tid * 4) = sc; }
        }
        if (tid < 32) lcnt[tid] = 0u;
        __syncthreads();
        f32x4 acc0 = {0.f, 0.f, 0.f, 0.f}, acc1 = {0.f, 0.f, 0.f, 0.f}; float ss = 0.f;
        {   const int f0 = rt_f(r), f1 = rt_f(16 + r);
            const LAS unsigned char* row0 = lds + r * 2048; const LAS unsigned char* row1 = lds + (16 + r) * 2048;
#pragma unroll
            for (int ks = 0; ks < 16; ++ks) {
                const int ch = kh * 64 + 4 * ks + g; const int o0 = (ch ^ f0) << 4, o1 = (ch ^ f1) << 4;
                const bf16x8 xb = __builtin_bit_cast(bf16x8, xf[ks]);
                acc0 = MFMA16(*(const LAS bf16x8*)(row0 + o0), xb, acc0); acc0 = MFMA16(*(const LAS bf16x8*)(row0 + RTW_LO + o0), xb, acc0);
                acc1 = MFMA16(*(const LAS bf16x8*)(row1 + o1), xb, acc1); acc1 = MFMA16(*(const LAS bf16x8*)(row1 + RTW_LO + o1), xb, acc1);
                f32x4 v0, v1; unpack8(xf[ks], v0, v1);
                ss += (v0[0] * v0[0] + v0[1] * v0[1]) + (v0[2] * v0[2] + v0[3] * v0[3]) + (v1[0] * v1[0] + v1[1] * v1[1]) + (v1[2] * v1[2] + v1[3] * v1[3]);
                if (ks & 1) asm volatile("" ::: "memory");
            } }
        ss += __shfl_xor(ss, 16); ss += __shfl_xor(ss, 32);
        if (g == 0) *(LAS float*)(lds + RT_SS + ((kh * 4 + tt) * 16 + r) * 4) = ss;
        if (kh == 1) { *(LAS f32x4*)(lds + RT_EX + (tt * 64 + lane) * 32) = acc0; *(LAS f32x4*)(lds + RT_EX + (tt * 64 + lane) * 32 + 16) = acc1; }
        __syncthreads();
        const float rs = rsqrtf((*(const LAS float*)(lds + RT_SS + ((0 * 4 + tt) * 16 + r) * 4) + *(const LAS float*)(lds + RT_SS + ((1 * 4 + tt) * 16 + r) * 4)) * (1.0f / 1024.0f) + EPS);
#pragma unroll
        for (int ks = 0; ks < 16; ++ks) {
            const int d = kh * 512 + 32 * ks + 8 * g;
            f32x4 v0, v1; unpack8(xf[ks], v0, v1);
            v0 = v0 * rs * *(const LAS f32x4*)(lds + RT_G_OFF + d * 4) + *(const LAS f32x4*)(lds + RT_S_OFF + d * 4);
            v1 = v1 * rs * *(const LAS f32x4*)(lds + RT_G_OFF + d * 4 + 16) + *(const LAS f32x4*)(lds + RT_S_OFF + d * 4 + 16);
            *(u32x4*)(HB + (size_t)t * 1024 + d) = pack8(v0, v1);
            if (ks & 1) asm volatile("" ::: "memory");
        }
        float lg[8], wk[8]; int rank[8]; unsigned lslot[8];
        int gq = g; asm volatile("" : "+v"(gq));
        if (kh == 0) {
            const f32x4 p0 = *(const LAS f32x4*)(lds + RT_EX + (tt * 64 + lane) * 32), p1 = *(const LAS f32x4*)(lds + RT_EX + (tt * 64 + lane) * 32 + 16);
            const f32x4 c0 = *(const LAS f32x4*)(lds + RT_CE + (4 * gq) * 4), c1 = *(const LAS f32x4*)(lds + RT_CE + (16 + 4 * gq) * 4);
#pragma unroll
            for (int j = 0; j < 4; ++j) { lg[j] = rs * (acc0[j] + p0[j]) + c0[j]; lg[4 + j] = rs * (acc1[j] + p1[j]) + c1[j]; rank[j] = 0; rank[4 + j] = 0; }
#if RT_DEBUG == 1
            {   float dl[8];
#pragma unroll
                for (int j = 0; j < 8; ++j) dl[j] = 0.f;
                for (int k = 0; k < 1024; ++k) { const float xv = __uint_as_float(((unsigned)((const unsigned short*)X)[(size_t)t * 1024 + k]) << 16);
                    const float v = xv * rs * *(const LAS float*)(lds + RT_G_OFF + k * 4) + *(const LAS float*)(lds + RT_S_OFF + k * 4);
#pragma unroll
                    for (int j = 0; j < 8; ++j) dl[j] += v * wr[(size_t)k * 32 + (j < 4 ? 0 : 16) + 4 * gq + (j & 3)]; }
#pragma unroll
                for (int j = 0; j < 8; ++j) lg[j] = dl[j] + br[(j < 4 ? 0 : 16) + 4 * gq + (j & 3)];
            }
#endif
#if RT_DEBUG == 3 || RT_DEBUG == 4
            {   float dl[8];
#pragma unroll
                for (int j = 0; j < 8; ++j) dl[j] = 0.f;
                const int kb = (RT_DEBUG == 3) ? 512 : 0;
                for (int k = kb; k < kb + 512; ++k) { const float xv = __uint_as_float(((unsigned)((const unsigned short*)X)[(size_t)t * 1024 + k]) << 16);
                    const float v = xv * *(const LAS float*)(lds + RT_G_OFF + k * 4);
#pragma unroll
                    for (int j = 0; j < 8; ++j) dl[j] += v * wr[(size_t)k * 32 + (j < 4 ? 0 : 16) + 4 * gq + (j & 3)]; }
#pragma unroll
                for (int j = 0; j < 4; ++j) {
                    if (RT_DEBUG == 3) { lg[j] = rs * (acc0[j] + dl[j]) + c0[j]; lg[4 + j] = rs * (acc1[j] + dl[4 + j]) + c1[j]; }
                    else { lg[j] = rs * (dl[j] + p0[j]) + c0[j]; lg[4 + j] = rs * (dl[4 + j] + p1[j]) + c1[j]; } }
            }
#endif
#if RT_DEBUG == 5
            {   float dl[8];
#pragma unroll
                for (int j = 0; j < 8; ++j) dl[j] = 0.f;
                for (int k = 0; k < 1024; ++k) { const float xv = __uint_as_float(((unsigned)((const unsigned short*)X)[(size_t)t * 1024 + k]) << 16);
#pragma unroll
                    for (int j = 0; j < 8; ++j) { const int e = (j < 4 ? 0 : 16) + 4 * gq + (j & 3); const int off = e * 2048 + (((k >> 3) ^ rt_f(e)) << 4) + (k & 7) * 2;
                        const float wh = __uint_as_float(((unsigned)*(const LAS unsigned short*)(lds + off)) << 16), wl = __uint_as_float(((unsigned)*(const LAS unsigned short*)(lds + RTW_LO + off)) << 16);
                        dl[j] += xv * (wh + wl); } }
#pragma unroll
                for (int j = 0; j < 4; ++j) { lg[j] = rs * dl[j] + c0[j]; lg[4 + j] = rs * dl[4 + j] + c1[j]; }
            }
#endif
#if RT_DEBUG == 2
            {   float dl[8];
#pragma unroll
                for (int j = 0; j < 8; ++j) dl[j] = 0.f;
                for (int k = 0; k < 1024; ++k) { const float xv = __uint_as_float(((unsigned)((const unsigned short*)X)[(size_t)t * 1024 + k]) << 16);
                    const float v = xv * *(const LAS float*)(lds + RT_G_OFF + k * 4);
#pragma unroll
                    for (int j = 0; j < 8; ++j) dl[j] += v * wr[(size_t)k * 32 + (j < 4 ? 0 : 16) + 4 * gq + (j & 3)]; }
#pragma unroll
                for (int j = 0; j < 4; ++j) { lg[j] = rs * dl[j] + c0[j]; lg[4 + j] = rs * dl[4 + j] + c1[j]; }
            }
#endif
#pragma unroll
            for (int j = 0; j < 8; ++j)
#pragma unroll
                for (int i = 0; i < 8; ++i) if (i != j) rank[j] += (lg[i] > lg[j] || (lg[i] == lg[j] && i < j)) ? 1 : 0;
#pragma unroll
            for (int x = 1; x < 4; ++x) {
                const bool glow = (gq ^ x) < gq;
#pragma unroll
                for (int i = 0; i < 8; ++i) { const float ov = __shfl_xor(lg[i], 16 * x);
#pragma unroll
                    for (int j = 0; j < 8; ++j) { const bool lower = (i < 4 && j >= 4) ? true : (i >= 4 && j < 4) ? false : glow;
                        rank[j] += (ov > lg[j] || (ov == lg[j] && lower)) ? 1 : 0; } }
            }
            float mx = lg[0];
#pragma unroll
            for (int j = 1; j < 8; ++j) mx = fmaxf(mx, lg[j]);
            mx = fmaxf(mx, __shfl_xor(mx, 16)); mx = fmaxf(mx, __shfl_xor(mx, 32));
            float den = 0.f;
#pragma unroll
            for (int j = 0; j < 8; ++j) { wk[j] = rank[j] < 4 ? __expf(lg[j] - mx) : 0.f; den += wk[j]; }
            den += __shfl_xor(den, 16); den += __shfl_xor(den, 32);
            const float invs = 1.0f / den;
#pragma unroll
            for (int j = 0; j < 8; ++j) { wk[j] *= invs; lslot[j] = 0u;
                if (rank[j] < 4) lslot[j] = __hip_atomic_fetch_add(lcnt + ((j < 4 ? 0 : 16) + 4 * gq + (j & 3)), 1u, __ATOMIC_RELAXED, __HIP_MEMORY_SCOPE_WORKGROUP); }
        }
        __syncthreads();
        if (tid < 32) { const unsigned c = lcnt[tid]; lbase[tid] = c ? __hip_atomic_fetch_add(CNT + tid * 64, c, __ATOMIC_RELAXED, __HIP_MEMORY_SCOPE_AGENT) : 0u; }
        __syncthreads();
        if (kh == 0) {
#pragma unroll
            for (int j = 0; j < 8; ++j) if (rank[j] < 4) { const int e = (j < 4 ? 0 : 16) + 4 * gq + (j & 3); const unsigned slot = lbase[e] + lslot[j]; const int a = t * 4 + rank[j];
                LIST[(size_t)e * T + slot] = a; AW[a] = wk[j]; }
        }
    }
    __syncthreads();
}
__device__ __forceinline__ void moe_tables(Frame& F, int l) {
    LAS int* cnt = (LAS int*)(F.lds + MOE_OFF); LAS int* toff = cnt + 32;
    const unsigned* CNT = (const unsigned*)(F.ws + WS_CTL) + CW_CNT + l * 32 * 64;
    __syncthreads();
    if (F.tid < 32) cnt[F.tid] = (int)__hip_atomic_load(CNT + F.tid * 64, __ATOMIC_RELAXED, __HIP_MEMORY_SCOPE_AGENT);
    __syncthreads();
    if (F.tid == 0) { int s = 0; for (int e = 0; e < 32; ++e) { toff[e] = s; s += (cnt[e] + 255) >> 8; } toff[32] = s; }
    __syncthreads();
}

constexpr int NPH = 11, PH_FINAL = 1 + DEPTH * NPH, PH_TOTAL = PH_FINAL + 1;
__global__ void __launch_bounds__(NWAVES * 64, 2) fwd_kernel(Args args) {
    extern __shared__ __attribute__((aligned(16))) unsigned char lds_raw[];
    Frame F;
    F.lds = (LAS unsigned char*)lds_raw; F.ws = args.ws; F.tid = threadIdx.x; F.lane = F.tid & 63; F.wave = __builtin_amdgcn_readfirstlane(F.tid >> 6); F.G = gridDim.x; F.bid = blockIdx.x; F.in = args.in;
    for (int u = F.tid; u < (LDS_BYTES - LDSCTL_OFF) / 4; u += NWAVES * 64) ((LAS unsigned*)(F.lds + LDSCTL_OFF))[u] = 0u;
    __syncthreads();
    const int lo = args.ph_lo, hi = args.ph_hi;
    const unsigned long long tk0_ = (TIME_KIND == 98) ? __builtin_amdgcn_s_memrealtime() : 0ull; unsigned long long tbar_ = 0ull;
    XcdBarrier bar; bar.bar = (unsigned*)(F.ws + WS_CTL) + CW_BAR; bar.x = 0; bar.st = nullptr;
    if (hi - lo > 1) bar = xcd_barrier_post((unsigned*)(F.ws + WS_CTL) + CW_BAR, (volatile LAS unsigned*)(F.lds + MISC_OFF) + 8);
#define IN(k) (lo <= (k) && (k) < hi)
#define PROJ ((bf16*)(ws + WS_PROJ))
#define SEAM(k) do { if (IN(k) && IN((k) + 1)) { const bool acc_ = (TIME_KIND == 97) && ((TIME_MASK >> ((((k) + NPH - 1) % NPH) + 1)) & 1); const unsigned long long tb0_ = acc_ ? __builtin_amdgcn_s_memrealtime() : 0ull; xcd_barrier(bar); if (acc_) tbar_ += __builtin_amdgcn_s_memrealtime() - tb0_; } } while (0)
#define TSTART(kind) unsigned long long t0_ = (TIME_KIND == (kind) || TIME_KIND == 99) ? __builtin_amdgcn_s_memrealtime() : 0ull
#define TSTALL(kind) do { if (TIME_KIND == (kind) || TIME_KIND == 99) { const unsigned long long t1_ = __builtin_amdgcn_s_memrealtime(); const unsigned long long dt_ = t1_ - t0_; while (__builtin_amdgcn_s_memrealtime() - t1_ < dt_) __builtin_amdgcn_s_sleep(8); } } while (0)
    unsigned char* ws = F.ws;
#define PHASE_ENTER() do { unsigned char* w_ = args.ws; asm volatile("" : "+s"(w_)); F.ws = w_; ws = w_; int t_ = threadIdx.x; asm volatile("" : "+v"(t_)); F.tid = t_; F.lane = t_ & 63; F.wave = __builtin_amdgcn_readfirstlane(t_ >> 6); } while (0)
    if (EN(0) && IN(0)) { PHASE_ENTER(); TSTART(0); REPS(0) { p_prologue(F); } SEAM(0); TSTALL(0); }
    for (int l = 0; l < DEPTH; ++l) {
        const int pb = 1 + l * NPH;
        if (EN(1) && IN(pb + 0)) { PHASE_ENTER(); TSTART(1); if (REP_KIND == 1) p_norm_mix(F, l, false, nullptr, true); p_norm_mix(F, l, false, nullptr); SEAM(pb + 0); TSTALL(1); }
        if (EN(2) && IN(pb + 1)) { PHASE_ENTER(); TSTART(2);
            REPS(2) {
            { pg8::DenseOrder S; S.init(T, NPROJ, F.G, F.bid, ws + WS_HB, 1024, (bf16*)wl(ws, l, WL_IN) + (size_t)NHT * 1024, 1024);
              EpiProj E{PROJ};
              pg8::gemm_phase(F.lds, 1024, S, E); }
            { int z = 0; asm volatile("" : "+s"(z)); pg8::DenseOrder S; S.init(NHT, T, F.G, (F.bid + 64 + z) % F.G, wl(ws, l, WL_IN) + z, 1024, ws + WS_HB + z, 1024);
              EpiHT E{(bf16*)(ws + WS_HT)};
              pg8::gemm_phase(F.lds, 1024, S, E); }
            }
            SEAM(pb + 1); TSTALL(2);
        }
        if (EN(3) && IN(pb + 2)) { PHASE_ENTER(); TSTART(3); REPS(3) { p_mla_prep(F); } SEAM(pb + 2); TSTALL(3); }
        if (EN(4) && IN(pb + 3)) { PHASE_ENTER(); TSTART(4);
#ifndef SUBMASK
#define SUBMASK 7
#endif
            REPS(4) {
            if (SUBMASK & 1) { pg8::DenseOrder S; S.init(T, 768, F.G, F.bid, PROJ + PCQ, NPROJ, wl(ws, l, WL_Q), 384);
              EpiQ E{(bf16*)(ws + WS_Q), (const float*)(ws + WS_RSQ), (const float*)(ws + WS_COS), (const float*)(ws + WS_SIN)};
              pg8::gemm_phase(F.lds, 384, S, E); }
            if (SUBMASK & 2) { int z = 0; asm volatile("" : "+s"(z)); pg8::DenseOrder S; S.init(T, 512, F.G, (F.bid + 64 + z) % F.G, PROJ + PCKV + z, NPROJ, wl(ws, l, WL_K) + z, 256);
              EpiK E{(bf16*)(ws + WS_K), (const float*)(ws + WS_RSKV)};
              pg8::gemm_phase(F.lds, 256, S, E); }
            if (SUBMASK & 4) { int z = 0; asm volatile("" : "+s"(z)); pg8::DenseOrder S; S.init(512, T, F.G, (F.bid + 192 + z) % F.G, wl(ws, l, WL_V) + z, 256, PROJ + PCKV + z, NPROJ);
              EpiV E{(bf16*)(ws + WS_VT), (const float*)(ws + WS_RSKV)};
              pg8::gemm_phase(F.lds, 256, S, E); }
            }
            SEAM(pb + 3); TSTALL(4);
        }
        if (EN(5) && IN(pb + 4)) { PHASE_ENTER(); TSTART(5);
            REPS(5) {
            if (rep_ == 0 || (REP_SUB & 1)) for (int u = F.bid; u < 128 * SCAN_REP; u += F.G) scan_unit2(F, l, u & 127);
            if (rep_ == 0 || (REP_SUB & 2)) {
                unsigned* qctr = (unsigned*)(ws + WS_CTL) + CW_Q + (l * 2 + rep_) * 64; volatile LAS unsigned* misc = (volatile LAS unsigned*)(F.lds + MISC_OFF);
                for (;;) { __syncthreads(); if (F.tid == 0) misc[0] = __hip_atomic_fetch_add(qctr, 1u, __ATOMIC_RELAXED, __HIP_MEMORY_SCOPE_AGENT); __syncthreads();
                    const int a = (int)misc[0]; if (a >= 512 * ATTN_REP) break; attn_unit(F, (a & 511) >> 3, (a & 7) * 256); }
            }
            }
            SEAM(pb + 4); TSTALL(5);
        }
        if (EN(6) && IN(pb + 5)) { PHASE_ENTER(); TSTART(6); REPS(6) { p_hgrn_post(F, l); } SEAM(pb + 5); TSTALL(6); }
        if (EN(7) && IN(pb + 6)) { PHASE_ENTER(); TSTART(7);
            REPS(7) {
            { pg8::DenseOrder S; S.init(T, 1024, F.G, F.bid, ws + WS_HA, 1024, wl(ws, l, WL_OUT), 1024);
              EpiOut E{(bf16*)(ws + WS_Y), PROJ};
              pg8::gemm_phase(F.lds, 1024, S, E); }
            }
            SEAM(pb + 6); TSTALL(7);
        }
        if (EN(8) && IN(pb + 7)) { PHASE_ENTER(); TSTART(8);
            pg8::DenseOrder S; S.init(T, 1024, F.G, F.bid, ws + WS_Y, 1024, wl(ws, l, WL_O), 1024);
            if (REP_KIND == 8) { EpiWo E2{(bf16*)(ws + WS_ACT), (const float*)(ws + WS_MOD) + (size_t)l * 8 * 6144 + 2 * 1024}; pg8::gemm_phase(F.lds, 1024, S, E2); }
            EpiWo E{(bf16*)(ws + WS_X), (const float*)(ws + WS_MOD) + (size_t)l * 8 * 6144 + 2 * 1024};
            pg8::gemm_phase(F.lds, 1024, S, E);
            if (REP_KIND == 13) { for (int q = 0; q < 10; ++q) xcd_barrier(bar); }
            SEAM(pb + 7); TSTALL(8);
        }
        if (EN(9) && IN(pb + 8)) { PHASE_ENTER(); TSTART(9); if (REP_KIND == 9) p_router(F, l, true); p_router(F, l); SEAM(pb + 8); TSTALL(9); }
        if (EN(10) && IN(pb + 9)) { PHASE_ENTER(); TSTART(10);
            moe_tables(F, l);
            pg8::MoeOrder<true> S; S.cnt = (const LAS int*)(F.lds + MOE_OFF); S.toff = S.cnt + 32; S.NT = 8; S.G = F.G; S.c = F.bid; S.Abase = (const char*)(ws + WS_HB); S.Bbase = (const char*)wl(ws, l, WL_GU);
            S.b_expert_bytes = (size_t)2048 * 1024 * 2; S.list = (const int*)(ws + WS_LIST); S.lda = 1024; S.ldb = 1024;
            EpiGU E{(bf16*)(ws + WS_ACT), F.in[20] + (size_t)l * 32 * 2048};
            REPS(10) { pg8::gemm_phase(F.lds, 1024, S, E); }
            SEAM(pb + 9); TSTALL(10);
        }
        if (EN(11) && IN(pb + 10)) { PHASE_ENTER(); TSTART(11);
            moe_tables(F, l);
            pg8::MoeOrder<false> S; S.cnt = (const LAS int*)(F.lds + MOE_OFF); S.toff = S.cnt + 32; S.NT = 4; S.G = F.G; S.c = F.bid; S.Abase = (const char*)(ws + WS_ACT); S.Bbase = (const char*)wl(ws, l, WL_DN);
            S.b_expert_bytes = (size_t)1024 * 1024 * 2; S.list = (const int*)(ws + WS_LIST); S.lda = 1024; S.ldb = 1024;
            EpiDown E{ws + WS_YR, F.in[22] + (size_t)l * 32 * 1024, (const int*)(ws + WS_LIST), (const float*)(ws + WS_AW)};
            REPS(11) { pg8::gemm_phase(F.lds, 1024, S, E); }
            SEAM(pb + 10); TSTALL(11);
        }
    }
    if (EN(12) && IN(PH_FINAL)) { PHASE_ENTER(); p_norm_mix(F, DEPTH, true, args.out); }
    if (TIME_KIND == 97 && F.bid == (TIME_BLOCK)) { const unsigned long long t1_ = __builtin_amdgcn_s_memrealtime(); while (__builtin_amdgcn_s_memrealtime() - t1_ < tbar_) __builtin_amdgcn_s_sleep(8); }
    if (TIME_KIND == 98 && F.bid == 0) { const unsigned long long t1_ = __builtin_amdgcn_s_memrealtime(); const unsigned long long dt_ = t1_ - tk0_; while (__builtin_amdgcn_s_memrealtime() - t1_ < dt_) __builtin_amdgcn_s_sleep(8); }
#undef IN
#undef SEAM
#undef PROJ
#undef PHASE_ENTER
}

extern "C" void kernel_launch(void* const* d_in, const int* in_sizes, int n_in, void* d_out, int out_size, void* d_ws, size_t ws_size, hipStream_t stream) {
    static int grid = 0;
    if (grid == 0) {
        if (n_in != 24 || in_sizes[0] != T * D || out_size != T * D || ws_size < WS_END) { fprintf(stderr, "kernel_launch: unexpected problem (n_in %d, in0 %d, out %d, ws %zu, need %zu)\n", n_in, n_in > 0 ? in_sizes[0] : -1, out_size, ws_size, (size_t)WS_END); grid = -1; return; }
        int dev = 0, cus = 0, per_cu = 0;
        if (hipGetDevice(&dev) != hipSuccess || hipDeviceGetAttribute(&cus, hipDeviceAttributeMultiprocessorCount, dev) != hipSuccess) { grid = -1; return; }
        if (hipFuncSetAttribute((const void*)fwd_kernel, hipFuncAttributeMaxDynamicSharedMemorySize, LDS_BYTES) != hipSuccess) { fprintf(stderr, "kernel_launch: hipFuncSetAttribute failed\n"); grid = -1; return; }
        if (hipOccupancyMaxActiveBlocksPerMultiprocessor(&per_cu, (const void*)fwd_kernel, NWAVES * 64, LDS_BYTES) != hipSuccess || per_cu < 1) { fprintf(stderr, "kernel_launch: occupancy query says %d\n", per_cu); (void)hipGetLastError(); }
        grid = cus - (cus % 8);
        if (grid < 64) { fprintf(stderr, "kernel_launch: only %d CUs\n", cus); grid = -1; return; }
    }
    if (grid < 0) return;
    if (hipMemsetAsync((char*)d_ws + WS_CTL, 0, CTL_ZERO_BYTES, stream) != hipSuccess) return;
    Args a{};
    for (int i = 0; i < 24; ++i) a.in[i] = (const float*)d_in[i];
    a.out = (float*)d_out; a.ws = (unsigned char*)d_ws;
#if MK_PER_PHASE
    for (int ph = 0; ph < PH_TOTAL; ++ph) { a.ph_lo = ph; a.ph_hi = ph + 1; hipLaunchKernelGGL(fwd_kernel, dim3(grid), dim3(NWAVES * 64), LDS_BYTES, stream, a); }
#else
    a.ph_lo = 0; a.ph_hi = PH_TOTAL; hipLaunchKernelGGL(fwd_kernel, dim3(grid), dim3(NWAVES * 64), LDS_BYTES, stream, a);
#endif
}
```

```cpp
#include <hip/hip_runtime.h>
#include <cstdio>
#include <cstdint>

#ifndef RT_DEBUG
#define RT_DEBUG 0
#endif
#ifndef PHASE_MASK
#define PHASE_MASK 0xFFFFu
#endif
#define EN(k) (((PHASE_MASK) >> (k)) & 1u)
#ifndef REP_KIND
#define REP_KIND -1
#endif
#ifndef REP_SUB
#define REP_SUB 3
#endif
#ifndef TIME_MASK
#define TIME_MASK 0xFFFF
#endif
#ifndef TIME_BLOCK
#define TIME_BLOCK 0
#endif
#ifndef TIME_KIND
#define TIME_KIND -1
#endif
#ifndef ATTN_REP
#define ATTN_REP 1
#endif
#ifndef SCAN_REP
#define SCAN_REP 1
#endif
#ifndef EPI_REP
#define EPI_REP 1
#endif
#define REPS(k) _Pragma("unroll 1") for (int rep_ = 0; rep_ < ((REP_KIND) == (k) ? 2 : 1); ++rep_)
#ifndef MK_PER_PHASE
#define MK_PER_PHASE 0
#endif

#define GAS __attribute__((address_space(1)))
#define LAS __attribute__((address_space(3)))
typedef unsigned short bf16;
typedef short bf16x8 __attribute__((ext_vector_type(8)));
typedef float f32x4 __attribute__((ext_vector_type(4)));
typedef float f32x2 __attribute__((ext_vector_type(2)));
typedef float f32x16 __attribute__((ext_vector_type(16)));
typedef unsigned u32x4 __attribute__((ext_vector_type(4)));
typedef unsigned u32x2 __attribute__((ext_vector_type(2)));
typedef __bf16 bfv2 __attribute__((ext_vector_type(2)));
__device__ __forceinline__ unsigned pk4_fp8(float a, float b, float c, float d) { unsigned w = 0u; w = __builtin_amdgcn_cvt_pk_fp8_f32(a, b, w, false); w = __builtin_amdgcn_cvt_pk_fp8_f32(c, d, w, true); return w; }
constexpr float YR_SCALE = 16.0f, YR_INV = 1.0f / 16.0f;

__device__ __forceinline__ unsigned pk2(float lo, float hi) { f32x2 v = {lo, hi}; bfv2 r = __builtin_convertvector(v, bfv2); return __builtin_bit_cast(unsigned, r); }
__device__ __forceinline__ float bf2f(unsigned short b) { return __uint_as_float(((unsigned)b) << 16); }
__device__ __forceinline__ float bflo(unsigned w) { return __uint_as_float(w << 16); }
__device__ __forceinline__ float bfhi(unsigned w) { return __uint_as_float(w & 0xffff0000u); }
__device__ __forceinline__ u32x4 pack8(f32x4 a, f32x4 b) { u32x4 w; w.x = pk2(a[0], a[1]); w.y = pk2(a[2], a[3]); w.z = pk2(b[0], b[1]); w.w = pk2(b[2], b[3]); return w; }
__device__ __forceinline__ void unpack8(u32x4 w, f32x4& a, f32x4& b) { a[0] = bflo(w.x); a[1] = bfhi(w.x); a[2] = bflo(w.y); a[3] = bfhi(w.y); b[0] = bflo(w.z); b[1] = bfhi(w.z); b[2] = bflo(w.w); b[3] = bfhi(w.w); }
__device__ __forceinline__ float sigmoidf_(float x) { return 1.0f / (1.0f + __expf(-x)); }
__device__ __forceinline__ float wave_sum(float v) {
#pragma unroll
    for (int o = 1; o < 64; o <<= 1) v += __shfl_xor(v, o);
    return v;
}
#define LDS_WAIT() asm volatile("s_waitcnt lgkmcnt(0)" ::: "memory")
#define VM_WAIT() asm volatile("s_waitcnt vmcnt(0)" ::: "memory")

#define XB_TMO      128
#define XB_XCNT(j)  (256  + 64 * (j))
#define XB_XSUB(j)  (1280 + 64 * (j))
#define XB_XGEN(j)  (2304 + 64 * (j))
#define XB_TOP      3328
#define XB_TOPGEN   3392
#define XCD_BAR_WORDS 3456
#define XB_SPIN_CAP (1u << 20)

__device__ __forceinline__ unsigned xb_ld(unsigned* p)              { return __hip_atomic_load(p, __ATOMIC_RELAXED, __HIP_MEMORY_SCOPE_AGENT); }
__device__ __forceinline__ unsigned xb_add(unsigned* p, unsigned v) { return __hip_atomic_fetch_add(p, v, __ATOMIC_RELAXED, __HIP_MEMORY_SCOPE_AGENT); }
__device__ __forceinline__ unsigned xb_xcc_id() { return (unsigned)__builtin_amdgcn_s_getreg((3 << 11) | 20) & 0xFu; }
#define XB_SPIN(cond, bar) do { unsigned _sp = 0; while (cond) { __builtin_amdgcn_s_sleep(1); \
    if ((++_sp & 255u) == 0u) { if (xb_ld(&(bar)[XB_TMO])) break; if (_sp > XB_SPIN_CAP) { atomicAdd(&(bar)[XB_TMO], 1u); break; } } } } while (0)

struct XcdBarrier { unsigned* bar; unsigned x; volatile LAS unsigned* st; };

__device__ __forceinline__ XcdBarrier xcd_barrier_post(unsigned* bar, volatile LAS unsigned* st) {
    XcdBarrier b; b.bar = bar; b.x = xb_xcc_id(); b.st = st;
    if (threadIdx.x == 0) (void)xb_add(&bar[XB_XCNT(b.x)], 1u);
    return b;
}
__device__ __forceinline__ void xcd_barrier_complete(unsigned* bar, unsigned x, unsigned& nloc, unsigned& nx) {
    const unsigned G = gridDim.x * gridDim.y * gridDim.z;
    unsigned sum, cnt, mine, sp = 0u;
    for (;;) {
        sum = 0u; cnt = 0u; mine = 0u;
#pragma unroll
        for (unsigned j = 0; j < 16; ++j) { const unsigned c = xb_ld(&bar[XB_XCNT(j)]); sum += c; cnt += (c > 0u) ? 1u : 0u; mine = (j == x) ? c : mine; }
        if (sum == G) break;
        __builtin_amdgcn_s_sleep(1);
        if ((++sp & 255u) == 0u) { if (xb_ld(&bar[XB_TMO])) break; if (sp > XB_SPIN_CAP) { atomicAdd(&bar[XB_TMO], 1u); break; } }
    }
    nloc = mine > 0u ? mine : 1u; nx = cnt > 0u ? cnt : 1u;
}
__device__ __forceinline__ void xcd_barrier(const XcdBarrier& b) {
    asm volatile("s_waitcnt vmcnt(0)" ::: "memory");
    __syncthreads();
    if (threadIdx.x == 0) {
        unsigned* bar = b.bar;
        __builtin_amdgcn_s_waitcnt(0);
        unsigned nloc = b.st[0], nx = b.st[1];
        if (nloc == 0u) { xcd_barrier_complete(bar, b.x, nloc, nx); b.st[0] = nloc; b.st[1] = nx; }
        const unsigned old = xb_add(&bar[XB_XSUB(b.x)], 1u);
        const unsigned gen = old / nloc;
        if (old + 1u == (gen + 1u) * nloc) {
            __builtin_amdgcn_fence(__ATOMIC_RELEASE, "agent");
            asm volatile("s_waitcnt vmcnt(0)" ::: "memory");
            const unsigned og = xb_add(&bar[XB_TOP], 1u);
            const unsigned tg = og / nx;
            if (og + 1u == (tg + 1u) * nx) xb_add(&bar[XB_TOPGEN], 1u);
            else XB_SPIN(xb_ld(&bar[XB_TOPGEN]) == tg, bar);
            __builtin_amdgcn_fence(__ATOMIC_ACQUIRE, "agent");
            xb_add(&bar[XB_XGEN(b.x)], 1u);
            asm volatile("s_waitcnt vmcnt(0)" ::: "memory");
        } else {
            XB_SPIN(xb_ld(&bar[XB_XGEN(b.x)]) == gen, bar);
            __builtin_amdgcn_fence(__ATOMIC_ACQUIRE, "agent");
            asm volatile("s_waitcnt vmcnt(0)" ::: "memory");
        }
    }
    __syncthreads();
}

constexpr int D = 1024, NB = 8, SEQ = 2048, T = NB * SEQ, DEPTH = 4;
constexpr int NPROJ = 3328;
constexpr int NHT = 2048;
constexpr int PGT = 0, PGA = 512, PGB = 1536, PCQ = 2560, PCKV = 2944, PKPE = 3200;
constexpr int HQ = 0, HFF = 512, HFB = 1024, HI = 1536;
constexpr int NE = 32, TOPK = 4, NASSIGN = T * TOPK, ACT_ROWS = NASSIGN + NE * 256;
constexpr float EPS = 1e-6f;
constexpr float QSCALE = 0.10206207261596575f * 1.4426950408889634f;

constexpr size_t MiB = 1u << 20;
constexpr size_t WS_CTL = 0, CTL_ZERO_BYTES = 1 * MiB;
constexpr size_t WS_MOD = 1 * MiB, WS_LB = 2 * MiB, WS_COS = 3 * MiB, WS_SIN = 4 * MiB, WS_RSQ = 5 * MiB, WS_RSKV = 5 * MiB + 65536, WS_AW = 6 * MiB, WS_LIST = 7 * MiB;
constexpr size_t WS_X = 16 * MiB, WS_HB = 80 * MiB, WS_PROJ = 112 * MiB, WS_HT = 216 * MiB, WS_Q = 280 * MiB, WS_K = 304 * MiB, WS_VT = 328 * MiB, WS_OF = 344 * MiB, WS_OB = 376 * MiB;
constexpr size_t WS_HA = 408 * MiB, WS_Y = 440 * MiB, WS_ACT = 472 * MiB, WS_YR = 616 * MiB, WS_W = 768 * MiB;
constexpr size_t WL_IN = 0, WL_Q = 11 * MiB, WL_K = 12 * MiB, WL_V = 12 * MiB + 256 * 1024, WL_OUT = 13 * MiB, WL_O = 15 * MiB, WL_GU = 17 * MiB, WL_DN = 145 * MiB, WL_STRIDE = 209 * MiB;
constexpr size_t WS_END = WS_W + DEPTH * WL_STRIDE;
static_assert((size_t)T * NPROJ * 2 <= WS_HT - WS_PROJ && (size_t)NB * NHT * SEQ * 2 <= WS_Q - WS_HT && (size_t)ACT_ROWS * 1024 * 2 <= WS_YR - WS_ACT && (size_t)NASSIGN * 1024 * 2 <= WS_W - WS_YR, "ws map");
constexpr int CW_BAR = 4096, CW_Q = 8192, CW_CNT = 16384;

constexpr int RING_BYTES = 131072;
constexpr int LDSCTL_OFF = 139264, MISC_OFF = LDSCTL_OFF + 320, MOE_OFF = LDSCTL_OFF + 1024;
constexpr int LDS_BYTES = 155648;
constexpr int RT_G_OFF = 143360, RT_S_OFF = 147456;
constexpr int NWAVES = 8;

namespace pg8 {
constexpr int BM = 256, BK = 64, HALF = 128, HTB = HALF * BK * 2, NXCD = 8, WGM = 8;
__device__ __forceinline__ int lds_byte(int r, int c) { const int st = (r >> 4) * 2 + (c >> 5), rr = r & 15, cc = c & 31, ob = rr * 64 + cc * 2; return st * 1024 + (ob ^ (((ob >> 9) & 1) << 5)); }
__device__ __forceinline__ void stage_rc(int b, int& R, int& C) { const int st = b / 1024, sb = b % 1024, swz = sb ^ (((sb >> 9) & 1) << 5); R = (st >> 1) * 16 + swz / 64; C = (st & 1) * 32 + (swz % 64) / 2; }
__device__ __forceinline__ int perm32(int rho) { const int n = rho >> 4, i = rho & 15; return 8 * (i >> 2) + 4 * n + (i & 3); }

struct Unit { const char* A; const char* B; int pm, pn, e, rowbase, mrows; };

struct DenseOrder {
    static constexpr bool GATHER_A = false;
    int nM, nN, nwg, G, c; const char* Abase; const char* Bbase; int lda, ldb;
    __device__ __forceinline__ void init(int M, int N, int G_, int c_, const void* A, int lda_, const void* B, int ldb_) { nM = M / BM; nN = N / BM; nwg = nM * nN; G = G_; c = c_; Abase = (const char*)A; Bbase = (const char*)B; lda = lda_; ldb = ldb_; }
    __device__ __forceinline__ bool next(int i, Unit& u) const {
        const long L = (long)i * G + c; if (L >= nwg) return false;
        int wgid = (int)L; { const int q = nwg / NXCD, r = nwg % NXCD, xcd = wgid % NXCD, off = wgid / NXCD; wgid = (xcd < r ? xcd * (q + 1) : r * (q + 1) + (xcd - r) * q) + off; }
        const int nig = WGM * nN, gid = wgid / nig, fm = gid * WGM, gsz = (nM - fm) < WGM ? (nM - fm) : WGM;
        u.pm = fm + ((wgid % nig) % gsz); u.pn = (wgid % nig) / gsz; u.e = 0; u.rowbase = 0; u.mrows = 256;
        u.A = Abase + (size_t)u.pm * 256 * lda * 2; u.B = Bbase + (size_t)u.pn * 256 * ldb * 2; return true;
    }
    __device__ __forceinline__ void aoff(const Unit&, const int (&R)[2], const int (&C)[2], unsigned (&v)[2][2]) const {
#pragma unroll
        for (int h = 0; h < 2; ++h)
#pragma unroll
            for (int i = 0; i < 2; ++i) v[h][i] = (unsigned)((128 * h + R[i]) * lda + C[i]) * 2u;
    }
};
template <bool GATHER> struct MoeOrder {
    static constexpr bool GATHER_A = GATHER;
    const LAS int* toff; const LAS int* cnt; int NT, G, c; const char* Abase; const char* Bbase; size_t b_expert_bytes; const int* list; int lda, ldb;
    __device__ __forceinline__ bool next(int i, Unit& u) const {
        const int spx = G >> 3, rpx = spx / NT, xcd = c & 7, slot = c >> 3;
        if (slot >= rpx * NT) return false;
        const int R = (i * 8 + xcd) * rpx + slot / NT; if (R >= toff[NE]) return false;
        int e = 0; while (toff[e + 1] <= R) ++e;
        u.e = e; u.pm = R - toff[e]; u.pn = slot % NT; u.rowbase = R * 256; u.mrows = cnt[e] - u.pm * 256;
        u.A = GATHER ? Abase : Abase + (size_t)u.rowbase * lda * 2; u.B = Bbase + (size_t)e * b_expert_bytes + (size_t)u.pn * 256 * ldb * 2; return true;
    }
    __device__ __forceinline__ void aoff(const Unit& u, const int (&R)[2], const int (&C)[2], unsigned (&v)[2][2]) const {
#pragma unroll
        for (int h = 0; h < 2; ++h)
#pragma unroll
            for (int i = 0; i < 2; ++i) {
                if (GATHER) { const int rl = 128 * h + R[i]; const int a = list[(size_t)u.e * T + u.pm * 256 + (rl < u.mrows ? rl : 0)]; v[h][i] = (unsigned)((a >> 2) * lda + C[i]) * 2u; }
                else v[h][i] = (unsigned)((128 * h + R[i]) * lda + C[i]) * 2u;
            }
    }
};

template <class E, class = void> struct has_mid { static constexpr bool value = false; };
template <class E> struct has_mid<E, decltype((void)E::HAS_MID)> { static constexpr bool value = true; };
template <class Epi, class Sched>
__device__ __forceinline__ void gemm_phase(LAS unsigned char* lds, const int K, const Sched& S, const Epi& E) {
    int tid_ = threadIdx.x; asm volatile("" : "+v"(tid_));
    const int tid = tid_, wid = __builtin_amdgcn_readfirstlane(tid >> 6), lane = tid & 63, wr = wid >> 2, wc = wid & 3, fr = lane & 15, fq = lane >> 4;
    int nt_ = K / BK; asm volatile("" : "+s"(nt_));
    const int nt = nt_;
    int sR[2], sC[2]; unsigned voffB[2];
#pragma unroll
    for (int i = 0; i < 2; ++i) { stage_rc(tid * 16 + i * 8192, sR[i], sC[i]); const int Rb = (sR[i] & ~31) + perm32(sR[i] & 31); voffB[i] = (unsigned)(Rb * S.ldb + sC[i]) * 2u; }
    constexpr bool GA = Sched::GATHER_A;
    unsigned voffA[2];
#pragma unroll
    for (int i = 0; i < 2; ++i) voffA[i] = (unsigned)(sR[i] * S.lda + sC[i]) * 2u;
    const size_t kstep = (size_t)(BK * 2);
    const size_t hstepB = (size_t)HALF * S.ldb * 2, hstepA = (size_t)HALF * S.lda * 2;
    const unsigned ldsw = (unsigned)wid * 1024u;
    const unsigned ldsbase = (unsigned)__builtin_amdgcn_readfirstlane((int)((unsigned)(size_t)lds + ldsw));
    const int aoff = lds_byte(wr * 64 + fr, fq * 8), boff = lds_byte(wc * 32 + fr, fq * 8);
#define PG8_SA(b, h) (((b) * 2 + (h)) * HTB)
#define PG8_SB(b, h) ((4 + (b) * 2 + (h)) * HTB)
#define PG8_DMA2(ldsaddr, gbase, v0_, v1_) do { unsigned keep_; \
        asm volatile("s_mov_b32 %0, m0\n\ts_mov_b32 m0, %4\n\ts_nop 0\n\tglobal_load_lds_dwordx4 %1, %3\n\ts_add_u32 m0, %4, 0x2000\n\ts_nop 0\n\tglobal_load_lds_dwordx4 %2, %3\n\ts_mov_b32 m0, %0" \
                     : "=&s"(keep_) : "v"(v0_), "v"(v1_), "s"(gbase), "s"(ldsaddr) : "memory", "scc"); } while (0)
#define PG8_STAGE(bufoff, gbase, voff) PG8_DMA2(ldsbase + (unsigned)(bufoff), (const char*)(gbase), (voff)[0], (voff)[1])
#define PG8_STAGEA(bufoff, gbase, h, nx) do { if constexpr (GA) { PG8_DMA2(ldsbase + (unsigned)(bufoff), (const char*)(gbase), ((nx) ? nvA[h][0] : vA[h][0]), ((nx) ? nvA[h][1] : vA[h][1])); } \
        else { PG8_DMA2(ldsbase + (unsigned)(bufoff), (const char*)(gbase) + (size_t)(h) * hstepA, voffA[0], voffA[1]); } } while (0)
#define PG8_LDA(dst, b, h) do { _Pragma("unroll") for (int m = 0; m < 4; ++m) _Pragma("unroll") for (int k = 0; k < 2; ++k) dst[m][k] = *(const LAS bf16x8*)(lds + PG8_SA(b, h) + aoff + m * 2048 + k * 1024); } while (0)
#define PG8_LDB(dst, b, h) do { _Pragma("unroll") for (int n = 0; n < 2; ++n) _Pragma("unroll") for (int k = 0; k < 2; ++k) dst[n][k] = *(const LAS bf16x8*)(lds + PG8_SB(b, h) + boff + n * 2048 + k * 1024); } while (0)
#define PG8_MMA(ai, bj, At, Bt) do { __builtin_amdgcn_s_setprio(1); _Pragma("unroll") for (int m = 0; m < 4; ++m) _Pragma("unroll") for (int n = 0; n < 2; ++n) _Pragma("unroll") for (int k = 0; k < 2; ++k) \
        acc[ai][bj][m][n] = __builtin_amdgcn_mfma_f32_16x16x32_bf16(Bt[n][k], At[m][k], acc[ai][bj][m][n], 0, 0, 0); __builtin_amdgcn_s_setprio(0); } while (0)
#define PG8_WAIT_V(n) asm volatile("s_waitcnt vmcnt(" #n ")" ::: "memory")
#define PG8_WAIT_L(n) asm volatile("s_waitcnt lgkmcnt(" #n ")" ::: "memory")
#define PG8_BAR __builtin_amdgcn_s_barrier()
#define PG8_SCHED __builtin_amdgcn_sched_barrier(0)
    Unit cur, nxt; int ui = 0;
    if (!S.next(0, cur)) return;
    f32x4 acc[2][2][4][2];
#pragma unroll
    for (int a = 0; a < 2; ++a)
#pragma unroll
        for (int b = 0; b < 2; ++b)
#pragma unroll
            for (int m = 0; m < 4; ++m)
#pragma unroll
                for (int n = 0; n < 2; ++n) acc[a][b][m][n] = (f32x4){0.f, 0.f, 0.f, 0.f};
    bf16x8 At[4][2], B0[2][2], B1[2][2];
    unsigned vA[2][2], nvA[2][2];
    if constexpr (GA) { S.aoff(cur, sR, sC, vA); }
    const char* cA = cur.A; const char* cB = cur.B;
    PG8_STAGE(PG8_SB(0, 0), cB, voffB); PG8_STAGE(PG8_SB(0, 1), cB + hstepB, voffB); PG8_STAGEA(PG8_SA(0, 0), cA, 0, false); PG8_STAGEA(PG8_SA(0, 1), cA, 1, false);
    if (wr == 1) PG8_BAR;
    PG8_WAIT_V(2); PG8_BAR;
    PG8_STAGE(PG8_SB(1, 0), cB + kstep, voffB); PG8_STAGEA(PG8_SA(1, 0), cA + kstep, 0, false); PG8_STAGE(PG8_SB(1, 1), cB + hstepB + kstep, voffB);
    PG8_WAIT_V(6); PG8_BAR;
    for (;;) {
        const bool has_next = S.next(ui + 1, nxt);
        const char* nA = has_next ? nxt.A : cA; const char* nB = has_next ? nxt.B : cB;
        if constexpr (GA) {
            if (has_next) S.aoff(nxt, sR, sC, nvA);
            else {
#pragma unroll
                for (int h = 0; h < 2; ++h)
#pragma unroll
                    for (int i = 0; i < 2; ++i) nvA[h][i] = vA[h][i]; } }
#pragma unroll 1
        for (int t = 0; t < nt; t += 2) {
            const bool last = (t == nt - 2);
            if constexpr (has_mid<Epi>::value) { if (t == Epi::MID_T) E.mid(acc, cur, wr, wc, fr, fq); }
            const char* a1 = cA + (size_t)(t + 1) * kstep;
            const char* a2 = last ? nA : cA + (size_t)(t + 2) * kstep; const char* b2 = last ? nB : cB + (size_t)(t + 2) * kstep;
            const char* a3 = a2 + kstep; const char* b3 = b2 + kstep;
            PG8_LDB(B0, 0, 0); PG8_LDB(B1, 0, 1); PG8_SCHED; PG8_LDA(At, 0, 0); PG8_STAGEA(PG8_SA(1, 1), a1, 1, false);
            PG8_WAIT_V(8); PG8_WAIT_L(0); PG8_BAR; PG8_MMA(0, 0, At, B0); PG8_MMA(0, 1, At, B1); PG8_BAR; PG8_SCHED;
            PG8_LDA(At, 0, 1); PG8_STAGE(PG8_SB(0, 0), b2, voffB); PG8_STAGE(PG8_SB(0, 1), b2 + hstepB, voffB); PG8_STAGEA(PG8_SA(0, 0), a2, 0, last);
            PG8_WAIT_V(8); PG8_WAIT_L(0); PG8_BAR; PG8_MMA(1, 0, At, B0); PG8_MMA(1, 1, At, B1); PG8_BAR; PG8_SCHED;
            PG8_LDB(B0, 1, 0); PG8_LDB(B1, 1, 1); PG8_SCHED; PG8_LDA(At, 1, 0); PG8_STAGEA(PG8_SA(0, 1), a2, 1, last);
            PG8_WAIT_V(8); PG8_WAIT_L(0); PG8_BAR; PG8_MMA(0, 0, At, B0); PG8_MMA(0, 1, At, B1); PG8_BAR; PG8_SCHED;
            PG8_LDA(At, 1, 1); PG8_STAGE(PG8_SB(1, 0), b3, voffB); PG8_STAGE(PG8_SB(1, 1), b3 + hstepB, voffB); PG8_STAGEA(PG8_SA(1, 0), a3, 0, last);
            PG8_WAIT_V(8); PG8_WAIT_L(0); PG8_BAR; PG8_MMA(1, 0, At, B0); PG8_MMA(1, 1, At, B1); PG8_BAR; PG8_SCHED;
        }
        if (wr == 0) PG8_BAR;
        E(acc, cur, wr, wc, fr, fq);
        if constexpr (EPI_REP > 1 && Epi::IDEMPOTENT) { asm volatile("" ::: "memory"); E(acc, cur, wr, wc, fr, fq); }
        if (!has_next) break;
#pragma unroll
        for (int a = 0; a < 2; ++a)
#pragma unroll
            for (int b = 0; b < 2; ++b)
#pragma unroll
                for (int m = 0; m < 4; ++m)
#pragma unroll
                    for (int n = 0; n < 2; ++n) acc[a][b][m][n] = (f32x4){0.f, 0.f, 0.f, 0.f};
        cur = nxt; cA = nA; cB = nB; ++ui;
        if constexpr (GA) {
#pragma unroll
            for (int h = 0; h < 2; ++h)
#pragma unroll
                for (int i = 0; i < 2; ++i) vA[h][i] = nvA[h][i]; }
        if (wr == 1) PG8_BAR;
    }
    PG8_WAIT_V(0);
    PG8_BAR;
#undef PG8_SA
#undef PG8_SB
#undef PG8_STAGE
#undef PG8_STAGEA
#undef PG8_DMA2
#undef PG8_LDA
#undef PG8_LDB
#undef PG8_MMA
#undef PG8_WAIT_V
#undef PG8_WAIT_L
#undef PG8_BAR
#undef PG8_SCHED
}
}
using pg8::Unit;
typedef const f32x4 (&AccRef)[2][2][4][2];

struct Args {
    const float* in[24]; float* out; unsigned char* ws; int ph_lo, ph_hi;
};
struct Frame {
    LAS unsigned char* lds; unsigned char* ws; int tid, lane, wave, G, bid;
    const float* const* in;
};
__device__ __forceinline__ unsigned char* wl(unsigned char* ws, int l, size_t off) { return ws + WS_W + (size_t)l * WL_STRIDE + off; }

#define EPI_LOOP_BEGIN _Pragma("unroll") for (int ai = 0; ai < 2; ++ai) _Pragma("unroll") for (int m = 0; m < 4; ++m) { const int rl = ai * 128 + wr * 64 + m * 16 + fr; _Pragma("unroll") for (int bj = 0; bj < 2; ++bj) { const int cl = bj * 128 + wc * 32 + 8 * fq; const f32x4 v0 = acc[ai][bj][m][0], v1 = acc[ai][bj][m][1];
#define EPI_LOOP_END } asm volatile("" ::: "memory"); }

struct EpiProj {
    static constexpr bool IDEMPOTENT = (EPI_REP > 2);
    bf16* O;
    __device__ __forceinline__ void operator()(AccRef acc, const Unit& u, int wr, int wc, int fr, int fq) const {
        EPI_LOOP_BEGIN
            *(u32x4*)(O + (size_t)(u.pm * 256 + rl) * NPROJ + u.pn * 256 + cl) = pack8(v0, v1);
        EPI_LOOP_END
    }
};
struct EpiHT {
    static constexpr bool IDEMPOTENT = (EPI_REP > 2);
    bf16* HT;
    __device__ __forceinline__ void operator()(AccRef acc, const Unit& u, int wr, int wc, int fr, int fq) const {
        const int seg = u.pm >> 1;
        EPI_LOOP_BEGIN
            const int f = u.pm * 256 + rl, t0 = u.pn * 256 + cl, b = t0 >> 11, s = t0 & 2047;
            f32x4 a = v0, d = v1;
            if (seg == 0) {
#pragma unroll
                for (int j = 0; j < 4; ++j) { a[j] = a[j] * __builtin_amdgcn_rcpf(1.0f + __builtin_amdgcn_exp2f(-1.4426950408889634f * a[j])); d[j] = d[j] * __builtin_amdgcn_rcpf(1.0f + __builtin_amdgcn_exp2f(-1.4426950408889634f * d[j])); }
            } else if (seg < 3) {
#pragma unroll
                for (int j = 0; j < 4; ++j) { a[j] = __builtin_amdgcn_rcpf(1.0f + __builtin_amdgcn_exp2f(1.4426950408889634f * a[j])); d[j] = __builtin_amdgcn_rcpf(1.0f + __builtin_amdgcn_exp2f(1.4426950408889634f * d[j])); }
            }
            *(u32x4*)(HT + ((size_t)b * NHT + f) * SEQ + s) = pack8(a, d);
        EPI_LOOP_END
    }
};
struct EpiQ {
    static constexpr bool IDEMPOTENT = (EPI_REP > 2);
    bf16* Q; const float* rsq; const float* cs; const float* sn;
    __device__ __forceinline__ void operator()(AccRef acc, const Unit& u, int wr, int wc, int fr, int fq) const {
        EPI_LOOP_BEGIN
            const int t = u.pm * 256 + rl, c0 = u.pn * 256 + cl, head = c0 / 96, w = c0 - head * 96, b = t >> 11, s = t & 2047;
            const float sc = rsq[t] * QSCALE;
            bf16* qp = Q + ((size_t)(b * 8 + head) * SEQ + s) * 96;
            f32x4 a = v0 * sc, d = v1 * sc;
            if (w < 64) { *(u32x4*)(qp + w) = pack8(a, d); }
            else { const int g = (w - 64) >> 3; const f32x4 co = *(const f32x4*)(cs + (size_t)t * 16 + 4 * g), si = *(const f32x4*)(sn + (size_t)t * 16 + 4 * g);
                const f32x4 o1 = a * co - d * si, o2 = d * co + a * si;
                u32x2 w1, w2; w1.x = pk2(o1[0], o1[1]); w1.y = pk2(o1[2], o1[3]); w2.x = pk2(o2[0], o2[1]); w2.y = pk2(o2[2], o2[3]);
                *(u32x2*)(qp + 64 + 4 * g) = w1; *(u32x2*)(qp + 80 + 4 * g) = w2; }
        EPI_LOOP_END
    }
};
struct EpiK {
    static constexpr bool IDEMPOTENT = (EPI_REP > 2);
    bf16* Kb; const float* rskv;
    __device__ __forceinline__ void operator()(AccRef acc, const Unit& u, int wr, int wc, int fr, int fq) const {
        EPI_LOOP_BEGIN
            const int t = u.pm * 256 + rl, c0 = u.pn * 256 + cl, head = c0 >> 6, w = c0 & 63, b = t >> 11, s = t & 2047;
            const float sc = rskv[t];
            *(u32x4*)(Kb + ((size_t)(b * 8 + head) * SEQ + s) * 96 + w) = pack8(v0 * sc, v1 * sc);
        EPI_LOOP_END
    }
};
struct EpiV {
    static constexpr bool IDEMPOTENT = (EPI_REP > 2);
    bf16* VT; const float* rskv;
    __device__ __forceinline__ void operator()(AccRef acc, const Unit& u, int wr, int wc, int fr, int fq) const {
        EPI_LOOP_BEGIN
            const int f = u.pm * 256 + rl, t0 = u.pn * 256 + cl, b = t0 >> 11, s = t0 & 2047, head = f >> 6, dv = f & 63;
            const f32x4 r0 = *(const f32x4*)(rskv + t0), r1 = *(const f32x4*)(rskv + t0 + 4);
            *(u32x4*)(VT + ((size_t)(b * 8 + head) * 64 + dv) * SEQ + s) = pack8(v0 * r0, v1 * r1);
        EPI_LOOP_END
    }
};
struct EpiOut {
    static constexpr bool IDEMPOTENT = false; static constexpr bool HAS_MID = true; static constexpr int MID_T = 8;
    bf16* Y; const bf16* proj;
    __device__ __forceinline__ void mid(f32x4 (&acc)[2][2][4][2], const Unit& u, int wr, int wc, int fr, int fq) const {
        unsigned off0 = (unsigned)((u.pm * 256 + wr * 64 + fr) * NPROJ + u.pn * 256 + wc * 32 + 8 * fq) * 2u;
        asm volatile("" : "+v"(off0));
        const char* gp0 = (const char*)proj;
#pragma unroll
        for (int ai = 0; ai < 2; ++ai)
#pragma unroll
            for (int mp = 0; mp < 2; ++mp) {
                u32x4 ga[2][2], gb[2][2];
#pragma unroll
                for (int mm = 0; mm < 2; ++mm)
#pragma unroll
                    for (int bj = 0; bj < 2; ++bj) { const unsigned o = off0 + (unsigned)(((ai * 128 + (2 * mp + mm) * 16) * NPROJ + bj * 128) * 2); ga[mm][bj] = *(const u32x4*)(gp0 + o + PGA * 2); gb[mm][bj] = *(const u32x4*)(gp0 + o + PGB * 2); }
#pragma unroll
                for (int mm = 0; mm < 2; ++mm)
#pragma unroll
                    for (int bj = 0; bj < 2; ++bj) {
                        f32x4 a0, a1, b0, b1; unpack8(ga[mm][bj], a0, a1); unpack8(gb[mm][bj], b0, b1);
#pragma unroll
                        for (int j = 0; j < 4; ++j) {
                            a0[j] = (1.0f + __builtin_amdgcn_exp2f(-1.4426950408889634f * b0[j])) * __builtin_amdgcn_rcpf(1.0f + __builtin_amdgcn_exp2f(-1.4426950408889634f * a0[j]));
                            a1[j] = (1.0f + __builtin_amdgcn_exp2f(-1.4426950408889634f * b1[j])) * __builtin_amdgcn_rcpf(1.0f + __builtin_amdgcn_exp2f(-1.4426950408889634f * a1[j])); }
                        acc[ai][bj][2 * mp + mm][0] *= a0; acc[ai][bj][2 * mp + mm][1] *= a1;
                    }
                asm volatile("" ::: "memory");
            }
    }
    __device__ __forceinline__ void operator()(AccRef acc, const Unit& u, int wr, int wc, int fr, int fq) const {
        const int c0 = u.pn * 256 + wc * 32 + 8 * fq;
        const bf16* gp = proj + (size_t)(u.pm * 256 + wr * 64 + fr) * NPROJ + PGB + c0;
        bf16* yp = Y + (size_t)(u.pm * 256 + wr * 64 + fr) * 1024 + c0;
#pragma unroll
        for (int ai = 0; ai < 2; ++ai) {
            u32x4 gw[4][2];
#pragma unroll
            for (int m = 0; m < 4; ++m)
#pragma unroll
                for (int bj = 0; bj < 2; ++bj) gw[m][bj] = *(const u32x4*)(gp + (size_t)(ai * 128 + m * 16) * NPROJ + bj * 128);
#pragma unroll
            for (int m = 0; m < 4; ++m)
#pragma unroll
                for (int bj = 0; bj < 2; ++bj) {
                    f32x4 g0, g1; unpack8(gw[m][bj], g0, g1);
#pragma unroll
                    for (int j = 0; j < 4; ++j) { g0[j] = __builtin_amdgcn_rcpf(1.0f + __builtin_amdgcn_exp2f(-1.4426950408889634f * g0[j])); g1[j] = __builtin_amdgcn_rcpf(1.0f + __builtin_amdgcn_exp2f(-1.4426950408889634f * g1[j])); }
                    *(u32x4*)(yp + (size_t)(ai * 128 + m * 16) * 1024 + bj * 128) = pack8(acc[ai][bj][m][0] * g0, acc[ai][bj][m][1] * g1);
                }
            asm volatile("" ::: "memory");
        }
    }
};
struct EpiWo {
    static constexpr bool IDEMPOTENT = false;
    bf16* X; const float* g1;
    __device__ __forceinline__ void operator()(AccRef acc, const Unit& u, int wr, int wc, int fr, int fq) const {
        const int c0 = u.pn * 256 + wc * 32 + 8 * fq, b = (u.pm * 256) >> 11;
        const float* gp = g1 + (size_t)b * 6144 + c0;
        const f32x4 ga0 = *(const f32x4*)gp, gb0 = *(const f32x4*)(gp + 4), ga1 = *(const f32x4*)(gp + 128), gb1 = *(const f32x4*)(gp + 132);
        bf16* xp = X + (size_t)(u.pm * 256 + wr * 64 + fr) * 1024 + c0;
#pragma unroll
        for (int ai = 0; ai < 2; ++ai) {
            u32x4 xv[4][2];
#pragma unroll
            for (int m = 0; m < 4; ++m) { const bf16* p = xp + (size_t)(ai * 128 + m * 16) * 1024; xv[m][0] = *(const u32x4*)p; xv[m][1] = *(const u32x4*)(p + 128); }
#pragma unroll
            for (int m = 0; m < 4; ++m) { bf16* p = xp + (size_t)(ai * 128 + m * 16) * 1024; f32x4 a, d;
                unpack8(xv[m][0], a, d); *(u32x4*)p = pack8(a + ga0 * acc[ai][0][m][0], d + gb0 * acc[ai][0][m][1]);
                unpack8(xv[m][1], a, d); *(u32x4*)(p + 128) = pack8(a + ga1 * acc[ai][1][m][0], d + gb1 * acc[ai][1][m][1]); }
            asm volatile("" ::: "memory");
        }
    }
};
struct EpiGU {
    static constexpr bool IDEMPOTENT = true;
    bf16* ACT; const float* bgu;
    __device__ __forceinline__ void operator()(AccRef acc, const Unit& u, int wr, int wc, int fr, int fq) const {
        const int j0 = u.pn * 128 + wc * 32 + 8 * fq;
        const float* bp = bgu + (size_t)u.e * 2048 + 2 * j0;
        const f32x4 b0 = *(const f32x4*)bp, b1 = *(const f32x4*)(bp + 4), b2 = *(const f32x4*)(bp + 8), b3 = *(const f32x4*)(bp + 12);
        const float bg[8] = {b0[0], b0[2], b1[0], b1[2], b2[0], b2[2], b3[0], b3[2]}, bu[8] = {b0[1], b0[3], b1[1], b1[3], b2[1], b2[3], b3[1], b3[3]};
        bf16* ap = ACT + (size_t)(u.rowbase + wr * 64 + fr) * 1024 + j0;
#pragma unroll
        for (int ai = 0; ai < 2; ++ai)
#pragma unroll
            for (int m = 0; m < 4; ++m) {
                float o[8];
#pragma unroll
                for (int j = 0; j < 8; ++j) {
                    float g = acc[ai][0][m][j >> 2][j & 3] + bg[j], up = acc[ai][1][m][j >> 2][j & 3] + bu[j];
                    g = fminf(g, 7.0f); up = fminf(fmaxf(up, -7.0f), 7.0f);
                    o[j] = (up + 1.0f) * g * __builtin_amdgcn_rcpf(1.0f + __builtin_amdgcn_exp2f(-1.702f * 1.4426950408889634f * g)); }
                u32x4 w; w.x = pk2(o[0], o[1]); w.y = pk2(o[2], o[3]); w.z = pk2(o[4], o[5]); w.w = pk2(o[6], o[7]);
                *(u32x4*)(ap + (size_t)(ai * 128 + m * 16) * 1024) = w;
            }
    }
};
struct EpiDown {
    static constexpr bool IDEMPOTENT = true;
    unsigned char* YR; const float* bd; const int* list; const float* aw;
    __device__ __forceinline__ void operator()(AccRef acc, const Unit& u, int wr, int wc, int fr, int fq) const {
        const int cb = u.pn * 256 + wc * 32 + 8 * fq;
        const float* bp = bd + (size_t)u.e * 1024 + cb;
        const f32x4 ba0 = *(const f32x4*)bp, bb0 = *(const f32x4*)(bp + 4), ba1 = *(const f32x4*)(bp + 128), bb1 = *(const f32x4*)(bp + 132);
        int a[8]; float w[8];
        const int* lp = list + (size_t)u.e * T + u.pm * 256 + wr * 64 + fr;
#pragma unroll
        for (int q = 0; q < 8; ++q) { const int rl = (q >> 2) * 128 + wr * 64 + (q & 3) * 16 + fr; a[q] = (rl < u.mrows) ? lp[(q >> 2) * 128 + (q & 3) * 16] : -1; }
#pragma unroll
        for (int q = 0; q < 8; ++q) w[q] = (a[q] >= 0) ? aw[a[q]] : 0.f;
#pragma unroll
        for (int q = 0; q < 8; ++q) {
            const int ai = q >> 2, m = q & 3;
            if (a[q] >= 0) { unsigned char* yp = YR + (size_t)a[q] * 1024 + cb;
                const float ws_ = w[q] * YR_SCALE;
                const f32x4 y0 = (acc[ai][0][m][0] + ba0) * ws_, y1 = (acc[ai][0][m][1] + bb0) * ws_, y2 = (acc[ai][1][m][0] + ba1) * ws_, y3 = (acc[ai][1][m][1] + bb1) * ws_;
                *(u32x2*)yp = (u32x2){pk4_fp8(y0[0], y0[1], y0[2], y0[3]), pk4_fp8(y1[0], y1[1], y1[2], y1[3])};
                *(u32x2*)(yp + 128) = (u32x2){pk4_fp8(y2[0], y2[1], y2[2], y2[3]), pk4_fp8(y3[0], y3[1], y3[2], y3[3])}; }
        }
    }
};

enum { MAP_ID = 0, MAP_WIN = 1, MAP_WQ = 2, MAP_WKV = 3, MAP_GU = 4 };
__device__ __forceinline__ int map_row(int kind, int n) {
    if (kind == MAP_WIN) { if (n < 2560) return n; if (n < 2944) return NHT + PCQ + (n - 2560); if (n < 3200) return NHT + PCKV + (n - 2944); if (n < 3232) return NHT + PKPE + (n - 3200); return NHT + PGA + (n - 3232); }
    if (kind == MAP_WQ) { const int h = n / 96, j = n - h * 96; if (j < 64) return n; const int r = j - 64, i = r & 15; return h * 96 + 64 + 8 * (i >> 2) + ((r >> 4) << 2) + (i & 3); }
    if (kind == MAP_WKV) { const int h = n >> 7, j = n & 127; return (j < 64) ? (h * 64 + j) : (512 + h * 64 + (j - 64)); }
    if (kind == MAP_GU) { const int j = n >> 1, bj = n & 1; return (j >> 7) * 256 + bj * 128 + (j & 127); }
    return n;
}
__device__ __forceinline__ void conv_item(const float* W, int N, const float* kscale, bf16* WT, int dstK, int koff, int kind, LAS float* scr, int kb, int nb, int lane) {
    const int k0 = 64 * kb, n0 = 32 * nb;
    {
        const int kr = lane >> 3, c4 = (lane & 7) * 4; f32x4 v[8];
#pragma unroll
        for (int i = 0; i < 8; ++i) v[i] = *(const f32x4*)(W + (size_t)(k0 + 8 * i + kr) * N + n0 + c4);
#pragma unroll
        for (int i = 0; i < 8; ++i) { if (kscale) v[i] = v[i] * kscale[k0 + 8 * i + kr]; LAS float* d = scr + (8 * i + kr) * 33 + c4; d[0] = v[i][0]; d[1] = v[i][1]; d[2] = v[i][2]; d[3] = v[i][3]; }
    }
    LDS_WAIT(); asm volatile("" ::: "memory");
    const int c = lane & 7;
#pragma unroll
    for (int j = 0; j < 4; ++j) { const int n = (lane >> 3) + 8 * j; const LAS float* s = scr + (8 * c) * 33 + n;
        u32x4 o; o.x = pk2(s[0 * 33], s[1 * 33]); o.y = pk2(s[2 * 33], s[3 * 33]); o.z = pk2(s[4 * 33], s[5 * 33]); o.w = pk2(s[6 * 33], s[7 * 33]);
        *(u32x4*)(WT + (size_t)map_row(kind, n0 + n) * dstK + koff + k0 + 8 * c) = o; }
    LDS_WAIT(); asm volatile("" ::: "memory");
}
__device__ __forceinline__ void p_prologue(Frame& F) {
    const float* const* in = F.in;
    __syncthreads();
    {
        LAS float* cond = (LAS float*)F.lds;
        LAS float* part = (LAS float*)(F.lds + 32768);
        for (int i = F.tid; i < 8 * 1024; i += 512) { const float v = in[1][i]; cond[i] = v * sigmoidf_(v); }
        __syncthreads();
        for (int it = F.bid; it < DEPTH * 96; it += F.G) {
            const int l = it / 96, n0 = (it % 96) * 64, col = F.tid & 63, kg = F.tid >> 6;
            const float* w = in[3] + (size_t)l * 1024 * 6144 + n0 + col;
            float a[8] = {0.f, 0.f, 0.f, 0.f, 0.f, 0.f, 0.f, 0.f};
            for (int k0 = kg * 128; k0 < kg * 128 + 128; k0 += 16) {
                float wv[16];
#pragma unroll
                for (int q = 0; q < 16; ++q) wv[q] = w[(size_t)(k0 + q) * 6144];
#pragma unroll
                for (int q = 0; q < 16; ++q)
#pragma unroll
                    for (int b = 0; b < 8; ++b) a[b] += cond[b * 1024 + k0 + q] * wv[q]; }
#pragma unroll
            for (int b = 0; b < 8; ++b) part[(kg * 8 + b) * 64 + col] = a[b];
            __syncthreads();
            { const int b = F.tid >> 6; float s = 0.f;
#pragma unroll
              for (int g = 0; g < 8; ++g) s += part[(g * 8 + b) * 64 + col];
              ((float*)(F.ws + WS_MOD))[((size_t)l * 8 + b) * 6144 + n0 + col] = s + in[4][(size_t)l * 6144 + n0 + col]; }
            __syncthreads();
        }
    }
    const int gtid = F.bid * 512 + F.tid, NT_ = F.G * 512;
    for (int i = gtid; i < 1024; i += NT_) {
        float lg[DEPTH], mx = -1e30f; for (int l = 0; l < DEPTH; ++l) { lg[l] = in[8][(size_t)l * 1024 + i]; mx = fmaxf(mx, lg[l]); }
        float s = 0.f; for (int l = 0; l < DEPTH; ++l) { lg[l] = __expf(lg[l] - mx); s += lg[l]; }
        float c = 0.f; float* lb = (float*)(F.ws + WS_LB);
        for (int l = 0; l < DEPTH; ++l) { if (l > 0) c += lg[l] / s; lb[(size_t)l * 1024 + i] = c; }
    }
    for (int i = gtid; i < T * 16; i += NT_) {
        const int t = i >> 4, j = i & 15; const int pos = ((const int*)in[2])[t];
        const double base4[4] = {1.0, 0.5623413251903491, 0.31622776601683794, 0.1778279410038923};
        double f = base4[j & 3]; for (int q = 0; q < (j >> 2); ++q) f *= 0.1;
        const double ang = (double)pos * f; const double n = __builtin_rint(ang * 0.15915494309189535); const float r = (float)(ang - n * 6.283185307179586);
        ((float*)(F.ws + WS_COS))[i] = cosf(r); ((float*)(F.ws + WS_SIN))[i] = sinf(r);
    }
    for (int l = 0; l < DEPTH; ++l) { u32x4* p = (u32x4*)(wl(F.ws, l, WL_IN) + (size_t)5280 * 1024 * 2); for (int i = gtid; i < 96 * 1024 * 2 / 16; i += NT_) p[i] = (u32x4){0u, 0u, 0u, 0u}; }
    {
        LAS float* scr = (LAS float*)(F.lds + F.wave * 16384);
        const int gw = F.bid * NWAVES + F.wave, NGW = F.G * NWAVES;
        constexpr int I_IN = 16 * 165, I_Q = 6 * 24, I_KV = 4 * 32, I_OH = 8 * 32, I_OM = 8 * 32, I_O = 16 * 32, I_GU = 32 * 16 * 64, I_DN = 32 * 16 * 32;
        constexpr int I_LAYER = I_IN + I_Q + I_KV + I_OH + I_OM + I_O + I_GU + I_DN;
        for (int it = gw; it < DEPTH * I_LAYER; it += NGW) {
            const int l = it / I_LAYER; int r = it - l * I_LAYER;
            if (r < I_IN) { conv_item(in[7] + (size_t)l * 1024 * 5280, 5280, nullptr, (bf16*)wl(F.ws, l, WL_IN), 1024, 0, MAP_WIN, scr, r / 165, r % 165, F.lane); continue; } r -= I_IN;
            if (r < I_Q) { conv_item(in[12] + (size_t)l * 384 * 768, 768, in[11] + l * 384, (bf16*)wl(F.ws, l, WL_Q), 384, 0, MAP_WQ, scr, r / 24, r % 24, F.lane); continue; } r -= I_Q;
            if (r < I_KV) { conv_item(in[14] + (size_t)l * 256 * 1024, 1024, in[13] + l * 256, (bf16*)wl(F.ws, l, WL_K), 256, 0, MAP_WKV, scr, r / 32, r % 32, F.lane); continue; } r -= I_KV;
            if (r < I_OH) { conv_item(in[10] + (size_t)l * 512 * 1024, 1024, nullptr, (bf16*)wl(F.ws, l, WL_OUT), 1024, 0, MAP_ID, scr, r / 32, r % 32, F.lane); continue; } r -= I_OH;
            if (r < I_OM) { conv_item(in[15] + (size_t)l * 512 * 1024, 1024, nullptr, (bf16*)wl(F.ws, l, WL_OUT), 1024, 512, MAP_ID, scr, r / 32, r % 32, F.lane); continue; } r -= I_OM;
            if (r < I_O) { conv_item(in[16] + (size_t)l * 1024 * 1024, 1024, nullptr, (bf16*)wl(F.ws, l, WL_O), 1024, 0, MAP_ID, scr, r / 32, r % 32, F.lane); continue; } r -= I_O;
            if (r < I_GU) { const int e = r / (16 * 64), q = r % (16 * 64); conv_item(in[19] + ((size_t)l * 32 + e) * 1024 * 2048, 2048, nullptr, (bf16*)wl(F.ws, l, WL_GU) + (size_t)e * 2048 * 1024, 1024, 0, MAP_GU, scr, q / 64, q % 64, F.lane); continue; } r -= I_GU;
            { const int e = r / (16 * 32), q = r % (16 * 32); conv_item(in[21] + ((size_t)l * 32 + e) * 1024 * 1024, 1024, nullptr, (bf16*)wl(F.ws, l, WL_DN) + (size_t)e * 1024 * 1024, 1024, 0, MAP_ID, scr, q / 32, q % 32, F.lane); }
        }
    }
}

__device__ __forceinline__ void p_norm_mix(Frame& F, int l, bool fin, float* out, bool dummy = false) {
    const float* const* in = F.in;
    bf16* X = (bf16*)(F.ws + (dummy ? WS_ACT : WS_X));
    const float* MOD = (const float*)(F.ws + WS_MOD); const unsigned char* YR = F.ws + WS_YR; bf16* HB = (bf16*)(F.ws + (dummy ? WS_ACT + 64 * MiB : WS_HB));
    const int gw = F.bid * NWAVES + F.wave, NGW = F.G * NWAVES, per_wave = (T + NGW - 1) / NGW;
    f32x4 Gv[4], Sv[4], G2[4]; int bcur = -1;
    for (int q = 0; q < per_wave; ++q) {
        const int t = gw * per_wave + q; if (t >= T) break;
        const int b = t >> 11; f32x4 v[4];
        if (b != bcur) { bcur = b;
            const float* gn = fin ? in[23] : in[5] + (size_t)l * 1024; const float* sh = MOD + ((size_t)(fin ? 0 : l) * 8 + b) * 6144; const float* g2 = MOD + ((size_t)(l > 0 ? l - 1 : 0) * 8 + b) * 6144 + 5 * 1024;
#pragma unroll
            for (int j = 0; j < 4; ++j) { const int d = 4 * F.lane + 256 * j; const f32x4 g = *(const f32x4*)(gn + d);
                Gv[j] = fin ? g : g * (*(const f32x4*)(sh + 1024 + d) + 1.0f); Sv[j] = fin ? (f32x4){0.f, 0.f, 0.f, 0.f} : *(const f32x4*)(sh + d); G2[j] = *(const f32x4*)(g2 + d); } }
        if (l == 0) {
#pragma unroll
            for (int j = 0; j < 4; ++j) v[j] = *(const f32x4*)(in[0] + (size_t)t * 1024 + 4 * F.lane + 256 * j);
        } else {
#pragma unroll
            for (int j = 0; j < 4; ++j) { const u32x2 w = *(const u32x2*)(X + (size_t)t * 1024 + 4 * F.lane + 256 * j); v[j] = (f32x4){bflo(w.x), bfhi(w.x), bflo(w.y), bfhi(w.y)}; }
        }
        if (l > 0) {
#pragma unroll
            for (int j = 0; j < 4; ++j) { f32x4 s = {0.f, 0.f, 0.f, 0.f};
#pragma unroll
                for (int k = 0; k < 4; ++k) { const unsigned w = *(const unsigned*)(YR + ((size_t)t * 4 + k) * 1024 + 4 * F.lane + 256 * j);
                    s[0] += __builtin_amdgcn_cvt_f32_fp8(w, 0); s[1] += __builtin_amdgcn_cvt_f32_fp8(w, 1); s[2] += __builtin_amdgcn_cvt_f32_fp8(w, 2); s[3] += __builtin_amdgcn_cvt_f32_fp8(w, 3); }
                v[j] += G2[j] * s * YR_INV; }
        }
        float ss = 0.f;
#pragma unroll
        for (int j = 0; j < 4; ++j) ss += (v[j][0] * v[j][0] + v[j][1] * v[j][1]) + (v[j][2] * v[j][2] + v[j][3] * v[j][3]);
        const float rs = rsqrtf(wave_sum(ss) * (1.0f / 1024.0f) + EPS);
        if (fin) {
#pragma unroll
            for (int j = 0; j < 4; ++j) { const int d = 4 * F.lane + 256 * j; *(f32x4*)(out + (size_t)t * 1024 + d) = v[j] * rs * Gv[j]; }
        } else {
#pragma unroll
            for (int j = 0; j < 4; ++j) { const int d = 4 * F.lane + 256 * j; { u32x2 xw; xw.x = pk2(v[j][0], v[j][1]); xw.y = pk2(v[j][2], v[j][3]); *(u32x2*)(X + (size_t)t * 1024 + d) = xw; }
                const f32x4 h = v[j] * rs * Gv[j] + Sv[j]; u32x2 w; w.x = pk2(h[0], h[1]); w.y = pk2(h[2], h[3]);
                *(u32x2*)(HB + (size_t)t * 1024 + d) = w; }
        }
    }
}
__device__ __forceinline__ void p_mla_prep(Frame& F) {
    const bf16* PROJ = (const bf16*)(F.ws + WS_PROJ); float* RSQ = (float*)(F.ws + WS_RSQ); float* RSKV = (float*)(F.ws + WS_RSKV); bf16* Kb = (bf16*)(F.ws + WS_K);
    const float* CS = (const float*)(F.ws + WS_COS); const float* SN = (const float*)(F.ws + WS_SIN);
    const int gw = F.bid * NWAVES + F.wave, NGW = F.G * NWAVES;
    for (int t = gw; t < T; t += NGW) {
        const bf16* row = PROJ + (size_t)t * NPROJ;
        float sq = 0.f, skv = 0.f;
#pragma unroll
        for (int j = 0; j < 6; ++j) { const float v = bf2f(row[PCQ + F.lane + 64 * j]); sq += v * v; }
#pragma unroll
        for (int j = 0; j < 4; ++j) { const float v = bf2f(row[PCKV + F.lane + 64 * j]); skv += v * v; }
        sq = wave_sum(sq); skv = wave_sum(skv);
        if (F.lane == 0) { RSQ[t] = rsqrtf(sq * (1.0f / 384.0f) + EPS); RSKV[t] = rsqrtf(skv * (1.0f / 256.0f) + EPS); }
        if (F.lane < 16) {
            const float x1 = bf2f(row[PKPE + F.lane]), x2 = bf2f(row[PKPE + 16 + F.lane]), co = CS[(size_t)t * 16 + F.lane], si = SN[(size_t)t * 16 + F.lane];
            const bf16 o1 = (bf16)(pk2(x1 * co - x2 * si, 0.f) & 0xffffu), o2 = (bf16)(pk2(x2 * co + x1 * si, 0.f) & 0xffffu);
            const int b = t >> 11, s = t & 2047;
#pragma unroll
            for (int h = 0; h < 8; ++h) { bf16* kp = Kb + ((size_t)(b * 8 + h) * SEQ + s) * 96; kp[64 + F.lane] = o1; kp[80 + F.lane] = o2; }
        }
    }
}
__device__ __forceinline__ void p_hgrn_post(Frame& F, int l) {
    const bf16* OFp = (const bf16*)(F.ws + WS_OF); const bf16* OBp = (const bf16*)(F.ws + WS_OB); const bf16* PROJ = (const bf16*)(F.ws + WS_PROJ); bf16* HA = (bf16*)(F.ws + WS_HA);
    const float* gn = F.in[9] + (size_t)l * 128;
    const int gw = F.bid * NWAVES + F.wave, NGW = F.G * NWAVES;
    for (int t = gw; t < T; t += NGW) {
        const int c = 8 * F.lane;
        f32x4 a0, a1, b0, b1; unpack8(*(const u32x4*)(OFp + (size_t)t * 512 + c), a0, a1); unpack8(*(const u32x4*)(OBp + (size_t)t * 512 + c), b0, b1); a0 += b0; a1 += b1;
        float ss = (a0[0] * a0[0] + a0[1] * a0[1]) + (a0[2] * a0[2] + a0[3] * a0[3]) + (a1[0] * a1[0] + a1[1] * a1[1]) + (a1[2] * a1[2] + a1[3] * a1[3]);
#pragma unroll
        for (int o = 1; o < 16; o <<= 1) ss += __shfl_xor(ss, o);
        const float rs = rsqrtf(ss * (1.0f / 128.0f) + EPS);
        f32x4 g0, g1; unpack8(*(const u32x4*)(PROJ + (size_t)t * NPROJ + PGT + c), g0, g1);
        const f32x4 n0 = *(const f32x4*)(gn + (c & 127)), n1 = *(const f32x4*)(gn + (c & 127) + 4);
#pragma unroll
        for (int j = 0; j < 4; ++j) { a0[j] = a0[j] * rs * n0[j] * sigmoidf_(g0[j]); a1[j] = a1[j] * rs * n1[j] * sigmoidf_(g1[j]); }
        *(u32x4*)(HA + (size_t)t * 1024 + c) = pack8(a0, a1);
    }
}

#define MFMA16(a, b, c) __builtin_amdgcn_mfma_f32_16x16x32_bf16((a), (b), (c), 0, 0, 0)
constexpr int SC_QROW = 272, SC_TROW = 144;
constexpr int SC_QT = 0, SC_KT = SC_QT + 64 * SC_QROW, SC_KH = SC_KT + 64 * SC_QROW, SC_VT = SC_KH + 128 * SC_TROW, SC_DEC = SC_VT + 128 * SC_TROW, SC_ZERO = SC_DEC + 4 * 128 * 4, SC_END = SC_ZERO + 64;
__device__ __forceinline__ unsigned rot16(unsigned x) { return (x >> 16) | (x << 16); }
constexpr int SC_OX = 73984;
static_assert(SC_OX >= SC_END && SC_OX % 16 == 0 && SC_OX + 32768 <= RING_BYTES, "scan LDS map");
__device__ __forceinline__ void scan_unit2(Frame& F, int l, int u) {
    const int vh = u & 1, dir = (u >> 1) & 1, hh = (u >> 2) & 3, b = u >> 4;
    const bf16* HTb = (const bf16*)(F.ws + WS_HT) + (size_t)b * NHT * SEQ;
    const bf16* qg = HTb + (size_t)(HQ + hh * 128) * SEQ; const bf16* fg = HTb + (size_t)((dir ? HFB : HFF) + hh * 128) * SEQ; const bf16* vg = HTb + (size_t)(HI + hh * 128 + vh * 64) * SEQ;
    bf16* OUT = (bf16*)(F.ws + (dir ? WS_OB : WS_OF));
    LAS unsigned char* lds = F.lds;
    const int d = F.tid & 127, si = F.tid >> 7;
    const float lbv = ((const float*)(F.ws + WS_LB))[((size_t)l * 2 + dir) * 512 + hh * 128 + d];
    const int r = F.lane & 15, g = F.lane >> 4, vt = F.wave & 3, dh = F.wave >> 2;
    const int vcol = hh * 128 + vh * 64 + 16 * vt;
    f32x4 S[4];
#pragma unroll
    for (int i = 0; i < 4; ++i) S[i] = (f32x4){0.f, 0.f, 0.f, 0.f};
    __syncthreads();
    if (F.tid < 16) *(LAS unsigned*)(lds + SC_ZERO + F.tid * 4) = 0u;
    u32x4 pq[2], pf[2], pv;
    const int vrow0 = F.tid >> 3, vmc = F.tid & 7;
    {   const int m0 = dir ? SEQ - 64 : 0; const int mb = dir ? m0 + 48 - 16 * si : m0 + 16 * si;
        pq[0] = *(const u32x4*)(qg + (size_t)d * SEQ + mb); pq[1] = *(const u32x4*)(qg + (size_t)d * SEQ + mb + 8);
        pf[0] = *(const u32x4*)(fg + (size_t)d * SEQ + mb); pf[1] = *(const u32x4*)(fg + (size_t)d * SEQ + mb + 8);
        pv = *(const u32x4*)(vg + (size_t)vrow0 * SEQ + m0 + 8 * vmc); }
    int mprev = 0;
#pragma unroll 1
    for (int c = 0; c <= SEQ / 64; ++c) {
        const bool live = c < SEQ / 64;
        const int m0 = dir ? SEQ - 64 * (c + 1) : 64 * c;
        float qt[16], kt[16], E = 1.0f;
        if (live) {
            float rq[16], rf[16];
#pragma unroll
            for (int j = 0; j < 2; ++j) {
                rq[8 * j + 0] = bflo(pq[j].x); rq[8 * j + 1] = bfhi(pq[j].x); rq[8 * j + 2] = bflo(pq[j].y); rq[8 * j + 3] = bfhi(pq[j].y); rq[8 * j + 4] = bflo(pq[j].z); rq[8 * j + 5] = bfhi(pq[j].z); rq[8 * j + 6] = bflo(pq[j].w); rq[8 * j + 7] = bfhi(pq[j].w);
                rf[8 * j + 0] = bflo(pf[j].x); rf[8 * j + 1] = bfhi(pf[j].x); rf[8 * j + 2] = bflo(pf[j].y); rf[8 * j + 3] = bfhi(pf[j].y); rf[8 * j + 4] = bflo(pf[j].z); rf[8 * j + 5] = bfhi(pf[j].z); rf[8 * j + 6] = bflo(pf[j].w); rf[8 * j + 7] = bfhi(pf[j].w); }
#pragma unroll
            for (int k = 0; k < 16; ++k) {
                const float un = dir ? rf[15 - k] : rf[k], qs = dir ? rq[15 - k] : rq[k];
                const float kk = (1.0f - lbv) * un; E = fmaxf(E * (1.0f - kk), 1e-30f);
                qt[k] = qs * E; kt[k] = kk * __builtin_amdgcn_rcpf(E);
            }
        }
        __syncthreads();
        if (c > 0) {
#pragma unroll
            for (int ii = 0; ii < 2; ++ii) { const int i = 2 * dh + ii;
                const f32x4 a = *(const LAS f32x4*)(lds + SC_OX + (((0 * 4 + vt) * 4 + i) * 64 + F.lane) * 16), bq = *(const LAS f32x4*)(lds + SC_OX + (((1 * 4 + vt) * 4 + i) * 64 + F.lane) * 16);
                const int m = dir ? mprev + 63 - 16 * i - r : mprev + 16 * i + r;
                const f32x4 o = a + bq; u32x2 w; w.x = pk2(o[0], o[1]); w.y = pk2(o[2], o[3]);
                *(u32x2*)(OUT + (size_t)(b * SEQ + m) * 512 + vcol + 4 * g) = w; }
        }
        if (!live) break;
        {   LAS unsigned char* qp = lds + SC_QT + (16 * si) * SC_QROW + d * 2; LAS unsigned char* kp = lds + SC_KT + (16 * si) * SC_QROW + d * 2;
#pragma unroll
            for (int k = 0; k < 16; k += 2) { const unsigned wq = pk2(qt[k], qt[k + 1]), wk = pk2(kt[k], kt[k + 1]);
                *(LAS unsigned short*)(qp + k * SC_QROW) = (unsigned short)wq; *(LAS unsigned short*)(qp + (k + 1) * SC_QROW) = (unsigned short)(wq >> 16);
                *(LAS unsigned short*)(kp + k * SC_QROW) = (unsigned short)wk; *(LAS unsigned short*)(kp + (k + 1) * SC_QROW) = (unsigned short)(wk >> 16); }
            u32x4 h0, h1;
            h0.x = pk2(kt[0] * E, kt[1] * E); h0.y = pk2(kt[2] * E, kt[3] * E); h0.z = pk2(kt[4] * E, kt[5] * E); h0.w = pk2(kt[6] * E, kt[7] * E);
            h1.x = pk2(kt[8] * E, kt[9] * E); h1.y = pk2(kt[10] * E, kt[11] * E); h1.z = pk2(kt[12] * E, kt[13] * E); h1.w = pk2(kt[14] * E, kt[15] * E);
            *(LAS u32x4*)(lds + SC_KH + d * SC_TROW + 32 * si) = h0; *(LAS u32x4*)(lds + SC_KH + d * SC_TROW + 32 * si + 16) = h1;
            *(LAS float*)(lds + SC_DEC + (si * 128 + d) * 4) = E;
            { u32x4 w = pv; int tl0 = 8 * vmc;
              if (dir) { w = (u32x4){rot16(pv.w), rot16(pv.z), rot16(pv.y), rot16(pv.x)}; tl0 = 56 - 8 * vmc; }
              *(LAS u32x4*)(lds + SC_VT + vrow0 * SC_TROW + tl0 * 2) = w; }
        }
        if (c + 1 < SEQ / 64) {
            const int m1 = dir ? SEQ - 64 * (c + 2) : 64 * (c + 1); const int mb = dir ? m1 + 48 - 16 * si : m1 + 16 * si;
            pq[0] = *(const u32x4*)(qg + (size_t)d * SEQ + mb); pq[1] = *(const u32x4*)(qg + (size_t)d * SEQ + mb + 8);
            pf[0] = *(const u32x4*)(fg + (size_t)d * SEQ + mb); pf[1] = *(const u32x4*)(fg + (size_t)d * SEQ + mb + 8);
            pv = *(const u32x4*)(vg + (size_t)vrow0 * SEQ + m1 + 8 * vmc);
        }
        mprev = m0;
        __syncthreads();
        f32x4 oI[2];
#pragma unroll
        for (int ii = 0; ii < 2; ++ii) {
            const int i = 2 * dh + ii;
            const LAS unsigned char* qrow = lds + SC_QT + (16 * i + r) * SC_QROW; const LAS unsigned char* krow = lds + SC_KT + (16 * i + r) * SC_QROW;
            f32x4 pT = {0.f, 0.f, 0.f, 0.f};
#pragma unroll
            for (int ks = 0; ks < 4; ++ks) pT = MFMA16(*(const LAS bf16x8*)(krow + (32 * ks + 8 * g) * 2), *(const LAS bf16x8*)(qrow + (32 * ks + 8 * g) * 2), pT);
#pragma unroll
            for (int q = 0; q < 4; ++q) pT[q] = (4 * g + q <= r) ? pT[q] : 0.0f;
            const bf16x8 pfrag = __builtin_bit_cast(bf16x8, ((u32x4){pk2(pT[0], pT[1]), pk2(pT[2], pT[3]), 0u, 0u}));
            const u32x2 vt4 = *(const LAS u32x2*)(lds + SC_VT + (16 * vt + r) * SC_TROW + (16 * i + 4 * g) * 2);
            oI[ii] = MFMA16(__builtin_bit_cast(bf16x8, ((u32x4){vt4.x, vt4.y, 0u, 0u})), pfrag, ((f32x4){0.f, 0.f, 0.f, 0.f}));
        }
        const bool zl = (g >= 2);
#pragma unroll
        for (int i = 0; i < 4; ++i) {
            const LAS unsigned char* qrow = lds + SC_QT + (16 * i + r) * SC_QROW + (64 * dh) * 2;
            f32x4 o = ((i >> 1) == dh) ? oI[i & 1] : (f32x4){0.f, 0.f, 0.f, 0.f};
#pragma unroll
            for (int kk = 0; kk < 2; ++kk) {
                const bf16x8 sfrag = __builtin_bit_cast(bf16x8, ((u32x4){pk2(S[2 * kk][0], S[2 * kk][1]), pk2(S[2 * kk][2], S[2 * kk][3]), pk2(S[2 * kk + 1][0], S[2 * kk + 1][1]), pk2(S[2 * kk + 1][2], S[2 * kk + 1][3])}));
                const u32x2 qa = *(const LAS u32x2*)(qrow + (32 * kk + 4 * g) * 2), qb = *(const LAS u32x2*)(qrow + (32 * kk + 16 + 4 * g) * 2);
                o = MFMA16(sfrag, __builtin_bit_cast(bf16x8, ((u32x4){qa.x, qa.y, qb.x, qb.y})), o);
            }
            *(LAS f32x4*)(lds + SC_OX + (((dh * 4 + vt) * 4 + i) * 64 + F.lane) * 16) = o;
            const LAS unsigned char* vtp = zl ? lds + SC_ZERO : lds + SC_VT + (16 * vt + r) * SC_TROW + (16 * i + 8 * g) * 2;
            const bf16x8 vfrag = *(const LAS bf16x8*)vtp;
#pragma unroll
            for (int dt = 0; dt < 4; ++dt) {
                const f32x4 dec = *(const LAS f32x4*)(lds + SC_DEC + (i * 128 + 64 * dh + 16 * dt + 4 * g) * 4);
                const LAS unsigned char* khp = zl ? lds + SC_ZERO : lds + SC_KH + (64 * dh + 16 * dt + r) * SC_TROW + (16 * i + 8 * g) * 2;
                S[dt] = MFMA16(*(const LAS bf16x8*)khp, vfrag, S[dt] * dec);
            }
        }
    }
    __syncthreads();
}

#define MFMA32(a, b, c) __builtin_amdgcn_mfma_f32_32x32x16_bf16((a), (b), (c), 0, 0, 0)
constexpr int AT_KROW = 208, AT_VROW = 136, AT_KBYTES = 64 * AT_KROW, AT_BUF = AT_KBYTES + 64 * AT_VROW;
__device__ __forceinline__ void attn_unit(Frame& F, int bh, int q0) {
    const GAS bf16* Q = (const GAS bf16*)(F.ws + WS_Q); const GAS char* Kg = (const GAS char*)(F.ws + WS_K) + (size_t)bh * SEQ * 96 * 2; const GAS char* Vg = (const GAS char*)(F.ws + WS_VT) + (size_t)bh * 64 * SEQ * 2;
    GAS bf16* HA = (GAS bf16*)(F.ws + WS_HA);
    LAS unsigned char* lds = F.lds;
    const int r = F.lane & 31, h = F.lane >> 5;
    bf16x8 qf[6];
    { const GAS bf16* qrow = Q + ((size_t)bh * SEQ + q0 + F.wave * 32 + r) * 96;
#pragma unroll
      for (int ks = 0; ks < 6; ++ks) qf[ks] = *(const GAS bf16x8*)(qrow + 16 * ks + 8 * h); }
    f32x16 o0, o1;
#pragma unroll
    for (int i = 0; i < 16; ++i) { o0[i] = 0.f; o1[i] = 0.f; }
    float mref = 0.f, lsum = 0.f;
    const int kc0 = F.tid, kc1 = F.tid + 512; const bool has1 = F.tid < 256;
    const int kl0 = (kc0 / 12) * AT_KROW + (kc0 % 12) * 16, kl1 = (kc1 / 12) * AT_KROW + (kc1 % 12) * 16;
    const int vrow = F.tid >> 3, vpc = F.tid & 7; const int vl = AT_KBYTES + vrow * AT_VROW + vpc * 16;
    u32x4 rk0, rk1 = {0u, 0u, 0u, 0u}, rv;
    __syncthreads();
    rk0 = *(const GAS u32x4*)(Kg + (size_t)kc0 * 16); if (has1) rk1 = *(const GAS u32x4*)(Kg + (size_t)kc1 * 16);
    rv = *(const GAS u32x4*)(Vg + (size_t)vrow * SEQ * 2 + vpc * 16);
    *(LAS u32x4*)(lds + kl0) = rk0; if (has1) *(LAS u32x4*)(lds + kl1) = rk1;
    *(LAS u32x2*)(lds + vl) = (u32x2){rv.x, rv.y}; *(LAS u32x2*)(lds + vl + 8) = (u32x2){rv.z, rv.w};
    __syncthreads();
    for (int j = 0; j < SEQ / 64; ++j) {
        const int buf = (j & 1) * AT_BUF, nbuf = ((j + 1) & 1) * AT_BUF;
        if (j + 1 < SEQ / 64) {
            const GAS char* kg = Kg + (size_t)(j + 1) * 64 * 96 * 2;
            rk0 = *(const GAS u32x4*)(kg + (size_t)kc0 * 16); if (has1) rk1 = *(const GAS u32x4*)(kg + (size_t)kc1 * 16);
            rv = *(const GAS u32x4*)(Vg + (size_t)vrow * SEQ * 2 + (size_t)(j + 1) * 128 + vpc * 16);
        }
        f32x16 s0, s1;
#pragma unroll
        for (int i = 0; i < 16; ++i) { s0[i] = -mref; s1[i] = -mref; }
#pragma unroll
        for (int ks = 0; ks < 6; ++ks) {
            const bf16x8 k0 = *(const LAS bf16x8*)(lds + buf + r * AT_KROW + (16 * ks + 8 * h) * 2);
            const bf16x8 k1 = *(const LAS bf16x8*)(lds + buf + (32 + r) * AT_KROW + (16 * ks + 8 * h) * 2);
            s0 = MFMA32(k0, qf[ks], s0); s1 = MFMA32(k1, qf[ks], s1);
        }
        float mx = s0[0];
#pragma unroll
        for (int i = 1; i < 16; ++i) mx = fmaxf(mx, s0[i]);
#pragma unroll
        for (int i = 0; i < 16; ++i) mx = fmaxf(mx, s1[i]);
        mx = fmaxf(mx, __shfl_xor(mx, 32));
        const bool grow = (j == 0) || (mx > 8.0f);
        if (__builtin_amdgcn_ballot_w64(grow) != 0ull) {
            const float dlt = grow ? mx : 0.0f, fsc = __builtin_amdgcn_exp2f(-dlt); mref += dlt; lsum *= fsc;
#pragma unroll
            for (int i = 0; i < 16; ++i) { s0[i] -= dlt; s1[i] -= dlt; o0[i] *= fsc; o1[i] *= fsc; } }
        float ps = 0.f;
#pragma unroll
        for (int i = 0; i < 16; ++i) { s0[i] = __builtin_amdgcn_exp2f(s0[i]); s1[i] = __builtin_amdgcn_exp2f(s1[i]); ps += s0[i] + s1[i]; }
        lsum += ps;
        bf16x8 pf[2][2];
#pragma unroll
        for (int sp = 0; sp < 2; ++sp) {
            u32x4 w0, w1;
            w0.x = pk2(s0[8 * sp + 0], s0[8 * sp + 1]); w0.y = pk2(s0[8 * sp + 2], s0[8 * sp + 3]); w0.z = pk2(s0[8 * sp + 4], s0[8 * sp + 5]); w0.w = pk2(s0[8 * sp + 6], s0[8 * sp + 7]);
            w1.x = pk2(s1[8 * sp + 0], s1[8 * sp + 1]); w1.y = pk2(s1[8 * sp + 2], s1[8 * sp + 3]); w1.z = pk2(s1[8 * sp + 4], s1[8 * sp + 5]); w1.w = pk2(s1[8 * sp + 6], s1[8 * sp + 7]);
            pf[0][sp] = __builtin_bit_cast(bf16x8, w0); pf[1][sp] = __builtin_bit_cast(bf16x8, w1);
        }
#pragma unroll
        for (int kb = 0; kb < 2; ++kb)
#pragma unroll
            for (int sp = 0; sp < 2; ++sp) {
                const int kbase = (32 * kb + 16 * sp + 4 * h) * 2;
                const LAS unsigned char* v0p = lds + buf + AT_KBYTES + r * AT_VROW + kbase;
                const LAS unsigned char* v1p = lds + buf + AT_KBYTES + (32 + r) * AT_VROW + kbase;
                const u32x2 a0 = *(const LAS u32x2*)v0p, a1 = *(const LAS u32x2*)(v0p + 16), c0 = *(const LAS u32x2*)v1p, c1 = *(const LAS u32x2*)(v1p + 16);
                const bf16x8 vf0 = __builtin_bit_cast(bf16x8, ((u32x4){a0.x, a0.y, a1.x, a1.y})), vf1 = __builtin_bit_cast(bf16x8, ((u32x4){c0.x, c0.y, c1.x, c1.y}));
                o0 = MFMA32(vf0, pf[kb][sp], o0); o1 = MFMA32(vf1, pf[kb][sp], o1);
            }
        if (j + 1 < SEQ / 64) {
            *(LAS u32x4*)(lds + nbuf + kl0) = rk0; if (has1) *(LAS u32x4*)(lds + nbuf + kl1) = rk1;
            *(LAS u32x2*)(lds + nbuf + vl) = (u32x2){rv.x, rv.y}; *(LAS u32x2*)(lds + nbuf + vl + 8) = (u32x2){rv.z, rv.w};
        }
        __syncthreads();
    }
    lsum += __shfl_xor(lsum, 32);
    const float inv = 1.0f / lsum;
    const int head = bh & 7, b = bh >> 3;
    GAS bf16* orow = HA + (size_t)(b * SEQ + q0 + F.wave * 32 + r) * 1024 + 512 + head * 64;
#pragma unroll
    for (int i = 0; i < 4; ++i) {
        u32x2 w0, w1;
        w0.x = pk2(o0[4 * i] * inv, o0[4 * i + 1] * inv); w0.y = pk2(o0[4 * i + 2] * inv, o0[4 * i + 3] * inv);
        w1.x = pk2(o1[4 * i] * inv, o1[4 * i + 1] * inv); w1.y = pk2(o1[4 * i + 2] * inv, o1[4 * i + 3] * inv);
        *(GAS u32x2*)(orow + 8 * i + 4 * h) = w0; *(GAS u32x2*)(orow + 32 + 8 * i + 4 * h) = w1;
    }
}

constexpr int RTW_LO = 65536, RT_EX = 131072, RT_CP = 151552, RT_CE = 153600, RT_SS = 153728;
static_assert(RT_EX + 8192 <= LDSCTL_OFF && RT_SS + 512 <= LDS_BYTES && RT_S_OFF + 4096 <= RT_CP, "router LDS map");
__device__ __forceinline__ int rt_f(int e) { return ((e >> 2) & 3) | (((e ^ (e >> 4)) & 1) << 2) | (((e >> 1) & 1) << 3); }
__device__ __forceinline__ void p_router(Frame& F, int l, bool dummy = false) {
    const float* const* in = F.in;
    const bf16* X = (const bf16*)(F.ws + WS_X); const float* MOD = (const float*)(F.ws + WS_MOD); bf16* HB = (bf16*)(F.ws + WS_HB);
    int* LIST = (int*)(F.ws + (dummy ? WS_Y : WS_LIST)); float* AW = (float*)(F.ws + (dummy ? WS_Y + 4 * MiB : WS_AW)); unsigned* CNT = (unsigned*)(F.ws + WS_CTL) + CW_CNT + (l + (dummy ? 4 : 0)) * 32 * 64;
    LAS unsigned char* lds = F.lds;
    const float* wr = in[17] + (size_t)l * 1024 * 32; const float* gn = in[6] + (size_t)l * 1024; const float* br = in[18] + (size_t)l * 32;
    LAS unsigned* lcnt = (LAS unsigned*)(lds + MOE_OFF + 512); LAS unsigned* lbase = lcnt + 32;
    int cur_b = -1;
    for (int tile = F.bid; tile < T / 64; tile += F.G) {
        int tid = F.tid; asm volatile("" : "+v"(tid));
        const int lane = tid & 63, wv = tid >> 6, r = lane & 15, g = lane >> 4, tt = wv & 3, kh = wv >> 2;
        const int b = tile >> 5; const int t = tile * 64 + 16 * tt + r;
        u32x4 xf[16];
        {   const bf16* xrow = X + (size_t)t * 1024 + kh * 512 + 8 * g;
#pragma unroll
            for (int ks = 0; ks < 16; ++ks) xf[ks] = *(const u32x4*)(xrow + 32 * ks); }
        __syncthreads();
        if (b != cur_b) {
            cur_b = b;
            const float* sh = MOD + ((size_t)l * 8 + b) * 6144 + 3 * 1024;
            for (int d = tid; d < 1024; d += 512) { *(LAS float*)(lds + RT_G_OFF + d * 4) = gn[d] * (sh[1024 + d] + 1.0f); *(LAS float*)(lds + RT_S_OFF + d * 4) = sh[d]; }
            __syncthreads();
#pragma unroll 2
            for (int q = tid; q < 4096; q += 512) {
                const int kp = q >> 3, c = q & 7;
                const f32x4 w0 = *(const f32x4*)(wr + (size_t)(2 * kp) * 32 + 4 * c), w1 = *(const f32x4*)(wr + (size_t)(2 * kp + 1) * 32 + 4 * c);
                const float g0 = *(const LAS float*)(lds + RT_G_OFF + (2 * kp) * 4), g1 = *(const LAS float*)(lds + RT_G_OFF + (2 * kp + 1) * 4);
#pragma unroll
                for (int j = 0; j < 4; ++j) { const int e = 4 * c + j; const float a0 = w0[j] * g0, a1 = w1[j] * g1;
                    const unsigned hi = pk2(a0, a1); const unsigned lo = pk2(a0 - bflo(hi), a1 - bfhi(hi));
                    const int off = e * 2048 + (((kp >> 2) ^ rt_f(e)) << 4) + (kp & 3) * 4;
                    *(LAS unsigned*)(lds + off) = hi; *(LAS unsigned*)(lds + RTW_LO + off) = lo; }
            }
            {   const int e = tid & 31, kg = tid >> 5; float cp = 0.f;
#pragma unroll 8
                for (int i = 0; i < 64; ++i) { const int k = kg * 64 + i; cp += *(const LAS float*)(lds + RT_S_OFF + k * 4) * wr[(size_t)k * 32 + e]; }
                *(LAS float*)(lds + RT_CP + (kg * 32 + e) * 4) = cp; }
            __syncthreads();
            if (tid < 32) { float sc = br[tid];
#pragma unroll
                for (int kg = 0; kg < 16; ++kg) sc += *(const LAS float*)(lds + RT_CP + (kg * 32 + tid) * 4);
                *(LAS float*)(lds + RT_CE + tid * 4) = sc; }
        }
        if (tid < 32) lcnt[tid] = 0u;
        __syncthreads();
        f32x4 acc0 = {0.f, 0.f, 0.f, 0.f}, acc1 = {0.f, 0.f, 0.f, 0.f}; float ss = 0.f;
        {   const int f0 = rt_f(r), f1 = rt_f(16 + r);
            const LAS unsigned char* row0 = lds + r * 2048; const LAS unsigned char* row1 = lds + (16 + r) * 2048;
#pragma unroll
            for (int ks = 0; ks < 16; ++ks) {
                const int ch = kh * 64 + 4 * ks + g; const int o0 = (ch ^ f0) << 4, o1 = (ch ^ f1) << 4;
                const bf16x8 xb = __builtin_bit_cast(bf16x8, xf[ks]);
                acc0 = MFMA16(*(const LAS bf16x8*)(row0 + o0), xb, acc0); acc0 = MFMA16(*(const LAS bf16x8*)(row0 + RTW_LO + o0), xb, acc0);
                acc1 = MFMA16(*(const LAS bf16x8*)(row1 + o1), xb, acc1); acc1 = MFMA16(*(const LAS bf16x8*)(row1 + RTW_LO + o1), xb, acc1);
                f32x4 v0, v1; unpack8(xf[ks], v0, v1);
                ss += (v0[0] * v0[0] + v0[1] * v0[1]) + (v0[2] * v0[2] + v0[3] * v0[3]) + (v1[0] * v1[0] + v1[1] * v1[1]) + (v1[2] * v1[2] + v1[3] * v1[3]);
                if (ks & 1) asm volatile("" ::: "memory");
            } }
        ss += __shfl_xor(ss, 16); ss += __shfl_xor(ss, 32);
        if (g == 0) *(LAS float*)(lds + RT_SS + ((kh * 4 + tt) * 16 + r) * 4) = ss;
        if (kh == 1) { *(LAS f32x4*)(lds + RT_EX + (tt * 64 + lane) * 32) = acc0; *(LAS f32x4*)(lds + RT_EX + (tt * 64 + lane) * 32 + 16) = acc1; }
        __syncthreads();
        const float rs = rsqrtf((*(const LAS float*)(lds + RT_SS + ((0 * 4 + tt) * 16 + r) * 4) + *(const LAS float*)(lds + RT_SS + ((1 * 4 + tt) * 16 + r) * 4)) * (1.0f / 1024.0f) + EPS);
#pragma unroll
        for (int ks = 0; ks < 16; ++ks) {
            const int d = kh * 512 + 32 * ks + 8 * g;
            f32x4 v0, v1; unpack8(xf[ks], v0, v1);
            v0 = v0 * rs * *(const LAS f32x4*)(lds + RT_G_OFF + d * 4) + *(const LAS f32x4*)(lds + RT_S_OFF + d * 4);
            v1 = v1 * rs * *(const LAS f32x4*)(lds + RT_G_OFF + d * 4 + 16) + *(const LAS f32x4*)(lds + RT_S_OFF + d * 4 + 16);
            *(u32x4*)(HB + (size_t)t * 1024 + d) = pack8(v0, v1);
            if (ks & 1) asm volatile("" ::: "memory");
        }
        float lg[8], wk[8]; int rank[8]; unsigned lslot[8];
        int gq = g; asm volatile("" : "+v"(gq));
        if (kh == 0) {
            const f32x4 p0 = *(const LAS f32x4*)(lds + RT_EX + (tt * 64 + lane) * 32), p1 = *(const LAS f32x4*)(lds + RT_EX + (tt * 64 + lane) * 32 + 16);
            const f32x4 c0 = *(const LAS f32x4*)(lds + RT_CE + (4 * gq) * 4), c1 = *(const LAS f32x4*)(lds + RT_CE + (16 + 4 * gq) * 4);
#pragma unroll
            for (int j = 0; j < 4; ++j) { lg[j] = rs * (acc0[j] + p0[j]) + c0[j]; lg[4 + j] = rs * (acc1[j] + p1[j]) + c1[j]; rank[j] = 0; rank[4 + j] = 0; }
#if RT_DEBUG == 1
            {   float dl[8];
#pragma unroll
                for (int j = 0; j < 8; ++j) dl[j] = 0.f;
                for (int k = 0; k < 1024; ++k) { const float xv = __uint_as_float(((unsigned)((const unsigned short*)X)[(size_t)t * 1024 + k]) << 16);
                    const float v = xv * rs * *(const LAS float*)(lds + RT_G_OFF + k * 4) + *(const LAS float*)(lds + RT_S_OFF + k * 4);
#pragma unroll
                    for (int j = 0; j < 8; ++j) dl[j] += v * wr[(size_t)k * 32 + (j < 4 ? 0 : 16) + 4 * gq + (j & 3)]; }
#pragma unroll
                for (int j = 0; j < 8; ++j) lg[j] = dl[j] + br[(j < 4 ? 0 : 16) + 4 * gq + (j & 3)];
            }
#endif
#if RT_DEBUG == 3 || RT_DEBUG == 4
            {   float dl[8];
#pragma unroll
                for (int j = 0; j < 8; ++j) dl[j] = 0.f;
                const int kb = (RT_DEBUG == 3) ? 512 : 0;
                for (int k = kb; k < kb + 512; ++k) { const float xv = __uint_as_float(((unsigned)((const unsigned short*)X)[(size_t)t * 1024 + k]) << 16);
                    const float v = xv * *(const LAS float*)(lds + RT_G_OFF + k * 4);
#pragma unroll
                    for (int j = 0; j < 8; ++j) dl[j] += v * wr[(size_t)k * 32 + (j < 4 ? 0 : 16) + 4 * gq + (j & 3)]; }
#pragma unroll
                for (int j = 0; j < 4; ++j) {
                    if (RT_DEBUG == 3) { lg[j] = rs * (acc0[j] + dl[j]) + c0[j]; lg[4 + j] = rs * (acc1[j] + dl[4 + j]) + c1[j]; }
                    else { lg[j] = rs * (dl[j] + p0[j]) + c0[j]; lg[4 + j] = rs * (dl[4 + j] + p1[j]) + c1[j]; } }
            }
#endif
#if RT_DEBUG == 5
            {   float dl[8];
#pragma unroll
                for (int j = 0; j < 8; ++j) dl[j] = 0.f;
                for (int k = 0; k < 1024; ++k) { const float xv = __uint_as_float(((unsigned)((const unsigned short*)X)[(size_t)t * 1024 + k]) << 16);
#pragma unroll
                    for (int j = 0; j < 8; ++j) { const int e = (j < 4 ? 0 : 16) + 4 * gq + (j & 3); const int off = e * 2048 + (((k >> 3) ^ rt_f(e)) << 4) + (k & 7) * 2;
                        const float wh = __uint_as_float(((unsigned)*(const LAS unsigned short*)(lds + off)) << 16), wl = __uint_as_float(((unsigned)*(const LAS unsigned short*)(lds + RTW_LO + off)) << 16);
                        dl[j] += xv * (wh + wl); } }
#pragma unroll
                for (int j = 0; j < 4; ++j) { lg[j] = rs * dl[j] + c0[j]; lg[4 + j] = rs * dl[4 + j] + c1[j]; }
            }
#endif
#if RT_DEBUG == 2
            {   float dl[8];
#pragma unroll
                for (int j = 0; j < 8; ++j) dl[j] = 0.f;
                for (int k = 0; k < 1024; ++k) { const float xv = __uint_as_float(((unsigned)((const unsigned short*)X)[(size_t)t * 1024 + k]) << 16);
                    const float v = xv * *(const LAS float*)(lds + RT_G_OFF + k * 4);
#pragma unroll
                    for (int j = 0; j < 8; ++j) dl[j] += v * wr[(size_t)k * 32 + (j < 4 ? 0 : 16) + 4 * gq + (j & 3)]; }
#pragma unroll
                for (int j = 0; j < 4; ++j) { lg[j] = rs * dl[j] + c0[j]; lg[4 + j] = rs * dl[4 + j] + c1[j]; }
            }
#endif
#pragma unroll
            for (int j = 0; j < 8; ++j)
#pragma unroll
                for (int i = 0; i < 8; ++i) if (i != j) rank[j] += (lg[i] > lg[j] || (lg[i] == lg[j] && i < j)) ? 1 : 0;
#pragma unroll
            for (int x = 1; x < 4; ++x) {
                const bool glow = (gq ^ x) < gq;
#pragma unroll
                for (int i = 0; i < 8; ++i) { const float ov = __shfl_xor(lg[i], 16 * x);
#pragma unroll
                    for (int j = 0; j < 8; ++j) { const bool lower = (i < 4 && j >= 4) ? true : (i >= 4 && j < 4) ? false : glow;
                        rank[j] += (ov > lg[j] || (ov == lg[j] && lower)) ? 1 : 0; } }
            }
            float mx = lg[0];
#pragma unroll
            for (int j = 1; j < 8; ++j) mx = fmaxf(mx, lg[j]);
            mx = fmaxf(mx, __shfl_xor(mx, 16)); mx = fmaxf(mx, __shfl_xor(mx, 32));
            float den = 0.f;
#pragma unroll
            for (int j = 0; j < 8; ++j) { wk[j] = rank[j] < 4 ? __expf(lg[j] - mx) : 0.f; den += wk[j]; }
            den += __shfl_xor(den, 16); den += __shfl_xor(den, 32);
            const float invs = 1.0f / den;
#pragma unroll
            for (int j = 0; j < 8; ++j) { wk[j] *= invs; lslot[j] = 0u;
                if (rank[j] < 4) lslot[j] = __hip_atomic_fetch_add(lcnt + ((j < 4 ? 0 : 16) + 4 * gq + (j & 3)), 1u, __ATOMIC_RELAXED, __HIP_MEMORY_SCOPE_WORKGROUP); }
        }
        __syncthreads();
        if (tid < 32) { const unsigned c = lcnt[tid]; lbase[tid] = c ? __hip_atomic_fetch_add(CNT + tid * 64, c, __ATOMIC_RELAXED, __HIP_MEMORY_SCOPE_AGENT) : 0u; }
        __syncthreads();
        if (kh == 0) {
#pragma unroll
            for (int j = 0; j < 8; ++j) if (rank[j] < 4) { const int e = (j < 4 ? 0 : 16) + 4 * gq + (j & 3); const unsigned slot = lbase[e] + lslot[j]; const int a = t * 4 + rank[j];
                LIST[(size_t)e * T + slot] = a; AW[a] = wk[j]; }
        }
    }
    __syncthreads();
}
__device__ __forceinline__ void moe_tables(Frame& F, int l) {
    LAS int* cnt = (LAS int*)(F.lds + MOE_OFF); LAS int* toff = cnt + 32;
    const unsigned* CNT = (const unsigned*)(F.ws + WS_CTL) + CW_CNT + l * 32 * 64;
    __syncthreads();
    if (F.tid < 32) cnt[F.tid] = (int)__hip_atomic_load(CNT + F.tid * 64, __ATOMIC_RELAXED, __HIP_MEMORY_SCOPE_AGENT);
    __syncthreads();
    if (F.tid == 0) { int s = 0; for (int e = 0; e < 32; ++e) { toff[e] = s; s += (cnt[e] + 255) >> 8; } toff[32] = s; }
    __syncthreads();
}

constexpr int NPH = 11, PH_FINAL = 1 + DEPTH * NPH, PH_TOTAL = PH_FINAL + 1;
__global__ void __launch_bounds__(NWAVES * 64, 2) fwd_kernel(Args args) {
    extern __shared__ __attribute__((aligned(16))) unsigned char lds_raw[];
    Frame F;
    F.lds = (LAS unsigned char*)lds_raw; F.ws = args.ws; F.tid = threadIdx.x; F.lane = F.tid & 63; F.wave = __builtin_amdgcn_readfirstlane(F.tid >> 6); F.G = gridDim.x; F.bid = blockIdx.x; F.in = args.in;
    for (int u = F.tid; u < (LDS_BYTES - LDSCTL_OFF) / 4; u += NWAVES * 64) ((LAS unsigned*)(F.lds + LDSCTL_OFF))[u] = 0u;
    __syncthreads();
    const int lo = args.ph_lo, hi = args.ph_hi;
    const unsigned long long tk0_ = (TIME_KIND == 98) ? __builtin_amdgcn_s_memrealtime() : 0ull; unsigned long long tbar_ = 0ull;
    XcdBarrier bar; bar.bar = (unsigned*)(F.ws + WS_CTL) + CW_BAR; bar.x = 0; bar.st = nullptr;
    if (hi - lo > 1) bar = xcd_barrier_post((unsigned*)(F.ws + WS_CTL) + CW_BAR, (volatile LAS unsigned*)(F.lds + MISC_OFF) + 8);
#define IN(k) (lo <= (k) && (k) < hi)
#define PROJ ((bf16*)(ws + WS_PROJ))
#define SEAM(k) do { if (IN(k) && IN((k) + 1)) { const bool acc_ = (TIME_KIND == 97) && ((TIME_MASK >> ((((k) + NPH - 1) % NPH) + 1)) & 1); const unsigned long long tb0_ = acc_ ? __builtin_amdgcn_s_memrealtime() : 0ull; xcd_barrier(bar); if (acc_) tbar_ += __builtin_amdgcn_s_memrealtime() - tb0_; } } while (0)
#define TSTART(kind) unsigned long long t0_ = (TIME_KIND == (kind) || TIME_KIND == 99) ? __builtin_amdgcn_s_memrealtime() : 0ull
#define TSTALL(kind) do { if (TIME_KIND == (kind) || TIME_KIND == 99) { const unsigned long long t1_ = __builtin_amdgcn_s_memrealtime(); const unsigned long long dt_ = t1_ - t0_; while (__builtin_amdgcn_s_memrealtime() - t1_ < dt_) __builtin_amdgcn_s_sleep(8); } } while (0)
    unsigned char* ws = F.ws;
#define PHASE_ENTER() do { unsigned char* w_ = args.ws; asm volatile("" : "+s"(w_)); F.ws = w_; ws = w_; int t_ = threadIdx.x; asm volatile("" : "+v"(t_)); F.tid = t_; F.lane = t_ & 63; F.wave = __builtin_amdgcn_readfirstlane(t_ >> 6); } while (0)
    if (EN(0) && IN(0)) { PHASE_ENTER(); TSTART(0); REPS(0) { p_prologue(F); } SEAM(0); TSTALL(0); }
    for (int l = 0; l < DEPTH; ++l) {
        const int pb = 1 + l * NPH;
        if (EN(1) && IN(pb + 0)) { PHASE_ENTER(); TSTART(1); if (REP_KIND == 1) p_norm_mix(F, l, false, nullptr, true); p_norm_mix(F, l, false, nullptr); SEAM(pb + 0); TSTALL(1); }
        if (EN(2) && IN(pb + 1)) { PHASE_ENTER(); TSTART(2);
            REPS(2) {
            { pg8::DenseOrder S; S.init(T, NPROJ - 256, F.G, F.bid, ws + WS_HB, 1024, (bf16*)wl(ws, l, WL_IN) + (size_t)(NHT + 256) * 1024, 1024);
              EpiProj E{PROJ + 256};
              pg8::gemm_phase(F.lds, 1024, S, E); }
            { int z = 0; asm volatile("" : "+s"(z)); pg8::DenseOrder S; S.init(NHT, T, F.G, (F.bid + 64 + z) % F.G, wl(ws, l, WL_IN) + z, 1024, ws + WS_HB + z, 1024);
              EpiHT E{(bf16*)(ws + WS_HT)};
              pg8::gemm_phase(F.lds, 1024, S, E); }
            }
            SEAM(pb + 1); TSTALL(2);
        }
        if (EN(3) && IN(pb + 2)) { PHASE_ENTER(); TSTART(3); REPS(3) { p_mla_prep(F); } SEAM(pb + 2); TSTALL(3); }
        if (EN(4) && IN(pb + 3)) { PHASE_ENTER(); TSTART(4);
#ifndef SUBMASK
#define SUBMASK 7
#endif
            REPS(4) {
            const bool shift_ = F.G >= 128;
            { int z = 0; asm volatile("" : "+s"(z)); pg8::DenseOrder S; S.init(T, 256, F.G, (F.bid + 64 + z) % F.G, ws + WS_HB + z, 1024, (bf16*)wl(ws, l, WL_IN) + (size_t)NHT * 1024 + z, 1024);
              EpiProj E{PROJ};
              pg8::gemm_phase(F.lds, 1024, S, E); }
            if (SUBMASK & 1) { pg8::DenseOrder S; S.init(T, 768, F.G, F.bid, PROJ + PCQ, NPROJ, wl(ws, l, WL_Q), 384);
              EpiQ E{(bf16*)(ws + WS_Q), (const float*)(ws + WS_RSQ), (const float*)(ws + WS_COS), (const float*)(ws + WS_SIN)};
              pg8::gemm_phase(F.lds, 384, S, E); }
            if (SUBMASK & 2) { int z = 0; asm volatile("" : "+s"(z)); pg8::DenseOrder S; S.init(T, 512, F.G, shift_ ? F.bid + z : (F.bid + 64 + z) % F.G, PROJ + PCKV + z, NPROJ, wl(ws, l, WL_K) + z, 256);
              EpiK E{(bf16*)(ws + WS_K), (const float*)(ws + WS_RSKV)};
              pg8::gemm_phase(F.lds, 256, S, E); }
            if (SUBMASK & 4) { int z = 0; asm volatile("" : "+s"(z)); pg8::DenseOrder S; S.init(512, T, F.G, (F.bid + 192 + z) % F.G, wl(ws, l, WL_V) + z, 256, PROJ + PCKV + z, NPROJ);
              if (shift_) { S.G = F.G - 64; S.c = F.bid < F.G - 64 ? (F.bid + 64) % (F.G - 64) : S.nwg; }
              EpiV E{(bf16*)(ws + WS_VT), (const float*)(ws + WS_RSKV)};
              pg8::gemm_phase(F.lds, 256, S, E); }
            }
            SEAM(pb + 3); TSTALL(4);
        }
        if (EN(5) && IN(pb + 4)) { PHASE_ENTER(); TSTART(5);
            REPS(5) {
            if (rep_ == 0 || (REP_SUB & 1)) for (int u = F.bid; u < 128 * SCAN_REP; u += F.G) scan_unit2(F, l, u & 127);
            if (rep_ == 0 || (REP_SUB & 2)) {
                unsigned* qctr = (unsigned*)(ws + WS_CTL) + CW_Q + (l * 2 + rep_) * 64; volatile LAS unsigned* misc = (volatile LAS unsigned*)(F.lds + MISC_OFF);
                for (;;) { __syncthreads(); if (F.tid == 0) misc[0] = __hip_atomic_fetch_add(qctr, 1u, __ATOMIC_RELAXED, __HIP_MEMORY_SCOPE_AGENT); __syncthreads();
                    const int a = (int)misc[0]; if (a >= 512 * ATTN_REP) break; attn_unit(F, (a & 511) >> 3, (a & 7) * 256); }
            }
            }
            SEAM(pb + 4); TSTALL(5);
        }
        if (EN(6) && IN(pb + 5)) { PHASE_ENTER(); TSTART(6); REPS(6) { p_hgrn_post(F, l); } SEAM(pb + 5); TSTALL(6); }
        if (EN(7) && IN(pb + 6)) { PHASE_ENTER(); TSTART(7);
            REPS(7) {
            { pg8::DenseOrder S; S.init(T, 1024, F.G, F.bid, ws + WS_HA, 1024, wl(ws, l, WL_OUT), 1024);
              EpiOut E{(bf16*)(ws + WS_Y), PROJ};
              pg8::gemm_phase(F.lds, 1024, S, E); }
            }
            SEAM(pb + 6); TSTALL(7);
        }
        if (EN(8) && IN(pb + 7)) { PHASE_ENTER(); TSTART(8);
            pg8::DenseOrder S; S.init(T, 1024, F.G, F.bid, ws + WS_Y, 1024, wl(ws, l, WL_O), 1024);
            if (REP_KIND == 8) { EpiWo E2{(bf16*)(ws + WS_ACT), (const float*)(ws + WS_MOD) + (size_t)l * 8 * 6144 + 2 * 1024}; pg8::gemm_phase(F.lds, 1024, S, E2); }
            EpiWo E{(bf16*)(ws + WS_X), (const float*)(ws + WS_MOD) + (size_t)l * 8 * 6144 + 2 * 1024};
            pg8::gemm_phase(F.lds, 1024, S, E);
            if (REP_KIND == 13) { for (int q = 0; q < 10; ++q) xcd_barrier(bar); }
            SEAM(pb + 7); TSTALL(8);
        }
        if (EN(9) && IN(pb + 8)) { PHASE_ENTER(); TSTART(9); if (REP_KIND == 9) p_router(F, l, true); p_router(F, l); SEAM(pb + 8); TSTALL(9); }
        if (EN(10) && IN(pb + 9)) { PHASE_ENTER(); TSTART(10);
            moe_tables(F, l);
            pg8::MoeOrder<true> S; S.cnt = (const LAS int*)(F.lds + MOE_OFF); S.toff = S.cnt + 32; S.NT = 8; S.G = F.G; S.c = F.bid; S.Abase = (const char*)(ws + WS_HB); S.Bbase = (const char*)wl(ws, l, WL_GU);
            S.b_expert_bytes = (size_t)2048 * 1024 * 2; S.list = (const int*)(ws + WS_LIST); S.lda = 1024; S.ldb = 1024;
            EpiGU E{(bf16*)(ws + WS_ACT), F.in[20] + (size_t)l * 32 * 2048};
            REPS(10) { pg8::gemm_phase(F.lds, 1024, S, E); }
            SEAM(pb + 9); TSTALL(10);
        }
        if (EN(11) && IN(pb + 10)) { PHASE_ENTER(); TSTART(11);
            moe_tables(F, l);
            pg8::MoeOrder<false> S; S.cnt = (const LAS int*)(F.lds + MOE_OFF); S.toff = S.cnt + 32; S.NT = 4; S.G = F.G; S.c = F.bid; S.Abase = (const char*)(ws + WS_ACT); S.Bbase = (const char*)wl(ws, l, WL_DN);
            S.b_expert_bytes = (size_t)1024 * 1024 * 2; S.list = (const int*)(ws + WS_LIST); S.lda = 1024; S.ldb = 1024;
            EpiDown E{ws + WS_YR, F.in[22] + (size_t)l * 32 * 1024, (const int*)(ws + WS_LIST), (const float*)(ws + WS_AW)};
            REPS(11) { pg8::gemm_phase(F.lds, 1024, S, E); }
            SEAM(pb + 10); TSTALL(11);
        }
    }
    if (EN(12) && IN(PH_FINAL)) { PHASE_ENTER(); p_norm_mix(F, DEPTH, true, args.out); }
    if (TIME_KIND == 97 && F.bid == (TIME_BLOCK)) { const unsigned long long t1_ = __builtin_amdgcn_s_memrealtime(); while (__builtin_amdgcn_s_memrealtime() - t1_ < tbar_) __builtin_amdgcn_s_sleep(8); }
    if (TIME_KIND == 98 && F.bid == 0) { const unsigned long long t1_ = __builtin_amdgcn_s_memrealtime(); const unsigned long long dt_ = t1_ - tk0_; while (__builtin_amdgcn_s_memrealtime() - t1_ < dt_) __builtin_amdgcn_s_sleep(8); }
#undef IN
#undef SEAM
#undef PROJ
#undef PHASE_ENTER
}

extern "C" void kernel_launch(void* const* d_in, const int* in_sizes, int n_in, void* d_out, int out_size, void* d_ws, size_t ws_size, hipStream_t stream) {
    static int grid = 0;
    if (grid == 0) {
        if (n_in != 24 || in_sizes[0] != T * D || out_size != T * D || ws_size < WS_END) { fprintf(stderr, "kernel_launch: unexpected problem (n_in %d, in0 %d, out %d, ws %zu, need %zu)\n", n_in, n_in > 0 ? in_sizes[0] : -1, out_size, ws_size, (size_t)WS_END); grid = -1; return; }
        int dev = 0, cus = 0, per_cu = 0;
        if (hipGetDevice(&dev) != hipSuccess || hipDeviceGetAttribute(&cus, hipDeviceAttributeMultiprocessorCount, dev) != hipSuccess) { grid = -1; return; }
        if (hipFuncSetAttribute((const void*)fwd_kernel, hipFuncAttributeMaxDynamicSharedMemorySize, LDS_BYTES) != hipSuccess) { fprintf(stderr, "kernel_launch: hipFuncSetAttribute failed\n"); grid = -1; return; }
        if (hipOccupancyMaxActiveBlocksPerMultiprocessor(&per_cu, (const void*)fwd_kernel, NWAVES * 64, LDS_BYTES) != hipSuccess || per_cu < 1) { fprintf(stderr, "kernel_launch: occupancy query says %d\n", per_cu); (void)hipGetLastError(); }
        grid = cus - (cus % 8);
        if (grid < 64) { fprintf(stderr, "kernel_launch: only %d CUs\n", cus); grid = -1; return; }
    }
    if (grid < 0) return;
    if (hipMemsetAsync((char*)d_ws + WS_CTL, 0, CTL_ZERO_BYTES, stream) != hipSuccess) return;
    Args a{};
    for (int i = 0; i < 24; ++i) a.in[i] = (const float*)d_in[i];
    a.out = (float*)d_out; a.ws = (unsigned char*)d_ws;
#if MK_PER_PHASE
    for (int ph = 0; ph < PH_TOTAL; ++ph) { a.ph_lo = ph; a.ph_hi = ph + 1; hipLaunchKernelGGL(fwd_kernel, dim3(grid), dim3(NWAVES * 64), LDS_BYTES, stream, a); }
#else
    a.ph_lo = 0; a.ph_hi = PH_TOTAL; hipLaunchKernelGGL(fwd_kernel, dim3(grid), dim3(NWAVES * 64), LDS_BYTES, stream, a);
#endif
}
```

```cpp
#include <hip/hip_runtime.h>
#include <cstdio>
#include <cstdint>

#ifndef RT_DEBUG
#define RT_DEBUG 0
#endif
#ifndef PHASE_MASK
#define PHASE_MASK 0xFFFFu
#endif
#define EN(k) (((PHASE_MASK) >> (k)) & 1u)
#ifndef REP_KIND
#define REP_KIND -1
#endif
#ifndef REP_SUB
#define REP_SUB 3
#endif
#ifndef TIME_MASK
#define TIME_MASK 0xFFFF
#endif
#ifndef TIME_BLOCK
#define TIME_BLOCK 0
#endif
#ifndef TIME_KIND
#define TIME_KIND -1
#endif
#ifndef ATTN_REP
#define ATTN_REP 1
#endif
#ifndef SCAN_REP
#define SCAN_REP 1
#endif
#ifndef EPI_REP
#define EPI_REP 1
#endif
#define REPS(k) _Pragma("unroll 1") for (int rep_ = 0; rep_ < ((REP_KIND) == (k) ? 2 : 1); ++rep_)
#ifndef MK_PER_PHASE
#define MK_PER_PHASE 0
#endif

#define GAS __attribute__((address_space(1)))
#define LAS __attribute__((address_space(3)))
typedef unsigned short bf16;
typedef short bf16x8 __attribute__((ext_vector_type(8)));
typedef float f32x4 __attribute__((ext_vector_type(4)));
typedef float f32x2 __attribute__((ext_vector_type(2)));
typedef float f32x16 __attribute__((ext_vector_type(16)));
typedef unsigned u32x4 __attribute__((ext_vector_type(4)));
typedef unsigned u32x2 __attribute__((ext_vector_type(2)));
typedef __bf16 bfv2 __attribute__((ext_vector_type(2)));
__device__ __forceinline__ unsigned pk4_fp8(float a, float b, float c, float d) { unsigned w = 0u; w = __builtin_amdgcn_cvt_pk_fp8_f32(a, b, w, false); w = __builtin_amdgcn_cvt_pk_fp8_f32(c, d, w, true); return w; }
constexpr float YR_SCALE = 16.0f, YR_INV = 1.0f / 16.0f;

__device__ __forceinline__ unsigned pk2(float lo, float hi) { f32x2 v = {lo, hi}; bfv2 r = __builtin_convertvector(v, bfv2); return __builtin_bit_cast(unsigned, r); }
__device__ __forceinline__ float bf2f(unsigned short b) { return __uint_as_float(((unsigned)b) << 16); }
__device__ __forceinline__ float bflo(unsigned w) { return __uint_as_float(w << 16); }
__device__ __forceinline__ float bfhi(unsigned w) { return __uint_as_float(w & 0xffff0000u); }
__device__ __forceinline__ u32x4 pack8(f32x4 a, f32x4 b) { u32x4 w; w.x = pk2(a[0], a[1]); w.y = pk2(a[2], a[3]); w.z = pk2(b[0], b[1]); w.w = pk2(b[2], b[3]); return w; }
__device__ __forceinline__ void unpack8(u32x4 w, f32x4& a, f32x4& b) { a[0] = bflo(w.x); a[1] = bfhi(w.x); a[2] = bflo(w.y); a[3] = bfhi(w.y); b[0] = bflo(w.z); b[1] = bfhi(w.z); b[2] = bflo(w.w); b[3] = bfhi(w.w); }
__device__ __forceinline__ float sigmoidf_(float x) { return 1.0f / (1.0f + __expf(-x)); }
__device__ __forceinline__ float wave_sum(float v) {
#pragma unroll
    for (int o = 1; o < 64; o <<= 1) v += __shfl_xor(v, o);
    return v;
}
#define LDS_WAIT() asm volatile("s_waitcnt lgkmcnt(0)" ::: "memory")
#define VM_WAIT() asm volatile("s_waitcnt vmcnt(0)" ::: "memory")

#define XB_TMO      128
#define XB_XCNT(j)  (256  + 64 * (j))
#define XB_XSUB(j)  (1280 + 64 * (j))
#define XB_XGEN(j)  (2304 + 64 * (j))
#define XB_TOP      3328
#define XB_TOPGEN   3392
#define XCD_BAR_WORDS 3456
#define XB_SPIN_CAP (1u << 20)

__device__ __forceinline__ unsigned xb_ld(unsigned* p)              { return __hip_atomic_load(p, __ATOMIC_RELAXED, __HIP_MEMORY_SCOPE_AGENT); }
__device__ __forceinline__ unsigned xb_add(unsigned* p, unsigned v) { return __hip_atomic_fetch_add(p, v, __ATOMIC_RELAXED, __HIP_MEMORY_SCOPE_AGENT); }
__device__ __forceinline__ unsigned xb_xcc_id() { return (unsigned)__builtin_amdgcn_s_getreg((3 << 11) | 20) & 0xFu; }
#define XB_SPIN(cond, bar) do { unsigned _sp = 0; while (cond) { __builtin_amdgcn_s_sleep(1); \
    if ((++_sp & 255u) == 0u) { if (xb_ld(&(bar)[XB_TMO])) break; if (_sp > XB_SPIN_CAP) { atomicAdd(&(bar)[XB_TMO], 1u); break; } } } } while (0)

struct XcdBarrier { unsigned* bar; unsigned x; volatile LAS unsigned* st; };

__device__ __forceinline__ XcdBarrier xcd_barrier_post(unsigned* bar, volatile LAS unsigned* st) {
    XcdBarrier b; b.bar = bar; b.x = xb_xcc_id(); b.st = st;
    if (threadIdx.x == 0) (void)xb_add(&bar[XB_XCNT(b.x)], 1u);
    return b;
}
__device__ __forceinline__ void xcd_barrier_complete(unsigned* bar, unsigned x, unsigned& nloc, unsigned& nx) {
    const unsigned G = gridDim.x * gridDim.y * gridDim.z;
    unsigned sum, cnt, mine, sp = 0u;
    for (;;) {
        sum = 0u; cnt = 0u; mine = 0u;
#pragma unroll
        for (unsigned j = 0; j < 16; ++j) { const unsigned c = xb_ld(&bar[XB_XCNT(j)]); sum += c; cnt += (c > 0u) ? 1u : 0u; mine = (j == x) ? c : mine; }
        if (sum == G) break;
        __builtin_amdgcn_s_sleep(1);
        if ((++sp & 255u) == 0u) { if (xb_ld(&bar[XB_TMO])) break; if (sp > XB_SPIN_CAP) { atomicAdd(&bar[XB_TMO], 1u); break; } }
    }
    nloc = mine > 0u ? mine : 1u; nx = cnt > 0u ? cnt : 1u;
}
__device__ __forceinline__ void xcd_barrier(const XcdBarrier& b) {
    asm volatile("s_waitcnt vmcnt(0)" ::: "memory");
    __syncthreads();
    if (threadIdx.x == 0) {
        unsigned* bar = b.bar;
        __builtin_amdgcn_s_waitcnt(0);
        unsigned nloc = b.st[0], nx = b.st[1];
        if (nloc == 0u) { xcd_barrier_complete(bar, b.x, nloc, nx); b.st[0] = nloc; b.st[1] = nx; }
        const unsigned old = xb_add(&bar[XB_XSUB(b.x)], 1u);
        const unsigned gen = old / nloc;
        if (old + 1u == (gen + 1u) * nloc) {
            __builtin_amdgcn_fence(__ATOMIC_RELEASE, "agent");
            asm volatile("s_waitcnt vmcnt(0)" ::: "memory");
            const unsigned og = xb_add(&bar[XB_TOP], 1u);
            const unsigned tg = og / nx;
            if (og + 1u == (tg + 1u) * nx) xb_add(&bar[XB_TOPGEN], 1u);
            else XB_SPIN(xb_ld(&bar[XB_TOPGEN]) == tg, bar);
            __builtin_amdgcn_fence(__ATOMIC_ACQUIRE, "agent");
            xb_add(&bar[XB_XGEN(b.x)], 1u);
            asm volatile("s_waitcnt vmcnt(0)" ::: "memory");
        } else {
            XB_SPIN(xb_ld(&bar[XB_XGEN(b.x)]) == gen, bar);
            __builtin_amdgcn_fence(__ATOMIC_ACQUIRE, "agent");
            asm volatile("s_waitcnt vmcnt(0)" ::: "memory");
        }
    }
    __syncthreads();
}

constexpr int D = 1024, NB = 8, SEQ = 2048, T = NB * SEQ, DEPTH = 4;
constexpr int NPROJ = 3328;
constexpr int NHT = 2048;
constexpr int PGT = 0, PGA = 512, PGB = 1536, PCQ = 2560, PCKV = 2944, PKPE = 3200;
constexpr int HQ = 0, HFF = 512, HFB = 1024, HI = 1536;
constexpr int NE = 32, TOPK = 4, NASSIGN = T * TOPK, ACT_ROWS = NASSIGN + NE * 256;
constexpr float EPS = 1e-6f;
constexpr float QSCALE = 0.10206207261596575f * 1.4426950408889634f;

constexpr size_t MiB = 1u << 20;
constexpr size_t WS_CTL = 0, CTL_ZERO_BYTES = 1 * MiB;
constexpr size_t WS_MOD = 1 * MiB, WS_LB = 2 * MiB, WS_COS = 3 * MiB, WS_SIN = 4 * MiB, WS_RSQ = 5 * MiB, WS_RSKV = 5 * MiB + 65536, WS_AW = 6 * MiB, WS_LIST = 7 * MiB;
constexpr size_t WS_X = 16 * MiB, WS_HB = 80 * MiB, WS_PROJ = 112 * MiB, WS_HT = 216 * MiB, WS_Q = 280 * MiB, WS_K = 304 * MiB, WS_VT = 328 * MiB, WS_OF = 344 * MiB, WS_OB = 376 * MiB;
constexpr size_t WS_HA = 408 * MiB, WS_Y = 440 * MiB, WS_ACT = 472 * MiB, WS_YR = 616 * MiB, WS_W = 768 * MiB;
constexpr size_t WL_IN = 0, WL_Q = 11 * MiB, WL_K = 12 * MiB, WL_V = 12 * MiB + 256 * 1024, WL_OUT = 13 * MiB, WL_O = 15 * MiB, WL_GU = 17 * MiB, WL_DN = 145 * MiB, WL_STRIDE = 209 * MiB;
constexpr size_t WS_END = WS_W + DEPTH * WL_STRIDE;
static_assert((size_t)T * NPROJ * 2 <= WS_HT - WS_PROJ && (size_t)NB * NHT * SEQ * 2 <= WS_Q - WS_HT && (size_t)ACT_ROWS * 1024 * 2 <= WS_YR - WS_ACT && (size_t)NASSIGN * 1024 * 2 <= WS_W - WS_YR, "ws map");
constexpr int CW_BAR = 4096, CW_Q = 8192, CW_CNT = 16384;

constexpr int RING_BYTES = 131072;
constexpr int LDSCTL_OFF = 139264, MISC_OFF = LDSCTL_OFF + 320, MOE_OFF = LDSCTL_OFF + 1024;
constexpr int LDS_BYTES = 155648;
constexpr int RT_G_OFF = 143360, RT_S_OFF = 147456;
constexpr int NWAVES = 8;

namespace pg8 {
constexpr int BM = 256, BK = 64, HALF = 128, HTB = HALF * BK * 2, NXCD = 8, WGM = 8;
__device__ __forceinline__ int lds_byte(int r, int c) { const int st = (r >> 4) * 2 + (c >> 5), rr = r & 15, cc = c & 31, ob = rr * 64 + cc * 2; return st * 1024 + (ob ^ (((ob >> 9) & 1) << 5)); }
__device__ __forceinline__ void stage_rc(int b, int& R, int& C) { const int st = b / 1024, sb = b % 1024, swz = sb ^ (((sb >> 9) & 1) << 5); R = (st >> 1) * 16 + swz / 64; C = (st & 1) * 32 + (swz % 64) / 2; }
__device__ __forceinline__ int perm32(int rho) { const int n = rho >> 4, i = rho & 15; return 8 * (i >> 2) + 4 * n + (i & 3); }

struct Unit { const char* A; const char* B; int pm, pn, e, rowbase, mrows; };

struct DenseOrder {
    static constexpr bool GATHER_A = false;
    int nM, nN, nwg, G, c; const char* Abase; const char* Bbase; int lda, ldb;
    __device__ __forceinline__ void init(int M, int N, int G_, int c_, const void* A, int lda_, const void* B, int ldb_) { nM = M / BM; nN = N / BM; nwg = nM * nN; G = G_; c = c_; Abase = (const char*)A; Bbase = (const char*)B; lda = lda_; ldb = ldb_; }
    __device__ __forceinline__ bool next(int i, Unit& u) const {
        const long L = (long)i * G + c; if (L >= nwg) return false;
        int wgid = (int)L; { const int q = nwg / NXCD, r = nwg % NXCD, xcd = wgid % NXCD, off = wgid / NXCD; wgid = (xcd < r ? xcd * (q + 1) : r * (q + 1) + (xcd - r) * q) + off; }
        const int nig = WGM * nN, gid = wgid / nig, fm = gid * WGM, gsz = (nM - fm) < WGM ? (nM - fm) : WGM;
        u.pm = fm + ((wgid % nig) % gsz); u.pn = (wgid % nig) / gsz; u.e = 0; u.rowbase = 0; u.mrows = 256;
        u.A = Abase + (size_t)u.pm * 256 * lda * 2; u.B = Bbase + (size_t)u.pn * 256 * ldb * 2; return true;
    }
    __device__ __forceinline__ void aoff(const Unit&, const int (&R)[2], const int (&C)[2], unsigned (&v)[2][2]) const {
#pragma unroll
        for (int h = 0; h < 2; ++h)
#pragma unroll
            for (int i = 0; i < 2; ++i) v[h][i] = (unsigned)((128 * h + R[i]) * lda + C[i]) * 2u;
    }
};
template <bool GATHER> struct MoeOrder {
    static constexpr bool GATHER_A = GATHER;
    const LAS int* toff; const LAS int* cnt; int NT, G, c; const char* Abase; const char* Bbase; size_t b_expert_bytes; const int* list; int lda, ldb;
    __device__ __forceinline__ bool next(int i, Unit& u) const {
        const int spx = G >> 3, rpx = spx / NT, xcd = c & 7, slot = c >> 3;
        if (slot >= rpx * NT) return false;
        const int R = (i * 8 + xcd) * rpx + slot / NT; if (R >= toff[NE]) return false;
        int e = 0; while (toff[e + 1] <= R) ++e;
        u.e = e; u.pm = R - toff[e]; u.pn = slot % NT; u.rowbase = R * 256; u.mrows = cnt[e] - u.pm * 256;
        u.A = GATHER ? Abase : Abase + (size_t)u.rowbase * lda * 2; u.B = Bbase + (size_t)e * b_expert_bytes + (size_t)u.pn * 256 * ldb * 2; return true;
    }
    __device__ __forceinline__ void aoff(const Unit& u, const int (&R)[2], const int (&C)[2], unsigned (&v)[2][2]) const {
#pragma unroll
        for (int h = 0; h < 2; ++h)
#pragma unroll
            for (int i = 0; i < 2; ++i) {
                if (GATHER) { const int rl = 128 * h + R[i]; const int a = list[(size_t)u.e * T + u.pm * 256 + (rl < u.mrows ? rl : 0)]; v[h][i] = (unsigned)((a >> 2) * lda + C[i]) * 2u; }
                else v[h][i] = (unsigned)((128 * h + R[i]) * lda + C[i]) * 2u;
            }
    }
};

template <class E, class = void> struct has_mid { static constexpr bool value = false; };
template <class E> struct has_mid<E, decltype((void)E::HAS_MID)> { static constexpr bool value = true; };
template <class Epi, class Sched>
__device__ __forceinline__ void gemm_phase(LAS unsigned char* lds, const int K, const Sched& S, const Epi& E) {
    int tid_ = threadIdx.x; asm volatile("" : "+v"(tid_));
    const int tid = tid_, wid = __builtin_amdgcn_readfirstlane(tid >> 6), lane = tid & 63, wr = wid >> 2, wc = wid & 3, fr = lane & 15, fq = lane >> 4;
    int nt_ = K / BK; asm volatile("" : "+s"(nt_));
    const int nt = nt_;
    int sR[2], sC[2]; unsigned voffB[2];
#pragma unroll
    for (int i = 0; i < 2; ++i) { stage_rc(tid * 16 + i * 8192, sR[i], sC[i]); const int Rb = (sR[i] & ~31) + perm32(sR[i] & 31); voffB[i] = (unsigned)(Rb * S.ldb + sC[i]) * 2u; }
    constexpr bool GA = Sched::GATHER_A;
    unsigned voffA[2];
#pragma unroll
    for (int i = 0; i < 2; ++i) voffA[i] = (unsigned)(sR[i] * S.lda + sC[i]) * 2u;
    const size_t kstep = (size_t)(BK * 2);
    const size_t hstepB = (size_t)HALF * S.ldb * 2, hstepA = (size_t)HALF * S.lda * 2;
    const unsigned ldsw = (unsigned)wid * 1024u;
    const unsigned ldsbase = (unsigned)__builtin_amdgcn_readfirstlane((int)((unsigned)(size_t)lds + ldsw));
    const int aoff = lds_byte(wr * 64 + fr, fq * 8), boff = lds_byte(wc * 32 + fr, fq * 8);
#define PG8_SA(b, h) (((b) * 2 + (h)) * HTB)
#define PG8_SB(b, h) ((4 + (b) * 2 + (h)) * HTB)
#define PG8_DMA2(ldsaddr, gbase, v0_, v1_) do { unsigned keep_; \
        asm volatile("s_mov_b32 %0, m0\n\ts_mov_b32 m0, %4\n\ts_nop 0\n\tglobal_load_lds_dwordx4 %1, %3\n\ts_add_u32 m0, %4, 0x2000\n\ts_nop 0\n\tglobal_load_lds_dwordx4 %2, %3\n\ts_mov_b32 m0, %0" \
                     : "=&s"(keep_) : "v"(v0_), "v"(v1_), "s"(gbase), "s"(ldsaddr) : "memory", "scc"); } while (0)
#define PG8_STAGE(bufoff, gbase, voff) PG8_DMA2(ldsbase + (unsigned)(bufoff), (const char*)(gbase), (voff)[0], (voff)[1])
#define PG8_STAGEA(bufoff, gbase, h, nx) do { if constexpr (GA) { PG8_DMA2(ldsbase + (unsigned)(bufoff), (const char*)(gbase), ((nx) ? nvA[h][0] : vA[h][0]), ((nx) ? nvA[h][1] : vA[h][1])); } \
        else { PG8_DMA2(ldsbase + (unsigned)(bufoff), (const char*)(gbase) + (size_t)(h) * hstepA, voffA[0], voffA[1]); } } while (0)
#define PG8_LDA(dst, b, h) do { _Pragma("unroll") for (int m = 0; m < 4; ++m) _Pragma("unroll") for (int k = 0; k < 2; ++k) dst[m][k] = *(const LAS bf16x8*)(lds + PG8_SA(b, h) + aoff + m * 2048 + k * 1024); } while (0)
#define PG8_LDB(dst, b, h) do { _Pragma("unroll") for (int n = 0; n < 2; ++n) _Pragma("unroll") for (int k = 0; k < 2; ++k) dst[n][k] = *(const LAS bf16x8*)(lds + PG8_SB(b, h) + boff + n * 2048 + k * 1024); } while (0)
#define PG8_MMA(ai, bj, At, Bt) do { __builtin_amdgcn_s_setprio(1); _Pragma("unroll") for (int m = 0; m < 4; ++m) _Pragma("unroll") for (int n = 0; n < 2; ++n) _Pragma("unroll") for (int k = 0; k < 2; ++k) \
        acc[ai][bj][m][n] = __builtin_amdgcn_mfma_f32_16x16x32_bf16(Bt[n][k], At[m][k], acc[ai][bj][m][n], 0, 0, 0); __builtin_amdgcn_s_setprio(0); } while (0)
#define PG8_WAIT_V(n) asm volatile("s_waitcnt vmcnt(" #n ")" ::: "memory")
#define PG8_WAIT_L(n) asm volatile("s_waitcnt lgkmcnt(" #n ")" ::: "memory")
#define PG8_BAR __builtin_amdgcn_s_barrier()
#define PG8_SCHED __builtin_amdgcn_sched_barrier(0)
    Unit cur, nxt; int ui = 0;
    if (!S.next(0, cur)) return;
    f32x4 acc[2][2][4][2];
#pragma unroll
    for (int a = 0; a < 2; ++a)
#pragma unroll
        for (int b = 0; b < 2; ++b)
#pragma unroll
            for (int m = 0; m < 4; ++m)
#pragma unroll
                for (int n = 0; n < 2; ++n) acc[a][b][m][n] = (f32x4){0.f, 0.f, 0.f, 0.f};
    bf16x8 At[4][2], B0[2][2], B1[2][2];
    unsigned vA[2][2], nvA[2][2];
    if constexpr (GA) { S.aoff(cur, sR, sC, vA); }
    const char* cA = cur.A; const char* cB = cur.B;
    PG8_STAGE(PG8_SB(0, 0), cB, voffB); PG8_STAGE(PG8_SB(0, 1), cB + hstepB, voffB); PG8_STAGEA(PG8_SA(0, 0), cA, 0, false); PG8_STAGEA(PG8_SA(0, 1), cA, 1, false);
    if (wr == 1) PG8_BAR;
    PG8_WAIT_V(2); PG8_BAR;
    PG8_STAGE(PG8_SB(1, 0), cB + kstep, voffB); PG8_STAGEA(PG8_SA(1, 0), cA + kstep, 0, false); PG8_STAGE(PG8_SB(1, 1), cB + hstepB + kstep, voffB);
    PG8_WAIT_V(6); PG8_BAR;
    for (;;) {
        const bool has_next = S.next(ui + 1, nxt);
        const char* nA = has_next ? nxt.A : cA; const char* nB = has_next ? nxt.B : cB;
        if constexpr (GA) {
            if (has_next) S.aoff(nxt, sR, sC, nvA);
            else {
#pragma unroll
                for (int h = 0; h < 2; ++h)
#pragma unroll
                    for (int i = 0; i < 2; ++i) nvA[h][i] = vA[h][i]; } }
#pragma unroll 1
        for (int t = 0; t < nt; t += 2) {
            const bool last = (t == nt - 2);
            if constexpr (has_mid<Epi>::value) { if (t == Epi::MID_T) E.mid(acc, cur, wr, wc, fr, fq); }
            const char* a1 = cA + (size_t)(t + 1) * kstep;
            const char* a2 = last ? nA : cA + (size_t)(t + 2) * kstep; const char* b2 = last ? nB : cB + (size_t)(t + 2) * kstep;
            const char* a3 = a2 + kstep; const char* b3 = b2 + kstep;
            PG8_LDB(B0, 0, 0); PG8_LDB(B1, 0, 1); PG8_SCHED; PG8_LDA(At, 0, 0); PG8_STAGEA(PG8_SA(1, 1), a1, 1, false);
            PG8_WAIT_V(8); PG8_WAIT_L(0); PG8_BAR; PG8_MMA(0, 0, At, B0); PG8_MMA(0, 1, At, B1); PG8_BAR; PG8_SCHED;
            PG8_LDA(At, 0, 1); PG8_STAGE(PG8_SB(0, 0), b2, voffB); PG8_STAGE(PG8_SB(0, 1), b2 + hstepB, voffB); PG8_STAGEA(PG8_SA(0, 0), a2, 0, last);
            PG8_WAIT_V(8); PG8_WAIT_L(0); PG8_BAR; PG8_MMA(1, 0, At, B0); PG8_MMA(1, 1, At, B1); PG8_BAR; PG8_SCHED;
            PG8_LDB(B0, 1, 0); PG8_LDB(B1, 1, 1); PG8_SCHED; PG8_LDA(At, 1, 0); PG8_STAGEA(PG8_SA(0, 1), a2, 1, last);
            PG8_WAIT_V(8); PG8_WAIT_L(0); PG8_BAR; PG8_MMA(0, 0, At, B0); PG8_MMA(0, 1, At, B1); PG8_BAR; PG8_SCHED;
            PG8_LDA(At, 1, 1); PG8_STAGE(PG8_SB(1, 0), b3, voffB); PG8_STAGE(PG8_SB(1, 1), b3 + hstepB, voffB); PG8_STAGEA(PG8_SA(1, 0), a3, 0, last);
            PG8_WAIT_V(8); PG8_WAIT_L(0); PG8_BAR; PG8_MMA(1, 0, At, B0); PG8_MMA(1, 1, At, B1); PG8_BAR; PG8_SCHED;
        }
        if (wr == 0) PG8_BAR;
        E(acc, cur, wr, wc, fr, fq);
        if constexpr (EPI_REP > 1 && Epi::IDEMPOTENT) { asm volatile("" ::: "memory"); E(acc, cur, wr, wc, fr, fq); }
        if (!has_next) break;
#pragma unroll
        for (int a = 0; a < 2; ++a)
#pragma unroll
            for (int b = 0; b < 2; ++b)
#pragma unroll
                for (int m = 0; m < 4; ++m)
#pragma unroll
                    for (int n = 0; n < 2; ++n) acc[a][b][m][n] = (f32x4){0.f, 0.f, 0.f, 0.f};
        cur = nxt; cA = nA; cB = nB; ++ui;
        if constexpr (GA) {
#pragma unroll
            for (int h = 0; h < 2; ++h)
#pragma unroll
                for (int i = 0; i < 2; ++i) vA[h][i] = nvA[h][i]; }
        if (wr == 1) PG8_BAR;
    }
    PG8_WAIT_V(0);
    PG8_BAR;
#undef PG8_SA
#undef PG8_SB
#undef PG8_STAGE
#undef PG8_STAGEA
#undef PG8_DMA2
#undef PG8_LDA
#undef PG8_LDB
#undef PG8_MMA
#undef PG8_WAIT_V
#undef PG8_WAIT_L
#undef PG8_BAR
#undef PG8_SCHED
}
}
using pg8::Unit;
typedef const f32x4 (&AccRef)[2][2][4][2];

struct Args {
    const float* in[24]; float* out; unsigned char* ws; int ph_lo, ph_hi;
};
struct Frame {
    LAS unsigned char* lds; unsigned char* ws; int tid, lane, wave, G, bid;
    const float* const* in;
};
__device__ __forceinline__ unsigned char* wl(unsigned char* ws, int l, size_t off) { return ws + WS_W + (size_t)l * WL_STRIDE + off; }

#define EPI_LOOP_BEGIN _Pragma("unroll") for (int ai = 0; ai < 2; ++ai) _Pragma("unroll") for (int m = 0; m < 4; ++m) { const int rl = ai * 128 + wr * 64 + m * 16 + fr; _Pragma("unroll") for (int bj = 0; bj < 2; ++bj) { const int cl = bj * 128 + wc * 32 + 8 * fq; const f32x4 v0 = acc[ai][bj][m][0], v1 = acc[ai][bj][m][1];
#define EPI_LOOP_END } asm volatile("" ::: "memory"); }

struct EpiProj {
    static constexpr bool IDEMPOTENT = (EPI_REP > 2);
    bf16* O;
    __device__ __forceinline__ void operator()(AccRef acc, const Unit& u, int wr, int wc, int fr, int fq) const {
        EPI_LOOP_BEGIN
            *(u32x4*)(O + (size_t)(u.pm * 256 + rl) * NPROJ + u.pn * 256 + cl) = pack8(v0, v1);
        EPI_LOOP_END
    }
};
struct EpiHT {
    static constexpr bool IDEMPOTENT = (EPI_REP > 2);
    bf16* HT;
    __device__ __forceinline__ void operator()(AccRef acc, const Unit& u, int wr, int wc, int fr, int fq) const {
        const int seg = u.pm >> 1;
        EPI_LOOP_BEGIN
            const int f = u.pm * 256 + rl, t0 = u.pn * 256 + cl, b = t0 >> 11, s = t0 & 2047;
            f32x4 a = v0, d = v1;
            if (seg == 0) {
#pragma unroll
                for (int j = 0; j < 4; ++j) { a[j] = a[j] * __builtin_amdgcn_rcpf(1.0f + __builtin_amdgcn_exp2f(-1.4426950408889634f * a[j])); d[j] = d[j] * __builtin_amdgcn_rcpf(1.0f + __builtin_amdgcn_exp2f(-1.4426950408889634f * d[j])); }
            } else if (seg < 3) {
#pragma unroll
                for (int j = 0; j < 4; ++j) { a[j] = __builtin_amdgcn_rcpf(1.0f + __builtin_amdgcn_exp2f(1.4426950408889634f * a[j])); d[j] = __builtin_amdgcn_rcpf(1.0f + __builtin_amdgcn_exp2f(1.4426950408889634f * d[j])); }
            }
            *(u32x4*)(HT + ((size_t)b * NHT + f) * SEQ + s) = pack8(a, d);
        EPI_LOOP_END
    }
};
struct EpiQ {
    static constexpr bool IDEMPOTENT = (EPI_REP > 2);
    bf16* Q; const float* rsq; const float* cs; const float* sn;
    __device__ __forceinline__ void operator()(AccRef acc, const Unit& u, int wr, int wc, int fr, int fq) const {
        EPI_LOOP_BEGIN
            const int t = u.pm * 256 + rl, c0 = u.pn * 256 + cl, head = c0 / 96, w = c0 - head * 96, b = t >> 11, s = t & 2047;
            const float sc = rsq[t] * QSCALE;
            bf16* qp = Q + ((size_t)(b * 8 + head) * SEQ + s) * 96;
            f32x4 a = v0 * sc, d = v1 * sc;
            if (w < 64) { *(u32x4*)(qp + w) = pack8(a, d); }
            else { const int g = (w - 64) >> 3; const f32x4 co = *(const f32x4*)(cs + (size_t)t * 16 + 4 * g), si = *(const f32x4*)(sn + (size_t)t * 16 + 4 * g);
                const f32x4 o1 = a * co - d * si, o2 = d * co + a * si;
                u32x2 w1, w2; w1.x = pk2(o1[0], o1[1]); w1.y = pk2(o1[2], o1[3]); w2.x = pk2(o2[0], o2[1]); w2.y = pk2(o2[2], o2[3]);
                *(u32x2*)(qp + 64 + 4 * g) = w1; *(u32x2*)(qp + 80 + 4 * g) = w2; }
        EPI_LOOP_END
    }
};
struct EpiK {
    static constexpr bool IDEMPOTENT = (EPI_REP > 2);
    bf16* Kb; const float* rskv;
    __device__ __forceinline__ void operator()(AccRef acc, const Unit& u, int wr, int wc, int fr, int fq) const {
        EPI_LOOP_BEGIN
            const int t = u.pm * 256 + rl, c0 = u.pn * 256 + cl, head = c0 >> 6, w = c0 & 63, b = t >> 11, s = t & 2047;
            const float sc = rskv[t];
            *(u32x4*)(Kb + ((size_t)(b * 8 + head) * SEQ + s) * 96 + w) = pack8(v0 * sc, v1 * sc);
        EPI_LOOP_END
    }
};
struct EpiV {
    static constexpr bool IDEMPOTENT = (EPI_REP > 2);
    bf16* VT; const float* rskv;
    __device__ __forceinline__ void operator()(AccRef acc, const Unit& u, int wr, int wc, int fr, int fq) const {
        EPI_LOOP_BEGIN
            const int f = u.pm * 256 + rl, t0 = u.pn * 256 + cl, b = t0 >> 11, s = t0 & 2047, head = f >> 6, dv = f & 63;
            const f32x4 r0 = *(const f32x4*)(rskv + t0), r1 = *(const f32x4*)(rskv + t0 + 4);
            *(u32x4*)(VT + ((size_t)(b * 8 + head) * 64 + dv) * SEQ + s) = pack8(v0 * r0, v1 * r1);
        EPI_LOOP_END
    }
};
struct EpiOut {
    static constexpr bool IDEMPOTENT = false; static constexpr bool HAS_MID = true; static constexpr int MID_T = 8;
    bf16* Y; const bf16* proj;
    __device__ __forceinline__ void mid(f32x4 (&acc)[2][2][4][2], const Unit& u, int wr, int wc, int fr, int fq) const {
        unsigned off0 = (unsigned)((u.pm * 256 + wr * 64 + fr) * NPROJ + u.pn * 256 + wc * 32 + 8 * fq) * 2u;
        asm volatile("" : "+v"(off0));
        const char* gp0 = (const char*)proj;
#pragma unroll
        for (int ai = 0; ai < 2; ++ai)
#pragma unroll
            for (int mp = 0; mp < 2; ++mp) {
                u32x4 ga[2][2], gb[2][2];
#pragma unroll
                for (int mm = 0; mm < 2; ++mm)
#pragma unroll
                    for (int bj = 0; bj < 2; ++bj) { const unsigned o = off0 + (unsigned)(((ai * 128 + (2 * mp + mm) * 16) * NPROJ + bj * 128) * 2); ga[mm][bj] = *(const u32x4*)(gp0 + o + PGA * 2); gb[mm][bj] = *(const u32x4*)(gp0 + o + PGB * 2); }
#pragma unroll
                for (int mm = 0; mm < 2; ++mm)
#pragma unroll
                    for (int bj = 0; bj < 2; ++bj) {
                        f32x4 a0, a1, b0, b1; unpack8(ga[mm][bj], a0, a1); unpack8(gb[mm][bj], b0, b1);
#pragma unroll
                        for (int j = 0; j < 4; ++j) {
                            a0[j] = (1.0f + __builtin_amdgcn_exp2f(-1.4426950408889634f * b0[j])) * __builtin_amdgcn_rcpf(1.0f + __builtin_amdgcn_exp2f(-1.4426950408889634f * a0[j]));
                            a1[j] = (1.0f + __builtin_amdgcn_exp2f(-1.4426950408889634f * b1[j])) * __builtin_amdgcn_rcpf(1.0f + __builtin_amdgcn_exp2f(-1.4426950408889634f * a1[j])); }
                        acc[ai][bj][2 * mp + mm][0] *= a0; acc[ai][bj][2 * mp + mm][1] *= a1;
                    }
                asm volatile("" ::: "memory");
            }
    }
    __device__ __forceinline__ void operator()(AccRef acc, const Unit& u, int wr, int wc, int fr, int fq) const {
        const int c0 = u.pn * 256 + wc * 32 + 8 * fq;
        const bf16* gp = proj + (size_t)(u.pm * 256 + wr * 64 + fr) * NPROJ + PGB + c0;
        bf16* yp = Y + (size_t)(u.pm * 256 + wr * 64 + fr) * 1024 + c0;
#pragma unroll
        for (int ai = 0; ai < 2; ++ai) {
            u32x4 gw[4][2];
#pragma unroll
            for (int m = 0; m < 4; ++m)
#pragma unroll
                for (int bj = 0; bj < 2; ++bj) gw[m][bj] = *(const u32x4*)(gp + (size_t)(ai * 128 + m * 16) * NPROJ + bj * 128);
#pragma unroll
            for (int m = 0; m < 4; ++m)
#pragma unroll
                for (int bj = 0; bj < 2; ++bj) {
                    f32x4 g0, g1; unpack8(gw[m][bj], g0, g1);
#pragma unroll
                    for (int j = 0; j < 4; ++j) { g0[j] = __builtin_amdgcn_rcpf(1.0f + __builtin_amdgcn_exp2f(-1.4426950408889634f * g0[j])); g1[j] = __builtin_amdgcn_rcpf(1.0f + __builtin_amdgcn_exp2f(-1.4426950408889634f * g1[j])); }
                    *(u32x4*)(yp + (size_t)(ai * 128 + m * 16) * 1024 + bj * 128) = pack8(acc[ai][bj][m][0] * g0, acc[ai][bj][m][1] * g1);
                }
            asm volatile("" ::: "memory");
        }
    }
};
struct EpiWo {
    static constexpr bool IDEMPOTENT = false;
    bf16* X; const float* g1;
    __device__ __forceinline__ void operator()(AccRef acc, const Unit& u, int wr, int wc, int fr, int fq) const {
        const int c0 = u.pn * 256 + wc * 32 + 8 * fq, b = (u.pm * 256) >> 11;
        const float* gp = g1 + (size_t)b * 6144 + c0;
        const f32x4 ga0 = *(const f32x4*)gp, gb0 = *(const f32x4*)(gp + 4), ga1 = *(const f32x4*)(gp + 128), gb1 = *(const f32x4*)(gp + 132);
        bf16* xp = X + (size_t)(u.pm * 256 + wr * 64 + fr) * 1024 + c0;
#pragma unroll
        for (int ai = 0; ai < 2; ++ai) {
            u32x4 xv[4][2];
#pragma unroll
            for (int m = 0; m < 4; ++m) { const bf16* p = xp + (size_t)(ai * 128 + m * 16) * 1024; xv[m][0] = *(const u32x4*)p; xv[m][1] = *(const u32x4*)(p + 128); }
#pragma unroll
            for (int m = 0; m < 4; ++m) { bf16* p = xp + (size_t)(ai * 128 + m * 16) * 1024; f32x4 a, d;
                unpack8(xv[m][0], a, d); *(u32x4*)p = pack8(a + ga0 * acc[ai][0][m][0], d + gb0 * acc[ai][0][m][1]);
                unpack8(xv[m][1], a, d); *(u32x4*)(p + 128) = pack8(a + ga1 * acc[ai][1][m][0], d + gb1 * acc[ai][1][m][1]); }
            asm volatile("" ::: "memory");
        }
    }
};
struct EpiGU {
    static constexpr bool IDEMPOTENT = true;
    bf16* ACT; const float* bgu;
    __device__ __forceinline__ void operator()(AccRef acc, const Unit& u, int wr, int wc, int fr, int fq) const {
        const int j0 = u.pn * 128 + wc * 32 + 8 * fq;
        const float* bp = bgu + (size_t)u.e * 2048 + 2 * j0;
        const f32x4 b0 = *(const f32x4*)bp, b1 = *(const f32x4*)(bp + 4), b2 = *(const f32x4*)(bp + 8), b3 = *(const f32x4*)(bp + 12);
        const float bg[8] = {b0[0], b0[2], b1[0], b1[2], b2[0], b2[2], b3[0], b3[2]}, bu[8] = {b0[1], b0[3], b1[1], b1[3], b2[1], b2[3], b3[1], b3[3]};
        bf16* ap = ACT + (size_t)(u.rowbase + wr * 64 + fr) * 1024 + j0;
#pragma unroll
        for (int ai = 0; ai < 2; ++ai)
#pragma unroll
            for (int m = 0; m < 4; ++m) {
                float o[8];
#pragma unroll
                for (int j = 0; j < 8; ++j) {
                    float g = acc[ai][0][m][j >> 2][j & 3] + bg[j], up = acc[ai][1][m][j >> 2][j & 3] + bu[j];
                    g = fminf(g, 7.0f); up = fminf(fmaxf(up, -7.0f), 7.0f);
                    o[j] = (up + 1.0f) * g * __builtin_amdgcn_rcpf(1.0f + __builtin_amdgcn_exp2f(-1.702f * 1.4426950408889634f * g)); }
                u32x4 w; w.x = pk2(o[0], o[1]); w.y = pk2(o[2], o[3]); w.z = pk2(o[4], o[5]); w.w = pk2(o[6], o[7]);
                *(u32x4*)(ap + (size_t)(ai * 128 + m * 16) * 1024) = w;
            }
    }
};
struct EpiDown {
    static constexpr bool IDEMPOTENT = true;
    unsigned char* YR; const float* bd; const int* list; const float* aw;
    __device__ __forceinline__ void operator()(AccRef acc, const Unit& u, int wr, int wc, int fr, int fq) const {
        const int cb = u.pn * 256 + wc * 32 + 8 * fq;
        const float* bp = bd + (size_t)u.e * 1024 + cb;
        const f32x4 ba0 = *(const f32x4*)bp, bb0 = *(const f32x4*)(bp + 4), ba1 = *(const f32x4*)(bp + 128), bb1 = *(const f32x4*)(bp + 132);
        int a[8]; float w[8];
        const int* lp = list + (size_t)u.e * T + u.pm * 256 + wr * 64 + fr;
#pragma unroll
        for (int q = 0; q < 8; ++q) { const int rl = (q >> 2) * 128 + wr * 64 + (q & 3) * 16 + fr; a[q] = (rl < u.mrows) ? lp[(q >> 2) * 128 + (q & 3) * 16] : -1; }
#pragma unroll
        for (int q = 0; q < 8; ++q) w[q] = (a[q] >= 0) ? aw[a[q]] : 0.f;
#pragma unroll
        for (int q = 0; q < 8; ++q) {
            const int ai = q >> 2, m = q & 3;
            if (a[q] >= 0) { unsigned char* yp = YR + (size_t)a[q] * 1024 + cb;
                const float ws_ = w[q] * YR_SCALE;
                const f32x4 y0 = (acc[ai][0][m][0] + ba0) * ws_, y1 = (acc[ai][0][m][1] + bb0) * ws_, y2 = (acc[ai][1][m][0] + ba1) * ws_, y3 = (acc[ai][1][m][1] + bb1) * ws_;
                *(u32x2*)yp = (u32x2){pk4_fp8(y0[0], y0[1], y0[2], y0[3]), pk4_fp8(y1[0], y1[1], y1[2], y1[3])};
                *(u32x2*)(yp + 128) = (u32x2){pk4_fp8(y2[0], y2[1], y2[2], y2[3]), pk4_fp8(y3[0], y3[1], y3[2], y3[3])}; }
        }
    }
};

enum { MAP_ID = 0, MAP_WIN = 1, MAP_WQ = 2, MAP_WKV = 3, MAP_GU = 4 };
__device__ __forceinline__ int map_row(int kind, int n) {
    if (kind == MAP_WIN) { if (n < 2560) return n; if (n < 2944) return NHT + PCQ + (n - 2560); if (n < 3200) return NHT + PCKV + (n - 2944); if (n < 3232) return NHT + PKPE + (n - 3200); return NHT + PGA + (n - 3232); }
    if (kind == MAP_WQ) { const int h = n / 96, j = n - h * 96; if (j < 64) return n; const int r = j - 64, i = r & 15; return h * 96 + 64 + 8 * (i >> 2) + ((r >> 4) << 2) + (i & 3); }
    if (kind == MAP_WKV) { const int h = n >> 7, j = n & 127; return (j < 64) ? (h * 64 + j) : (512 + h * 64 + (j - 64)); }
    if (kind == MAP_GU) { const int j = n >> 1, bj = n & 1; return (j >> 7) * 256 + bj * 128 + (j & 127); }
    return n;
}
__device__ __forceinline__ void conv_item(const float* W, int N, const float* kscale, bf16* WT, int dstK, int koff, int kind, LAS float* scr, int kb, int nb, int lane) {
    const int k0 = 64 * kb, n0 = 32 * nb;
    {
        const int kr = lane >> 3, c4 = (lane & 7) * 4; f32x4 v[8];
#pragma unroll
        for (int i = 0; i < 8; ++i) v[i] = *(const f32x4*)(W + (size_t)(k0 + 8 * i + kr) * N + n0 + c4);
#pragma unroll
        for (int i = 0; i < 8; ++i) { if (kscale) v[i] = v[i] * kscale[k0 + 8 * i + kr]; LAS float* d = scr + (8 * i + kr) * 33 + c4; d[0] = v[i][0]; d[1] = v[i][1]; d[2] = v[i][2]; d[3] = v[i][3]; }
    }
    LDS_WAIT(); asm volatile("" ::: "memory");
    const int c = lane & 7;
#pragma unroll
    for (int j = 0; j < 4; ++j) { const int n = (lane >> 3) + 8 * j; const LAS float* s = scr + (8 * c) * 33 + n;
        u32x4 o; o.x = pk2(s[0 * 33], s[1 * 33]); o.y = pk2(s[2 * 33], s[3 * 33]); o.z = pk2(s[4 * 33], s[5 * 33]); o.w = pk2(s[6 * 33], s[7 * 33]);
        *(u32x4*)(WT + (size_t)map_row(kind, n0 + n) * dstK + koff + k0 + 8 * c) = o; }
    LDS_WAIT(); asm volatile("" ::: "memory");
}
__device__ __forceinline__ void p_prologue(Frame& F) {
    const float* const* in = F.in;
    __syncthreads();
    {
        LAS float* cond = (LAS float*)F.lds;
        LAS float* part = (LAS float*)(F.lds + 32768);
        for (int i = F.tid; i < 8 * 1024; i += 512) { const float v = in[1][i]; cond[i] = v * sigmoidf_(v); }
        __syncthreads();
        for (int it = F.bid; it < DEPTH * 96; it += F.G) {
            const int l = it / 96, n0 = (it % 96) * 64, col = F.tid & 63, kg = F.tid >> 6;
            const float* w = in[3] + (size_t)l * 1024 * 6144 + n0 + col;
            float a[8] = {0.f, 0.f, 0.f, 0.f, 0.f, 0.f, 0.f, 0.f};
            for (int k0 = kg * 128; k0 < kg * 128 + 128; k0 += 16) {
                float wv[16];
#pragma unroll
                for (int q = 0; q < 16; ++q) wv[q] = w[(size_t)(k0 + q) * 6144];
#pragma unroll
                for (int q = 0; q < 16; ++q)
#pragma unroll
                    for (int b = 0; b < 8; ++b) a[b] += cond[b * 1024 + k0 + q] * wv[q]; }
#pragma unroll
            for (int b = 0; b < 8; ++b) part[(kg * 8 + b) * 64 + col] = a[b];
            __syncthreads();
            { const int b = F.tid >> 6; float s = 0.f;
#pragma unroll
              for (int g = 0; g < 8; ++g) s += part[(g * 8 + b) * 64 + col];
              ((float*)(F.ws + WS_MOD))[((size_t)l * 8 + b) * 6144 + n0 + col] = s + in[4][(size_t)l * 6144 + n0 + col]; }
            __syncthreads();
        }
    }
    const int gtid = F.bid * 512 + F.tid, NT_ = F.G * 512;
    for (int i = gtid; i < 1024; i += NT_) {
        float lg[DEPTH], mx = -1e30f; for (int l = 0; l < DEPTH; ++l) { lg[l] = in[8][(size_t)l * 1024 + i]; mx = fmaxf(mx, lg[l]); }
        float s = 0.f; for (int l = 0; l < DEPTH; ++l) { lg[l] = __expf(lg[l] - mx); s += lg[l]; }
        float c = 0.f; float* lb = (float*)(F.ws + WS_LB);
        for (int l = 0; l < DEPTH; ++l) { if (l > 0) c += lg[l] / s; lb[(size_t)l * 1024 + i] = c; }
    }
    for (int i = gtid; i < T * 16; i += NT_) {
        const int t = i >> 4, j = i & 15; const int pos = ((const int*)in[2])[t];
        const double base4[4] = {1.0, 0.5623413251903491, 0.31622776601683794, 0.1778279410038923};
        double f = base4[j & 3]; for (int q = 0; q < (j >> 2); ++q) f *= 0.1;
        const double ang = (double)pos * f; const double n = __builtin_rint(ang * 0.15915494309189535); const float r = (float)(ang - n * 6.283185307179586);
        ((float*)(F.ws + WS_COS))[i] = cosf(r); ((float*)(F.ws + WS_SIN))[i] = sinf(r);
    }
    for (int l = 0; l < DEPTH; ++l) { u32x4* p = (u32x4*)(wl(F.ws, l, WL_IN) + (size_t)5280 * 1024 * 2); for (int i = gtid; i < 96 * 1024 * 2 / 16; i += NT_) p[i] = (u32x4){0u, 0u, 0u, 0u}; }
    {
        LAS float* scr = (LAS float*)(F.lds + F.wave * 16384);
        const int gw = F.bid * NWAVES + F.wave, NGW = F.G * NWAVES;
        constexpr int I_IN = 16 * 165, I_Q = 6 * 24, I_KV = 4 * 32, I_OH = 8 * 32, I_OM = 8 * 32, I_O = 16 * 32, I_GU = 32 * 16 * 64, I_DN = 32 * 16 * 32;
        constexpr int I_LAYER = I_IN + I_Q + I_KV + I_OH + I_OM + I_O + I_GU + I_DN;
        for (int it = gw; it < DEPTH * I_LAYER; it += NGW) {
            const int l = it / I_LAYER; int r = it - l * I_LAYER;
            if (r < I_IN) { conv_item(in[7] + (size_t)l * 1024 * 5280, 5280, nullptr, (bf16*)wl(F.ws, l, WL_IN), 1024, 0, MAP_WIN, scr, r / 165, r % 165, F.lane); continue; } r -= I_IN;
            if (r < I_Q) { conv_item(in[12] + (size_t)l * 384 * 768, 768, in[11] + l * 384, (bf16*)wl(F.ws, l, WL_Q), 384, 0, MAP_WQ, scr, r / 24, r % 24, F.lane); continue; } r -= I_Q;
            if (r < I_KV) { conv_item(in[14] + (size_t)l * 256 * 1024, 1024, in[13] + l * 256, (bf16*)wl(F.ws, l, WL_K), 256, 0, MAP_WKV, scr, r / 32, r % 32, F.lane); continue; } r -= I_KV;
            if (r < I_OH) { conv_item(in[10] + (size_t)l * 512 * 1024, 1024, nullptr, (bf16*)wl(F.ws, l, WL_OUT), 1024, 0, MAP_ID, scr, r / 32, r % 32, F.lane); continue; } r -= I_OH;
            if (r < I_OM) { conv_item(in[15] + (size_t)l * 512 * 1024, 1024, nullptr, (bf16*)wl(F.ws, l, WL_OUT), 1024, 512, MAP_ID, scr, r / 32, r % 32, F.lane); continue; } r -= I_OM;
            if (r < I_O) { conv_item(in[16] + (size_t)l * 1024 * 1024, 1024, nullptr, (bf16*)wl(F.ws, l, WL_O), 1024, 0, MAP_ID, scr, r / 32, r % 32, F.lane); continue; } r -= I_O;
            if (r < I_GU) { const int e = r / (16 * 64), q = r % (16 * 64); conv_item(in[19] + ((size_t)l * 32 + e) * 1024 * 2048, 2048, nullptr, (bf16*)wl(F.ws, l, WL_GU) + (size_t)e * 2048 * 1024, 1024, 0, MAP_GU, scr, q / 64, q % 64, F.lane); continue; } r -= I_GU;
            { const int e = r / (16 * 32), q = r % (16 * 32); conv_item(in[21] + ((size_t)l * 32 + e) * 1024 * 1024, 1024, nullptr, (bf16*)wl(F.ws, l, WL_DN) + (size_t)e * 1024 * 1024, 1024, 0, MAP_ID, scr, q / 32, q % 32, F.lane); }
        }
    }
}

__device__ __forceinline__ void p_norm_mix(Frame& F, int l, bool fin, float* out, bool dummy = false) {
    const float* const* in = F.in;
    bf16* X = (bf16*)(F.ws + (dummy ? WS_ACT : WS_X));
    const float* MOD = (const float*)(F.ws + WS_MOD); const unsigned char* YR = F.ws + WS_YR; bf16* HB = (bf16*)(F.ws + (dummy ? WS_ACT + 64 * MiB : WS_HB));
    const int gw = F.bid * NWAVES + F.wave, NGW = F.G * NWAVES, per_wave = (T + NGW - 1) / NGW;
    f32x4 Gv[4], Sv[4], G2[4]; int bcur = -1;
    for (int q = 0; q < per_wave; ++q) {
        const int t = gw * per_wave + q; if (t >= T) break;
        const int b = t >> 11; f32x4 v[4];
        if (b != bcur) { bcur = b;
            const float* gn = fin ? in[23] : in[5] + (size_t)l * 1024; const float* sh = MOD + ((size_t)(fin ? 0 : l) * 8 + b) * 6144; const float* g2 = MOD + ((size_t)(l > 0 ? l - 1 : 0) * 8 + b) * 6144 + 5 * 1024;
#pragma unroll
            for (int j = 0; j < 4; ++j) { const int d = 4 * F.lane + 256 * j; const f32x4 g = *(const f32x4*)(gn + d);
                Gv[j] = fin ? g : g * (*(const f32x4*)(sh + 1024 + d) + 1.0f); Sv[j] = fin ? (f32x4){0.f, 0.f, 0.f, 0.f} : *(const f32x4*)(sh + d); G2[j] = *(const f32x4*)(g2 + d); } }
        if (l == 0) {
#pragma unroll
            for (int j = 0; j < 4; ++j) v[j] = *(const f32x4*)(in[0] + (size_t)t * 1024 + 4 * F.lane + 256 * j);
        } else {
#pragma unroll
            for (int j = 0; j < 4; ++j) { const u32x2 w = *(const u32x2*)(X + (size_t)t * 1024 + 4 * F.lane + 256 * j); v[j] = (f32x4){bflo(w.x), bfhi(w.x), bflo(w.y), bfhi(w.y)}; }
        }
        if (l > 0) {
#pragma unroll
            for (int j = 0; j < 4; ++j) { f32x4 s = {0.f, 0.f, 0.f, 0.f};
#pragma unroll
                for (int k = 0; k < 4; ++k) { const unsigned w = *(const unsigned*)(YR + ((size_t)t * 4 + k) * 1024 + 4 * F.lane + 256 * j);
                    s[0] += __builtin_amdgcn_cvt_f32_fp8(w, 0); s[1] += __builtin_amdgcn_cvt_f32_fp8(w, 1); s[2] += __builtin_amdgcn_cvt_f32_fp8(w, 2); s[3] += __builtin_amdgcn_cvt_f32_fp8(w, 3); }
                v[j] += G2[j] * s * YR_INV; }
        }
        float ss = 0.f;
#pragma unroll
        for (int j = 0; j < 4; ++j) ss += (v[j][0] * v[j][0] + v[j][1] * v[j][1]) + (v[j][2] * v[j][2] + v[j][3] * v[j][3]);
        const float rs = rsqrtf(wave_sum(ss) * (1.0f / 1024.0f) + EPS);
        if (fin) {
#pragma unroll
            for (int j = 0; j < 4; ++j) { const int d = 4 * F.lane + 256 * j; *(f32x4*)(out + (size_t)t * 1024 + d) = v[j] * rs * Gv[j]; }
        } else {
#pragma unroll
            for (int j = 0; j < 4; ++j) { const int d = 4 * F.lane + 256 * j; { u32x2 xw; xw.x = pk2(v[j][0], v[j][1]); xw.y = pk2(v[j][2], v[j][3]); *(u32x2*)(X + (size_t)t * 1024 + d) = xw; }
                const f32x4 h = v[j] * rs * Gv[j] + Sv[j]; u32x2 w; w.x = pk2(h[0], h[1]); w.y = pk2(h[2], h[3]);
                *(u32x2*)(HB + (size_t)t * 1024 + d) = w; }
        }
    }
}
__device__ __forceinline__ void p_mla_prep(Frame& F) {
    const bf16* PROJ = (const bf16*)(F.ws + WS_PROJ); float* RSQ = (float*)(F.ws + WS_RSQ); float* RSKV = (float*)(F.ws + WS_RSKV); bf16* Kb = (bf16*)(F.ws + WS_K);
    const float* CS = (const float*)(F.ws + WS_COS); const float* SN = (const float*)(F.ws + WS_SIN);
    const int gw = F.bid * NWAVES + F.wave, NGW = F.G * NWAVES;
    for (int t = gw; t < T; t += NGW) {
        const bf16* row = PROJ + (size_t)t * NPROJ;
        float sq = 0.f, skv = 0.f;
#pragma unroll
        for (int j = 0; j < 6; ++j) { const float v = bf2f(row[PCQ + F.lane + 64 * j]); sq += v * v; }
#pragma unroll
        for (int j = 0; j < 4; ++j) { const float v = bf2f(row[PCKV + F.lane + 64 * j]); skv += v * v; }
        sq = wave_sum(sq); skv = wave_sum(skv);
        if (F.lane == 0) { RSQ[t] = rsqrtf(sq * (1.0f / 384.0f) + EPS); RSKV[t] = rsqrtf(skv * (1.0f / 256.0f) + EPS); }
        if (F.lane < 16) {
            const float x1 = bf2f(row[PKPE + F.lane]), x2 = bf2f(row[PKPE + 16 + F.lane]), co = CS[(size_t)t * 16 + F.lane], si = SN[(size_t)t * 16 + F.lane];
            const bf16 o1 = (bf16)(pk2(x1 * co - x2 * si, 0.f) & 0xffffu), o2 = (bf16)(pk2(x2 * co + x1 * si, 0.f) & 0xffffu);
            const int b = t >> 11, s = t & 2047;
#pragma unroll
            for (int h = 0; h < 8; ++h) { bf16* kp = Kb + ((size_t)(b * 8 + h) * SEQ + s) * 96; kp[64 + F.lane] = o1; kp[80 + F.lane] = o2; }
        }
    }
}
__device__ __forceinline__ void p_hgrn_post(Frame& F, int l) {
    const bf16* OFp = (const bf16*)(F.ws + WS_OF); const bf16* OBp = (const bf16*)(F.ws + WS_OB); const bf16* PROJ = (const bf16*)(F.ws + WS_PROJ); bf16* HA = (bf16*)(F.ws + WS_HA);
    const float* gn = F.in[9] + (size_t)l * 128;
    const int gw = F.bid * NWAVES + F.wave, NGW = F.G * NWAVES;
    for (int t = gw; t < T; t += NGW) {
        const int c = 8 * F.lane;
        f32x4 a0, a1, b0, b1; unpack8(*(const u32x4*)(OFp + (size_t)t * 512 + c), a0, a1); unpack8(*(const u32x4*)(OBp + (size_t)t * 512 + c), b0, b1); a0 += b0; a1 += b1;
        float ss = (a0[0] * a0[0] + a0[1] * a0[1]) + (a0[2] * a0[2] + a0[3] * a0[3]) + (a1[0] * a1[0] + a1[1] * a1[1]) + (a1[2] * a1[2] + a1[3] * a1[3]);
#pragma unroll
        for (int o = 1; o < 16; o <<= 1) ss += __shfl_xor(ss, o);
        const float rs = rsqrtf(ss * (1.0f / 128.0f) + EPS);
        f32x4 g0, g1; unpack8(*(const u32x4*)(PROJ + (size_t)t * NPROJ + PGT + c), g0, g1);
        const f32x4 n0 = *(const f32x4*)(gn + (c & 127)), n1 = *(const f32x4*)(gn + (c & 127) + 4);
#pragma unroll
        for (int j = 0; j < 4; ++j) { a0[j] = a0[j] * rs * n0[j] * sigmoidf_(g0[j]); a1[j] = a1[j] * rs * n1[j] * sigmoidf_(g1[j]); }
        *(u32x4*)(HA + (size_t)t * 1024 + c) = pack8(a0, a1);
    }
}

#define MFMA16(a, b, c) __builtin_amdgcn_mfma_f32_16x16x32_bf16((a), (b), (c), 0, 0, 0)
constexpr int SC_QROW = 272, SC_TROW = 144;
constexpr int SC_QT = 0, SC_KT = SC_QT + 64 * SC_QROW, SC_KH = SC_KT + 64 * SC_QROW, SC_VT = SC_KH + 128 * SC_TROW, SC_DEC = SC_VT + 128 * SC_TROW, SC_ZERO = SC_DEC + 4 * 128 * 4, SC_END = SC_ZERO + 64;
__device__ __forceinline__ unsigned rot16(unsigned x) { return (x >> 16) | (x << 16); }
constexpr int SC_OX = 73984;
static_assert(SC_OX >= SC_END && SC_OX % 16 == 0 && SC_OX + 32768 <= RING_BYTES, "scan LDS map");
__device__ __forceinline__ void scan_unit2(Frame& F, int l, int u) {
    const int dir = u & 1, hh = (u >> 1) & 3, b = u >> 3;
    const bf16* HTb = (const bf16*)(F.ws + WS_HT) + (size_t)b * NHT * SEQ;
    const bf16* qg = HTb + (size_t)(HQ + hh * 128) * SEQ; const bf16* fg = HTb + (size_t)((dir ? HFB : HFF) + hh * 128) * SEQ; const bf16* vg = HTb + (size_t)(HI + hh * 128) * SEQ;
    bf16* OUT = (bf16*)(F.ws + (dir ? WS_OB : WS_OF));
    LAS unsigned char* lds = F.lds;
    const int d = F.tid & 127, si = F.tid >> 7;
    const float lbv = ((const float*)(F.ws + WS_LB))[((size_t)l * 2 + dir) * 512 + hh * 128 + d];
    const int r = F.lane & 15, g = F.lane >> 4, vt = F.wave & 3, dh = F.wave >> 2;
    const int vcol = hh * 128 + 16 * vt;
    f32x4 S[2][4], ok[2][2];
#pragma unroll
    for (int h = 0; h < 2; ++h) {
#pragma unroll
        for (int i = 0; i < 4; ++i) S[h][i] = (f32x4){0.f, 0.f, 0.f, 0.f};
        ok[h][0] = (f32x4){0.f, 0.f, 0.f, 0.f}; ok[h][1] = (f32x4){0.f, 0.f, 0.f, 0.f}; }
    __syncthreads();
    if (F.tid < 16) *(LAS unsigned*)(lds + SC_ZERO + F.tid * 4) = 0u;
    u32x4 pq[2], pf[2], pv[2];
    const int vrow0 = F.tid >> 3, vmc = F.tid & 7;
    {   const int m0 = dir ? SEQ - 64 : 0; const int mb = dir ? m0 + 48 - 16 * si : m0 + 16 * si;
        pq[0] = *(const u32x4*)(qg + (size_t)d * SEQ + mb); pq[1] = *(const u32x4*)(qg + (size_t)d * SEQ + mb + 8);
        pf[0] = *(const u32x4*)(fg + (size_t)d * SEQ + mb); pf[1] = *(const u32x4*)(fg + (size_t)d * SEQ + mb + 8);
        pv[0] = *(const u32x4*)(vg + (size_t)vrow0 * SEQ + m0 + 8 * vmc); pv[1] = *(const u32x4*)(vg + (size_t)(vrow0 + 64) * SEQ + m0 + 8 * vmc); }
    int mprev = 0;
#pragma unroll 1
    for (int c = 0; c <= SEQ / 64; ++c) {
        const bool live = c < SEQ / 64;
        const int m0 = dir ? SEQ - 64 * (c + 1) : 64 * c;
        float qt[16], kt[16], E = 1.0f;
        if (live) {
            float rq[16], rf[16];
#pragma unroll
            for (int j = 0; j < 2; ++j) {
                rq[8 * j + 0] = bflo(pq[j].x); rq[8 * j + 1] = bfhi(pq[j].x); rq[8 * j + 2] = bflo(pq[j].y); rq[8 * j + 3] = bfhi(pq[j].y); rq[8 * j + 4] = bflo(pq[j].z); rq[8 * j + 5] = bfhi(pq[j].z); rq[8 * j + 6] = bflo(pq[j].w); rq[8 * j + 7] = bfhi(pq[j].w);
                rf[8 * j + 0] = bflo(pf[j].x); rf[8 * j + 1] = bfhi(pf[j].x); rf[8 * j + 2] = bflo(pf[j].y); rf[8 * j + 3] = bfhi(pf[j].y); rf[8 * j + 4] = bflo(pf[j].z); rf[8 * j + 5] = bfhi(pf[j].z); rf[8 * j + 6] = bflo(pf[j].w); rf[8 * j + 7] = bfhi(pf[j].w); }
#pragma unroll
            for (int k = 0; k < 16; ++k) {
                const float un = dir ? rf[15 - k] : rf[k], qs = dir ? rq[15 - k] : rq[k];
                const float kk = (1.0f - lbv) * un; E = fmaxf(E * (1.0f - kk), 1e-30f);
                qt[k] = qs * E; kt[k] = kk * __builtin_amdgcn_rcpf(E);
            }
        }
        __syncthreads();
        if (c > 0) {
#pragma unroll
            for (int h = 0; h < 2; ++h)
#pragma unroll
            for (int ii = 0; ii < 2; ++ii) { const int i = 2 * dh + ii;
                const f32x4 pp = *(const LAS f32x4*)(lds + SC_OX + ((((h * 2 + (1 - dh)) * 4 + vt) * 2 + ii) * 64 + F.lane) * 16);
                const int m = dir ? mprev + 63 - 16 * i - r : mprev + 16 * i + r;
                const f32x4 o = dh == 0 ? ok[h][ii] + pp : pp + ok[h][ii]; u32x2 w; w.x = pk2(o[0], o[1]); w.y = pk2(o[2], o[3]);
                *(u32x2*)(OUT + (size_t)(b * SEQ + m) * 512 + vcol + 64 * h + 4 * g) = w; }
        }
        if (!live) break;
        {   LAS unsigned char* qp = lds + SC_QT + (16 * si) * SC_QROW + d * 2; LAS unsigned char* kp = lds + SC_KT + (16 * si) * SC_QROW + d * 2;
#pragma unroll
            for (int k = 0; k < 16; k += 2) { const unsigned wq = pk2(qt[k], qt[k + 1]), wk = pk2(kt[k], kt[k + 1]);
                *(LAS unsigned short*)(qp + k * SC_QROW) = (unsigned short)wq; *(LAS unsigned short*)(qp + (k + 1) * SC_QROW) = (unsigned short)(wq >> 16);
                *(LAS unsigned short*)(kp + k * SC_QROW) = (unsigned short)wk; *(LAS unsigned short*)(kp + (k + 1) * SC_QROW) = (unsigned short)(wk >> 16); }
            u32x4 h0, h1;
            h0.x = pk2(kt[0] * E, kt[1] * E); h0.y = pk2(kt[2] * E, kt[3] * E); h0.z = pk2(kt[4] * E, kt[5] * E); h0.w = pk2(kt[6] * E, kt[7] * E);
            h1.x = pk2(kt[8] * E, kt[9] * E); h1.y = pk2(kt[10] * E, kt[11] * E); h1.z = pk2(kt[12] * E, kt[13] * E); h1.w = pk2(kt[14] * E, kt[15] * E);
            *(LAS u32x4*)(lds + SC_KH + d * SC_TROW + 32 * si) = h0; *(LAS u32x4*)(lds + SC_KH + d * SC_TROW + 32 * si + 16) = h1;
            *(LAS float*)(lds + SC_DEC + (si * 128 + d) * 4) = E;
#pragma unroll
            for (int h = 0; h < 2; ++h) { u32x4 w = pv[h]; int tl0 = 8 * vmc;
              if (dir) { w = (u32x4){rot16(pv[h].w), rot16(pv[h].z), rot16(pv[h].y), rot16(pv[h].x)}; tl0 = 56 - 8 * vmc; }
              *(LAS u32x4*)(lds + SC_VT + (vrow0 + 64 * h) * SC_TROW + tl0 * 2) = w; }
        }
        if (c + 1 < SEQ / 64) {
            const int m1 = dir ? SEQ - 64 * (c + 2) : 64 * (c + 1); const int mb = dir ? m1 + 48 - 16 * si : m1 + 16 * si;
            pq[0] = *(const u32x4*)(qg + (size_t)d * SEQ + mb); pq[1] = *(const u32x4*)(qg + (size_t)d * SEQ + mb + 8);
            pf[0] = *(const u32x4*)(fg + (size_t)d * SEQ + mb); pf[1] = *(const u32x4*)(fg + (size_t)d * SEQ + mb + 8);
            pv[0] = *(const u32x4*)(vg + (size_t)vrow0 * SEQ + m1 + 8 * vmc); pv[1] = *(const u32x4*)(vg + (size_t)(vrow0 + 64) * SEQ + m1 + 8 * vmc);
        }
        mprev = m0;
        __syncthreads();
        f32x4 oI[2][2];
#pragma unroll
        for (int ii = 0; ii < 2; ++ii) {
            const int i = 2 * dh + ii;
            const LAS unsigned char* qrow = lds + SC_QT + (16 * i + r) * SC_QROW; const LAS unsigned char* krow = lds + SC_KT + (16 * i + r) * SC_QROW;
            f32x4 pT = {0.f, 0.f, 0.f, 0.f};
#pragma unroll
            for (int ks = 0; ks < 4; ++ks) pT = MFMA16(*(const LAS bf16x8*)(krow + (32 * ks + 8 * g) * 2), *(const LAS bf16x8*)(qrow + (32 * ks + 8 * g) * 2), pT);
#pragma unroll
            for (int q = 0; q < 4; ++q) pT[q] = (4 * g + q <= r) ? pT[q] : 0.0f;
            const bf16x8 pfrag = __builtin_bit_cast(bf16x8, ((u32x4){pk2(pT[0], pT[1]), pk2(pT[2], pT[3]), 0u, 0u}));
#pragma unroll
            for (int h = 0; h < 2; ++h) {
                const u32x2 vt4 = *(const LAS u32x2*)(lds + SC_VT + (64 * h + 16 * vt + r) * SC_TROW + (16 * i + 4 * g) * 2);
                oI[h][ii] = MFMA16(__builtin_bit_cast(bf16x8, ((u32x4){vt4.x, vt4.y, 0u, 0u})), pfrag, ((f32x4){0.f, 0.f, 0.f, 0.f})); }
        }
        const bool zl = (g >= 2);
#pragma unroll
        for (int i = 0; i < 4; ++i) {
            const LAS unsigned char* qrow = lds + SC_QT + (16 * i + r) * SC_QROW + (64 * dh) * 2;
            const bool mine = (i >> 1) == dh;
            f32x4 o[2];
#pragma unroll
            for (int h = 0; h < 2; ++h) o[h] = mine ? oI[h][i & 1] : (f32x4){0.f, 0.f, 0.f, 0.f};
#pragma unroll
            for (int kk = 0; kk < 2; ++kk) {
                const u32x2 qa = *(const LAS u32x2*)(qrow + (32 * kk + 4 * g) * 2), qb = *(const LAS u32x2*)(qrow + (32 * kk + 16 + 4 * g) * 2);
                const bf16x8 qfrag = __builtin_bit_cast(bf16x8, ((u32x4){qa.x, qa.y, qb.x, qb.y}));
#pragma unroll
                for (int h = 0; h < 2; ++h) {
                    const bf16x8 sfrag = __builtin_bit_cast(bf16x8, ((u32x4){pk2(S[h][2 * kk][0], S[h][2 * kk][1]), pk2(S[h][2 * kk][2], S[h][2 * kk][3]), pk2(S[h][2 * kk + 1][0], S[h][2 * kk + 1][1]), pk2(S[h][2 * kk + 1][2], S[h][2 * kk + 1][3])}));
                    o[h] = MFMA16(sfrag, qfrag, o[h]); }
            }
#pragma unroll
            for (int h = 0; h < 2; ++h) {
                if (mine) ok[h][i & 1] = o[h];
                else *(LAS f32x4*)(lds + SC_OX + ((((h * 2 + dh) * 4 + vt) * 2 + (i & 1)) * 64 + F.lane) * 16) = o[h]; }
            bf16x8 vfrag[2];
#pragma unroll
            for (int h = 0; h < 2; ++h) { const LAS unsigned char* vtp = zl ? lds + SC_ZERO : lds + SC_VT + (64 * h + 16 * vt + r) * SC_TROW + (16 * i + 8 * g) * 2; vfrag[h] = *(const LAS bf16x8*)vtp; }
#pragma unroll
            for (int dt = 0; dt < 4; ++dt) {
                const f32x4 dec = *(const LAS f32x4*)(lds + SC_DEC + (i * 128 + 64 * dh + 16 * dt + 4 * g) * 4);
                const LAS unsigned char* khp = zl ? lds + SC_ZERO : lds + SC_KH + (64 * dh + 16 * dt + r) * SC_TROW + (16 * i + 8 * g) * 2;
                const bf16x8 kfrag = *(const LAS bf16x8*)khp;
#pragma unroll
                for (int h = 0; h < 2; ++h) S[h][dt] = MFMA16(kfrag, vfrag[h], S[h][dt] * dec);
            }
        }
    }
    __syncthreads();
}

#define MFMA32(a, b, c) __builtin_amdgcn_mfma_f32_32x32x16_bf16((a), (b), (c), 0, 0, 0)
constexpr int AT_KROW = 208, AT_VROW = 136, AT_KBYTES = 64 * AT_KROW, AT_BUF = AT_KBYTES + 64 * AT_VROW;
__device__ __forceinline__ void attn_unit(Frame& F, int bh, int q0) {
    const GAS bf16* Q = (const GAS bf16*)(F.ws + WS_Q); const GAS char* Kg = (const GAS char*)(F.ws + WS_K) + (size_t)bh * SEQ * 96 * 2; const GAS char* Vg = (const GAS char*)(F.ws + WS_VT) + (size_t)bh * 64 * SEQ * 2;
    GAS bf16* HA = (GAS bf16*)(F.ws + WS_HA);
    LAS unsigned char* lds = F.lds;
    const int r = F.lane & 31, h = F.lane >> 5;
    bf16x8 qf[6];
    { const GAS bf16* qrow = Q + ((size_t)bh * SEQ + q0 + F.wave * 32 + r) * 96;
#pragma unroll
      for (int ks = 0; ks < 6; ++ks) qf[ks] = *(const GAS bf16x8*)(qrow + 16 * ks + 8 * h); }
    f32x16 o0, o1;
#pragma unroll
    for (int i = 0; i < 16; ++i) { o0[i] = 0.f; o1[i] = 0.f; }
    float mref = 0.f, lsum = 0.f;
    const int kc0 = F.tid, kc1 = F.tid + 512; const bool has1 = F.tid < 256;
    const int kl0 = (kc0 / 12) * AT_KROW + (kc0 % 12) * 16, kl1 = (kc1 / 12) * AT_KROW + (kc1 % 12) * 16;
    const int vrow = F.tid >> 3, vpc = F.tid & 7; const int vl = AT_KBYTES + vrow * AT_VROW + vpc * 16;
    u32x4 rk0, rk1 = {0u, 0u, 0u, 0u}, rv;
    __syncthreads();
    rk0 = *(const GAS u32x4*)(Kg + (size_t)kc0 * 16); if (has1) rk1 = *(const GAS u32x4*)(Kg + (size_t)kc1 * 16);
    rv = *(const GAS u32x4*)(Vg + (size_t)vrow * SEQ * 2 + vpc * 16);
    *(LAS u32x4*)(lds + kl0) = rk0; if (has1) *(LAS u32x4*)(lds + kl1) = rk1;
    *(LAS u32x2*)(lds + vl) = (u32x2){rv.x, rv.y}; *(LAS u32x2*)(lds + vl + 8) = (u32x2){rv.z, rv.w};
    __syncthreads();
    for (int j = 0; j < SEQ / 64; ++j) {
        const int buf = (j & 1) * AT_BUF, nbuf = ((j + 1) & 1) * AT_BUF;
        if (j + 1 < SEQ / 64) {
            const GAS char* kg = Kg + (size_t)(j + 1) * 64 * 96 * 2;
            rk0 = *(const GAS u32x4*)(kg + (size_t)kc0 * 16); if (has1) rk1 = *(const GAS u32x4*)(kg + (size_t)kc1 * 16);
            rv = *(const GAS u32x4*)(Vg + (size_t)vrow * SEQ * 2 + (size_t)(j + 1) * 128 + vpc * 16);
        }
        f32x16 s0, s1;
#pragma unroll
        for (int i = 0; i < 16; ++i) { s0[i] = -mref; s1[i] = -mref; }
#pragma unroll
        for (int ks = 0; ks < 6; ++ks) {
            const bf16x8 k0 = *(const LAS bf16x8*)(lds + buf + r * AT_KROW + (16 * ks + 8 * h) * 2);
            const bf16x8 k1 = *(const LAS bf16x8*)(lds + buf + (32 + r) * AT_KROW + (16 * ks + 8 * h) * 2);
            s0 = MFMA32(k0, qf[ks], s0); s1 = MFMA32(k1, qf[ks], s1);
        }
        float mx = s0[0];
#pragma unroll
        for (int i = 1; i < 16; ++i) mx = fmaxf(mx, s0[i]);
#pragma unroll
        for (int i = 0; i < 16; ++i) mx = fmaxf(mx, s1[i]);
        mx = fmaxf(mx, __shfl_xor(mx, 32));
        const bool grow = (j == 0) || (mx > 8.0f);
        if (__builtin_amdgcn_ballot_w64(grow) != 0ull) {
            const float dlt = grow ? mx : 0.0f, fsc = __builtin_amdgcn_exp2f(-dlt); mref += dlt; lsum *= fsc;
#pragma unroll
            for (int i = 0; i < 16; ++i) { s0[i] -= dlt; s1[i] -= dlt; o0[i] *= fsc; o1[i] *= fsc; } }
        float ps = 0.f;
#pragma unroll
        for (int i = 0; i < 16; ++i) { s0[i] = __builtin_amdgcn_exp2f(s0[i]); s1[i] = __builtin_amdgcn_exp2f(s1[i]); ps += s0[i] + s1[i]; }
        lsum += ps;
        bf16x8 pf[2][2];
#pragma unroll
        for (int sp = 0; sp < 2; ++sp) {
            u32x4 w0, w1;
            w0.x = pk2(s0[8 * sp + 0], s0[8 * sp + 1]); w0.y = pk2(s0[8 * sp + 2], s0[8 * sp + 3]); w0.z = pk2(s0[8 * sp + 4], s0[8 * sp + 5]); w0.w = pk2(s0[8 * sp + 6], s0[8 * sp + 7]);
            w1.x = pk2(s1[8 * sp + 0], s1[8 * sp + 1]); w1.y = pk2(s1[8 * sp + 2], s1[8 * sp + 3]); w1.z = pk2(s1[8 * sp + 4], s1[8 * sp + 5]); w1.w = pk2(s1[8 * sp + 6], s1[8 * sp + 7]);
            pf[0][sp] = __builtin_bit_cast(bf16x8, w0); pf[1][sp] = __builtin_bit_cast(bf16x8, w1);
        }
#pragma unroll
        for (int kb = 0; kb < 2; ++kb)
#pragma unroll
            for (int sp = 0; sp < 2; ++sp) {
                const int kbase = (32 * kb + 16 * sp + 4 * h) * 2;
                const LAS unsigned char* v0p = lds + buf + AT_KBYTES + r * AT_VROW + kbase;
                const LAS unsigned char* v1p = lds + buf + AT_KBYTES + (32 + r) * AT_VROW + kbase;
                const u32x2 a0 = *(const LAS u32x2*)v0p, a1 = *(const LAS u32x2*)(v0p + 16), c0 = *(const LAS u32x2*)v1p, c1 = *(const LAS u32x2*)(v1p + 16);
                const bf16x8 vf0 = __builtin_bit_cast(bf16x8, ((u32x4){a0.x, a0.y, a1.x, a1.y})), vf1 = __builtin_bit_cast(bf16x8, ((u32x4){c0.x, c0.y, c1.x, c1.y}));
                o0 = MFMA32(vf0, pf[kb][sp], o0); o1 = MFMA32(vf1, pf[kb][sp], o1);
            }
        if (j + 1 < SEQ / 64) {
            *(LAS u32x4*)(lds + nbuf + kl0) = rk0; if (has1) *(LAS u32x4*)(lds + nbuf + kl1) = rk1;
            *(LAS u32x2*)(lds + nbuf + vl) = (u32x2){rv.x, rv.y}; *(LAS u32x2*)(lds + nbuf + vl + 8) = (u32x2){rv.z, rv.w};
        }
        __syncthreads();
    }
    lsum += __shfl_xor(lsum, 32);
    const float inv = 1.0f / lsum;
    const int head = bh & 7, b = bh >> 3;
    GAS bf16* orow = HA + (size_t)(b * SEQ + q0 + F.wave * 32 + r) * 1024 + 512 + head * 64;
#pragma unroll
    for (int i = 0; i < 4; ++i) {
        u32x2 w0, w1;
        w0.x = pk2(o0[4 * i] * inv, o0[4 * i + 1] * inv); w0.y = pk2(o0[4 * i + 2] * inv, o0[4 * i + 3] * inv);
        w1.x = pk2(o1[4 * i] * inv, o1[4 * i + 1] * inv); w1.y = pk2(o1[4 * i + 2] * inv, o1[4 * i + 3] * inv);
        *(GAS u32x2*)(orow + 8 * i + 4 * h) = w0; *(GAS u32x2*)(orow + 32 + 8 * i + 4 * h) = w1;
    }
}

constexpr int RTW_LO = 65536, RT_EX = 131072, RT_CP = 151552, RT_CE = 153600, RT_SS = 153728;
static_assert(RT_EX + 8192 <= LDSCTL_OFF && RT_SS + 512 <= LDS_BYTES && RT_S_OFF + 4096 <= RT_CP, "router LDS map");
__device__ __forceinline__ int rt_f(int e) { return ((e >> 2) & 3) | (((e ^ (e >> 4)) & 1) << 2) | (((e >> 1) & 1) << 3); }
__device__ __forceinline__ void p_router(Frame& F, int l, bool dummy = false) {
    const float* const* in = F.in;
    const bf16* X = (const bf16*)(F.ws + WS_X); const float* MOD = (const float*)(F.ws + WS_MOD); bf16* HB = (bf16*)(F.ws + WS_HB);
    int* LIST = (int*)(F.ws + (dummy ? WS_Y : WS_LIST)); float* AW = (float*)(F.ws + (dummy ? WS_Y + 4 * MiB : WS_AW)); unsigned* CNT = (unsigned*)(F.ws + WS_CTL) + CW_CNT + (l + (dummy ? 4 : 0)) * 32 * 64;
    LAS unsigned char* lds = F.lds;
    const float* wr = in[17] + (size_t)l * 1024 * 32; const float* gn = in[6] + (size_t)l * 1024; const float* br = in[18] + (size_t)l * 32;
    LAS unsigned* lcnt = (LAS unsigned*)(lds + MOE_OFF + 512); LAS unsigned* lbase = lcnt + 32;
    int cur_b = -1;
    for (int tile = F.bid; tile < T / 64; tile += F.G) {
        int tid = F.tid; asm volatile("" : "+v"(tid));
        const int lane = tid & 63, wv = tid >> 6, r = lane & 15, g = lane >> 4, tt = wv & 3, kh = wv >> 2;
        const int b = tile >> 5; const int t = tile * 64 + 16 * tt + r;
        u32x4 xf[16];
        {   const bf16* xrow = X + (size_t)t * 1024 + kh * 512 + 8 * g;
#pragma unroll
            for (int ks = 0; ks < 16; ++ks) xf[ks] = *(const u32x4*)(xrow + 32 * ks); }
        __syncthreads();
        if (b != cur_b) {
            cur_b = b;
            const float* sh = MOD + ((size_t)l * 8 + b) * 6144 + 3 * 1024;
            for (int d = tid; d < 1024; d += 512) { *(LAS float*)(lds + RT_G_OFF + d * 4) = gn[d] * (sh[1024 + d] + 1.0f); *(LAS float*)(lds + RT_S_OFF + d * 4) = sh[d]; }
            __syncthreads();
#pragma unroll 2
            for (int q = tid; q < 4096; q += 512) {
                const int kp = q >> 3, c = q & 7;
                const f32x4 w0 = *(const f32x4*)(wr + (size_t)(2 * kp) * 32 + 4 * c), w1 = *(const f32x4*)(wr + (size_t)(2 * kp + 1) * 32 + 4 * c);
                const float g0 = *(const LAS float*)(lds + RT_G_OFF + (2 * kp) * 4), g1 = *(const LAS float*)(lds + RT_G_OFF + (2 * kp + 1) * 4);
#pragma unroll
                for (int j = 0; j < 4; ++j) { const int e = 4 * c + j; const float a0 = w0[j] * g0, a1 = w1[j] * g1;
                    const unsigned hi = pk2(a0, a1); const unsigned lo = pk2(a0 - bflo(hi), a1 - bfhi(hi));
                    const int off = e * 2048 + (((kp >> 2) ^ rt_f(e)) << 4) + (kp & 3) * 4;
                    *(LAS unsigned*)(lds + off) = hi; *(LAS unsigned*)(lds + RTW_LO + off) = lo; }
            }
            {   const int e = tid & 31, kg = tid >> 5; float cp = 0.f;
#pragma unroll 8
                for (int i = 0; i < 64; ++i) { const int k = kg * 64 + i; cp += *(const LAS float*)(lds + RT_S_OFF + k * 4) * wr[(size_t)k * 32 + e]; }
                *(LAS float*)(lds + RT_CP + (kg * 32 + e) * 4) = cp; }
            __syncthreads();
            if (tid < 32) { float sc = br[tid];
#pragma unroll
                for (int kg = 0; kg < 16; ++kg) sc += *(const LAS float*)(lds + RT_CP + (kg * 32 + tid) * 4);
                *(LAS float*)(lds + RT_CE + tid * 4) = sc; }
        }
        if (tid < 32) lcnt[tid] = 0u;
        __syncthreads();
        f32x4 acc0 = {0.f, 0.f, 0.f, 0.f}, acc1 = {0.f, 0.f, 0.f, 0.f}; float ss = 0.f;
        {   const int f0 = rt_f(r), f1 = rt_f(16 + r);
            const LAS unsigned char* row0 = lds + r * 2048; const LAS unsigned char* row1 = lds + (16 + r) * 2048;
#pragma unroll
            for (int ks = 0; ks < 16; ++ks) {
                const int ch = kh * 64 + 4 * ks + g; const int o0 = (ch ^ f0) << 4, o1 = (ch ^ f1) << 4;
                const bf16x8 xb = __builtin_bit_cast(bf16x8, xf[ks]);
                acc0 = MFMA16(*(const LAS bf16x8*)(row0 + o0), xb, acc0); acc0 = MFMA16(*(const LAS bf16x8*)(row0 + RTW_LO + o0), xb, acc0);
                acc1 = MFMA16(*(const LAS bf16x8*)(row1 + o1), xb, acc1); acc1 = MFMA16(*(const LAS bf16x8*)(row1 + RTW_LO + o1), xb, acc1);
                f32x4 v0, v1; unpack8(xf[ks], v0, v1);
                ss += (v0[0] * v0[0] + v0[1] * v0[1]) + (v0[2] * v0[2] + v0[3] * v0[3]) + (v1[0] * v1[0] + v1[1] * v1[1]) + (v1[2] * v1[2] + v1[3] * v1[3]);
                if (ks & 1) asm volatile("" ::: "memory");
            } }
        ss += __shfl_xor(ss, 16); ss += __shfl_xor(ss, 32);
        if (g == 0) *(LAS float*)(lds + RT_SS + ((kh * 4 + tt) * 16 + r) * 4) = ss;
        if (kh == 1) { *(LAS f32x4*)(lds + RT_EX + (tt * 64 + lane) * 32) = acc0; *(LAS f32x4*)(lds + RT_EX + (tt * 64 + lane) * 32 + 16) = acc1; }
        __syncthreads();
        const float rs = rsqrtf((*(const LAS float*)(lds + RT_SS + ((0 * 4 + tt) * 16 + r) * 4) + *(const LAS float*)(lds + RT_SS + ((1 * 4 + tt) * 16 + r) * 4)) * (1.0f / 1024.0f) + EPS);
#pragma unroll
        for (int ks = 0; ks < 16; ++ks) {
            const int d = kh * 512 + 32 * ks + 8 * g;
            f32x4 v0, v1; unpack8(xf[ks], v0, v1);
            v0 = v0 * rs * *(const LAS f32x4*)(lds + RT_G_OFF + d * 4) + *(const LAS f32x4*)(lds + RT_S_OFF + d * 4);
            v1 = v1 * rs * *(const LAS f32x4*)(lds + RT_G_OFF + d * 4 + 16) + *(const LAS f32x4*)(lds + RT_S_OFF + d * 4 + 16);
            *(u32x4*)(HB + (size_t)t * 1024 + d) = pack8(v0, v1);
            if (ks & 1) asm volatile("" ::: "memory");
        }
        float lg[8], wk[8]; int rank[8]; unsigned lslot[8];
        int gq = g; asm volatile("" : "+v"(gq));
        if (kh == 0) {
            const f32x4 p0 = *(const LAS f32x4*)(lds + RT_EX + (tt * 64 + lane) * 32), p1 = *(const LAS f32x4*)(lds + RT_EX + (tt * 64 + lane) * 32 + 16);
            const f32x4 c0 = *(const LAS f32x4*)(lds + RT_CE + (4 * gq) * 4), c1 = *(const LAS f32x4*)(lds + RT_CE + (16 + 4 * gq) * 4);
#pragma unroll
            for (int j = 0; j < 4; ++j) { lg[j] = rs * (acc0[j] + p0[j]) + c0[j]; lg[4 + j] = rs * (acc1[j] + p1[j]) + c1[j]; rank[j] = 0; rank[4 + j] = 0; }
#if RT_DEBUG == 1
            {   float dl[8];
#pragma unroll
                for (int j = 0; j < 8; ++j) dl[j] = 0.f;
                for (int k = 0; k < 1024; ++k) { const float xv = __uint_as_float(((unsigned)((const unsigned short*)X)[(size_t)t * 1024 + k]) << 16);
                    const float v = xv * rs * *(const LAS float*)(lds + RT_G_OFF + k * 4) + *(const LAS float*)(lds + RT_S_OFF + k * 4);
#pragma unroll
                    for (int j = 0; j < 8; ++j) dl[j] += v * wr[(size_t)k * 32 + (j < 4 ? 0 : 16) + 4 * gq + (j & 3)]; }
#pragma unroll
                for (int j = 0; j < 8; ++j) lg[j] = dl[j] + br[(j < 4 ? 0 : 16) + 4 * gq + (j & 3)];
            }
#endif
#if RT_DEBUG == 3 || RT_DEBUG == 4
            {   float dl[8];
#pragma unroll
                for (int j = 0; j < 8; ++j) dl[j] = 0.f;
                const int kb = (RT_DEBUG == 3) ? 512 : 0;
                for (int k = kb; k < kb + 512; ++k) { const float xv = __uint_as_float(((unsigned)((const unsigned short*)X)[(size_t)t * 1024 + k]) << 16);
                    const float v = xv * *(const LAS float*)(lds + RT_G_OFF + k * 4);
#pragma unroll
                    for (int j = 0; j < 8; ++j) dl[j] += v * wr[(size_t)k * 32 + (j < 4 ? 0 : 16) + 4 * gq + (j & 3)]; }
#pragma unroll
                for (int j = 0; j < 4; ++j) {
                    if (RT_DEBUG == 3) { lg[j] = rs * (acc0[j] + dl[j]) + c0[j]; lg[4 + j] = rs * (acc1[j] + dl[4 + j]) + c1[j]; }
                    else { lg[j] = rs * (dl[j] + p0[j]) + c0[j]; lg[4 + j] = rs * (dl[4 + j] + p1[j]) + c1[j]; } }
            }
#endif
#if RT_DEBUG == 5
            {   float dl[8];
#pragma unroll
                for (int j = 0; j < 8; ++j) dl[j] = 0.f;
                for (int k = 0; k < 1024; ++k) { const float xv = __uint_as_float(((unsigned)((const unsigned short*)X)[(size_t)t * 1024 + k]) << 16);
#pragma unroll
                    for (int j = 0; j < 8; ++j) { const int e = (j < 4 ? 0 : 16) + 4 * gq + (j & 3); const int off = e * 2048 + (((k >> 3) ^ rt_f(e)) << 4) + (k & 7) * 2;
                        const float wh = __uint_as_float(((unsigned)*(const LAS unsigned short*)(lds + off)) << 16), wl = __uint_as_float(((unsigned)*(const LAS unsigned short*)(lds + RTW_LO + off)) << 16);
                        dl[j] += xv * (wh + wl); } }
#pragma unroll
                for (int j = 0; j < 4; ++j) { lg[j] = rs * dl[j] + c0[j]; lg[4 + j] = rs * dl[4 + j] + c1[j]; }
            }
#endif
#if RT_DEBUG == 2
            {   float dl[8];
#pragma unroll
                for (int j = 0; j < 8; ++j) dl[j] = 0.f;
                for (int k = 0; k < 1024; ++k) { const float xv = __uint_as_float(((unsigned)((const unsigned short*)X)[(size_t)t * 1024 + k]) << 16);
                    const float v = xv * *(const LAS float*)(lds + RT_G_OFF + k * 4);
#pragma unroll
                    for (int j = 0; j < 8; ++j) dl[j] += v * wr[(size_t)k * 32 + (j < 4 ? 0 : 16) + 4 * gq + (j & 3)]; }
#pragma unroll
                for (int j = 0; j < 4; ++j) { lg[j] = rs * dl[j] + c0[j]; lg[4 + j] = rs * dl[4 + j] + c1[j]; }
            }
#endif
#pragma unroll
            for (int j = 0; j < 8; ++j)
#pragma unroll
                for (int i = 0; i < 8; ++i) if (i != j) rank[j] += (lg[i] > lg[j] || (lg[i] == lg[j] && i < j)) ? 1 : 0;
#pragma unroll
            for (int x = 1; x < 4; ++x) {
                const bool glow = (gq ^ x) < gq;
#pragma unroll
                for (int i = 0; i < 8; ++i) { const float ov = __shfl_xor(lg[i], 16 * x);
#pragma unroll
                    for (int j = 0; j < 8; ++j) { const bool lower = (i < 4 && j >= 4) ? true : (i >= 4 && j < 4) ? false : glow;
                        rank[j] += (ov > lg[j] || (ov == lg[j] && lower)) ? 1 : 0; } }
            }
            float mx = lg[0];
#pragma unroll
            for (int j = 1; j < 8; ++j) mx = fmaxf(mx, lg[j]);
            mx = fmaxf(mx, __shfl_xor(mx, 16)); mx = fmaxf(mx, __shfl_xor(mx, 32));
            float den = 0.f;
#pragma unroll
            for (int j = 0; j < 8; ++j) { wk[j] = rank[j] < 4 ? __expf(lg[j] - mx) : 0.f; den += wk[j]; }
            den += __shfl_xor(den, 16); den += __shfl_xor(den, 32);
            const float invs = 1.0f / den;
#pragma unroll
            for (int j = 0; j < 8; ++j) { wk[j] *= invs; lslot[j] = 0u;
                if (rank[j] < 4) lslot[j] = __hip_atomic_fetch_add(lcnt + ((j < 4 ? 0 : 16) + 4 * gq + (j & 3)), 1u, __ATOMIC_RELAXED, __HIP_MEMORY_SCOPE_WORKGROUP); }
        }
        __syncthreads();
        if (tid < 32) { const unsigned c = lcnt[tid]; lbase[tid] = c ? __hip_atomic_fetch_add(CNT + tid * 64, c, __ATOMIC_RELAXED, __HIP_MEMORY_SCOPE_AGENT) : 0u; }
        __syncthreads();
        if (kh == 0) {
#pragma unroll
            for (int j = 0; j < 8; ++j) if (rank[j] < 4) { const int e = (j < 4 ? 0 : 16) + 4 * gq + (j & 3); const unsigned slot = lbase[e] + lslot[j]; const int a = t * 4 + rank[j];
                LIST[(size_t)e * T + slot] = a; AW[a] = wk[j]; }
        }
    }
    __syncthreads();
}
__device__ __forceinline__ void moe_tables(Frame& F, int l) {
    LAS int* cnt = (LAS int*)(F.lds + MOE_OFF); LAS int* toff = cnt + 32;
    const unsigned* CNT = (const unsigned*)(F.ws + WS_CTL) + CW_CNT + l * 32 * 64;
    __syncthreads();
    if (F.tid < 32) cnt[F.tid] = (int)__hip_atomic_load(CNT + F.tid * 64, __ATOMIC_RELAXED, __HIP_MEMORY_SCOPE_AGENT);
    __syncthreads();
    if (F.tid == 0) { int s = 0; for (int e = 0; e < 32; ++e) { toff[e] = s; s += (cnt[e] + 255) >> 8; } toff[32] = s; }
    __syncthreads();
}

constexpr int NPH = 11, PH_FINAL = 1 + DEPTH * NPH, PH_TOTAL = PH_FINAL + 1;
__global__ void __launch_bounds__(NWAVES * 64, 2) fwd_kernel(Args args) {
    extern __shared__ __attribute__((aligned(16))) unsigned char lds_raw[];
    Frame F;
    F.lds = (LAS unsigned char*)lds_raw; F.ws = args.ws; F.tid = threadIdx.x; F.lane = F.tid & 63; F.wave = __builtin_amdgcn_readfirstlane(F.tid >> 6); F.G = gridDim.x; F.bid = blockIdx.x; F.in = args.in;
    for (int u = F.tid; u < (LDS_BYTES - LDSCTL_OFF) / 4; u += NWAVES * 64) ((LAS unsigned*)(F.lds + LDSCTL_OFF))[u] = 0u;
    __syncthreads();
    const int lo = args.ph_lo, hi = args.ph_hi;
    const unsigned long long tk0_ = (TIME_KIND == 98) ? __builtin_amdgcn_s_memrealtime() : 0ull; unsigned long long tbar_ = 0ull;
    XcdBarrier bar; bar.bar = (unsigned*)(F.ws + WS_CTL) + CW_BAR; bar.x = 0; bar.st = nullptr;
    if (hi - lo > 1) bar = xcd_barrier_post((unsigned*)(F.ws + WS_CTL) + CW_BAR, (volatile LAS unsigned*)(F.lds + MISC_OFF) + 8);
#define IN(k) (lo <= (k) && (k) < hi)
#define PROJ ((bf16*)(ws + WS_PROJ))
#define SEAM(k) do { if (IN(k) && IN((k) + 1)) { const bool acc_ = (TIME_KIND == 97) && ((TIME_MASK >> ((((k) + NPH - 1) % NPH) + 1)) & 1); const unsigned long long tb0_ = acc_ ? __builtin_amdgcn_s_memrealtime() : 0ull; xcd_barrier(bar); if (acc_) tbar_ += __builtin_amdgcn_s_memrealtime() - tb0_; } } while (0)
#define TSTART(kind) unsigned long long t0_ = (TIME_KIND == (kind) || TIME_KIND == 99) ? __builtin_amdgcn_s_memrealtime() : 0ull
#define TSTALL(kind) do { if (TIME_KIND == (kind) || TIME_KIND == 99) { const unsigned long long t1_ = __builtin_amdgcn_s_memrealtime(); const unsigned long long dt_ = t1_ - t0_; while (__builtin_amdgcn_s_memrealtime() - t1_ < dt_) __builtin_amdgcn_s_sleep(8); } } while (0)
    unsigned char* ws = F.ws;
#define PHASE_ENTER() do { unsigned char* w_ = args.ws; asm volatile("" : "+s"(w_)); F.ws = w_; ws = w_; int t_ = threadIdx.x; asm volatile("" : "+v"(t_)); F.tid = t_; F.lane = t_ & 63; F.wave = __builtin_amdgcn_readfirstlane(t_ >> 6); } while (0)
    if (EN(0) && IN(0)) { PHASE_ENTER(); TSTART(0); REPS(0) { p_prologue(F); } SEAM(0); TSTALL(0); }
    for (int l = 0; l < DEPTH; ++l) {
        const int pb = 1 + l * NPH;
        if (EN(1) && IN(pb + 0)) { PHASE_ENTER(); TSTART(1); if (REP_KIND == 1) p_norm_mix(F, l, false, nullptr, true); p_norm_mix(F, l, false, nullptr); SEAM(pb + 0); TSTALL(1); }
        if (EN(2) && IN(pb + 1)) { PHASE_ENTER(); TSTART(2);
            REPS(2) {
            { pg8::DenseOrder S; S.init(T, NPROJ - 256, F.G, F.bid, ws + WS_HB, 1024, (bf16*)wl(ws, l, WL_IN) + (size_t)(NHT + 256) * 1024, 1024);
              EpiProj E{PROJ + 256};
              pg8::gemm_phase(F.lds, 1024, S, E); }
            { int z = 0; asm volatile("" : "+s"(z)); pg8::DenseOrder S; S.init(NHT, T, F.G, (F.bid + 64 + z) % F.G, wl(ws, l, WL_IN) + z, 1024, ws + WS_HB + z, 1024);
              EpiHT E{(bf16*)(ws + WS_HT)};
              pg8::gemm_phase(F.lds, 1024, S, E); }
            }
            SEAM(pb + 1); TSTALL(2);
        }
        if (EN(3) && IN(pb + 2)) { PHASE_ENTER(); TSTART(3); REPS(3) { p_mla_prep(F); } SEAM(pb + 2); TSTALL(3); }
        if (EN(4) && IN(pb + 3)) { PHASE_ENTER(); TSTART(4);
#ifndef SUBMASK
#define SUBMASK 7
#endif
            REPS(4) {
            const bool shift_ = F.G >= 128;
            { int z = 0; asm volatile("" : "+s"(z)); pg8::DenseOrder S; S.init(T, 256, F.G, (F.bid + 64 + z) % F.G, ws + WS_HB + z, 1024, (bf16*)wl(ws, l, WL_IN) + (size_t)NHT * 1024 + z, 1024);
              EpiProj E{PROJ};
              pg8::gemm_phase(F.lds, 1024, S, E); }
            if (SUBMASK & 1) { pg8::DenseOrder S; S.init(T, 768, F.G, F.bid, PROJ + PCQ, NPROJ, wl(ws, l, WL_Q), 384);
              EpiQ E{(bf16*)(ws + WS_Q), (const float*)(ws + WS_RSQ), (const float*)(ws + WS_COS), (const float*)(ws + WS_SIN)};
              pg8::gemm_phase(F.lds, 384, S, E); }
            if (SUBMASK & 2) { int z = 0; asm volatile("" : "+s"(z)); pg8::DenseOrder S; S.init(T, 512, F.G, shift_ ? F.bid + z : (F.bid + 64 + z) % F.G, PROJ + PCKV + z, NPROJ, wl(ws, l, WL_K) + z, 256);
              EpiK E{(bf16*)(ws + WS_K), (const float*)(ws + WS_RSKV)};
              pg8::gemm_phase(F.lds, 256, S, E); }
            if (SUBMASK & 4) { int z = 0; asm volatile("" : "+s"(z)); pg8::DenseOrder S; S.init(512, T, F.G, (F.bid + 192 + z) % F.G, wl(ws, l, WL_V) + z, 256, PROJ + PCKV + z, NPROJ);
              if (shift_) { S.G = F.G - 64; S.c = F.bid < F.G - 64 ? (F.bid + 64) % (F.G - 64) : S.nwg; }
              EpiV E{(bf16*)(ws + WS_VT), (const float*)(ws + WS_RSKV)};
              pg8::gemm_phase(F.lds, 256, S, E); }
            }
            SEAM(pb + 3); TSTALL(4);
        }
        if (EN(5) && IN(pb + 4)) { PHASE_ENTER(); TSTART(5);
            REPS(5) {
            if (rep_ == 0 || (REP_SUB & 1)) for (int u = F.bid; u < 64 * SCAN_REP; u += F.G) scan_unit2(F, l, u & 63);
            if (rep_ == 0 || (REP_SUB & 2)) {
                unsigned* qctr = (unsigned*)(ws + WS_CTL) + CW_Q + (l * 2 + rep_) * 64; volatile LAS unsigned* misc = (volatile LAS unsigned*)(F.lds + MISC_OFF);
                for (;;) { __syncthreads(); if (F.tid == 0) misc[0] = __hip_atomic_fetch_add(qctr, 1u, __ATOMIC_RELAXED, __HIP_MEMORY_SCOPE_AGENT); __syncthreads();
                    const int a = (int)misc[0]; if (a >= 512 * ATTN_REP) break; attn_unit(F, (a & 511) >> 3, (a & 7) * 256); }
            }
            }
            SEAM(pb + 4); TSTALL(5);
        }
        if (EN(6) && IN(pb + 5)) { PHASE_ENTER(); TSTART(6); REPS(6) { p_hgrn_post(F, l); } SEAM(pb + 5); TSTALL(6); }
        if (EN(7) && IN(pb + 6)) { PHASE_ENTER(); TSTART(7);
            REPS(7) {
            { pg8::DenseOrder S; S.init(T, 1024, F.G, F.bid, ws + WS_HA, 1024, wl(ws, l, WL_OUT), 1024);
              EpiOut E{(bf16*)(ws + WS_Y), PROJ};
              pg8::gemm_phase(F.lds, 1024, S, E); }
            }
            SEAM(pb + 6); TSTALL(7);
        }
        if (EN(8) && IN(pb + 7)) { PHASE_ENTER(); TSTART(8);
            pg8::DenseOrder S; S.init(T, 1024, F.G, F.bid, ws + WS_Y, 1024, wl(ws, l, WL_O), 1024);
            if (REP_KIND == 8) { EpiWo E2{(bf16*)(ws + WS_ACT), (const float*)(ws + WS_MOD) + (size_t)l * 8 * 6144 + 2 * 1024}; pg8::gemm_phase(F.lds, 1024, S, E2); }
            EpiWo E{(bf16*)(ws + WS_X), (const float*)(ws + WS_MOD) + (size_t)l * 8 * 6144 + 2 * 1024};
            pg8::gemm_phase(F.lds, 1024, S, E);
            if (REP_KIND == 13) { for (int q = 0; q < 10; ++q) xcd_barrier(bar); }
            SEAM(pb + 7); TSTALL(8);
        }
        if (EN(9) && IN(pb + 8)) { PHASE_ENTER(); TSTART(9); if (REP_KIND == 9) p_router(F, l, true); p_router(F, l); SEAM(pb + 8); TSTALL(9); }
        if (EN(10) && IN(pb + 9)) { PHASE_ENTER(); TSTART(10);
            moe_tables(F, l);
            pg8::MoeOrder<true> S; S.cnt = (const LAS int*)(F.lds + MOE_OFF); S.toff = S.cnt + 32; S.NT = 8; S.G = F.G; S.c = F.bid; S.Abase = (const char*)(ws + WS_HB); S.Bbase = (const char*)wl(ws, l, WL_GU);
            S.b_expert_bytes = (size_t)2048 * 1024 * 2; S.list = (const int*)(ws + WS_LIST); S.lda = 1024; S.ldb = 1024;
            EpiGU E{(bf16*)(ws + WS_ACT), F.in[20] + (size_t)l * 32 * 2048};
            REPS(10) { pg8::gemm_phase(F.lds, 1024, S, E); }
            SEAM(pb + 9); TSTALL(10);
        }
        if (EN(11) && IN(pb + 10)) { PHASE_ENTER(); TSTART(11);
            moe_tables(F, l);
            pg8::MoeOrder<false> S; S.cnt = (const LAS int*)(F.lds + MOE_OFF); S.toff = S.cnt + 32; S.NT = 4; S.G = F.G; S.c = F.bid; S.Abase = (const char*)(ws + WS_ACT); S.Bbase = (const char*)wl(ws, l, WL_DN);
            S.b_expert_bytes = (size_t)1024 * 1024 * 2; S.list = (const int*)(ws + WS_LIST); S.lda = 1024; S.ldb = 1024;
            EpiDown E{ws + WS_YR, F.in[22] + (size_t)l * 32 * 1024, (const int*)(ws + WS_LIST), (const float*)(ws + WS_AW)};
            REPS(11) { pg8::gemm_phase(F.lds, 1024, S, E); }
            SEAM(pb + 10); TSTALL(11);
        }
    }
    if (EN(12) && IN(PH_FINAL)) { PHASE_ENTER(); p_norm_mix(F, DEPTH, true, args.out); }
    if (TIME_KIND == 97 && F.bid == (TIME_BLOCK)) { const unsigned long long t1_ = __builtin_amdgcn_s_memrealtime(); while (__builtin_amdgcn_s_memrealtime() - t1_ < tbar_) __builtin_amdgcn_s_sleep(8); }
    if (TIME_KIND == 98 && F.bid == 0) { const unsigned long long t1_ = __builtin_amdgcn_s_memrealtime(); const unsigned long long dt_ = t1_ - tk0_; while (__builtin_amdgcn_s_memrealtime() - t1_ < dt_) __builtin_amdgcn_s_sleep(8); }
#undef IN
#undef SEAM
#undef PROJ
#undef PHASE_ENTER
}

extern "C" void kernel_launch(void* const* d_in, const int* in_sizes, int n_in, void* d_out, int out_size, void* d_ws, size_t ws_size, hipStream_t stream) {
    static int grid = 0;
    if (grid == 0) {
        if (n_in != 24 || in_sizes[0] != T * D || out_size != T * D || ws_size < WS_END) { fprintf(stderr, "kernel_launch: unexpected problem (n_in %d, in0 %d, out %d, ws %zu, need %zu)\n", n_in, n_in > 0 ? in_sizes[0] : -1, out_size, ws_size, (size_t)WS_END); grid = -1; return; }
        int dev = 0, cus = 0, per_cu = 0;
        if (hipGetDevice(&dev) != hipSuccess || hipDeviceGetAttribute(&cus, hipDeviceAttributeMultiprocessorCount, dev) != hipSuccess) { grid = -1; return; }
        if (hipFuncSetAttribute((const void*)fwd_kernel, hipFuncAttributeMaxDynamicSharedMemorySize, LDS_BYTES) != hipSuccess) { fprintf(stderr, "kernel_launch: hipFuncSetAttribute failed\n"); grid = -1; return; }
        if (hipOccupancyMaxActiveBlocksPerMultiprocessor(&per_cu, (const void*)fwd_kernel, NWAVES * 64, LDS_BYTES) != hipSuccess || per_cu < 1) { fprintf(stderr, "kernel_launch: occupancy query says %d\n", per_cu); (void)hipGetLastError(); }
        grid = cus - (cus % 8);
        if (grid < 64) { fprintf(stderr, "kernel_launch: only %d CUs\n", cus); grid = -1; return; }
    }
    if (grid < 0) return;
    if (hipMemsetAsync((char*)d_ws + WS_CTL, 0, CTL_ZERO_BYTES, stream) != hipSuccess) return;
    Args a{};
    for (int i = 0; i < 24; ++i) a.in[i] = (const float*)d_in[i];
    a.out = (float*)d_out; a.ws = (unsigned char*)d_ws;
#if MK_PER_PHASE
    for (int ph = 0; ph < PH_TOTAL; ++ph) { a.ph_lo = ph; a.ph_hi = ph + 1; hipLaunchKernelGGL(fwd_kernel, dim3(grid), dim3(NWAVES * 64), LDS_BYTES, stream, a); }
#else
    a.ph_lo = 0; a.ph_hi = PH_TOTAL; hipLaunchKernelGGL(fwd_kernel, dim3(grid), dim3(NWAVES * 64), LDS_BYTES, stream, a);
#endif
}
```

```cpp
#include <hip/hip_runtime.h>
#include <cstdio>
#include <cstdint>

#ifndef CONV_Q
#define CONV_Q 12
#endif
#ifndef RT_DEBUG
#define RT_DEBUG 0
#endif
#ifndef PHASE_MASK
#define PHASE_MASK 0xFFFFu
#endif
#define EN(k) (((PHASE_MASK) >> (k)) & 1u)
#ifndef REP_KIND
#define REP_KIND -1
#endif
#ifndef REP_SUB
#define REP_SUB 3
#endif
#ifndef TIME_MASK
#define TIME_MASK 0xFFFF
#endif
#ifndef TIME_BLOCK
#define TIME_BLOCK 0
#endif
#ifndef TIME_KIND
#define TIME_KIND -1
#endif
#ifndef ATTN_REP
#define ATTN_REP 1
#endif
#ifndef SCAN_REP
#define SCAN_REP 1
#endif
#ifndef EPI_REP
#define EPI_REP 1
#endif
#define REPS(k) _Pragma("unroll 1") for (int rep_ = 0; rep_ < ((REP_KIND) == (k) ? 2 : 1); ++rep_)
#ifndef MK_PER_PHASE
#define MK_PER_PHASE 0
#endif

#define GAS __attribute__((address_space(1)))
#define LAS __attribute__((address_space(3)))
typedef unsigned short bf16;
typedef short bf16x8 __attribute__((ext_vector_type(8)));
typedef float f32x4 __attribute__((ext_vector_type(4)));
typedef float f32x2 __attribute__((ext_vector_type(2)));
typedef float f32x16 __attribute__((ext_vector_type(16)));
typedef unsigned u32x4 __attribute__((ext_vector_type(4)));
typedef unsigned u32x2 __attribute__((ext_vector_type(2)));
typedef __bf16 bfv2 __attribute__((ext_vector_type(2)));
__device__ __forceinline__ unsigned pk4_fp8(float a, float b, float c, float d) { unsigned w = 0u; w = __builtin_amdgcn_cvt_pk_fp8_f32(a, b, w, false); w = __builtin_amdgcn_cvt_pk_fp8_f32(c, d, w, true); return w; }
constexpr float YR_SCALE = 16.0f, YR_INV = 1.0f / 16.0f;

__device__ __forceinline__ unsigned pk2(float lo, float hi) { f32x2 v = {lo, hi}; bfv2 r = __builtin_convertvector(v, bfv2); return __builtin_bit_cast(unsigned, r); }
__device__ __forceinline__ float bf2f(unsigned short b) { return __uint_as_float(((unsigned)b) << 16); }
__device__ __forceinline__ float bflo(unsigned w) { return __uint_as_float(w << 16); }
__device__ __forceinline__ float bfhi(unsigned w) { return __uint_as_float(w & 0xffff0000u); }
__device__ __forceinline__ u32x4 pack8(f32x4 a, f32x4 b) { u32x4 w; w.x = pk2(a[0], a[1]); w.y = pk2(a[2], a[3]); w.z = pk2(b[0], b[1]); w.w = pk2(b[2], b[3]); return w; }
__device__ __forceinline__ void unpack8(u32x4 w, f32x4& a, f32x4& b) { a[0] = bflo(w.x); a[1] = bfhi(w.x); a[2] = bflo(w.y); a[3] = bfhi(w.y); b[0] = bflo(w.z); b[1] = bfhi(w.z); b[2] = bflo(w.w); b[3] = bfhi(w.w); }
__device__ __forceinline__ float sigmoidf_(float x) { return 1.0f / (1.0f + __expf(-x)); }
__device__ __forceinline__ float wave_sum(float v) {
#pragma unroll
    for (int o = 1; o < 64; o <<= 1) v += __shfl_xor(v, o);
    return v;
}
#define LDS_WAIT() asm volatile("s_waitcnt lgkmcnt(0)" ::: "memory")
#define VM_WAIT() asm volatile("s_waitcnt vmcnt(0)" ::: "memory")

#define XB_TMO      128
#define XB_XCNT(j)  (256  + 64 * (j))
#define XB_XSUB(j)  (1280 + 64 * (j))
#define XB_XGEN(j)  (2304 + 64 * (j))
#define XB_TOP      3328
#define XB_TOPGEN   3392
#define XCD_BAR_WORDS 3456
#define XB_SPIN_CAP (1u << 20)

__device__ __forceinline__ unsigned xb_ld(unsigned* p)              { return __hip_atomic_load(p, __ATOMIC_RELAXED, __HIP_MEMORY_SCOPE_AGENT); }
__device__ __forceinline__ unsigned xb_add(unsigned* p, unsigned v) { return __hip_atomic_fetch_add(p, v, __ATOMIC_RELAXED, __HIP_MEMORY_SCOPE_AGENT); }
__device__ __forceinline__ unsigned xb_xcc_id() { return (unsigned)__builtin_amdgcn_s_getreg((3 << 11) | 20) & 0xFu; }
#define XB_SPIN(cond, bar) do { unsigned _sp = 0; while (cond) { __builtin_amdgcn_s_sleep(1); \
    if ((++_sp & 255u) == 0u) { if (xb_ld(&(bar)[XB_TMO])) break; if (_sp > XB_SPIN_CAP) { atomicAdd(&(bar)[XB_TMO], 1u); break; } } } } while (0)

struct XcdBarrier { unsigned* bar; unsigned x; volatile LAS unsigned* st; };

__device__ __forceinline__ XcdBarrier xcd_barrier_post(unsigned* bar, volatile LAS unsigned* st) {
    XcdBarrier b; b.bar = bar; b.x = xb_xcc_id(); b.st = st;
    if (threadIdx.x == 0) (void)xb_add(&bar[XB_XCNT(b.x)], 1u);
    return b;
}
__device__ __forceinline__ void xcd_barrier_complete(unsigned* bar, unsigned x, unsigned& nloc, unsigned& nx) {
    const unsigned G = gridDim.x * gridDim.y * gridDim.z;
    unsigned sum, cnt, mine, sp = 0u;
    for (;;) {
        sum = 0u; cnt = 0u; mine = 0u;
#pragma unroll
        for (unsigned j = 0; j < 16; ++j) { const unsigned c = xb_ld(&bar[XB_XCNT(j)]); sum += c; cnt += (c > 0u) ? 1u : 0u; mine = (j == x) ? c : mine; }
        if (sum == G) break;
        __builtin_amdgcn_s_sleep(1);
        if ((++sp & 255u) == 0u) { if (xb_ld(&bar[XB_TMO])) break; if (sp > XB_SPIN_CAP) { atomicAdd(&bar[XB_TMO], 1u); break; } }
    }
    nloc = mine > 0u ? mine : 1u; nx = cnt > 0u ? cnt : 1u;
}
__device__ __forceinline__ void xcd_barrier(const XcdBarrier& b) {
    asm volatile("s_waitcnt vmcnt(0)" ::: "memory");
    __syncthreads();
    if (threadIdx.x == 0) {
        unsigned* bar = b.bar;
        __builtin_amdgcn_s_waitcnt(0);
        unsigned nloc = b.st[0], nx = b.st[1];
        if (nloc == 0u) { xcd_barrier_complete(bar, b.x, nloc, nx); b.st[0] = nloc; b.st[1] = nx; }
        const unsigned old = xb_add(&bar[XB_XSUB(b.x)], 1u);
        const unsigned gen = old / nloc;
        if (old + 1u == (gen + 1u) * nloc) {
            __builtin_amdgcn_fence(__ATOMIC_RELEASE, "agent");
            asm volatile("s_waitcnt vmcnt(0)" ::: "memory");
            const unsigned og = xb_add(&bar[XB_TOP], 1u);
            const unsigned tg = og / nx;
            if (og + 1u == (tg + 1u) * nx) xb_add(&bar[XB_TOPGEN], 1u);
            else XB_SPIN(xb_ld(&bar[XB_TOPGEN]) == tg, bar);
            __builtin_amdgcn_fence(__ATOMIC_ACQUIRE, "agent");
            xb_add(&bar[XB_XGEN(b.x)], 1u);
            asm volatile("s_waitcnt vmcnt(0)" ::: "memory");
        } else {
            XB_SPIN(xb_ld(&bar[XB_XGEN(b.x)]) == gen, bar);
            __builtin_amdgcn_fence(__ATOMIC_ACQUIRE, "agent");
            asm volatile("s_waitcnt vmcnt(0)" ::: "memory");
        }
    }
    __syncthreads();
}

constexpr int D = 1024, NB = 8, SEQ = 2048, T = NB * SEQ, DEPTH = 4;
constexpr int NPROJ = 3328;
constexpr int NHT = 2048;
constexpr int PGT = 0, PGA = 512, PGB = 1536, PCQ = 2560, PCKV = 2944, PKPE = 3200;
constexpr int HQ = 0, HFF = 512, HFB = 1024, HI = 1536;
constexpr int NE = 32, TOPK = 4, NASSIGN = T * TOPK, ACT_ROWS = NASSIGN + NE * 256;
constexpr float EPS = 1e-6f;
constexpr float QSCALE = 0.10206207261596575f * 1.4426950408889634f;

constexpr size_t MiB = 1u << 20;
constexpr size_t WS_CTL = 0, CTL_ZERO_BYTES = 1 * MiB;
constexpr size_t WS_MOD = 1 * MiB, WS_LB = 2 * MiB, WS_COS = 3 * MiB, WS_SIN = 4 * MiB, WS_RSQ = 5 * MiB, WS_RSKV = 5 * MiB + 65536, WS_AW = 6 * MiB, WS_LIST = 7 * MiB, WS_LW = 10 * MiB;
constexpr size_t WS_X = 16 * MiB, WS_HB = 80 * MiB, WS_PROJ = 112 * MiB, WS_HT = 216 * MiB, WS_Q = 280 * MiB, WS_K = 304 * MiB, WS_VT = 328 * MiB, WS_OF = 344 * MiB, WS_OB = 376 * MiB;
constexpr size_t WS_HA = 408 * MiB, WS_Y = 440 * MiB, WS_ACT = 472 * MiB, WS_YR = 616 * MiB, WS_W = 768 * MiB;
constexpr size_t WL_IN = 0, WL_Q = 11 * MiB, WL_K = 12 * MiB, WL_V = 12 * MiB + 256 * 1024, WL_OUT = 13 * MiB, WL_O = 15 * MiB, WL_GU = 17 * MiB, WL_DN = 145 * MiB, WL_STRIDE = 209 * MiB;
constexpr size_t WS_END = WS_W + DEPTH * WL_STRIDE;
static_assert((size_t)T * NPROJ * 2 <= WS_HT - WS_PROJ && (size_t)NB * NHT * SEQ * 2 <= WS_Q - WS_HT && (size_t)ACT_ROWS * 1024 * 2 <= WS_YR - WS_ACT && (size_t)NASSIGN * 1024 * 2 <= WS_W - WS_YR, "ws map");
constexpr int CW_BAR = 4096, CW_Q = 8192, CW_CNT = 16384, CW_CONV = 32768;

constexpr int RING_BYTES = 131072;
constexpr int LDSCTL_OFF = 139264, MISC_OFF = LDSCTL_OFF + 320, MOE_OFF = LDSCTL_OFF + 1024;
constexpr int LDS_BYTES = 155648;
constexpr int RT_G_OFF = 143360, RT_S_OFF = 147456;
constexpr int NWAVES = 8;

namespace pg8 {
constexpr int BM = 256, BK = 64, HALF = 128, HTB = HALF * BK * 2, NXCD = 8, WGM = 8;
__device__ __forceinline__ int lds_byte(int r, int c) { const int st = (r >> 4) * 2 + (c >> 5), rr = r & 15, cc = c & 31, ob = rr * 64 + cc * 2; return st * 1024 + (ob ^ (((ob >> 9) & 1) << 5)); }
__device__ __forceinline__ void stage_rc(int b, int& R, int& C) { const int st = b / 1024, sb = b % 1024, swz = sb ^ (((sb >> 9) & 1) << 5); R = (st >> 1) * 16 + swz / 64; C = (st & 1) * 32 + (swz % 64) / 2; }
__device__ __forceinline__ int perm32(int rho) { const int n = rho >> 4, i = rho & 15; return 8 * (i >> 2) + 4 * n + (i & 3); }

struct Unit { const char* A; const char* B; int pm, pn, e, rowbase, mrows; };

struct DenseOrder {
    static constexpr bool GATHER_A = false;
    int nM, nN, nwg, G, c; const char* Abase; const char* Bbase; int lda, ldb;
    __device__ __forceinline__ void init(int M, int N, int G_, int c_, const void* A, int lda_, const void* B, int ldb_) { nM = M / BM; nN = N / BM; nwg = nM * nN; G = G_; c = c_; Abase = (const char*)A; Bbase = (const char*)B; lda = lda_; ldb = ldb_; }
    __device__ __forceinline__ bool next(int i, Unit& u) const {
        const long L = (long)i * G + c; if (L >= nwg) return false;
        int wgid = (int)L; { const int q = nwg / NXCD, r = nwg % NXCD, xcd = wgid % NXCD, off = wgid / NXCD; wgid = (xcd < r ? xcd * (q + 1) : r * (q + 1) + (xcd - r) * q) + off; }
        const int nig = WGM * nN, gid = wgid / nig, fm = gid * WGM, gsz = (nM - fm) < WGM ? (nM - fm) : WGM;
        u.pm = fm + ((wgid % nig) % gsz); u.pn = (wgid % nig) / gsz; u.e = 0; u.rowbase = 0; u.mrows = 256;
        u.A = Abase + (size_t)u.pm * 256 * lda * 2; u.B = Bbase + (size_t)u.pn * 256 * ldb * 2; return true;
    }
    __device__ __forceinline__ void aoff(const Unit&, const int (&R)[2], const int (&C)[2], unsigned (&v)[2][2]) const {
#pragma unroll
        for (int h = 0; h < 2; ++h)
#pragma unroll
            for (int i = 0; i < 2; ++i) v[h][i] = (unsigned)((128 * h + R[i]) * lda + C[i]) * 2u;
    }
};
template <bool GATHER> struct MoeOrder {
    static constexpr bool GATHER_A = GATHER;
    const LAS int* toff; const LAS int* cnt; int NT, G, c; const char* Abase; const char* Bbase; size_t b_expert_bytes; const int* list; int lda, ldb;
    __device__ __forceinline__ bool next(int i, Unit& u) const {
        const int spx = G >> 3, rpx = spx / NT, xcd = c & 7, slot = c >> 3;
        if (slot >= rpx * NT) return false;
        const int R = (i * 8 + xcd) * rpx + slot / NT; if (R >= toff[NE]) return false;
        int e = 0; while (toff[e + 1] <= R) ++e;
        u.e = e; u.pm = R - toff[e]; u.pn = slot % NT; u.rowbase = R * 256; u.mrows = cnt[e] - u.pm * 256;
        u.A = GATHER ? Abase : Abase + (size_t)u.rowbase * lda * 2; u.B = Bbase + (size_t)e * b_expert_bytes + (size_t)u.pn * 256 * ldb * 2; return true;
    }
    __device__ __forceinline__ void aoff(const Unit& u, const int (&R)[2], const int (&C)[2], unsigned (&v)[2][2]) const {
#pragma unroll
        for (int h = 0; h < 2; ++h)
#pragma unroll
            for (int i = 0; i < 2; ++i) {
                if (GATHER) { const int rl = 128 * h + R[i]; const int a = list[(size_t)u.e * T + u.pm * 256 + (rl < u.mrows ? rl : 0)]; v[h][i] = (unsigned)((a >> 2) * lda + C[i]) * 2u; }
                else v[h][i] = (unsigned)((128 * h + R[i]) * lda + C[i]) * 2u;
            }
    }
};

template <class E, class = void> struct has_mid { static constexpr bool value = false; };
template <class E> struct has_mid<E, decltype((void)E::HAS_MID)> { static constexpr bool value = true; };
template <class Epi, class Sched>
__device__ __forceinline__ void gemm_phase(LAS unsigned char* lds, const int K, const Sched& S, const Epi& E) {
    int tid_ = threadIdx.x; asm volatile("" : "+v"(tid_));
    const int tid = tid_, wid = __builtin_amdgcn_readfirstlane(tid >> 6), lane = tid & 63, wr = wid >> 2, wc = wid & 3, fr = lane & 15, fq = lane >> 4;
    int nt_ = K / BK; asm volatile("" : "+s"(nt_));
    const int nt = nt_;
    int sR[2], sC[2]; unsigned voffB[2];
#pragma unroll
    for (int i = 0; i < 2; ++i) { stage_rc(tid * 16 + i * 8192, sR[i], sC[i]); const int Rb = (sR[i] & ~31) + perm32(sR[i] & 31); voffB[i] = (unsigned)(Rb * S.ldb + sC[i]) * 2u; }
    constexpr bool GA = Sched::GATHER_A;
    unsigned voffA[2];
#pragma unroll
    for (int i = 0; i < 2; ++i) voffA[i] = (unsigned)(sR[i] * S.lda + sC[i]) * 2u;
    const size_t kstep = (size_t)(BK * 2);
    const size_t hstepB = (size_t)HALF * S.ldb * 2, hstepA = (size_t)HALF * S.lda * 2;
    const unsigned ldsw = (unsigned)wid * 1024u;
    const unsigned ldsbase = (unsigned)__builtin_amdgcn_readfirstlane((int)((unsigned)(size_t)lds + ldsw));
    const int aoff = lds_byte(wr * 64 + fr, fq * 8), boff = lds_byte(wc * 32 + fr, fq * 8);
#define PG8_SA(b, h) (((b) * 2 + (h)) * HTB)
#define PG8_SB(b, h) ((4 + (b) * 2 + (h)) * HTB)
#define PG8_DMA2(ldsaddr, gbase, v0_, v1_) do { unsigned keep_; \
        asm volatile("s_mov_b32 %0, m0\n\ts_mov_b32 m0, %4\n\ts_nop 0\n\tglobal_load_lds_dwordx4 %1, %3\n\ts_add_u32 m0, %4, 0x2000\n\ts_nop 0\n\tglobal_load_lds_dwordx4 %2, %3\n\ts_mov_b32 m0, %0" \
                     : "=&s"(keep_) : "v"(v0_), "v"(v1_), "s"(gbase), "s"(ldsaddr) : "memory", "scc"); } while (0)
#define PG8_STAGE(bufoff, gbase, voff) PG8_DMA2(ldsbase + (unsigned)(bufoff), (const char*)(gbase), (voff)[0], (voff)[1])
#define PG8_STAGEA(bufoff, gbase, h, nx) do { if constexpr (GA) { PG8_DMA2(ldsbase + (unsigned)(bufoff), (const char*)(gbase), ((nx) ? nvA[h][0] : vA[h][0]), ((nx) ? nvA[h][1] : vA[h][1])); } \
        else { PG8_DMA2(ldsbase + (unsigned)(bufoff), (const char*)(gbase) + (size_t)(h) * hstepA, voffA[0], voffA[1]); } } while (0)
#define PG8_LDA(dst, b, h) do { _Pragma("unroll") for (int m = 0; m < 4; ++m) _Pragma("unroll") for (int k = 0; k < 2; ++k) dst[m][k] = *(const LAS bf16x8*)(lds + PG8_SA(b, h) + aoff + m * 2048 + k * 1024); } while (0)
#define PG8_LDB(dst, b, h) do { _Pragma("unroll") for (int n = 0; n < 2; ++n) _Pragma("unroll") for (int k = 0; k < 2; ++k) dst[n][k] = *(const LAS bf16x8*)(lds + PG8_SB(b, h) + boff + n * 2048 + k * 1024); } while (0)
#define PG8_MMA(ai, bj, At, Bt) do { __builtin_amdgcn_s_setprio(1); _Pragma("unroll") for (int m = 0; m < 4; ++m) _Pragma("unroll") for (int n = 0; n < 2; ++n) _Pragma("unroll") for (int k = 0; k < 2; ++k) \
        acc[ai][bj][m][n] = __builtin_amdgcn_mfma_f32_16x16x32_bf16(Bt[n][k], At[m][k], acc[ai][bj][m][n], 0, 0, 0); __builtin_amdgcn_s_setprio(0); } while (0)
#define PG8_WAIT_V(n) asm volatile("s_waitcnt vmcnt(" #n ")" ::: "memory")
#define PG8_WAIT_L(n) asm volatile("s_waitcnt lgkmcnt(" #n ")" ::: "memory")
#define PG8_BAR __builtin_amdgcn_s_barrier()
#define PG8_SCHED __builtin_amdgcn_sched_barrier(0)
    Unit cur, nxt; int ui = 0;
    if (!S.next(0, cur)) return;
    f32x4 acc[2][2][4][2];
#pragma unroll
    for (int a = 0; a < 2; ++a)
#pragma unroll
        for (int b = 0; b < 2; ++b)
#pragma unroll
            for (int m = 0; m < 4; ++m)
#pragma unroll
                for (int n = 0; n < 2; ++n) acc[a][b][m][n] = (f32x4){0.f, 0.f, 0.f, 0.f};
    bf16x8 At[4][2], B0[2][2], B1[2][2];
    unsigned vA[2][2], nvA[2][2];
    if constexpr (GA) { S.aoff(cur, sR, sC, vA); }
    const char* cA = cur.A; const char* cB = cur.B;
    PG8_STAGE(PG8_SB(0, 0), cB, voffB); PG8_STAGE(PG8_SB(0, 1), cB + hstepB, voffB); PG8_STAGEA(PG8_SA(0, 0), cA, 0, false); PG8_STAGEA(PG8_SA(0, 1), cA, 1, false);
    if (wr == 1) PG8_BAR;
    PG8_WAIT_V(2); PG8_BAR;
    PG8_STAGE(PG8_SB(1, 0), cB + kstep, voffB); PG8_STAGEA(PG8_SA(1, 0), cA + kstep, 0, false); PG8_STAGE(PG8_SB(1, 1), cB + hstepB + kstep, voffB);
    PG8_WAIT_V(6); PG8_BAR;
    for (;;) {
        const bool has_next = S.next(ui + 1, nxt);
        const char* nA = has_next ? nxt.A : cA; const char* nB = has_next ? nxt.B : cB;
        if constexpr (GA) {
            if (has_next) S.aoff(nxt, sR, sC, nvA);
            else {
#pragma unroll
                for (int h = 0; h < 2; ++h)
#pragma unroll
                    for (int i = 0; i < 2; ++i) nvA[h][i] = vA[h][i]; } }
#pragma unroll 1
        for (int t = 0; t < nt; t += 2) {
            const bool last = (t == nt - 2);
            if constexpr (has_mid<Epi>::value) { if (t == Epi::MID_T) E.mid(acc, cur, wr, wc, fr, fq); }
            const char* a1 = cA + (size_t)(t + 1) * kstep;
            const char* a2 = last ? nA : cA + (size_t)(t + 2) * kstep; const char* b2 = last ? nB : cB + (size_t)(t + 2) * kstep;
            const char* a3 = a2 + kstep; const char* b3 = b2 + kstep;
            PG8_LDB(B0, 0, 0); PG8_LDB(B1, 0, 1); PG8_SCHED; PG8_LDA(At, 0, 0); PG8_STAGEA(PG8_SA(1, 1), a1, 1, false);
            PG8_WAIT_V(8); PG8_WAIT_L(0); PG8_BAR; PG8_MMA(0, 0, At, B0); PG8_MMA(0, 1, At, B1); PG8_BAR; PG8_SCHED;
            PG8_LDA(At, 0, 1); PG8_STAGE(PG8_SB(0, 0), b2, voffB); PG8_STAGE(PG8_SB(0, 1), b2 + hstepB, voffB); PG8_STAGEA(PG8_SA(0, 0), a2, 0, last);
            PG8_WAIT_V(8); PG8_WAIT_L(0); PG8_BAR; PG8_MMA(1, 0, At, B0); PG8_MMA(1, 1, At, B1); PG8_BAR; PG8_SCHED;
            PG8_LDB(B0, 1, 0); PG8_LDB(B1, 1, 1); PG8_SCHED; PG8_LDA(At, 1, 0); PG8_STAGEA(PG8_SA(0, 1), a2, 1, last);
            PG8_WAIT_V(8); PG8_WAIT_L(0); PG8_BAR; PG8_MMA(0, 0, At, B0); PG8_MMA(0, 1, At, B1); PG8_BAR; PG8_SCHED;
            PG8_LDA(At, 1, 1); PG8_STAGE(PG8_SB(1, 0), b3, voffB); PG8_STAGE(PG8_SB(1, 1), b3 + hstepB, voffB); PG8_STAGEA(PG8_SA(1, 0), a3, 0, last);
            PG8_WAIT_V(8); PG8_WAIT_L(0); PG8_BAR; PG8_MMA(1, 0, At, B0); PG8_MMA(1, 1, At, B1); PG8_BAR; PG8_SCHED;
        }
        if (wr == 0) PG8_BAR;
        E(acc, cur, wr, wc, fr, fq);
        if constexpr (EPI_REP > 1 && Epi::IDEMPOTENT) { asm volatile("" ::: "memory"); E(acc, cur, wr, wc, fr, fq); }
        if (!has_next) break;
#pragma unroll
        for (int a = 0; a < 2; ++a)
#pragma unroll
            for (int b = 0; b < 2; ++b)
#pragma unroll
                for (int m = 0; m < 4; ++m)
#pragma unroll
                    for (int n = 0; n < 2; ++n) acc[a][b][m][n] = (f32x4){0.f, 0.f, 0.f, 0.f};
        cur = nxt; cA = nA; cB = nB; ++ui;
        if constexpr (GA) {
#pragma unroll
            for (int h = 0; h < 2; ++h)
#pragma unroll
                for (int i = 0; i < 2; ++i) vA[h][i] = nvA[h][i]; }
        if (wr == 1) PG8_BAR;
    }
    PG8_WAIT_V(0);
    PG8_BAR;
#undef PG8_SA
#undef PG8_SB
#undef PG8_STAGE
#undef PG8_STAGEA
#undef PG8_DMA2
#undef PG8_LDA
#undef PG8_LDB
#undef PG8_MMA
#undef PG8_WAIT_V
#undef PG8_WAIT_L
#undef PG8_BAR
#undef PG8_SCHED
}
}
using pg8::Unit;
typedef const f32x4 (&AccRef)[2][2][4][2];

struct Args {
    const float* in[24]; float* out; unsigned char* ws; int ph_lo, ph_hi;
};
struct Frame {
    LAS unsigned char* lds; unsigned char* ws; int tid, lane, wave, G, bid;
    const float* const* in;
};
__device__ __forceinline__ unsigned char* wl(unsigned char* ws, int l, size_t off) { return ws + WS_W + (size_t)l * WL_STRIDE + off; }

#define EPI_LOOP_BEGIN _Pragma("unroll") for (int ai = 0; ai < 2; ++ai) _Pragma("unroll") for (int m = 0; m < 4; ++m) { const int rl = ai * 128 + wr * 64 + m * 16 + fr; _Pragma("unroll") for (int bj = 0; bj < 2; ++bj) { const int cl = bj * 128 + wc * 32 + 8 * fq; const f32x4 v0 = acc[ai][bj][m][0], v1 = acc[ai][bj][m][1];
#define EPI_LOOP_END } asm volatile("" ::: "memory"); }

struct EpiProj {
    static constexpr bool IDEMPOTENT = (EPI_REP > 2);
    bf16* O;
    __device__ __forceinline__ void operator()(AccRef acc, const Unit& u, int wr, int wc, int fr, int fq) const {
        EPI_LOOP_BEGIN
            *(u32x4*)(O + (size_t)(u.pm * 256 + rl) * NPROJ + u.pn * 256 + cl) = pack8(v0, v1);
        EPI_LOOP_END
    }
};
struct EpiHT {
    static constexpr bool IDEMPOTENT = (EPI_REP > 2);
    bf16* HT;
    __device__ __forceinline__ void operator()(AccRef acc, const Unit& u, int wr, int wc, int fr, int fq) const {
        const int seg = u.pm >> 1;
        EPI_LOOP_BEGIN
            const int f = u.pm * 256 + rl, t0 = u.pn * 256 + cl, b = t0 >> 11, s = t0 & 2047;
            f32x4 a = v0, d = v1;
            if (seg == 0) {
#pragma unroll
                for (int j = 0; j < 4; ++j) { a[j] = a[j] * __builtin_amdgcn_rcpf(1.0f + __builtin_amdgcn_exp2f(-1.4426950408889634f * a[j])); d[j] = d[j] * __builtin_amdgcn_rcpf(1.0f + __builtin_amdgcn_exp2f(-1.4426950408889634f * d[j])); }
            } else if (seg < 3) {
#pragma unroll
                for (int j = 0; j < 4; ++j) { a[j] = __builtin_amdgcn_rcpf(1.0f + __builtin_amdgcn_exp2f(1.4426950408889634f * a[j])); d[j] = __builtin_amdgcn_rcpf(1.0f + __builtin_amdgcn_exp2f(1.4426950408889634f * d[j])); }
            }
            *(u32x4*)(HT + ((size_t)b * NHT + f) * SEQ + s) = pack8(a, d);
        EPI_LOOP_END
    }
};
struct EpiQ {
    static constexpr bool IDEMPOTENT = (EPI_REP > 2);
    bf16* Q; const float* rsq; const float* cs; const float* sn;
    __device__ __forceinline__ void operator()(AccRef acc, const Unit& u, int wr, int wc, int fr, int fq) const {
        EPI_LOOP_BEGIN
            const int t = u.pm * 256 + rl, c0 = u.pn * 256 + cl, head = c0 / 96, w = c0 - head * 96, b = t >> 11, s = t & 2047;
            const float sc = rsq[t] * QSCALE;
            bf16* qp = Q + ((size_t)(b * 8 + head) * SEQ + s) * 96;
            f32x4 a = v0 * sc, d = v1 * sc;
            if (w < 64) { *(u32x4*)(qp + w) = pack8(a, d); }
            else { const int g = (w - 64) >> 3; const f32x4 co = *(const f32x4*)(cs + (size_t)t * 16 + 4 * g), si = *(const f32x4*)(sn + (size_t)t * 16 + 4 * g);
                const f32x4 o1 = a * co - d * si, o2 = d * co + a * si;
                u32x2 w1, w2; w1.x = pk2(o1[0], o1[1]); w1.y = pk2(o1[2], o1[3]); w2.x = pk2(o2[0], o2[1]); w2.y = pk2(o2[2], o2[3]);
                *(u32x2*)(qp + 64 + 4 * g) = w1; *(u32x2*)(qp + 80 + 4 * g) = w2; }
        EPI_LOOP_END
    }
};
struct EpiK {
    static constexpr bool IDEMPOTENT = (EPI_REP > 2);
    bf16* Kb; const float* rskv;
    __device__ __forceinline__ void operator()(AccRef acc, const Unit& u, int wr, int wc, int fr, int fq) const {
        EPI_LOOP_BEGIN
            const int t = u.pm * 256 + rl, c0 = u.pn * 256 + cl, head = c0 >> 6, w = c0 & 63, b = t >> 11, s = t & 2047;
            const float sc = rskv[t];
            *(u32x4*)(Kb + ((size_t)(b * 8 + head) * SEQ + s) * 96 + w) = pack8(v0 * sc, v1 * sc);
        EPI_LOOP_END
    }
};
struct EpiV {
    static constexpr bool IDEMPOTENT = (EPI_REP > 2);
    bf16* VT; const float* rskv;
    __device__ __forceinline__ void operator()(AccRef acc, const Unit& u, int wr, int wc, int fr, int fq) const {
        EPI_LOOP_BEGIN
            const int f = u.pm * 256 + rl, t0 = u.pn * 256 + cl, b = t0 >> 11, s = t0 & 2047, head = f >> 6, dv = f & 63;
            const f32x4 r0 = *(const f32x4*)(rskv + t0), r1 = *(const f32x4*)(rskv + t0 + 4);
            *(u32x4*)(VT + ((size_t)(b * 8 + head) * 64 + dv) * SEQ + s) = pack8(v0 * r0, v1 * r1);
        EPI_LOOP_END
    }
};
struct EpiOut {
    static constexpr bool IDEMPOTENT = false; static constexpr bool HAS_MID = true; static constexpr int MID_T = 8;
    bf16* Y; const bf16* proj;
    __device__ __forceinline__ void mid(f32x4 (&acc)[2][2][4][2], const Unit& u, int wr, int wc, int fr, int fq) const {
        unsigned off0 = (unsigned)((u.pm * 256 + wr * 64 + fr) * NPROJ + u.pn * 256 + wc * 32 + 8 * fq) * 2u;
        asm volatile("" : "+v"(off0));
        const char* gp0 = (const char*)proj;
#pragma unroll
        for (int ai = 0; ai < 2; ++ai)
#pragma unroll
            for (int mp = 0; mp < 2; ++mp) {
                u32x4 ga[2][2], gb[2][2];
#pragma unroll
                for (int mm = 0; mm < 2; ++mm)
#pragma unroll
                    for (int bj = 0; bj < 2; ++bj) { const unsigned o = off0 + (unsigned)(((ai * 128 + (2 * mp + mm) * 16) * NPROJ + bj * 128) * 2); ga[mm][bj] = *(const u32x4*)(gp0 + o + PGA * 2); gb[mm][bj] = *(const u32x4*)(gp0 + o + PGB * 2); }
#pragma unroll
                for (int mm = 0; mm < 2; ++mm)
#pragma unroll
                    for (int bj = 0; bj < 2; ++bj) {
                        f32x4 a0, a1, b0, b1; unpack8(ga[mm][bj], a0, a1); unpack8(gb[mm][bj], b0, b1);
#pragma unroll
                        for (int j = 0; j < 4; ++j) {
                            a0[j] = (1.0f + __builtin_amdgcn_exp2f(-1.4426950408889634f * b0[j])) * __builtin_amdgcn_rcpf(1.0f + __builtin_amdgcn_exp2f(-1.4426950408889634f * a0[j]));
                            a1[j] = (1.0f + __builtin_amdgcn_exp2f(-1.4426950408889634f * b1[j])) * __builtin_amdgcn_rcpf(1.0f + __builtin_amdgcn_exp2f(-1.4426950408889634f * a1[j])); }
                        acc[ai][bj][2 * mp + mm][0] *= a0; acc[ai][bj][2 * mp + mm][1] *= a1;
                    }
                asm volatile("" ::: "memory");
            }
    }
    __device__ __forceinline__ void operator()(AccRef acc, const Unit& u, int wr, int wc, int fr, int fq) const {
        const int c0 = u.pn * 256 + wc * 32 + 8 * fq;
        const bf16* gp = proj + (size_t)(u.pm * 256 + wr * 64 + fr) * NPROJ + PGB + c0;
        bf16* yp = Y + (size_t)(u.pm * 256 + wr * 64 + fr) * 1024 + c0;
#pragma unroll
        for (int ai = 0; ai < 2; ++ai) {
            u32x4 gw[4][2];
#pragma unroll
            for (int m = 0; m < 4; ++m)
#pragma unroll
                for (int bj = 0; bj < 2; ++bj) gw[m][bj] = *(const u32x4*)(gp + (size_t)(ai * 128 + m * 16) * NPROJ + bj * 128);
#pragma unroll
            for (int m = 0; m < 4; ++m)
#pragma unroll
                for (int bj = 0; bj < 2; ++bj) {
                    f32x4 g0, g1; unpack8(gw[m][bj], g0, g1);
#pragma unroll
                    for (int j = 0; j < 4; ++j) { g0[j] = __builtin_amdgcn_rcpf(1.0f + __builtin_amdgcn_exp2f(-1.4426950408889634f * g0[j])); g1[j] = __builtin_amdgcn_rcpf(1.0f + __builtin_amdgcn_exp2f(-1.4426950408889634f * g1[j])); }
                    *(u32x4*)(yp + (size_t)(ai * 128 + m * 16) * 1024 + bj * 128) = pack8(acc[ai][bj][m][0] * g0, acc[ai][bj][m][1] * g1);
                }
            asm volatile("" ::: "memory");
        }
    }
};
struct EpiWo {
    static constexpr bool IDEMPOTENT = false;
    bf16* X; const float* g1;
    __device__ __forceinline__ void operator()(AccRef acc, const Unit& u, int wr, int wc, int fr, int fq) const {
        const int c0 = u.pn * 256 + wc * 32 + 8 * fq, b = (u.pm * 256) >> 11;
        const float* gp = g1 + (size_t)b * 6144 + c0;
        const f32x4 ga0 = *(const f32x4*)gp, gb0 = *(const f32x4*)(gp + 4), ga1 = *(const f32x4*)(gp + 128), gb1 = *(const f32x4*)(gp + 132);
        bf16* xp = X + (size_t)(u.pm * 256 + wr * 64 + fr) * 1024 + c0;
#pragma unroll
        for (int ai = 0; ai < 2; ++ai) {
            u32x4 xv[4][2];
#pragma unroll
            for (int m = 0; m < 4; ++m) { const bf16* p = xp + (size_t)(ai * 128 + m * 16) * 1024; xv[m][0] = *(const u32x4*)p; xv[m][1] = *(const u32x4*)(p + 128); }
#pragma unroll
            for (int m = 0; m < 4; ++m) { bf16* p = xp + (size_t)(ai * 128 + m * 16) * 1024; f32x4 a, d;
                unpack8(xv[m][0], a, d); *(u32x4*)p = pack8(a + ga0 * acc[ai][0][m][0], d + gb0 * acc[ai][0][m][1]);
                unpack8(xv[m][1], a, d); *(u32x4*)(p + 128) = pack8(a + ga1 * acc[ai][1][m][0], d + gb1 * acc[ai][1][m][1]); }
            asm volatile("" ::: "memory");
        }
    }
};
struct EpiGU {
    static constexpr bool IDEMPOTENT = true;
    bf16* ACT; const float* bgu;
    __device__ __forceinline__ void operator()(AccRef acc, const Unit& u, int wr, int wc, int fr, int fq) const {
        const int j0 = u.pn * 128 + wc * 32 + 8 * fq;
        const float* bp = bgu + (size_t)u.e * 2048 + 2 * j0;
        const f32x4 b0 = *(const f32x4*)bp, b1 = *(const f32x4*)(bp + 4), b2 = *(const f32x4*)(bp + 8), b3 = *(const f32x4*)(bp + 12);
        const float bg[8] = {b0[0], b0[2], b1[0], b1[2], b2[0], b2[2], b3[0], b3[2]}, bu[8] = {b0[1], b0[3], b1[1], b1[3], b2[1], b2[3], b3[1], b3[3]};
        bf16* ap = ACT + (size_t)(u.rowbase + wr * 64 + fr) * 1024 + j0;
#pragma unroll
        for (int ai = 0; ai < 2; ++ai)
#pragma unroll
            for (int m = 0; m < 4; ++m) {
                float o[8];
#pragma unroll
                for (int j = 0; j < 8; ++j) {
                    float g = acc[ai][0][m][j >> 2][j & 3] + bg[j], up = acc[ai][1][m][j >> 2][j & 3] + bu[j];
                    g = fminf(g, 7.0f); up = fminf(fmaxf(up, -7.0f), 7.0f);
                    o[j] = (up + 1.0f) * g * __builtin_amdgcn_rcpf(1.0f + __builtin_amdgcn_exp2f(-1.702f * 1.4426950408889634f * g)); }
                u32x4 w; w.x = pk2(o[0], o[1]); w.y = pk2(o[2], o[3]); w.z = pk2(o[4], o[5]); w.w = pk2(o[6], o[7]);
                *(u32x4*)(ap + (size_t)(ai * 128 + m * 16) * 1024) = w;
            }
    }
};
struct EpiDown {
    static constexpr bool IDEMPOTENT = true;
    unsigned char* YR; const float* bd; const int* list; const float* lw;
    __device__ __forceinline__ void operator()(AccRef acc, const Unit& u, int wr, int wc, int fr, int fq) const {
        const int cb = u.pn * 256 + wc * 32 + 8 * fq;
        const float* bp = bd + (size_t)u.e * 1024 + cb;
        const f32x4 ba0 = *(const f32x4*)bp, bb0 = *(const f32x4*)(bp + 4), ba1 = *(const f32x4*)(bp + 128), bb1 = *(const f32x4*)(bp + 132);
        int a[8]; float w[8];
        const int* lp = list + (size_t)u.e * T + u.pm * 256 + wr * 64 + fr; const float* wp = lw + (size_t)u.e * T + u.pm * 256 + wr * 64 + fr;
#pragma unroll
        for (int q = 0; q < 8; ++q) { const int rl = (q >> 2) * 128 + wr * 64 + (q & 3) * 16 + fr; a[q] = (rl < u.mrows) ? lp[(q >> 2) * 128 + (q & 3) * 16] : -1; }
#pragma unroll
        for (int q = 0; q < 8; ++q) { const int rl = (q >> 2) * 128 + wr * 64 + (q & 3) * 16 + fr; w[q] = (rl < u.mrows) ? wp[(q >> 2) * 128 + (q & 3) * 16] : 0.f; }
#pragma unroll
        for (int q = 0; q < 8; ++q) {
            const int ai = q >> 2, m = q & 3;
            if (a[q] >= 0) { unsigned char* yp = YR + (size_t)a[q] * 1024 + cb;
                const float ws_ = w[q] * YR_SCALE;
                const f32x4 y0 = (acc[ai][0][m][0] + ba0) * ws_, y1 = (acc[ai][0][m][1] + bb0) * ws_, y2 = (acc[ai][1][m][0] + ba1) * ws_, y3 = (acc[ai][1][m][1] + bb1) * ws_;
                *(u32x2*)yp = (u32x2){pk4_fp8(y0[0], y0[1], y0[2], y0[3]), pk4_fp8(y1[0], y1[1], y1[2], y1[3])};
                *(u32x2*)(yp + 128) = (u32x2){pk4_fp8(y2[0], y2[1], y2[2], y2[3]), pk4_fp8(y3[0], y3[1], y3[2], y3[3])}; }
        }
    }
};

enum { MAP_ID = 0, MAP_WIN = 1, MAP_WQ = 2, MAP_WKV = 3, MAP_GU = 4 };
__device__ __forceinline__ int map_row(int kind, int n) {
    if (kind == MAP_WIN) { if (n < 2560) return n; if (n < 2944) return NHT + PCQ + (n - 2560); if (n < 3200) return NHT + PCKV + (n - 2944); if (n < 3232) return NHT + PKPE + (n - 3200); return NHT + PGA + (n - 3232); }
    if (kind == MAP_WQ) { const int h = n / 96, j = n - h * 96; if (j < 64) return n; const int r = j - 64, i = r & 15; return h * 96 + 64 + 8 * (i >> 2) + ((r >> 4) << 2) + (i & 3); }
    if (kind == MAP_WKV) { const int h = n >> 7, j = n & 127; return (j < 64) ? (h * 64 + j) : (512 + h * 64 + (j - 64)); }
    if (kind == MAP_GU) { const int j = n >> 1, bj = n & 1; return (j >> 7) * 256 + bj * 128 + (j & 127); }
    return n;
}
__device__ __forceinline__ void conv_item(const float* W, int N, const float* kscale, bf16* WT, int dstK, int koff, int kind, LAS float* scr, int kb, int nb, int lane) {
    const int k0 = 64 * kb, n0 = 32 * nb;
    {
        const int kr = lane >> 3, c4 = (lane & 7) * 4; f32x4 v[8];
#pragma unroll
        for (int i = 0; i < 8; ++i) v[i] = __builtin_nontemporal_load((const f32x4*)(W + (size_t)(k0 + 8 * i + kr) * N + n0 + c4));
#pragma unroll
        for (int i = 0; i < 8; ++i) { if (kscale) v[i] = v[i] * kscale[k0 + 8 * i + kr]; LAS float* d = scr + (8 * i + kr) * 33 + c4; d[0] = v[i][0]; d[1] = v[i][1]; d[2] = v[i][2]; d[3] = v[i][3]; }
    }
    LDS_WAIT(); asm volatile("" ::: "memory");
    const int c = lane & 7;
#pragma unroll
    for (int j = 0; j < 4; ++j) { const int n = (lane >> 3) + 8 * j; const LAS float* s = scr + (8 * c) * 33 + n;
        u32x4 o; o.x = pk2(s[0 * 33], s[1 * 33]); o.y = pk2(s[2 * 33], s[3 * 33]); o.z = pk2(s[4 * 33], s[5 * 33]); o.w = pk2(s[6 * 33], s[7 * 33]);
        *(u32x4*)(WT + (size_t)map_row(kind, n0 + n) * dstK + koff + k0 + 8 * c) = o; }
    LDS_WAIT(); asm volatile("" ::: "memory");
}
__device__ __forceinline__ void conv_pair(const float* W, int N, bf16* WT, int dstK, int kind, LAS float* scr, int kbA, int nbA, int kbB, int nbB, int lane) {
    const int kr = lane >> 3, c4 = (lane & 7) * 4, c = lane & 7; f32x4 va[8], vb[8];
#pragma unroll
    for (int i = 0; i < 8; ++i) va[i] = __builtin_nontemporal_load((const f32x4*)(W + (size_t)(64 * kbA + 8 * i + kr) * N + 32 * nbA + c4));
#pragma unroll
    for (int i = 0; i < 8; ++i) vb[i] = __builtin_nontemporal_load((const f32x4*)(W + (size_t)(64 * kbB + 8 * i + kr) * N + 32 * nbB + c4));
#pragma unroll
    for (int h = 0; h < 2; ++h) {
        const int k0 = 64 * (h ? kbB : kbA), n0 = 32 * (h ? nbB : nbA);
#pragma unroll
        for (int i = 0; i < 8; ++i) { const f32x4 v = h ? vb[i] : va[i]; LAS float* d = scr + (8 * i + kr) * 33 + c4; d[0] = v[0]; d[1] = v[1]; d[2] = v[2]; d[3] = v[3]; }
        LDS_WAIT(); asm volatile("" ::: "memory");
#pragma unroll
        for (int j = 0; j < 4; ++j) { const int n = (lane >> 3) + 8 * j; const LAS float* sp = scr + (8 * c) * 33 + n;
            u32x4 o; o.x = pk2(sp[0 * 33], sp[1 * 33]); o.y = pk2(sp[2 * 33], sp[3 * 33]); o.z = pk2(sp[4 * 33], sp[5 * 33]); o.w = pk2(sp[6 * 33], sp[7 * 33]);
            *(u32x4*)(WT + (size_t)map_row(kind, n0 + n) * dstK + k0 + 8 * c) = o; }
        LDS_WAIT(); asm volatile("" ::: "memory");
    }
}
__device__ __forceinline__ void p_prologue(Frame& F) {
    const float* const* in = F.in;
    __syncthreads();
    {
        LAS float* cond = (LAS float*)F.lds;
        LAS float* part = (LAS float*)(F.lds + 32768);
        for (int i = F.tid; i < 8 * 1024; i += 512) { const float v = in[1][i]; cond[i] = v * sigmoidf_(v); }
        __syncthreads();
        for (int it = F.bid; it < DEPTH * 96; it += F.G) {
            const int l = it / 96, n0 = (it % 96) * 64, col = F.tid & 63, kg = F.tid >> 6;
            const int c4 = F.lane & 15, kq = F.lane >> 4;
            const float* w = in[3] + (size_t)l * 1024 * 6144 + n0 + 4 * c4;
            f32x4 a4[8];
#pragma unroll
            for (int b = 0; b < 8; ++b) a4[b] = (f32x4){0.f, 0.f, 0.f, 0.f};
            for (int j0 = 0; j0 < 32; j0 += 16) {
                f32x4 wv[16];
#pragma unroll
                for (int q = 0; q < 16; ++q) wv[q] = *(const f32x4*)(w + (size_t)(kg * 128 + kq + 4 * (j0 + q)) * 6144);
#pragma unroll
                for (int q = 0; q < 16; ++q)
#pragma unroll
                    for (int b = 0; b < 8; ++b) a4[b] += cond[b * 1024 + kg * 128 + kq + 4 * (j0 + q)] * wv[q]; }
#pragma unroll
            for (int b = 0; b < 8; ++b)
#pragma unroll
                for (int i = 0; i < 4; ++i) { float v = a4[b][i]; v += __shfl_xor(v, 16); v += __shfl_xor(v, 32); a4[b][i] = v; }
            if (kq == 0) {
#pragma unroll
                for (int b = 0; b < 8; ++b) *(LAS f32x4*)(part + (kg * 8 + b) * 64 + 4 * c4) = a4[b]; }
            __syncthreads();
            { const int b = F.tid >> 6; float s = 0.f;
#pragma unroll
              for (int g = 0; g < 8; ++g) s += part[(g * 8 + b) * 64 + col];
              ((float*)(F.ws + WS_MOD))[((size_t)l * 8 + b) * 6144 + n0 + col] = s + in[4][(size_t)l * 6144 + n0 + col]; }
            __syncthreads();
        }
    }
    const int gtid = F.bid * 512 + F.tid, NT_ = F.G * 512;
    for (int i = gtid; i < 1024; i += NT_) {
        float lg[DEPTH], mx = -1e30f; for (int l = 0; l < DEPTH; ++l) { lg[l] = in[8][(size_t)l * 1024 + i]; mx = fmaxf(mx, lg[l]); }
        float s = 0.f; for (int l = 0; l < DEPTH; ++l) { lg[l] = __expf(lg[l] - mx); s += lg[l]; }
        float c = 0.f; float* lb = (float*)(F.ws + WS_LB);
        for (int l = 0; l < DEPTH; ++l) { if (l > 0) c += lg[l] / s; lb[(size_t)l * 1024 + i] = c; }
    }
    for (int i = gtid; i < T * 16; i += NT_) {
        const int t = i >> 4, j = i & 15; const int pos = ((const int*)in[2])[t];
        const double base4[4] = {1.0, 0.5623413251903491, 0.31622776601683794, 0.1778279410038923};
        double f = base4[j & 3]; for (int q = 0; q < (j >> 2); ++q) f *= 0.1;
        const double ang = (double)pos * f; const double n = __builtin_rint(ang * 0.15915494309189535); const float r = (float)(ang - n * 6.283185307179586);
        ((float*)(F.ws + WS_COS))[i] = cosf(r); ((float*)(F.ws + WS_SIN))[i] = sinf(r);
    }
    for (int l = 0; l < DEPTH; ++l) { u32x4* p = (u32x4*)(wl(F.ws, l, WL_IN) + (size_t)5280 * 1024 * 2); for (int i = gtid; i < 96 * 1024 * 2 / 16; i += NT_) p[i] = (u32x4){0u, 0u, 0u, 0u}; }
    {
        LAS float* scr = (LAS float*)(F.lds + F.wave * 16384);
        const int gw = F.bid * NWAVES + F.wave, NGW = F.G * NWAVES;
        constexpr int I_IN = 16 * 165, I_Q = 6 * 24, I_KV = 4 * 32, I_OH = 8 * 32, I_OM = 8 * 32, I_O = 16 * 32, I_GU = 32 * 16 * 64, I_DN = 32 * 16 * 32;
        constexpr int I_LAYER = I_IN + I_Q + I_KV + I_OH + I_OM + I_O + I_GU + I_DN;
        for (int it = gw; it < DEPTH * I_LAYER; it += NGW) {
            const int l = it / I_LAYER; int r = it - l * I_LAYER;
            if (r < I_IN) { conv_item(in[7] + (size_t)l * 1024 * 5280, 5280, nullptr, (bf16*)wl(F.ws, l, WL_IN), 1024, 0, MAP_WIN, scr, r / 165, r % 165, F.lane); continue; } r -= I_IN;
            if (r < I_Q) { conv_item(in[12] + (size_t)l * 384 * 768, 768, in[11] + l * 384, (bf16*)wl(F.ws, l, WL_Q), 384, 0, MAP_WQ, scr, r / 24, r % 24, F.lane); continue; } r -= I_Q;
            if (r < I_KV) { conv_item(in[14] + (size_t)l * 256 * 1024, 1024, in[13] + l * 256, (bf16*)wl(F.ws, l, WL_K), 256, 0, MAP_WKV, scr, r / 32, r % 32, F.lane); continue; } r -= I_KV;
            if (r < I_OH) { conv_item(in[10] + (size_t)l * 512 * 1024, 1024, nullptr, (bf16*)wl(F.ws, l, WL_OUT), 1024, 0, MAP_ID, scr, r / 32, r % 32, F.lane); continue; } r -= I_OH;
            if (r < I_OM) { conv_item(in[15] + (size_t)l * 512 * 1024, 1024, nullptr, (bf16*)wl(F.ws, l, WL_OUT), 1024, 512, MAP_ID, scr, r / 32, r % 32, F.lane); continue; } r -= I_OM;
            if (r < I_O) { conv_item(in[16] + (size_t)l * 1024 * 1024, 1024, nullptr, (bf16*)wl(F.ws, l, WL_O), 1024, 0, MAP_ID, scr, r / 32, r % 32, F.lane); continue; } r -= I_O;
            if (r < I_GU) { if (l > 0) continue; const int e = r / (16 * 64), q = r % (16 * 64); conv_item(in[19] + ((size_t)l * 32 + e) * 1024 * 2048, 2048, nullptr, (bf16*)wl(F.ws, l, WL_GU) + (size_t)e * 2048 * 1024, 1024, 0, MAP_GU, scr, q / 64, q % 64, F.lane); continue; } r -= I_GU;
            if (false) { const int e = r / (16 * 32), q = r % (16 * 32); conv_item(in[21] + ((size_t)l * 32 + e) * 1024 * 1024, 1024, nullptr, (bf16*)wl(F.ws, l, WL_DN) + (size_t)e * 1024 * 1024, 1024, 0, MAP_ID, scr, q / 32, q % 32, F.lane); }
        }
    }
}

constexpr int CV_GU = 32 * 16 * 64, CV_DN = 32 * 16 * 32, CV_TOTAL = CV_GU + CV_DN;
static_assert(CV_TOTAL % 16 == 0 && CV_GU % 16 == 0 && (CONV_Q) % 2 == 0, "conversion tickets");
template <int grab> __device__ __forceinline__ void conv_moe_stream(Frame& F, int l, int quota) {
    if (l >= DEPTH) return;
    unsigned* ctr = (unsigned*)(F.ws + WS_CTL) + CW_CONV + l * 64;
    LAS float* scr = (LAS float*)(F.lds + F.wave * 16384);
    volatile LAS unsigned* misc = (volatile LAS unsigned*)(F.lds + MISC_OFF);
    const float* const* in = F.in;
    constexpr int UNITS = CV_TOTAL / 16;
    const int ubase = (l == 0) ? CV_GU / 16 : 0;
    for (int q = 0; q < quota; ++q) {
        __syncthreads(); if (F.tid == 0) misc[1] = __hip_atomic_fetch_add(ctr, (unsigned)grab, __ATOMIC_RELAXED, __HIP_MEMORY_SCOPE_AGENT); __syncthreads();
        const int u0 = (int)misc[1] + ubase; if (u0 >= UNITS) break;
        const int u1 = u0 + grab < UNITS ? u0 + grab : UNITS;
#pragma unroll 1
        for (int u = u0; u < u1; ++u) {
            int r = u * 16 + F.wave * 2;
            if (r < CV_GU) { const int e = r >> 10, q2 = r & 1023; conv_pair(in[19] + ((size_t)l * 32 + e) * 1024 * 2048, 2048, (bf16*)wl(F.ws, l, WL_GU) + (size_t)e * 2048 * 1024, 1024, MAP_GU, scr, q2 >> 6, q2 & 63, (q2 + 1) >> 6, (q2 + 1) & 63, F.lane); }
            else { r -= CV_GU; const int e = r >> 9, q2 = r & 511; conv_pair(in[21] + ((size_t)l * 32 + e) * 1024 * 1024, 1024, (bf16*)wl(F.ws, l, WL_DN) + (size_t)e * 1024 * 1024, 1024, MAP_ID, scr, q2 >> 5, q2 & 31, (q2 + 1) >> 5, (q2 + 1) & 31, F.lane); }
        }
    }
    __syncthreads();
}
__device__ __forceinline__ int moe_missing(int Rtot, int NT, int G, int c) {
    const int spx = G >> 3, rpx = spx / NT, xcd = c & 7, slot = c >> 3, per = 8 * rpx;
    if (rpx < 1) return 0;
    const int maxn = (Rtot + per - 1) / per;
    const int first = xcd * rpx + slot / NT;
    const int mine = (slot >= rpx * NT || first >= Rtot) ? 0 : (Rtot - first + per - 1) / per;
    return maxn - mine;
}

__device__ __forceinline__ void p_norm_final(Frame& F, float* out) {
    const float* const* in = F.in;
    const bf16* X = (const bf16*)(F.ws + WS_X); const float* MOD = (const float*)(F.ws + WS_MOD); const unsigned char* YR = F.ws + WS_YR;
    int G_ = F.G; asm volatile("" : "+s"(G_));
    const int gw = F.bid * NWAVES + F.wave, NGW = G_ * NWAVES, per_wave = (T + NGW - 1) / NGW;
    constexpr int NB = 2;
    const int c0 = 4 * F.lane;
    f32x4 Gv[4], G2[4]; int bcur = -1;
    for (int q0 = 0; q0 < per_wave; q0 += NB) {
        const int t0 = __builtin_amdgcn_readfirstlane(gw * per_wave + q0); if (t0 >= T) break;
        u32x2 xr[NB][4]; unsigned yr[NB][4][4];
#pragma unroll
        for (int u = 0; u < NB; ++u) { const int t = (t0 + u < T) ? t0 + u : T - 1;
#pragma unroll
            for (int j = 0; j < 4; ++j) { xr[u][j] = *(const u32x2*)(X + (size_t)t * 1024 + c0 + 256 * j);
#pragma unroll
                for (int k = 0; k < 4; ++k) yr[u][j][k] = *(const unsigned*)(YR + ((size_t)t * 4 + k) * 1024 + c0 + 256 * j); } }
#pragma unroll
        for (int u = 0; u < NB; ++u) {
            const int t = t0 + u; if (q0 + u >= per_wave || t >= T) break;
            const int b = t >> 11; f32x4 v[4];
            if (b != bcur) { bcur = b; const float* g2 = MOD + ((size_t)(DEPTH - 1) * 8 + b) * 6144 + 5 * 1024;
#pragma unroll
                for (int j = 0; j < 4; ++j) { Gv[j] = *(const f32x4*)(in[23] + c0 + 256 * j); G2[j] = *(const f32x4*)(g2 + c0 + 256 * j); } }
            float ss = 0.f;
#pragma unroll
            for (int j = 0; j < 4; ++j) { const u32x2 w = xr[u][j]; v[j] = (f32x4){bflo(w.x), bfhi(w.x), bflo(w.y), bfhi(w.y)}; f32x4 s = {0.f, 0.f, 0.f, 0.f};
#pragma unroll
                for (int k = 0; k < 4; ++k) { const unsigned yw = yr[u][j][k];
                    s[0] += __builtin_amdgcn_cvt_f32_fp8(yw, 0); s[1] += __builtin_amdgcn_cvt_f32_fp8(yw, 1); s[2] += __builtin_amdgcn_cvt_f32_fp8(yw, 2); s[3] += __builtin_amdgcn_cvt_f32_fp8(yw, 3); }
                v[j] += G2[j] * s * YR_INV;
                ss += (v[j][0] * v[j][0] + v[j][1] * v[j][1]) + (v[j][2] * v[j][2] + v[j][3] * v[j][3]); }
            const float rs = rsqrtf(wave_sum(ss) * (1.0f / 1024.0f) + EPS);
#pragma unroll
            for (int j = 0; j < 4; ++j) *(f32x4*)(out + (size_t)t * 1024 + c0 + 256 * j) = v[j] * rs * Gv[j];
        }
    }
}
__device__ __forceinline__ void p_norm_mix(Frame& F, int l, bool fin, float* out, bool dummy = false) {
    const float* const* in = F.in;
    bf16* X = (bf16*)(F.ws + (dummy ? WS_ACT : WS_X));
    const float* MOD = (const float*)(F.ws + WS_MOD); const unsigned char* YR = F.ws + WS_YR; bf16* HB = (bf16*)(F.ws + (dummy ? WS_ACT + 64 * MiB : WS_HB));
    const int gw = F.bid * NWAVES + F.wave, NGW = F.G * NWAVES, per_wave = (T + NGW - 1) / NGW;
    constexpr int NB = 2;
    const int c0 = 8 * F.lane;
    f32x4 Gv[4], Sv[4], G2[4]; int bcur = -1;
    for (int q0 = 0; q0 < per_wave; q0 += NB) {
        const int t0 = __builtin_amdgcn_readfirstlane(gw * per_wave + q0); if (t0 >= T) break;
        u32x4 raw[NB][6];
#pragma unroll
        for (int u = 0; u < NB; ++u) { const int t = (t0 + u < T) ? t0 + u : T - 1;
            if (l == 0) {
#pragma unroll
                for (int j = 0; j < 4; ++j) raw[u][j] = *(const u32x4*)(in[0] + (size_t)t * 1024 + (j >> 1) * 512 + c0 + 4 * (j & 1));
            } else {
                raw[u][0] = *(const u32x4*)(X + (size_t)t * 1024 + c0); raw[u][1] = *(const u32x4*)(X + (size_t)t * 1024 + 512 + c0);
#pragma unroll
                for (int k = 0; k < 4; ++k) { const u32x2 ya = *(const u32x2*)(YR + ((size_t)t * 4 + k) * 1024 + c0), yb = *(const u32x2*)(YR + ((size_t)t * 4 + k) * 1024 + 512 + c0); raw[u][2 + k] = (u32x4){ya.x, ya.y, yb.x, yb.y}; }
            } }
#pragma unroll
        for (int u = 0; u < NB; ++u) {
            const int t = t0 + u; if (q0 + u >= per_wave || t >= T) break;
            const int b = t >> 11; f32x4 v[4];
            if (b != bcur) { bcur = b;
                const float* gn = fin ? in[23] : in[5] + (size_t)l * 1024; const float* sh = MOD + ((size_t)(fin ? 0 : l) * 8 + b) * 6144; const float* g2 = MOD + ((size_t)(l > 0 ? l - 1 : 0) * 8 + b) * 6144 + 5 * 1024;
#pragma unroll
                for (int j = 0; j < 4; ++j) { const int d = (j >> 1) * 512 + c0 + 4 * (j & 1); const f32x4 g = *(const f32x4*)(gn + d);
                    Gv[j] = fin ? g : g * (*(const f32x4*)(sh + 1024 + d) + 1.0f); Sv[j] = fin ? (f32x4){0.f, 0.f, 0.f, 0.f} : *(const f32x4*)(sh + d); G2[j] = *(const f32x4*)(g2 + d); } }
            if (l == 0) {
#pragma unroll
                for (int j = 0; j < 4; ++j) v[j] = __builtin_bit_cast(f32x4, raw[u][j]);
            } else {
                unpack8(raw[u][0], v[0], v[1]); unpack8(raw[u][1], v[2], v[3]);
#pragma unroll
                for (int j = 0; j < 4; ++j) { f32x4 s = {0.f, 0.f, 0.f, 0.f};
#pragma unroll
                    for (int k = 0; k < 4; ++k) { const unsigned w = raw[u][2 + k][j];
                        s[0] += __builtin_amdgcn_cvt_f32_fp8(w, 0); s[1] += __builtin_amdgcn_cvt_f32_fp8(w, 1); s[2] += __builtin_amdgcn_cvt_f32_fp8(w, 2); s[3] += __builtin_amdgcn_cvt_f32_fp8(w, 3); }
                    v[j] += G2[j] * s * YR_INV; }
            }
            float ss = 0.f;
#pragma unroll
            for (int j = 0; j < 4; ++j) ss += (v[j][0] * v[j][0] + v[j][1] * v[j][1]) + (v[j][2] * v[j][2] + v[j][3] * v[j][3]);
            const float rs = rsqrtf(wave_sum(ss) * (1.0f / 1024.0f) + EPS);
            if (fin) {
#pragma unroll
                for (int j = 0; j < 4; ++j) *(f32x4*)(out + (size_t)t * 1024 + (j >> 1) * 512 + c0 + 4 * (j & 1)) = v[j] * rs * Gv[j];
            } else {
                *(u32x4*)(X + (size_t)t * 1024 + c0) = pack8(v[0], v[1]); *(u32x4*)(X + (size_t)t * 1024 + 512 + c0) = pack8(v[2], v[3]);
                f32x4 h[4];
#pragma unroll
                for (int j = 0; j < 4; ++j) h[j] = v[j] * rs * Gv[j] + Sv[j];
                *(u32x4*)(HB + (size_t)t * 1024 + c0) = pack8(h[0], h[1]); *(u32x4*)(HB + (size_t)t * 1024 + 512 + c0) = pack8(h[2], h[3]);
            }
        }
    }
}
__device__ __forceinline__ void p_mla_prep(Frame& F) {
    const bf16* PROJ = (const bf16*)(F.ws + WS_PROJ); float* RSQ = (float*)(F.ws + WS_RSQ); float* RSKV = (float*)(F.ws + WS_RSKV); bf16* Kb = (bf16*)(F.ws + WS_K);
    const float* CS = (const float*)(F.ws + WS_COS); const float* SN = (const float*)(F.ws + WS_SIN);
    const int gw = F.bid * NWAVES + F.wave, NGW = F.G * NWAVES;
    const bool hq = F.lane < 48, hk = F.lane < 32, hp = F.lane < 16;
    for (int t0 = gw; t0 < T; t0 += 2 * NGW) {
        u32x4 rq[2], rk[2]; float x1[2], x2[2], co[2], si[2];
#pragma unroll
        for (int u = 0; u < 2; ++u) { const int t = (t0 + u * NGW < T) ? t0 + u * NGW : t0; const bf16* row = PROJ + (size_t)t * NPROJ;
            rq[u] = (u32x4){0u, 0u, 0u, 0u}; rk[u] = (u32x4){0u, 0u, 0u, 0u}; x1[u] = 0.f; x2[u] = 0.f; co[u] = 0.f; si[u] = 0.f;
            if (hq) rq[u] = *(const u32x4*)(row + PCQ + 8 * F.lane);
            if (hk) rk[u] = *(const u32x4*)(row + PCKV + 8 * F.lane);
            if (hp) { x1[u] = bf2f(row[PKPE + F.lane]); x2[u] = bf2f(row[PKPE + 16 + F.lane]); co[u] = CS[(size_t)t * 16 + F.lane]; si[u] = SN[(size_t)t * 16 + F.lane]; } }
#pragma unroll
        for (int u = 0; u < 2; ++u) { const int t = t0 + u * NGW; if (t >= T) break;
            f32x4 a0, a1, b0, b1; unpack8(rq[u], a0, a1); unpack8(rk[u], b0, b1);
            float sq = (a0[0] * a0[0] + a0[1] * a0[1]) + (a0[2] * a0[2] + a0[3] * a0[3]) + (a1[0] * a1[0] + a1[1] * a1[1]) + (a1[2] * a1[2] + a1[3] * a1[3]);
            float skv = (b0[0] * b0[0] + b0[1] * b0[1]) + (b0[2] * b0[2] + b0[3] * b0[3]) + (b1[0] * b1[0] + b1[1] * b1[1]) + (b1[2] * b1[2] + b1[3] * b1[3]);
            sq = wave_sum(sq); skv = wave_sum(skv);
            if (F.lane == 0) { RSQ[t] = rsqrtf(sq * (1.0f / 384.0f) + EPS); RSKV[t] = rsqrtf(skv * (1.0f / 256.0f) + EPS); }
            if (hp) {
                const bf16 o1 = (bf16)(pk2(x1[u] * co[u] - x2[u] * si[u], 0.f) & 0xffffu), o2 = (bf16)(pk2(x2[u] * co[u] + x1[u] * si[u], 0.f) & 0xffffu);
                const int b = t >> 11, sidx = t & 2047;
#pragma unroll
                for (int h = 0; h < 8; ++h) { bf16* kp = Kb + ((size_t)(b * 8 + h) * SEQ + sidx) * 96; kp[64 + F.lane] = o1; kp[80 + F.lane] = o2; }
            } }
    }
}
__device__ __forceinline__ void p_hgrn_post(Frame& F, int l) {
    const bf16* OFp = (const bf16*)(F.ws + WS_OF); const bf16* OBp = (const bf16*)(F.ws + WS_OB); const bf16* PROJ = (const bf16*)(F.ws + WS_PROJ); bf16* HA = (bf16*)(F.ws + WS_HA);
    const float* gn = F.in[9] + (size_t)l * 128;
    const int gw = F.bid * NWAVES + F.wave, NGW = F.G * NWAVES;
    const int c = 8 * F.lane;
    const f32x4 n0 = *(const f32x4*)(gn + (c & 127)), n1 = *(const f32x4*)(gn + (c & 127) + 4);
    for (int t0 = gw; t0 < T; t0 += 2 * NGW) {
        u32x4 ra[2], rb[2], rg[2];
#pragma unroll
        for (int u = 0; u < 2; ++u) { const int t = (t0 + u * NGW < T) ? t0 + u * NGW : t0;
            ra[u] = *(const u32x4*)(OFp + (size_t)t * 512 + c); rb[u] = *(const u32x4*)(OBp + (size_t)t * 512 + c); rg[u] = *(const u32x4*)(PROJ + (size_t)t * NPROJ + PGT + c); }
#pragma unroll
        for (int u = 0; u < 2; ++u) { const int t = t0 + u * NGW; if (t >= T) break;
            f32x4 a0, a1, b0, b1; unpack8(ra[u], a0, a1); unpack8(rb[u], b0, b1); a0 += b0; a1 += b1;
            float ss = (a0[0] * a0[0] + a0[1] * a0[1]) + (a0[2] * a0[2] + a0[3] * a0[3]) + (a1[0] * a1[0] + a1[1] * a1[1]) + (a1[2] * a1[2] + a1[3] * a1[3]);
#pragma unroll
            for (int o = 1; o < 16; o <<= 1) ss += __shfl_xor(ss, o);
            const float rs = rsqrtf(ss * (1.0f / 128.0f) + EPS);
            f32x4 g0, g1; unpack8(rg[u], g0, g1);
#pragma unroll
            for (int j = 0; j < 4; ++j) { a0[j] = a0[j] * rs * n0[j] * sigmoidf_(g0[j]); a1[j] = a1[j] * rs * n1[j] * sigmoidf_(g1[j]); }
            *(u32x4*)(HA + (size_t)t * 1024 + c) = pack8(a0, a1); }
    }
}

#define MFMA16(a, b, c) __builtin_amdgcn_mfma_f32_16x16x32_bf16((a), (b), (c), 0, 0, 0)
constexpr int SC_QROW = 272, SC_TROW = 144;
constexpr int SC_QT = 0, SC_KT = SC_QT + 64 * SC_QROW, SC_KH = SC_KT + 64 * SC_QROW, SC_VT = SC_KH + 128 * SC_TROW, SC_DEC = SC_VT + 128 * SC_TROW, SC_ZERO = SC_DEC + 4 * 128 * 4, SC_END = SC_ZERO + 64;
__device__ __forceinline__ unsigned rot16(unsigned x) { return (x >> 16) | (x << 16); }
constexpr int SC_OX = 73984;
static_assert(SC_OX >= SC_END && SC_OX % 16 == 0 && SC_OX + 32768 <= RING_BYTES, "scan LDS map");
__device__ __forceinline__ void scan_unit2(Frame& F, int l, int u) {
    const int dir = u & 1, hh = (u >> 1) & 3, b = u >> 3;
    const bf16* HTb = (const bf16*)(F.ws + WS_HT) + (size_t)b * NHT * SEQ;
    const bf16* qg = HTb + (size_t)(HQ + hh * 128) * SEQ; const bf16* fg = HTb + (size_t)((dir ? HFB : HFF) + hh * 128) * SEQ; const bf16* vg = HTb + (size_t)(HI + hh * 128) * SEQ;
    bf16* OUT = (bf16*)(F.ws + (dir ? WS_OB : WS_OF));
    LAS unsigned char* lds = F.lds;
    const int d = F.tid & 127, si = F.tid >> 7;
    const float lbv = ((const float*)(F.ws + WS_LB))[((size_t)l * 2 + dir) * 512 + hh * 128 + d];
    const int r = F.lane & 15, g = F.lane >> 4, vt = F.wave & 3, dh = F.wave >> 2;
    const int vcol = hh * 128 + 16 * vt;
    f32x4 S[2][4], ok[2][2];
#pragma unroll
    for (int h = 0; h < 2; ++h) {
#pragma unroll
        for (int i = 0; i < 4; ++i) S[h][i] = (f32x4){0.f, 0.f, 0.f, 0.f};
        ok[h][0] = (f32x4){0.f, 0.f, 0.f, 0.f}; ok[h][1] = (f32x4){0.f, 0.f, 0.f, 0.f}; }
    __syncthreads();
    if (F.tid < 16) *(LAS unsigned*)(lds + SC_ZERO + F.tid * 4) = 0u;
    u32x4 pq[2], pf[2], pv[2];
    const int vrow0 = F.tid >> 3, vmc = F.tid & 7;
    {   const int m0 = dir ? SEQ - 64 : 0; const int mb = dir ? m0 + 48 - 16 * si : m0 + 16 * si;
        pq[0] = *(const u32x4*)(qg + (size_t)d * SEQ + mb); pq[1] = *(const u32x4*)(qg + (size_t)d * SEQ + mb + 8);
        pf[0] = *(const u32x4*)(fg + (size_t)d * SEQ + mb); pf[1] = *(const u32x4*)(fg + (size_t)d * SEQ + mb + 8);
        pv[0] = *(const u32x4*)(vg + (size_t)vrow0 * SEQ + m0 + 8 * vmc); pv[1] = *(const u32x4*)(vg + (size_t)(vrow0 + 64) * SEQ + m0 + 8 * vmc); }
    int mprev = 0;
    if (F.wave >= 4) __builtin_amdgcn_s_setprio(1);
#pragma unroll 1
    for (int c = 0; c <= SEQ / 64; ++c) {
        const bool live = c < SEQ / 64;
        const int m0 = dir ? SEQ - 64 * (c + 1) : 64 * c;
        float qt[16], kt[16], E = 1.0f;
        if (live) {
            float rq[16], rf[16];
#pragma unroll
            for (int j = 0; j < 2; ++j) {
                rq[8 * j + 0] = bflo(pq[j].x); rq[8 * j + 1] = bfhi(pq[j].x); rq[8 * j + 2] = bflo(pq[j].y); rq[8 * j + 3] = bfhi(pq[j].y); rq[8 * j + 4] = bflo(pq[j].z); rq[8 * j + 5] = bfhi(pq[j].z); rq[8 * j + 6] = bflo(pq[j].w); rq[8 * j + 7] = bfhi(pq[j].w);
                rf[8 * j + 0] = bflo(pf[j].x); rf[8 * j + 1] = bfhi(pf[j].x); rf[8 * j + 2] = bflo(pf[j].y); rf[8 * j + 3] = bfhi(pf[j].y); rf[8 * j + 4] = bflo(pf[j].z); rf[8 * j + 5] = bfhi(pf[j].z); rf[8 * j + 6] = bflo(pf[j].w); rf[8 * j + 7] = bfhi(pf[j].w); }
#pragma unroll
            for (int k = 0; k < 16; ++k) {
                const float un = dir ? rf[15 - k] : rf[k], qs = dir ? rq[15 - k] : rq[k];
                const float kk = (1.0f - lbv) * un; E = fmaxf(E * (1.0f - kk), 1e-30f);
                qt[k] = qs * E; kt[k] = kk * __builtin_amdgcn_rcpf(E);
            }
        }
        __syncthreads();
        if (c > 0) {
#pragma unroll
            for (int h = 0; h < 2; ++h)
#pragma unroll
            for (int ii = 0; ii < 2; ++ii) { const int i = 2 * dh + ii;
                const f32x4 pp = *(const LAS f32x4*)(lds + SC_OX + ((((h * 2 + (1 - dh)) * 4 + vt) * 2 + ii) * 64 + F.lane) * 16);
                const int m = dir ? mprev + 63 - 16 * i - r : mprev + 16 * i + r;
                const f32x4 o = dh == 0 ? ok[h][ii] + pp : pp + ok[h][ii]; u32x2 w; w.x = pk2(o[0], o[1]); w.y = pk2(o[2], o[3]);
                *(u32x2*)(OUT + (size_t)(b * SEQ + m) * 512 + vcol + 64 * h + 4 * g) = w; }
        }
        if (!live) break;
        {   LAS unsigned char* qp = lds + SC_QT + (16 * si) * SC_QROW + d * 2; LAS unsigned char* kp = lds + SC_KT + (16 * si) * SC_QROW + d * 2;
#pragma unroll
            for (int k = 0; k < 16; k += 2) { const unsigned wq = pk2(qt[k], qt[k + 1]), wk = pk2(kt[k], kt[k + 1]);
                *(LAS unsigned short*)(qp + k * SC_QROW) = (unsigned short)wq; *(LAS unsigned short*)(qp + (k + 1) * SC_QROW) = (unsigned short)(wq >> 16);
                *(LAS unsigned short*)(kp + k * SC_QROW) = (unsigned short)wk; *(LAS unsigned short*)(kp + (k + 1) * SC_QROW) = (unsigned short)(wk >> 16); }
            u32x4 h0, h1;
            h0.x = pk2(kt[0] * E, kt[1] * E); h0.y = pk2(kt[2] * E, kt[3] * E); h0.z = pk2(kt[4] * E, kt[5] * E); h0.w = pk2(kt[6] * E, kt[7] * E);
            h1.x = pk2(kt[8] * E, kt[9] * E); h1.y = pk2(kt[10] * E, kt[11] * E); h1.z = pk2(kt[12] * E, kt[13] * E); h1.w = pk2(kt[14] * E, kt[15] * E);
            *(LAS u32x4*)(lds + SC_KH + d * SC_TROW + 32 * si) = h0; *(LAS u32x4*)(lds + SC_KH + d * SC_TROW + 32 * si + 16) = h1;
            *(LAS float*)(lds + SC_DEC + (si * 128 + d) * 4) = E;
#pragma unroll
            for (int h = 0; h < 2; ++h) { u32x4 w = pv[h]; int tl0 = 8 * vmc;
              if (dir) { w = (u32x4){rot16(pv[h].w), rot16(pv[h].z), rot16(pv[h].y), rot16(pv[h].x)}; tl0 = 56 - 8 * vmc; }
              *(LAS u32x4*)(lds + SC_VT + (vrow0 + 64 * h) * SC_TROW + tl0 * 2) = w; }
        }
        if (c + 1 < SEQ / 64) {
            const int m1 = dir ? SEQ - 64 * (c + 2) : 64 * (c + 1); const int mb = dir ? m1 + 48 - 16 * si : m1 + 16 * si;
            pq[0] = *(const u32x4*)(qg + (size_t)d * SEQ + mb); pq[1] = *(const u32x4*)(qg + (size_t)d * SEQ + mb + 8);
            pf[0] = *(const u32x4*)(fg + (size_t)d * SEQ + mb); pf[1] = *(const u32x4*)(fg + (size_t)d * SEQ + mb + 8);
            pv[0] = *(const u32x4*)(vg + (size_t)vrow0 * SEQ + m1 + 8 * vmc); pv[1] = *(const u32x4*)(vg + (size_t)(vrow0 + 64) * SEQ + m1 + 8 * vmc);
        }
        mprev = m0;
        __syncthreads();
        f32x4 oI[2][2];
#pragma unroll
        for (int ii = 0; ii < 2; ++ii) {
            const int i = 2 * dh + ii;
            const LAS unsigned char* qrow = lds + SC_QT + (16 * i + r) * SC_QROW; const LAS unsigned char* krow = lds + SC_KT + (16 * i + r) * SC_QROW;
            f32x4 pT = {0.f, 0.f, 0.f, 0.f};
#pragma unroll
            for (int ks = 0; ks < 4; ++ks) pT = MFMA16(*(const LAS bf16x8*)(krow + (32 * ks + 8 * g) * 2), *(const LAS bf16x8*)(qrow + (32 * ks + 8 * g) * 2), pT);
#pragma unroll
            for (int q = 0; q < 4; ++q) pT[q] = (4 * g + q <= r) ? pT[q] : 0.0f;
            const bf16x8 pfrag = __builtin_bit_cast(bf16x8, ((u32x4){pk2(pT[0], pT[1]), pk2(pT[2], pT[3]), 0u, 0u}));
#pragma unroll
            for (int h = 0; h < 2; ++h) {
                const u32x2 vt4 = *(const LAS u32x2*)(lds + SC_VT + (64 * h + 16 * vt + r) * SC_TROW + (16 * i + 4 * g) * 2);
                oI[h][ii] = MFMA16(__builtin_bit_cast(bf16x8, ((u32x4){vt4.x, vt4.y, 0u, 0u})), pfrag, ((f32x4){0.f, 0.f, 0.f, 0.f})); }
        }
        const bool zl = (g >= 2);
#pragma unroll
        for (int i = 0; i < 4; ++i) {
            const LAS unsigned char* qrow = lds + SC_QT + (16 * i + r) * SC_QROW + (64 * dh) * 2;
            const bool mine = (i >> 1) == dh;
            f32x4 o[2];
#pragma unroll
            for (int h = 0; h < 2; ++h) o[h] = mine ? oI[h][i & 1] : (f32x4){0.f, 0.f, 0.f, 0.f};
#pragma unroll
            for (int kk = 0; kk < 2; ++kk) {
                const u32x2 qa = *(const LAS u32x2*)(qrow + (32 * kk + 4 * g) * 2), qb = *(const LAS u32x2*)(qrow + (32 * kk + 16 + 4 * g) * 2);
                const bf16x8 qfrag = __builtin_bit_cast(bf16x8, ((u32x4){qa.x, qa.y, qb.x, qb.y}));
#pragma unroll
                for (int h = 0; h < 2; ++h) {
                    const bf16x8 sfrag = __builtin_bit_cast(bf16x8, ((u32x4){pk2(S[h][2 * kk][0], S[h][2 * kk][1]), pk2(S[h][2 * kk][2], S[h][2 * kk][3]), pk2(S[h][2 * kk + 1][0], S[h][2 * kk + 1][1]), pk2(S[h][2 * kk + 1][2], S[h][2 * kk + 1][3])}));
                    o[h] = MFMA16(sfrag, qfrag, o[h]); }
            }
#pragma unroll
            for (int h = 0; h < 2; ++h) {
                if (mine) ok[h][i & 1] = o[h];
                else *(LAS f32x4*)(lds + SC_OX + ((((h * 2 + dh) * 4 + vt) * 2 + (i & 1)) * 64 + F.lane) * 16) = o[h]; }
            bf16x8 vfrag[2];
#pragma unroll
            for (int h = 0; h < 2; ++h) { const LAS unsigned char* vtp = zl ? lds + SC_ZERO : lds + SC_VT + (64 * h + 16 * vt + r) * SC_TROW + (16 * i + 8 * g) * 2; vfrag[h] = *(const LAS bf16x8*)vtp; }
#pragma unroll
            for (int dt = 0; dt < 4; ++dt) {
                const f32x4 dec = *(const LAS f32x4*)(lds + SC_DEC + (i * 128 + 64 * dh + 16 * dt + 4 * g) * 4);
                const LAS unsigned char* khp = zl ? lds + SC_ZERO : lds + SC_KH + (64 * dh + 16 * dt + r) * SC_TROW + (16 * i + 8 * g) * 2;
                const bf16x8 kfrag = *(const LAS bf16x8*)khp;
#pragma unroll
                for (int h = 0; h < 2; ++h) S[h][dt] = MFMA16(kfrag, vfrag[h], S[h][dt] * dec);
            }
        }
    }
    __builtin_amdgcn_s_setprio(0);
    __syncthreads();
}

#define MFMA32(a, b, c) __builtin_amdgcn_mfma_f32_32x32x16_bf16((a), (b), (c), 0, 0, 0)
constexpr int AT_KROW = 208, AT_VROW = 136, AT_KBYTES = 64 * AT_KROW, AT_BUF = AT_KBYTES + 64 * AT_VROW;
__device__ __forceinline__ void attn_stream(Frame& F, unsigned* qctr, volatile LAS unsigned* misc) {
    const GAS bf16* Q = (const GAS bf16*)(F.ws + WS_Q); const GAS char* Kall = (const GAS char*)(F.ws + WS_K); const GAS char* Vall = (const GAS char*)(F.ws + WS_VT);
    unsigned pend_ = 0u; if (F.tid == 0) pend_ = __hip_atomic_fetch_add(qctr, 1u, __ATOMIC_RELAXED, __HIP_MEMORY_SCOPE_AGENT);
    __syncthreads(); if (F.tid == 0) misc[0] = pend_; __syncthreads();
    int a_ = __builtin_amdgcn_readfirstlane((int)misc[0]); if (a_ >= 512 * ATTN_REP) return;
    int bh = (a_ & 511) >> 3, q0 = (a_ & 7) * 256;
    const GAS char* Kg = Kall + (size_t)bh * SEQ * 96 * 2; const GAS char* Vg = Vall + (size_t)bh * 64 * SEQ * 2;
    GAS bf16* HA = (GAS bf16*)(F.ws + WS_HA);
    LAS unsigned char* lds = F.lds;
    const int r = F.lane & 31, h = F.lane >> 5;
    bf16x8 qf[6];
    { const GAS bf16* qrow = Q + ((size_t)bh * SEQ + q0 + F.wave * 32 + r) * 96;
#pragma unroll
      for (int ks = 0; ks < 6; ++ks) qf[ks] = *(const GAS bf16x8*)(qrow + 16 * ks + 8 * h); }
    f32x16 o0, o1;
    float mref = 0.f, lsum = 0.f;
    const int kc0 = F.tid, kc1 = F.tid + 512; const bool has1 = F.tid < 256;
    const int kl0 = (kc0 / 12) * AT_KROW + (kc0 % 12) * 16, kl1 = (kc1 / 12) * AT_KROW + (kc1 % 12) * 16;
    const int vrow = F.tid >> 3, vpc = F.tid & 7; const int vl = AT_KBYTES + vrow * AT_VROW + vpc * 16;
    u32x4 rk0, rk1 = {0u, 0u, 0u, 0u}, rv;
    rk0 = *(const GAS u32x4*)(Kg + (size_t)kc0 * 16); if (has1) rk1 = *(const GAS u32x4*)(Kg + (size_t)kc1 * 16);
    rv = *(const GAS u32x4*)(Vg + (size_t)vrow * SEQ * 2 + vpc * 16);
    *(LAS u32x4*)(lds + kl0) = rk0; if (has1) *(LAS u32x4*)(lds + kl1) = rk1;
    *(LAS u32x2*)(lds + vl) = (u32x2){rv.x, rv.y}; *(LAS u32x2*)(lds + vl + 8) = (u32x2){rv.z, rv.w};
    __syncthreads();
    for (;;) {
    if (F.tid == 0) pend_ = __hip_atomic_fetch_add(qctr, 1u, __ATOMIC_RELAXED, __HIP_MEMORY_SCOPE_AGENT);
    int an_ = 1 << 30; bool more_ = false; bf16x8 qn[6]; const GAS char* Kn = Kg; const GAS char* Vn = Vg; int bhn = bh, q0n = q0;
#pragma unroll
    for (int i = 0; i < 16; ++i) { o0[i] = 0.f; o1[i] = 0.f; }
    mref = 0.f; lsum = 0.f;
    if (F.wave >= 4) __builtin_amdgcn_s_setprio(1);
    for (int j = 0; j < SEQ / 64; ++j) {
        if (j == 16 && F.tid == 0) misc[0] = pend_;
        if (j == 17) { an_ = __builtin_amdgcn_readfirstlane((int)misc[0]); more_ = an_ < 512 * ATTN_REP;
            if (more_) { bhn = (an_ & 511) >> 3; q0n = (an_ & 7) * 256; Kn = Kall + (size_t)bhn * SEQ * 96 * 2; Vn = Vall + (size_t)bhn * 64 * SEQ * 2; } }
        const int buf = (j & 1) * AT_BUF, nbuf = ((j + 1) & 1) * AT_BUF;
        if (j + 1 < SEQ / 64) {
            const GAS char* kg = Kg + (size_t)(j + 1) * 64 * 96 * 2;
            rk0 = *(const GAS u32x4*)(kg + (size_t)kc0 * 16); if (has1) rk1 = *(const GAS u32x4*)(kg + (size_t)kc1 * 16);
            rv = *(const GAS u32x4*)(Vg + (size_t)vrow * SEQ * 2 + (size_t)(j + 1) * 128 + vpc * 16);
        } else if (more_) {
            rk0 = *(const GAS u32x4*)(Kn + (size_t)kc0 * 16); if (has1) rk1 = *(const GAS u32x4*)(Kn + (size_t)kc1 * 16);
            rv = *(const GAS u32x4*)(Vn + (size_t)vrow * SEQ * 2 + vpc * 16);
            const GAS bf16* qrow = Q + ((size_t)bhn * SEQ + q0n + F.wave * 32 + r) * 96;
#pragma unroll
            for (int ks = 0; ks < 6; ++ks) qn[ks] = *(const GAS bf16x8*)(qrow + 16 * ks + 8 * h);
        }
        f32x16 s0, s1;
#pragma unroll
        for (int i = 0; i < 16; ++i) { s0[i] = -mref; s1[i] = -mref; }
#pragma unroll
        for (int ks = 0; ks < 6; ++ks) {
            const bf16x8 k0 = *(const LAS bf16x8*)(lds + buf + r * AT_KROW + (16 * ks + 8 * h) * 2);
            const bf16x8 k1 = *(const LAS bf16x8*)(lds + buf + (32 + r) * AT_KROW + (16 * ks + 8 * h) * 2);
            s0 = MFMA32(k0, qf[ks], s0); s1 = MFMA32(k1, qf[ks], s1);
        }
        float mx = s0[0];
#pragma unroll
        for (int i = 1; i < 16; ++i) mx = fmaxf(mx, s0[i]);
#pragma unroll
        for (int i = 0; i < 16; ++i) mx = fmaxf(mx, s1[i]);
        mx = fmaxf(mx, __shfl_xor(mx, 32));
        const bool grow = (j == 0) || (mx > 8.0f);
        if (__builtin_amdgcn_ballot_w64(grow) != 0ull) {
            const float dlt = grow ? mx : 0.0f, fsc = __builtin_amdgcn_exp2f(-dlt); mref += dlt; lsum *= fsc;
#pragma unroll
            for (int i = 0; i < 16; ++i) { s0[i] -= dlt; s1[i] -= dlt; o0[i] *= fsc; o1[i] *= fsc; } }
        float ps = 0.f;
#pragma unroll
        for (int i = 0; i < 16; ++i) { s0[i] = __builtin_amdgcn_exp2f(s0[i]); s1[i] = __builtin_amdgcn_exp2f(s1[i]); ps += s0[i] + s1[i]; }
        lsum += ps;
        bf16x8 pf[2][2];
#pragma unroll
        for (int sp = 0; sp < 2; ++sp) {
            u32x4 w0, w1;
            w0.x = pk2(s0[8 * sp + 0], s0[8 * sp + 1]); w0.y = pk2(s0[8 * sp + 2], s0[8 * sp + 3]); w0.z = pk2(s0[8 * sp + 4], s0[8 * sp + 5]); w0.w = pk2(s0[8 * sp + 6], s0[8 * sp + 7]);
            w1.x = pk2(s1[8 * sp + 0], s1[8 * sp + 1]); w1.y = pk2(s1[8 * sp + 2], s1[8 * sp + 3]); w1.z = pk2(s1[8 * sp + 4], s1[8 * sp + 5]); w1.w = pk2(s1[8 * sp + 6], s1[8 * sp + 7]);
            pf[0][sp] = __builtin_bit_cast(bf16x8, w0); pf[1][sp] = __builtin_bit_cast(bf16x8, w1);
        }
#pragma unroll
        for (int kb = 0; kb < 2; ++kb)
#pragma unroll
            for (int sp = 0; sp < 2; ++sp) {
                const int kbase = (32 * kb + 16 * sp + 4 * h) * 2;
                const LAS unsigned char* v0p = lds + buf + AT_KBYTES + r * AT_VROW + kbase;
                const LAS unsigned char* v1p = lds + buf + AT_KBYTES + (32 + r) * AT_VROW + kbase;
                const u32x2 a0 = *(const LAS u32x2*)v0p, a1 = *(const LAS u32x2*)(v0p + 16), c0 = *(const LAS u32x2*)v1p, c1 = *(const LAS u32x2*)(v1p + 16);
                const bf16x8 vf0 = __builtin_bit_cast(bf16x8, ((u32x4){a0.x, a0.y, a1.x, a1.y})), vf1 = __builtin_bit_cast(bf16x8, ((u32x4){c0.x, c0.y, c1.x, c1.y}));
                o0 = MFMA32(vf0, pf[kb][sp], o0); o1 = MFMA32(vf1, pf[kb][sp], o1);
            }
        if (j + 1 < SEQ / 64 || more_) {
            *(LAS u32x4*)(lds + nbuf + kl0) = rk0; if (has1) *(LAS u32x4*)(lds + nbuf + kl1) = rk1;
            *(LAS u32x2*)(lds + nbuf + vl) = (u32x2){rv.x, rv.y}; *(LAS u32x2*)(lds + nbuf + vl + 8) = (u32x2){rv.z, rv.w};
        }
        __syncthreads();
    }
    lsum += __shfl_xor(lsum, 32);
    __builtin_amdgcn_s_setprio(0);
    const float inv = 1.0f / lsum;
    const int head = bh & 7, b = bh >> 3;
    GAS bf16* orow = HA + (size_t)(b * SEQ + q0 + F.wave * 32 + r) * 1024 + 512 + head * 64;
#pragma unroll
    for (int i = 0; i < 4; ++i) {
        u32x2 w0, w1;
        w0.x = pk2(o0[4 * i] * inv, o0[4 * i + 1] * inv); w0.y = pk2(o0[4 * i + 2] * inv, o0[4 * i + 3] * inv);
        w1.x = pk2(o1[4 * i] * inv, o1[4 * i + 1] * inv); w1.y = pk2(o1[4 * i + 2] * inv, o1[4 * i + 3] * inv);
        *(GAS u32x2*)(orow + 8 * i + 4 * h) = w0; *(GAS u32x2*)(orow + 32 + 8 * i + 4 * h) = w1;
    }
    if (!more_) break;
    bh = bhn; q0 = q0n; Kg = Kn; Vg = Vn;
#pragma unroll
    for (int ks = 0; ks < 6; ++ks) qf[ks] = qn[ks];
    }
}

constexpr int RTW_LO = 65536, RT_EX = 131072, RT_CP = 151552, RT_CE = 153600, RT_SS = 153728;
static_assert(RT_EX + 8192 <= LDSCTL_OFF && RT_SS + 512 <= LDS_BYTES && RT_S_OFF + 4096 <= RT_CP, "router LDS map");
__device__ __forceinline__ int rt_f(int e) { return ((e >> 2) & 3) | (((e ^ (e >> 4)) & 1) << 2) | (((e >> 1) & 1) << 3); }
__device__ __forceinline__ void p_router(Frame& F, int l, bool dummy = false) {
    const float* const* in = F.in;
    const bf16* X = (const bf16*)(F.ws + WS_X); const float* MOD = (const float*)(F.ws + WS_MOD); bf16* HB = (bf16*)(F.ws + WS_HB);
    int* LIST = (int*)(F.ws + (dummy ? WS_Y : WS_LIST)); float* LW = (float*)(F.ws + (dummy ? WS_Y + 4 * MiB : WS_LW)); unsigned* CNT = (unsigned*)(F.ws + WS_CTL) + CW_CNT + (l + (dummy ? 4 : 0)) * 32 * 64;
    LAS unsigned char* lds = F.lds;
    const float* wr = in[17] + (size_t)l * 1024 * 32; const float* gn = in[6] + (size_t)l * 1024; const float* br = in[18] + (size_t)l * 32;
    LAS unsigned* lcnt = (LAS unsigned*)(lds + MOE_OFF + 512); LAS unsigned* lbase = lcnt + 32;
    int cur_b = -1;
    for (int tile = F.bid; tile < T / 64; tile += F.G) {
        int tid = F.tid; asm volatile("" : "+v"(tid));
        const int lane = tid & 63, wv = tid >> 6, r = lane & 15, g = lane >> 4, tt = wv & 3, kh = wv >> 2;
        const int b = tile >> 5; const int t = tile * 64 + 16 * tt + r;
        u32x4 xf[16];
        {   const bf16* xrow = X + (size_t)t * 1024 + kh * 512 + 8 * g;
#pragma unroll
            for (int ks = 0; ks < 16; ++ks) xf[ks] = *(const u32x4*)(xrow + 32 * ks); }
        __syncthreads();
        if (b != cur_b) {
            cur_b = b;
            const float* sh = MOD + ((size_t)l * 8 + b) * 6144 + 3 * 1024;
            for (int d = tid; d < 1024; d += 512) { *(LAS float*)(lds + RT_G_OFF + d * 4) = gn[d] * (sh[1024 + d] + 1.0f); *(LAS float*)(lds + RT_S_OFF + d * 4) = sh[d]; }
            __syncthreads();
#pragma unroll 2
            for (int q = tid; q < 4096; q += 512) {
                const int kp = q >> 3, c = q & 7;
                const f32x4 w0 = *(const f32x4*)(wr + (size_t)(2 * kp) * 32 + 4 * c), w1 = *(const f32x4*)(wr + (size_t)(2 * kp + 1) * 32 + 4 * c);
                const float g0 = *(const LAS float*)(lds + RT_G_OFF + (2 * kp) * 4), g1 = *(const LAS float*)(lds + RT_G_OFF + (2 * kp + 1) * 4);
#pragma unroll
                for (int j = 0; j < 4; ++j) { const int e = 4 * c + j; const float a0 = w0[j] * g0, a1 = w1[j] * g1;
                    const unsigned hi = pk2(a0, a1); const unsigned lo = pk2(a0 - bflo(hi), a1 - bfhi(hi));
                    const int off = e * 2048 + (((kp >> 2) ^ rt_f(e)) << 4) + (kp & 3) * 4;
                    *(LAS unsigned*)(lds + off) = hi; *(LAS unsigned*)(lds + RTW_LO + off) = lo; }
            }
            {
                const int e4 = tid & 7, kg = tid >> 3; f32x4 wv[16]; f32x4 cp = {0.f, 0.f, 0.f, 0.f};
#pragma unroll
                for (int i = 0; i < 16; ++i) wv[i] = *(const f32x4*)(wr + (size_t)(kg * 16 + i) * 32 + 4 * e4);
#pragma unroll
                for (int i = 0; i < 16; ++i) cp += *(const LAS float*)(lds + RT_S_OFF + (kg * 16 + i) * 4) * wv[i];
                *(LAS f32x4*)(lds + RT_EX + (kg * 32 + 4 * e4) * 4) = cp; }
            __syncthreads();
            if (tid < 32) { float sc = br[tid];
#pragma unroll 16
                for (int kg = 0; kg < 64; ++kg) sc += *(const LAS float*)(lds + RT_EX + (kg * 32 + tid) * 4);
                *(LAS float*)(lds + RT_CE + tid * 4) = sc; }
        }
        if (tid < 32) lcnt[tid] = 0u;
        __syncthreads();
        f32x4 acc0 = {0.f, 0.f, 0.f, 0.f}, acc1 = {0.f, 0.f, 0.f, 0.f}; float ss = 0.f;
        {   const int f0 = rt_f(r), f1 = rt_f(16 + r);
            const LAS unsigned char* row0 = lds + r * 2048; const LAS unsigned char* row1 = lds + (16 + r) * 2048;
#pragma unroll
            for (int ks = 0; ks < 16; ++ks) {
                const int ch = kh * 64 + 4 * ks + g; const int o0 = (ch ^ f0) << 4, o1 = (ch ^ f1) << 4;
                const bf16x8 xb = __builtin_bit_cast(bf16x8, xf[ks]);
                acc0 = MFMA16(*(const LAS bf16x8*)(row0 + o0), xb, acc0); acc0 = MFMA16(*(const LAS bf16x8*)(row0 + RTW_LO + o0), xb, acc0);
                acc1 = MFMA16(*(const LAS bf16x8*)(row1 + o1), xb, acc1); acc1 = MFMA16(*(const LAS bf16x8*)(row1 + RTW_LO + o1), xb, acc1);
                f32x4 v0, v1; unpack8(xf[ks], v0, v1);
                ss += (v0[0] * v0[0] + v0[1] * v0[1]) + (v0[2] * v0[2] + v0[3] * v0[3]) + (v1[0] * v1[0] + v1[1] * v1[1]) + (v1[2] * v1[2] + v1[3] * v1[3]);
                if (ks & 1) asm volatile("" ::: "memory");
            } }
        ss += __shfl_xor(ss, 16); ss += __shfl_xor(ss, 32);
        if (g == 0) *(LAS float*)(lds + RT_SS + ((kh * 4 + tt) * 16 + r) * 4) = ss;
        if (kh == 1) { *(LAS f32x4*)(lds + RT_EX + (tt * 64 + lane) * 32) = acc0; *(LAS f32x4*)(lds + RT_EX + (tt * 64 + lane) * 32 + 16) = acc1; }
        __syncthreads();
        const float rs = rsqrtf((*(const LAS float*)(lds + RT_SS + ((0 * 4 + tt) * 16 + r) * 4) + *(const LAS float*)(lds + RT_SS + ((1 * 4 + tt) * 16 + r) * 4)) * (1.0f / 1024.0f) + EPS);
#pragma unroll
        for (int ks = 0; ks < 16; ++ks) {
            const int d = kh * 512 + 32 * ks + 8 * g;
            f32x4 v0, v1; unpack8(xf[ks], v0, v1);
            v0 = v0 * rs * *(const LAS f32x4*)(lds + RT_G_OFF + d * 4) + *(const LAS f32x4*)(lds + RT_S_OFF + d * 4);
            v1 = v1 * rs * *(const LAS f32x4*)(lds + RT_G_OFF + d * 4 + 16) + *(const LAS f32x4*)(lds + RT_S_OFF + d * 4 + 16);
            *(u32x4*)(HB + (size_t)t * 1024 + d) = pack8(v0, v1);
            if (ks & 1) asm volatile("" ::: "memory");
        }
        float lg[8], wk[8]; int rank[8]; unsigned lslot[8];
        int gq = g; asm volatile("" : "+v"(gq));
        if (kh == 0) {
            const f32x4 p0 = *(const LAS f32x4*)(lds + RT_EX + (tt * 64 + lane) * 32), p1 = *(const LAS f32x4*)(lds + RT_EX + (tt * 64 + lane) * 32 + 16);
            const f32x4 c0 = *(const LAS f32x4*)(lds + RT_CE + (4 * gq) * 4), c1 = *(const LAS f32x4*)(lds + RT_CE + (16 + 4 * gq) * 4);
#pragma unroll
            for (int j = 0; j < 4; ++j) { lg[j] = rs * (acc0[j] + p0[j]) + c0[j]; lg[4 + j] = rs * (acc1[j] + p1[j]) + c1[j]; rank[j] = 0; rank[4 + j] = 0; }
#if RT_DEBUG == 1
            {   float dl[8];
#pragma unroll
                for (int j = 0; j < 8; ++j) dl[j] = 0.f;
                for (int k = 0; k < 1024; ++k) { const float xv = __uint_as_float(((unsigned)((const unsigned short*)X)[(size_t)t * 1024 + k]) << 16);
                    const float v = xv * rs * *(const LAS float*)(lds + RT_G_OFF + k * 4) + *(const LAS float*)(lds + RT_S_OFF + k * 4);
#pragma unroll
                    for (int j = 0; j < 8; ++j) dl[j] += v * wr[(size_t)k * 32 + (j < 4 ? 0 : 16) + 4 * gq + (j & 3)]; }
#pragma unroll
                for (int j = 0; j < 8; ++j) lg[j] = dl[j] + br[(j < 4 ? 0 : 16) + 4 * gq + (j & 3)];
            }
#endif
#if RT_DEBUG == 3 || RT_DEBUG == 4
            {   float dl[8];
#pragma unroll
                for (int j = 0; j < 8; ++j) dl[j] = 0.f;
                const int kb = (RT_DEBUG == 3) ? 512 : 0;
                for (int k = kb; k < kb + 512; ++k) { const float xv = __uint_as_float(((unsigned)((const unsigned short*)X)[(size_t)t * 1024 + k]) << 16);
                    const float v = xv * *(const LAS float*)(lds + RT_G_OFF + k * 4);
#pragma unroll
                    for (int j = 0; j < 8; ++j) dl[j] += v * wr[(size_t)k * 32 + (j < 4 ? 0 : 16) + 4 * gq + (j & 3)]; }
#pragma unroll
                for (int j = 0; j < 4; ++j) {
                    if (RT_DEBUG == 3) { lg[j] = rs * (acc0[j] + dl[j]) + c0[j]; lg[4 + j] = rs * (acc1[j] + dl[4 + j]) + c1[j]; }
                    else { lg[j] = rs * (dl[j] + p0[j]) + c0[j]; lg[4 + j] = rs * (dl[4 + j] + p1[j]) + c1[j]; } }
            }
#endif
#if RT_DEBUG == 5
            {   float dl[8];
#pragma unroll
                for (int j = 0; j < 8; ++j) dl[j] = 0.f;
                for (int k = 0; k < 1024; ++k) { const float xv = __uint_as_float(((unsigned)((const unsigned short*)X)[(size_t)t * 1024 + k]) << 16);
#pragma unroll
                    for (int j = 0; j < 8; ++j) { const int e = (j < 4 ? 0 : 16) + 4 * gq + (j & 3); const int off = e * 2048 + (((k >> 3) ^ rt_f(e)) << 4) + (k & 7) * 2;
                        const float wh = __uint_as_float(((unsigned)*(const LAS unsigned short*)(lds + off)) << 16), wl = __uint_as_float(((unsigned)*(const LAS unsigned short*)(lds + RTW_LO + off)) << 16);
                        dl[j] += xv * (wh + wl); } }
#pragma unroll
                for (int j = 0; j < 4; ++j) { lg[j] = rs * dl[j] + c0[j]; lg[4 + j] = rs * dl[4 + j] + c1[j]; }
            }
#endif
#if RT_DEBUG == 2
            {   float dl[8];
#pragma unroll
                for (int j = 0; j < 8; ++j) dl[j] = 0.f;
                for (int k = 0; k < 1024; ++k) { const float xv = __uint_as_float(((unsigned)((const unsigned short*)X)[(size_t)t * 1024 + k]) << 16);
                    const float v = xv * *(const LAS float*)(lds + RT_G_OFF + k * 4);
#pragma unroll
                    for (int j = 0; j < 8; ++j) dl[j] += v * wr[(size_t)k * 32 + (j < 4 ? 0 : 16) + 4 * gq + (j & 3)]; }
#pragma unroll
                for (int j = 0; j < 4; ++j) { lg[j] = rs * dl[j] + c0[j]; lg[4 + j] = rs * dl[4 + j] + c1[j]; }
            }
#endif
#pragma unroll
            for (int j = 0; j < 8; ++j)
#pragma unroll
                for (int i = 0; i < 8; ++i) if (i != j) rank[j] += (lg[i] > lg[j] || (lg[i] == lg[j] && i < j)) ? 1 : 0;
#pragma unroll
            for (int x = 1; x < 4; ++x) {
                const bool glow = (gq ^ x) < gq;
#pragma unroll
                for (int i = 0; i < 8; ++i) { const float ov = __shfl_xor(lg[i], 16 * x);
#pragma unroll
                    for (int j = 0; j < 8; ++j) { const bool lower = (i < 4 && j >= 4) ? true : (i >= 4 && j < 4) ? false : glow;
                        rank[j] += (ov > lg[j] || (ov == lg[j] && lower)) ? 1 : 0; } }
            }
            float mx = lg[0];
#pragma unroll
            for (int j = 1; j < 8; ++j) mx = fmaxf(mx, lg[j]);
            mx = fmaxf(mx, __shfl_xor(mx, 16)); mx = fmaxf(mx, __shfl_xor(mx, 32));
            float den = 0.f;
#pragma unroll
            for (int j = 0; j < 8; ++j) { wk[j] = rank[j] < 4 ? __expf(lg[j] - mx) : 0.f; den += wk[j]; }
            den += __shfl_xor(den, 16); den += __shfl_xor(den, 32);
            const float invs = 1.0f / den;
#pragma unroll
            for (int j = 0; j < 8; ++j) { wk[j] *= invs; lslot[j] = 0u;
                if (rank[j] < 4) lslot[j] = __hip_atomic_fetch_add(lcnt + ((j < 4 ? 0 : 16) + 4 * gq + (j & 3)), 1u, __ATOMIC_RELAXED, __HIP_MEMORY_SCOPE_WORKGROUP); }
        }
        __syncthreads();
        if (tid < 32) { const unsigned c = lcnt[tid]; lbase[tid] = c ? __hip_atomic_fetch_add(CNT + tid * 64, c, __ATOMIC_RELAXED, __HIP_MEMORY_SCOPE_AGENT) : 0u; }
        __syncthreads();
        if (kh == 0) {
#pragma unroll
            for (int j = 0; j < 8; ++j) if (rank[j] < 4) { const int e = (j < 4 ? 0 : 16) + 4 * gq + (j & 3); const unsigned slot = lbase[e] + lslot[j]; const int a = t * 4 + rank[j];
                LIST[(size_t)e * T + slot] = a; LW[(size_t)e * T + slot] = wk[j]; }
        }
    }
    __syncthreads();
}
__device__ __forceinline__ void moe_tables(Frame& F, int l) {
    LAS int* cnt = (LAS int*)(F.lds + MOE_OFF); LAS int* toff = cnt + 32;
    const unsigned* CNT = (const unsigned*)(F.ws + WS_CTL) + CW_CNT + l * 32 * 64;
    __syncthreads();
    if (F.tid < 32) cnt[F.tid] = (int)__hip_atomic_load(CNT + F.tid * 64, __ATOMIC_RELAXED, __HIP_MEMORY_SCOPE_AGENT);
    __syncthreads();
    if (F.tid == 0) { int s = 0; for (int e = 0; e < 32; ++e) { toff[e] = s; s += (cnt[e] + 255) >> 8; } toff[32] = s; }
    __syncthreads();
}

constexpr int NPH = 11, PH_FINAL = 1 + DEPTH * NPH, PH_TOTAL = PH_FINAL + 1;
__global__ void __launch_bounds__(NWAVES * 64, 2) fwd_kernel(Args args) {
    extern __shared__ __attribute__((aligned(16))) unsigned char lds_raw[];
    Frame F;
    F.lds = (LAS unsigned char*)lds_raw; F.ws = args.ws; F.tid = threadIdx.x; F.lane = F.tid & 63; F.wave = __builtin_amdgcn_readfirstlane(F.tid >> 6); F.G = gridDim.x; F.bid = blockIdx.x; F.in = args.in;
    for (int u = F.tid; u < (LDS_BYTES - LDSCTL_OFF) / 4; u += NWAVES * 64) ((LAS unsigned*)(F.lds + LDSCTL_OFF))[u] = 0u;
    __syncthreads();
    const int lo = args.ph_lo, hi = args.ph_hi;
    const unsigned long long tk0_ = (TIME_KIND == 98) ? __builtin_amdgcn_s_memrealtime() : 0ull; unsigned long long tbar_ = 0ull;
    XcdBarrier bar; bar.bar = (unsigned*)(F.ws + WS_CTL) + CW_BAR; bar.x = 0; bar.st = nullptr;
    if (hi - lo > 1) bar = xcd_barrier_post((unsigned*)(F.ws + WS_CTL) + CW_BAR, (volatile LAS unsigned*)(F.lds + MISC_OFF) + 8);
#define IN(k) (lo <= (k) && (k) < hi)
#define PROJ ((bf16*)(ws + WS_PROJ))
#define SEAM(k) do { if (IN(k) && IN((k) + 1)) { const bool acc_ = (TIME_KIND == 97) && ((TIME_MASK >> ((((k) + NPH - 1) % NPH) + 1)) & 1); const unsigned long long tb0_ = acc_ ? __builtin_amdgcn_s_memrealtime() : 0ull; xcd_barrier(bar); if (acc_) tbar_ += __builtin_amdgcn_s_memrealtime() - tb0_; } } while (0)
#define TSTART(kind) unsigned long long t0_ = (TIME_KIND == (kind) || TIME_KIND == 99) ? __builtin_amdgcn_s_memrealtime() : 0ull
#define TSTALL(kind) do { if (TIME_KIND == (kind) || TIME_KIND == 99) { const unsigned long long t1_ = __builtin_amdgcn_s_memrealtime(); const unsigned long long dt_ = t1_ - t0_; while (__builtin_amdgcn_s_memrealtime() - t1_ < dt_) __builtin_amdgcn_s_sleep(8); } } while (0)
    unsigned char* ws = F.ws;
#define PHASE_ENTER() do { unsigned char* w_ = args.ws; asm volatile("" : "+s"(w_)); F.ws = w_; ws = w_; int t_ = threadIdx.x; asm volatile("" : "+v"(t_)); F.tid = t_; F.lane = t_ & 63; F.wave = __builtin_amdgcn_readfirstlane(t_ >> 6); } while (0)
    if (EN(0) && IN(0)) { PHASE_ENTER(); TSTART(0); REPS(0) { p_prologue(F); } SEAM(0); TSTALL(0); }
    for (int l = 0; l < DEPTH; ++l) {
        const int pb = 1 + l * NPH;
        if (EN(1) && IN(pb + 0)) { PHASE_ENTER(); TSTART(1); if (REP_KIND == 1) p_norm_mix(F, l, false, nullptr, true); p_norm_mix(F, l, false, nullptr); SEAM(pb + 0); TSTALL(1); }
        if (EN(2) && IN(pb + 1)) { PHASE_ENTER(); TSTART(2);
            REPS(2) {
            { pg8::DenseOrder S; S.init(T, NPROJ - 256, F.G, F.bid, ws + WS_HB, 1024, (bf16*)wl(ws, l, WL_IN) + (size_t)(NHT + 256) * 1024, 1024);
              EpiProj E{PROJ + 256};
              pg8::gemm_phase(F.lds, 1024, S, E); }
            { int z = 0; asm volatile("" : "+s"(z)); pg8::DenseOrder S; S.init(NHT, T, F.G, (F.bid + 64 + z) % F.G, wl(ws, l, WL_IN) + z, 1024, ws + WS_HB + z, 1024);
              EpiHT E{(bf16*)(ws + WS_HT)};
              pg8::gemm_phase(F.lds, 1024, S, E); }
            }
            SEAM(pb + 1); TSTALL(2);
        }
        if (EN(3) && IN(pb + 2)) { PHASE_ENTER(); TSTART(3); REPS(3) { p_mla_prep(F); } SEAM(pb + 2); TSTALL(3); }
        if (EN(4) && IN(pb + 3)) { PHASE_ENTER(); TSTART(4);
#ifndef SUBMASK
#define SUBMASK 7
#endif
            REPS(4) {
            if (SUBMASK & 1) { pg8::DenseOrder S; S.init(T, 768, F.G, F.bid, PROJ + PCQ, NPROJ, wl(ws, l, WL_Q), 384);
              EpiQ E{(bf16*)(ws + WS_Q), (const float*)(ws + WS_RSQ), (const float*)(ws + WS_COS), (const float*)(ws + WS_SIN)};
              pg8::gemm_phase(F.lds, 384, S, E); }
            if (SUBMASK & 2) { int z = 0; asm volatile("" : "+s"(z)); pg8::DenseOrder S; S.init(T, 512, F.G, (F.bid + 64 + z) % F.G, PROJ + PCKV + z, NPROJ, wl(ws, l, WL_K) + z, 256);
              EpiK E{(bf16*)(ws + WS_K), (const float*)(ws + WS_RSKV)};
              pg8::gemm_phase(F.lds, 256, S, E); }
            if (SUBMASK & 4) { int z = 0; asm volatile("" : "+s"(z)); pg8::DenseOrder S; S.init(512, T, F.G, (F.bid + 192 + z) % F.G, wl(ws, l, WL_V) + z, 256, PROJ + PCKV + z, NPROJ);
              EpiV E{(bf16*)(ws + WS_VT), (const float*)(ws + WS_RSKV)};
              pg8::gemm_phase(F.lds, 256, S, E); }
            }
            SEAM(pb + 3); TSTALL(4);
        }
        if (EN(5) && IN(pb + 4)) { PHASE_ENTER(); TSTART(5);
            REPS(5) {
            if (rep_ == 0 || (REP_SUB & 1)) for (int u = F.bid; u < 64 * SCAN_REP; u += F.G) scan_unit2(F, l, u & 63);
            if (rep_ == 0 || (REP_SUB & 2)) {
                unsigned* qctr = (unsigned*)(ws + WS_CTL) + CW_Q + (l * 2 + rep_) * 64; volatile LAS unsigned* misc = (volatile LAS unsigned*)(F.lds + MISC_OFF);
                attn_stream(F, qctr, misc);
                bool did_gemm = false;
                if (F.G < 128 || F.bid >= 64) for (;;) { __syncthreads(); if (F.tid == 0) misc[0] = __hip_atomic_fetch_add(qctr + 16, 1u, __ATOMIC_RELAXED, __HIP_MEMORY_SCOPE_AGENT); __syncthreads();
                    const int tk = (int)misc[0]; if (tk >= 64) break;
                    pg8::DenseOrder S; S.init(T, 256, 64, tk, ws + WS_HB, 1024, (bf16*)wl(ws, l, WL_IN) + (size_t)NHT * 1024, 1024);
                    EpiProj E{PROJ};
                    pg8::gemm_phase(F.lds, 1024, S, E); did_gemm = true; }
                if (CONV_Q > 0 && did_gemm && rep_ == 0) conv_moe_stream<(CONV_Q) / 2 + 2>(F, l, 1);
                if (CONV_Q > 0 && !did_gemm && F.G >= 128 && F.bid >= 64 && rep_ == 0) conv_moe_stream<(CONV_Q) / 3 + 1>(F, l, 1);
            }
            }
            SEAM(pb + 4); TSTALL(5);
        }
        if (EN(6) && IN(pb + 5)) { PHASE_ENTER(); TSTART(6); REPS(6) { p_hgrn_post(F, l); } SEAM(pb + 5); TSTALL(6); }
        if (EN(7) && IN(pb + 6)) { PHASE_ENTER(); TSTART(7);
            REPS(7) {
            { pg8::DenseOrder S; S.init(T, 1024, F.G, F.bid, ws + WS_HA, 1024, wl(ws, l, WL_OUT), 1024);
              EpiOut E{(bf16*)(ws + WS_Y), PROJ};
              pg8::gemm_phase(F.lds, 1024, S, E); }
            }
            SEAM(pb + 6); TSTALL(7);
        }
        if (EN(8) && IN(pb + 7)) { PHASE_ENTER(); TSTART(8);
            pg8::DenseOrder S; S.init(T, 1024, F.G, F.bid, ws + WS_Y, 1024, wl(ws, l, WL_O), 1024);
            if (REP_KIND == 8) { EpiWo E2{(bf16*)(ws + WS_ACT), (const float*)(ws + WS_MOD) + (size_t)l * 8 * 6144 + 2 * 1024}; pg8::gemm_phase(F.lds, 1024, S, E2); }
            EpiWo E{(bf16*)(ws + WS_X), (const float*)(ws + WS_MOD) + (size_t)l * 8 * 6144 + 2 * 1024};
            pg8::gemm_phase(F.lds, 1024, S, E);
            if (REP_KIND == 13) { for (int q = 0; q < 10; ++q) xcd_barrier(bar); }
            SEAM(pb + 7); TSTALL(8);
        }
        if (EN(9) && IN(pb + 8)) { PHASE_ENTER(); TSTART(9); conv_moe_stream<1>(F, l, 1 << 30); if (REP_KIND == 9) p_router(F, l, true); p_router(F, l); SEAM(pb + 8); TSTALL(9); }
        if (EN(10) && IN(pb + 9)) { PHASE_ENTER(); TSTART(10);
            moe_tables(F, l);
            pg8::MoeOrder<true> S; S.cnt = (const LAS int*)(F.lds + MOE_OFF); S.toff = S.cnt + 32; S.NT = 8; S.G = F.G; S.c = F.bid; S.Abase = (const char*)(ws + WS_HB); S.Bbase = (const char*)wl(ws, l, WL_GU);
            S.b_expert_bytes = (size_t)2048 * 1024 * 2; S.list = (const int*)(ws + WS_LIST); S.lda = 1024; S.ldb = 1024;
            EpiGU E{(bf16*)(ws + WS_ACT), F.in[20] + (size_t)l * 32 * 2048};
            REPS(10) { pg8::gemm_phase(F.lds, 1024, S, E); }
            if (CONV_Q > 0 && l + 1 < DEPTH) { const int ms = moe_missing(S.toff[NE], 8, F.G, F.bid); if (ms > 0) conv_moe_stream<(CONV_Q) / 2>(F, l + 1, ms); }
            SEAM(pb + 9); TSTALL(10);
        }
        if (EN(11) && IN(pb + 10)) { PHASE_ENTER(); TSTART(11);
            if (!(EN(10) && IN(pb + 9))) moe_tables(F, l);
            pg8::MoeOrder<false> S; S.cnt = (const LAS int*)(F.lds + MOE_OFF); S.toff = S.cnt + 32; S.NT = 4; S.G = F.G; S.c = F.bid; S.Abase = (const char*)(ws + WS_ACT); S.Bbase = (const char*)wl(ws, l, WL_DN);
            S.b_expert_bytes = (size_t)1024 * 1024 * 2; S.list = (const int*)(ws + WS_LIST); S.lda = 1024; S.ldb = 1024;
            EpiDown E{ws + WS_YR, F.in[22] + (size_t)l * 32 * 1024, (const int*)(ws + WS_LIST), (const float*)(ws + WS_LW)};
            REPS(11) { pg8::gemm_phase(F.lds, 1024, S, E); }
            if (CONV_Q > 0 && l + 1 < DEPTH) { const int ms = moe_missing(S.toff[NE], 4, F.G, F.bid); if (ms > 0) conv_moe_stream<(CONV_Q) / 2>(F, l + 1, ms); }
            SEAM(pb + 10); TSTALL(11);
        }
    }
    if (EN(12) && IN(PH_FINAL)) { PHASE_ENTER(); p_norm_final(F, args.out); }
    if (TIME_KIND == 97 && F.bid == (TIME_BLOCK)) { const unsigned long long t1_ = __builtin_amdgcn_s_memrealtime(); while (__builtin_amdgcn_s_memrealtime() - t1_ < tbar_) __builtin_amdgcn_s_sleep(8); }
    if (TIME_KIND == 98 && F.bid == 0) { const unsigned long long t1_ = __builtin_amdgcn_s_memrealtime(); const unsigned long long dt_ = t1_ - tk0_; while (__builtin_amdgcn_s_memrealtime() - t1_ < dt_) __builtin_amdgcn_s_sleep(8); }
#undef IN
#undef SEAM
#undef PROJ
#undef PHASE_ENTER
}

extern "C" void kernel_launch(void* const* d_in, const int* in_sizes, int n_in, void* d_out, int out_size, void* d_ws, size_t ws_size, hipStream_t stream) {
    static int grid = 0;
    if (grid == 0) {
        if (n_in != 24 || in_sizes[0] != T * D || out_size != T * D || ws_size < WS_END) { fprintf(stderr, "kernel_launch: unexpected problem (n_in %d, in0 %d, out %d, ws %zu, need %zu)\n", n_in, n_in > 0 ? in_sizes[0] : -1, out_size, ws_size, (size_t)WS_END); grid = -1; return; }
        int dev = 0, cus = 0, per_cu = 0;
        if (hipGetDevice(&dev) != hipSuccess || hipDeviceGetAttribute(&cus, hipDeviceAttributeMultiprocessorCount, dev) != hipSuccess) { grid = -1; return; }
        if (hipFuncSetAttribute((const void*)fwd_kernel, hipFuncAttributeMaxDynamicSharedMemorySize, LDS_BYTES) != hipSuccess) { fprintf(stderr, "kernel_launch: hipFuncSetAttribute failed\n"); grid = -1; return; }
        if (hipOccupancyMaxActiveBlocksPerMultiprocessor(&per_cu, (const void*)fwd_kernel, NWAVES * 64, LDS_BYTES) != hipSuccess || per_cu < 1) { fprintf(stderr, "kernel_launch: occupancy query says %d\n", per_cu); (void)hipGetLastError(); }
        grid = cus - (cus % 8);
        if (grid < 64) { fprintf(stderr, "kernel_launch: only %d CUs\n", cus); grid = -1; return; }
    }
    if (grid < 0) return;
    if (hipMemsetAsync((char*)d_ws + WS_CTL, 0, CTL_ZERO_BYTES, stream) != hipSuccess) return;
    Args a{};
    for (int i = 0; i < 24; ++i) a.in[i] = (const float*)d_in[i];
    a.out = (float*)d_out; a.ws = (unsigned char*)d_ws;
#if MK_PER_PHASE
    for (int ph = 0; ph < PH_TOTAL; ++ph) { a.ph_lo = ph; a.ph_hi = ph + 1; hipLaunchKernelGGL(fwd_kernel, dim3(grid), dim3(NWAVES * 64), LDS_BYTES, stream, a); }
#else
    a.ph_lo = 0; a.ph_hi = PH_TOTAL; hipLaunchKernelGGL(fwd_kernel, dim3(grid), dim3(NWAVES * 64), LDS_BYTES, stream, a);
#endif
}
```
